# Optimizing an MI355X kernel written in HIP

```python
import math
import jax, jax.numpy as jnp
from jax import lax
import numpy as np

D_MODEL = 1024
BATCH = 2
SEQ = 8192
DEPTH = 1

SSD_HEADS = 16
SSD_HEAD_DIM = 64
SSD_INNER = SSD_HEADS * SSD_HEAD_DIM
SSD_GROUPS = 2
SSD_STATE = 128
SSD_CONV = 4
SSD_CHUNK = 128
SSD_XBC = SSD_INNER + 2 * SSD_GROUPS * SSD_STATE
ATTN_HEADS = 8
ATTN_QK_DIM = 64
ATTN_V_DIM = 2 * ATTN_QK_DIM
ATTN_QK_WIDTH = ATTN_HEADS * 2 * ATTN_QK_DIM
ATTN_INNER = ATTN_HEADS * ATTN_V_DIM
Q_BLOCK = 128
MIX_WIDTH = SSD_INNER + ATTN_INNER
IN_WIDTH = SSD_INNER + SSD_XBC + SSD_HEADS + 2 * ATTN_QK_WIDTH + ATTN_INNER
REL_BUCKETS = 32
REL_MAX_DIST = 128
D_FF = 2816
N_MOD = 9
EPS = 1e-6

kernel_name = "hymba_ssd_diffattn_macaron_layer"


def rmsnorm(x, g):
    xf = x.astype(jnp.float32)
    y = xf * lax.rsqrt(jnp.mean(xf * xf, axis=-1, keepdims=True) + EPS)
    return (y * g.astype(jnp.float32)).astype(x.dtype)


def swiglu(h, w_gate, w_up, w_down):
    return (jax.nn.silu(h @ w_gate) * (h @ w_up)) @ w_down


def causal_dwconv(u, w, b):
    k_w, ch = w.shape
    out = lax.conv_general_dilated(
        u, w[:, None, :].astype(u.dtype), window_strides=(1,), padding=[(k_w - 1, 0)],
        dimension_numbers=('NWC', 'WIO', 'NWC'), feature_group_count=ch)
    return out + b


def ssd_chunked(xs, dt, a, bm, cm):
    bsz, s, h, p = xs.shape
    g, n = bm.shape[2], bm.shape[3]
    e = h // g
    q = SSD_CHUNK
    nc = s // q
    x = xs.reshape(bsz, nc, q, g, e, p)
    dtc = dt.reshape(bsz, nc, q, g, e)
    bc = bm.reshape(bsz, nc, q, g, n)
    cc = cm.reshape(bsz, nc, q, g, n)
    a_cum = jnp.cumsum(dtc * a.reshape(g, e), axis=2)
    seg = a_cum[:, :, :, None] - a_cum[:, :, None, :]
    causal = jnp.tril(jnp.ones((q, q), dtype=bool))[:, :, None, None]
    decay_in = jnp.exp(jnp.where(causal, seg, -jnp.inf))
    xdt = x * dtc[..., None]
    cb = jnp.einsum('bcign,bcjgn->bcijg', cc, bc)
    y_diag = jnp.einsum('bcijg,bcijge,bcjgep->bcigep', cb, decay_in, xdt)
    decay_to_end = jnp.exp(a_cum[:, :, -1:] - a_cum)
    states = jnp.einsum('bcjgn,bcjge,bcjgep->bcgepn', bc, decay_to_end, xdt)
    chunk_decay = jnp.exp(a_cum[:, :, -1])

    def step(hs, inp):
        st, dec = inp
        return hs * dec[..., None, None] + st, hs

    h0 = jnp.zeros((bsz, g, e, p, n), states.dtype)
    _, h_in = lax.scan(step, h0, (jnp.moveaxis(states, 1, 0), jnp.moveaxis(chunk_decay, 1, 0)))
    h_in = jnp.moveaxis(h_in, 0, 1)
    y_off = jnp.einsum('bcign,bcgepn,bcige->bcigep', cc, h_in, jnp.exp(a_cum))
    return (y_diag + y_off).reshape(bsz, s, h, p)


def t5_bucket(rel):
    n = jnp.maximum(rel, 0)
    max_exact = REL_BUCKETS // 2
    nf = jnp.maximum(n, 1).astype(jnp.float32)
    large = max_exact + (jnp.log(nf / max_exact) / math.log(REL_MAX_DIST / max_exact)
                         * (REL_BUCKETS - max_exact)).astype(jnp.int32)
    large = jnp.minimum(large, REL_BUCKETS - 1)
    return jnp.where(n < max_exact, n, large)


def diff_attention(q1, q2, k1, k2, v, lam, rel_bias):
    bsz, h, s, dq = q1.shape
    dv = v.shape[-1]
    nb = s // Q_BLOCK
    scale = dq ** -0.5
    kpos = jnp.arange(s)

    def blocks(t):
        return jnp.moveaxis(t.reshape(bsz, h, nb, Q_BLOCK, dq), 2, 0)

    def one_block(args):
        qb1, qb2, start = args
        qpos = start + jnp.arange(Q_BLOCK)
        rel = qpos[:, None] - kpos[None, :]
        bias = jnp.transpose(rel_bias[t5_bucket(rel)], (2, 0, 1)).astype(jnp.float32)
        mask = rel >= 0

        def probs(qb, kk):
            logits = jnp.einsum('bhqd,bhkd->bhqk', qb, kk).astype(jnp.float32) * scale + bias
            return jax.nn.softmax(jnp.where(mask, logits, -jnp.inf), axis=-1)

        attn = probs(qb1, k1) - lam * probs(qb2, k2)
        return jnp.einsum('bhqk,bhkv->bhqv', attn.astype(v.dtype), v)

    starts = jnp.arange(nb) * Q_BLOCK
    out = lax.map(one_block, (blocks(q1), blocks(q2), starts))
    return jnp.moveaxis(out, 0, 2).reshape(bsz, h, s, dv)


def token_mix(h, layer_idx, w_in, conv_w, conv_b, dt_bias, a_log, d_skip, ssd_norm_g,
              lambda_q1, lambda_k1, lambda_q2, lambda_k2, subln_g, rel_bias, w_out):
    bsz, s, _ = h.shape
    sizes = [SSD_INNER, SSD_XBC, SSD_HEADS, ATTN_QK_WIDTH, ATTN_QK_WIDTH, ATTN_INNER]
    splits = [int(v) for v in np.cumsum(sizes)[:-1]]
    proj = h @ w_in
    z, xbc, dt_raw, q, k, v = jnp.split(proj, splits, axis=-1)

    xbc = jax.nn.silu(causal_dwconv(xbc, conv_w, conv_b))
    xs, bm, cm = jnp.split(xbc, [SSD_INNER, SSD_INNER + SSD_GROUPS * SSD_STATE], axis=-1)
    xs4 = xs.reshape(bsz, s, SSD_HEADS, SSD_HEAD_DIM)
    dt = jax.nn.softplus(dt_raw.astype(jnp.float32) + dt_bias.astype(jnp.float32))
    a = -jnp.exp(a_log.astype(jnp.float32))
    y = ssd_chunked(xs4, dt, a,
                    bm.reshape(bsz, s, SSD_GROUPS, SSD_STATE),
                    cm.reshape(bsz, s, SSD_GROUPS, SSD_STATE))
    y = y + d_skip[:, None] * xs4
    y = y.reshape(bsz, s, SSD_INNER) * jax.nn.silu(z)
    y = rmsnorm(y.reshape(bsz, s, SSD_GROUPS, SSD_INNER // SSD_GROUPS),
                ssd_norm_g.reshape(SSD_GROUPS, SSD_INNER // SSD_GROUPS))
    y_ssd = y.reshape(bsz, s, SSD_INNER).astype(h.dtype)

    qh = q.reshape(bsz, s, ATTN_HEADS, 2, ATTN_QK_DIM)
    kh = k.reshape(bsz, s, ATTN_HEADS, 2, ATTN_QK_DIM)
    q1 = jnp.transpose(qh[:, :, :, 0], (0, 2, 1, 3))
    q2 = jnp.transpose(qh[:, :, :, 1], (0, 2, 1, 3))
    k1 = jnp.transpose(kh[:, :, :, 0], (0, 2, 1, 3))
    k2 = jnp.transpose(kh[:, :, :, 1], (0, 2, 1, 3))
    vh = jnp.transpose(v.reshape(bsz, s, ATTN_HEADS, ATTN_V_DIM), (0, 2, 1, 3))
    lam_init = 0.8 - 0.6 * math.exp(-0.3 * layer_idx)
    lam = (jnp.exp(jnp.sum(lambda_q1.astype(jnp.float32) * lambda_k1.astype(jnp.float32)))
           - jnp.exp(jnp.sum(lambda_q2.astype(jnp.float32) * lambda_k2.astype(jnp.float32)))
           + lam_init)
    o = diff_attention(q1, q2, k1, k2, vh, lam, rel_bias)
    o = rmsnorm(o, subln_g) * (1.0 - lam_init)
    y_attn = jnp.transpose(o, (0, 2, 1, 3)).reshape(bsz, s, ATTN_INNER).astype(h.dtype)

    return jnp.concatenate([y_ssd, y_attn], axis=-1) @ w_out


def setup_inputs(seed: int = 0) -> dict:
    key = jax.random.key(seed)
    ks = iter(jax.random.split(key, 40))

    def nrm(shape, scale):
        return jax.random.normal(next(ks), shape, jnp.float32) * scale

    def gain(shape):
        return 1.0 + nrm(shape, 0.02)

    L = DEPTH
    d = D_MODEL
    dt0 = jnp.exp(jax.random.uniform(next(ks), (L, SSD_HEADS)) * (math.log(0.1) - math.log(0.001))
                  + math.log(0.001))
    dt_bias = dt0 + jnp.log(-jnp.expm1(-dt0))
    a_log = jnp.log(jax.random.uniform(next(ks), (L, SSD_HEADS), minval=1.0, maxval=16.0))
    return {
        "x": nrm((BATCH, SEQ, d), 1.0),
        "c": nrm((BATCH, d), 1.0),
        "w_ada": nrm((L, d, N_MOD * d), 0.5 * d ** -0.5),
        "b_ada": nrm((L, N_MOD * d), 0.01),
        "ffn1_pre_g": gain((L, d)),
        "ffn1_post_g": gain((L, d)),
        "ffn1_w_gate": nrm((L, d, D_FF), d ** -0.5),
        "ffn1_w_up": nrm((L, d, D_FF), d ** -0.5),
        "ffn1_w_down": nrm((L, D_FF, d), D_FF ** -0.5),
        "mix_pre_g": gain((L, d)),
        "mix_post_g": gain((L, d)),
        "w_in": nrm((L, d, IN_WIDTH), d ** -0.5),
        "conv_w": nrm((L, SSD_CONV, SSD_XBC), SSD_CONV ** -0.5),
        "conv_b": nrm((L, SSD_XBC), 0.01),
        "dt_bias": dt_bias,
        "a_log": a_log,
        "d_skip": gain((L, SSD_HEADS)),
        "ssd_norm_g": gain((L, SSD_INNER)),
        "lambda_q1": nrm((L, ATTN_QK_DIM), 0.1),
        "lambda_k1": nrm((L, ATTN_QK_DIM), 0.1),
        "lambda_q2": nrm((L, ATTN_QK_DIM), 0.1),
        "lambda_k2": nrm((L, ATTN_QK_DIM), 0.1),
        "subln_g": gain((L, ATTN_V_DIM)),
        "w_out": nrm((L, MIX_WIDTH, d), MIX_WIDTH ** -0.5),
        "ffn2_pre_g": gain((L, d)),
        "ffn2_post_g": gain((L, d)),
        "ffn2_w_gate": nrm((L, d, D_FF), d ** -0.5),
        "ffn2_w_up": nrm((L, d, D_FF), d ** -0.5),
        "ffn2_w_down": nrm((L, D_FF, d), D_FF ** -0.5),
        "rel_bias": nrm((REL_BUCKETS, ATTN_HEADS), 0.5),
    }


def reference(x, c, w_ada, b_ada, ffn1_pre_g, ffn1_post_g, ffn1_w_gate, ffn1_w_up, ffn1_w_down,
              mix_pre_g, mix_post_g, w_in, conv_w, conv_b, dt_bias, a_log, d_skip, ssd_norm_g,
              lambda_q1, lambda_k1, lambda_q2, lambda_k2, subln_g, w_out,
              ffn2_pre_g, ffn2_post_g, ffn2_w_gate, ffn2_w_up, ffn2_w_down, rel_bias):
    cs = jax.nn.silu(c)
    for l in range(DEPTH):
        mod = (cs @ w_ada[l] + b_ada[l])[:, None, :]
        s1, sc1, g1, s2, sc2, g2, s3, sc3, g3 = jnp.split(mod, N_MOD, axis=-1)

        h = rmsnorm(x, ffn1_pre_g[l]) * (1.0 + sc1) + s1
        x = x + 0.5 * g1 * rmsnorm(swiglu(h, ffn1_w_gate[l], ffn1_w_up[l], ffn1_w_down[l]), ffn1_post_g[l])

        h = rmsnorm(x, mix_pre_g[l]) * (1.0 + sc2) + s2
        m = token_mix(h, l, w_in[l], conv_w[l], conv_b[l], dt_bias[l], a_log[l], d_skip[l],
                      ssd_norm_g[l], lambda_q1[l], lambda_k1[l], lambda_q2[l], lambda_k2[l],
                      subln_g[l], rel_bias, w_out[l])
        x = x + g2 * rmsnorm(m, mix_post_g[l])

        h = rmsnorm(x, ffn2_pre_g[l]) * (1.0 + sc3) + s3
        x = x + 0.5 * g3 * rmsnorm(swiglu(h, ffn2_w_gate[l], ffn2_w_up[l], ffn2_w_down[l]), ffn2_post_g[l])
    return x
```

```cpp
#include <hip/hip_runtime.h>
#include <hip/hip_cooperative_groups.h>
#include <hip/hip_bf16.h>
#include <cstdio>
#include <cstdint>
#include <cmath>
namespace cg = cooperative_groups;
namespace pg8 {
#define PG8_LAS __attribute__((address_space(3)))
typedef unsigned short bf16_t;
typedef short bf16x8 __attribute__((ext_vector_type(8)));
typedef float f32x4 __attribute__((ext_vector_type(4)));
typedef unsigned u32x4 __attribute__((ext_vector_type(4)));
constexpr int BM = 256, BK = 64, HALF = 128, HTB = HALF * BK * 2  , STAGE_BYTES = 8 * HTB, NXCD = 8, WGM = 8;

__host__ __device__ __forceinline__ int lds_byte(int r, int c) { const int st = (r >> 4) * 2 + (c >> 5), rr = r & 15, cc = c & 31, ob = rr * 64 + cc * 2; return st * 1024 + (ob ^ (((ob >> 9) & 1) << 5)); }
__host__ __device__ __forceinline__ void stage_rc(int b, int& R, int& C) { const int st = b / 1024, sb = b % 1024, swz = sb ^ (((sb >> 9) & 1) << 5); R = (st >> 1) * 16 + swz / 64; C = (st & 1) * 32 + (swz % 64) / 2; }
__host__ __device__ __forceinline__ int perm32(int rho) { const int n = rho >> 4, i = rho & 15; return 8 * (i >> 2) + 4 * n + (i & 3); }

struct Unit { int pm, pn; };
struct Gemm { const bf16_t* A; const bf16_t* Bt; int M, N, K; };

struct StaticOrder {
    int nM, nN, nwg, G, c;
    __host__ __device__ void init(int M, int N, int G_, int c_) { nM = M / BM; nN = N / BM; nwg = nM * nN; G = G_; c = c_; }
    __host__ __device__ bool next(int i, Unit& u) const {
        const long L = (long)i * G + c; if (L >= nwg) return false;
        int wgid = (int)L; { const int q = nwg / NXCD, r = nwg % NXCD, xcd = wgid % NXCD, off = wgid / NXCD; wgid = (xcd < r ? xcd * (q + 1) : r * (q + 1) + (xcd - r) * q) + off; }
        const int nig = WGM * nN, gid = wgid / nig, fm = gid * WGM, gsz = (nM - fm) < WGM ? (nM - fm) : WGM;
        u.pm = fm + ((wgid % nig) % gsz); u.pn = (wgid % nig) / gsz; return true;
    }
    __device__ __forceinline__ void a_ready(const Unit&) const {}
    __device__ __forceinline__ void done(const Unit&) const {}
};

__device__ __forceinline__ unsigned cvt_pk_bf16(float lo, float hi) { unsigned r; asm volatile("v_cvt_pk_bf16_f32 %0, %1, %2" : "=v"(r) : "v"(lo), "v"(hi)); return r; }
typedef float f32x2 __attribute__((ext_vector_type(2)));
__device__ __forceinline__ f32x2 gelu_pk(f32x2 v) {
    const f32x2 av = __builtin_elementwise_abs(v), d = av * 0.2316418882f + 1.0f;
    f32x2 t; t.x = __builtin_amdgcn_rcpf(d.x); t.y = __builtin_amdgcn_rcpf(d.y);
    f32x2 q = t * 0.5307027145f + (-0.7265760135f); q = q * t + 0.7107068705f; q = q * t + (-0.142248368f); q = q * t + 0.127414796f; q = q * t;
    const f32x2 s = (v * v) * (-0.72134752044f);
    f32x2 e; e.x = __builtin_amdgcn_exp2f(s.x); e.y = __builtin_amdgcn_exp2f(s.y);
    const f32x2 m = v * (q * e), r = v - m;
    f32x2 o; o.x = v.x < 0.f ? m.x : r.x; o.y = v.y < 0.f ? m.y : r.y; return o;
}

template <int ACT  > struct EpiBf16 {
    static constexpr bool PERM = true, AFTER_DRAIN = false; static_assert(ACT == 0 || ACT == 1, "EpiBf16: ACT is 0 (none) or 1 (gelu_pk)");
    bf16_t* O; int ldc; const float* bias; int split_cols; size_t split_stride; float scale0;
    __device__ __forceinline__ void operator()(const f32x4 (&acc)[2][2][4][2], const Unit& u, int wr, int wc, int fr, int fq) const {
        const int row0 = u.pm * BM + wr * 64 + fr; int colt = u.pn * BM; bf16_t* base = O;
        float sc = 1.f; if (split_cols) { const int t = colt / split_cols; base += (size_t)t * split_stride; colt -= t * split_cols; if (t == 0) sc = scale0; }
        const int col0 = colt + wc * 32 + 8 * fq, bcol0 = u.pn * BM + wc * 32 + 8 * fq;
        f32x4 bv[2][2];
#pragma unroll
        for (int bj = 0; bj < 2; ++bj)
#pragma unroll
            for (int n = 0; n < 2; ++n) bv[bj][n] = bias ? *(const f32x4*)(bias + bcol0 + bj * HALF + 4 * n) : (f32x4){0.f, 0.f, 0.f, 0.f};
#pragma unroll
        for (int ai = 0; ai < 2; ++ai)
#pragma unroll
            for (int m = 0; m < 4; ++m) { bf16_t* rowp = base + (size_t)(row0 + ai * HALF + m * 16) * ldc + col0;
#pragma unroll
                for (int bj = 0; bj < 2; ++bj) { f32x4 v0 = acc[ai][bj][m][0] + bv[bj][0], v1 = acc[ai][bj][m][1] + bv[bj][1];
                    if (ACT == 1) { f32x2 a = gelu_pk((f32x2){v0[0], v0[1]}), b = gelu_pk((f32x2){v0[2], v0[3]}), c = gelu_pk((f32x2){v1[0], v1[1]}), d = gelu_pk((f32x2){v1[2], v1[3]});
                        v0 = (f32x4){a.x, a.y, b.x, b.y}; v1 = (f32x4){c.x, c.y, d.x, d.y}; }
                    v0 = v0 * sc; v1 = v1 * sc; u32x4 w; w.x = cvt_pk_bf16(v0[0], v0[1]); w.y = cvt_pk_bf16(v0[2], v0[3]); w.z = cvt_pk_bf16(v1[0], v1[1]); w.w = cvt_pk_bf16(v1[2], v1[3]);
                    *(u32x4*)(rowp + bj * HALF) = w; } }
    }
};

struct PanelStats {
    unsigned* xbuf;
    unsigned* cnt;
    unsigned* tmo;
    int ntn; float eps;
    unsigned code;
    __device__ __forceinline__ bool run(const f32x4 (&v)[2][2][4][2], const Unit& u, int wr, int wc, int fr, int fq, PG8_LAS unsigned char* lds, int wid, int lane) const {
        typedef float f32x2v __attribute__((ext_vector_type(2)));
        PG8_LAS f32x2v* P = (PG8_LAS f32x2v*)lds;
        PG8_LAS f32x2v* S = (PG8_LAS f32x2v*)(lds + 8192);
        PG8_LAS unsigned* flag = (PG8_LAS unsigned*)(lds + 8192 + 2048);
#pragma unroll
        for (int ai = 0; ai < 2; ++ai)
#pragma unroll
            for (int m = 0; m < 4; ++m) {
                float s = 0.f;
#pragma unroll
                for (int bj = 0; bj < 2; ++bj)
#pragma unroll
                    for (int n = 0; n < 2; ++n) { const f32x4 x = v[ai][bj][m][n]; s += (x[0] + x[1]) + (x[2] + x[3]); }
                s += __shfl_xor(s, 16); s += __shfl_xor(s, 32);
                const float mw = s * (1.0f / 64.0f); float q = 0.f;
#pragma unroll
                for (int bj = 0; bj < 2; ++bj)
#pragma unroll
                    for (int n = 0; n < 2; ++n) { const f32x4 d = v[ai][bj][m][n] - mw; q += (d[0] * d[0] + d[1] * d[1]) + (d[2] * d[2] + d[3] * d[3]); }
                q += __shfl_xor(q, 16); q += __shfl_xor(q, 32);
                if (fq == 0) P[(ai * HALF + wr * 64 + m * 16 + fr) * 4 + wc] = (f32x2v){mw, q};
            }
        asm volatile("s_waitcnt lgkmcnt(0)" ::: "memory"); __builtin_amdgcn_s_barrier(); asm volatile("" ::: "memory");
#if defined(BROKEN_EXCHANGE_NO_WAIT)
#warning BROKEN CONTROL BUILD: the row-statistics exchange does not wait; results are wrong by design
        if (blockIdx.x >= 64) { const long long t0_ = clock64(); while (clock64() - t0_ < 60000) __builtin_amdgcn_s_sleep(8); }
#endif
        const int row = wid * 32 + (lane & 31);
        if (lane < 32) {
            const f32x2v a = P[row * 4 + 0], b = P[row * 4 + 1], c = P[row * 4 + 2], d = P[row * 4 + 3];
            const float mt = (a.x + b.x + c.x + d.x) * 0.25f;
            const float da = a.x - mt, db = b.x - mt, dc = c.x - mt, dd = d.x - mt;
            const float m2 = (a.y + b.y) + (c.y + d.y) + 64.0f * ((da * da + db * db) + (dc * dc + dd * dd));
            unsigned long long* slot = (unsigned long long*)xbuf + ((size_t)(u.pm * BM + row) * 4 + u.pn);
            __hip_atomic_store(slot, ((unsigned long long)__float_as_uint(m2) << 32) | __float_as_uint(mt), __ATOMIC_RELAXED, __HIP_MEMORY_SCOPE_AGENT);
        }
        asm volatile("s_waitcnt vmcnt(0)" ::: "memory");
        if (lane == 0) __hip_atomic_fetch_add(cnt + 64 * u.pm, 1u, __ATOMIC_RELAXED, __HIP_MEMORY_SCOPE_AGENT);
        if (wid == 0) {
            bool dead = false; const unsigned long long t0 = __builtin_amdgcn_s_memrealtime(); const unsigned want = 8u * (unsigned)ntn;
            for (;;) {
#if defined(BROKEN_EXCHANGE_NO_WAIT)
                break;
#endif
                if ((unsigned)__builtin_amdgcn_readfirstlane(__hip_atomic_load(cnt + 64 * u.pm, __ATOMIC_RELAXED, __HIP_MEMORY_SCOPE_AGENT)) >= want) break;
                if (__builtin_amdgcn_s_memrealtime() - t0 > 2000000ull) {
                    if (lane == 0) { unsigned expect = 0u; __hip_atomic_compare_exchange_strong(tmo + 1, &expect, code | (unsigned)(u.pm & 0xff), __ATOMIC_RELAXED, __ATOMIC_RELAXED, __HIP_MEMORY_SCOPE_AGENT);
                                     __hip_atomic_store(tmo, 1u, __ATOMIC_RELAXED, __HIP_MEMORY_SCOPE_AGENT); }
                    dead = true; break; }
                __builtin_amdgcn_s_sleep(2);
            }
            __builtin_amdgcn_fence(__ATOMIC_ACQUIRE, "agent");
            if (lane == 0) flag[0] = dead ? 1u : 0u;
        }
        asm volatile("s_waitcnt vmcnt(0) lgkmcnt(0)" ::: "memory"); __builtin_amdgcn_s_barrier(); asm volatile("" ::: "memory");
        const bool bad = flag[0] != 0u;
        if (lane < 32) {
            const unsigned long long* slot = (const unsigned long long*)xbuf + (size_t)(u.pm * BM + row) * 4; float mt[4], m2[4]; float ms = 0.f;
#pragma unroll
            for (int t = 0; t < 4; ++t) { if (t < ntn) { const unsigned long long w = __hip_atomic_load(slot + t, __ATOMIC_RELAXED, __HIP_MEMORY_SCOPE_AGENT); mt[t] = __uint_as_float((unsigned)w); m2[t] = __uint_as_float((unsigned)(w >> 32)); } else { mt[t] = 0.f; m2[t] = 0.f; } ms += mt[t]; }
            const float mean = ms / (float)ntn; float q = 0.f;
#pragma unroll
            for (int t = 0; t < 4; ++t) if (t < ntn) { const float dm = mt[t] - mean; q += m2[t] + 256.0f * dm * dm; }
            S[row] = (f32x2v){mean, 1.0f / sqrtf(q / (256.0f * (float)ntn) + eps)};
        }
        asm volatile("s_waitcnt lgkmcnt(0)" ::: "memory"); __builtin_amdgcn_s_barrier(); asm volatile("" ::: "memory");
        return bad;
    }
};
struct EpiLnRes {
    static constexpr bool PERM = false, AFTER_DRAIN = true;
    const float* base; float* out; int ldc; const float* bias; PanelStats st; unsigned poison;
    __device__ __forceinline__ void fused(f32x4 (&acc)[2][2][4][2], const Unit& u, int wr, int wc, int fr, int fq, PG8_LAS unsigned char* lds, int wid, int lane) const {
        typedef float f32x2v __attribute__((ext_vector_type(2)));
        const PG8_LAS f32x2v* S = (const PG8_LAS f32x2v*)(lds + 8192);
        const int col0 = u.pn * BM + wc * 32 + 4 * fq;
#pragma unroll
        for (int bj = 0; bj < 2; ++bj)
#pragma unroll
            for (int n = 0; n < 2; ++n) { const f32x4 bv = bias ? *(const f32x4*)(bias + col0 + bj * HALF + n * 16) : (f32x4){0.f, 0.f, 0.f, 0.f};
#pragma unroll
                for (int ai = 0; ai < 2; ++ai)
#pragma unroll
                    for (int m = 0; m < 4; ++m) acc[ai][bj][m][n] += bv; }
        f32x4 pre[4][2][2];
#pragma unroll
        for (int m = 0; m < 4; ++m) { const size_t off = (size_t)(u.pm * BM + wr * 64 + m * 16 + fr) * ldc + col0;
#pragma unroll
            for (int bj = 0; bj < 2; ++bj)
#pragma unroll
                for (int n = 0; n < 2; ++n) pre[m][bj][n] = *(const f32x4*)(base + off + bj * HALF + n * 16); }
        const bool bad = st.run(acc, u, wr, wc, fr, fq, lds, wid, lane) || poison != 0u;
        const float qnan = __builtin_nanf("");
#pragma unroll
        for (int ai = 0; ai < 2; ++ai)
#pragma unroll
            for (int m = 0; m < 4; ++m) { const int r = ai * HALF + wr * 64 + m * 16 + fr; const f32x2v sr = S[r]; const size_t off = (size_t)(u.pm * BM + r) * ldc + col0;
#pragma unroll
                for (int bj = 0; bj < 2; ++bj)
#pragma unroll
                    for (int n = 0; n < 2; ++n) { const f32x4 bs = ai == 0 ? pre[m][bj][n] : *(const f32x4*)(base + off + bj * HALF + n * 16); f32x4 o = bs + (acc[ai][bj][m][n] - sr.x) * sr.y;
                        if (bad) o = (f32x4){qnan, qnan, qnan, qnan}; *(f32x4*)(out + off + bj * HALF + n * 16) = o; }
                if (m & 1) asm volatile("" ::: "memory"); }
    }
};
struct EpiLnResLn {
    static constexpr bool PERM = false, AFTER_DRAIN = true;
    const float* base; float* out; bf16_t* xn; int ldc; const float* bias; PanelStats st1, st2; unsigned poison;
    __device__ __forceinline__ void fused(f32x4 (&acc)[2][2][4][2], const Unit& u, int wr, int wc, int fr, int fq, PG8_LAS unsigned char* lds, int wid, int lane) const {
        typedef float f32x2v __attribute__((ext_vector_type(2))); typedef unsigned u32x2v __attribute__((ext_vector_type(2)));
        const PG8_LAS f32x2v* S = (const PG8_LAS f32x2v*)(lds + 8192);
        const int col0 = u.pn * BM + wc * 32 + 4 * fq;
#pragma unroll
        for (int bj = 0; bj < 2; ++bj)
#pragma unroll
            for (int n = 0; n < 2; ++n) { const f32x4 bv = bias ? *(const f32x4*)(bias + col0 + bj * HALF + n * 16) : (f32x4){0.f, 0.f, 0.f, 0.f};
#pragma unroll
                for (int ai = 0; ai < 2; ++ai)
#pragma unroll
                    for (int m = 0; m < 4; ++m) acc[ai][bj][m][n] += bv; }
        bool bad = st1.run(acc, u, wr, wc, fr, fq, lds, wid, lane) || poison != 0u;
        const float qnan = __builtin_nanf("");
#pragma unroll
        for (int ai = 0; ai < 2; ++ai)
#pragma unroll
            for (int m = 0; m < 4; ++m) { const int r = ai * HALF + wr * 64 + m * 16 + fr; const f32x2v sr = S[r]; const size_t off = (size_t)(u.pm * BM + r) * ldc + col0;
#pragma unroll
                for (int bj = 0; bj < 2; ++bj)
#pragma unroll
                    for (int n = 0; n < 2; ++n) { const f32x4 bs = *(const f32x4*)(base + off + bj * HALF + n * 16); acc[ai][bj][m][n] = bs + (acc[ai][bj][m][n] - sr.x) * sr.y; }
                asm volatile("" : "+v"(acc[ai][0][m][0]), "+v"(acc[ai][0][m][1]), "+v"(acc[ai][1][m][0]), "+v"(acc[ai][1][m][1]));
                if (m & 1) asm volatile("" ::: "memory"); }
        const bool bad1 = bad;
        bad = st2.run(acc, u, wr, wc, fr, fq, lds, wid, lane) || bad;
#pragma unroll
        for (int ai = 0; ai < 2; ++ai)
#pragma unroll
            for (int m = 0; m < 4; ++m) { const int r = ai * HALF + wr * 64 + m * 16 + fr; const f32x2v sr = S[r]; const size_t off = (size_t)(u.pm * BM + r) * ldc + col0;
#pragma unroll
                for (int bj = 0; bj < 2; ++bj)
#pragma unroll
                    for (int n = 0; n < 2; ++n) { const f32x4 x1 = acc[ai][bj][m][n]; *(f32x4*)(out + off + bj * HALF + n * 16) = bad1 ? (f32x4){qnan, qnan, qnan, qnan} : x1;
                        const f32x4 o = (x1 - sr.x) * sr.y; u32x2v w; w.x = cvt_pk_bf16(o[0], o[1]); w.y = cvt_pk_bf16(o[2], o[3]);
                        if (bad) { w.x = 0x7fc07fc0u; w.y = 0x7fc07fc0u; } *(u32x2v*)(xn + off + bj * HALF + n * 16) = w; }
                asm volatile("" ::: "memory"); }
    }
};

template <class Epi, class Sched, bool ALIGN_EPI = false, bool SP2 = false>
__device__ __forceinline__ void gemm_phase(PG8_LAS unsigned char* lds, const Gemm g, const Sched& S, const Epi& E) {
    const int tid = threadIdx.x, wid = __builtin_amdgcn_readfirstlane(tid >> 6), lane = tid & 63, wr = wid >> 2, wc = wid & 3, fr = lane & 15, fq = lane >> 4;
    const int K = g.K, nt = K / BK;
    unsigned voffA[2], voffB[2];
#pragma unroll
    for (int i = 0; i < 2; ++i) { int R, C; stage_rc(tid * 16 + i * 8192, R, C); const int Rb = Epi::PERM ? ((R & ~31) + perm32(R & 31)) : R;
        voffA[i] = (unsigned)(R * K + C) * 2u; voffB[i] = (unsigned)(Rb * K + C) * 2u; }
    const size_t kstep = (size_t)(BK * 2);
    const size_t hstep = (size_t)HALF * K * 2;
    const size_t tstep = 2 * hstep;
    const unsigned ldsw = (unsigned)wid * 1024u;
    const int aoff = lds_byte(wr * 64 + fr, fq * 8), boff = lds_byte(wc * 32 + fr, fq * 8);
#define PG8_SA(b, h) (((b) * 2 + (h)) * HTB)
#define PG8_SB(b, h) ((4 + (b) * 2 + (h)) * HTB)
#define PG8_STAGE(bufoff, gbase, voff) do { _Pragma("unroll") for (int _i = 0; _i < 2; ++_i) \
        __builtin_amdgcn_global_load_lds((const unsigned*)((const char*)(gbase) + (voff)[_i]), (PG8_LAS unsigned*)(lds + (bufoff) + ldsw + _i * 8192), 16, 0, 0); } while (0)
#define PG8_LDA(dst, b, h) do { _Pragma("unroll") for (int m = 0; m < 4; ++m) _Pragma("unroll") for (int k = 0; k < 2; ++k) dst[m][k] = *(const PG8_LAS bf16x8*)(lds + PG8_SA(b, h) + aoff + m * 2048 + k * 1024); } while (0)
#define PG8_LDB(dst, b, h) do { _Pragma("unroll") for (int n = 0; n < 2; ++n) _Pragma("unroll") for (int k = 0; k < 2; ++k) dst[n][k] = *(const PG8_LAS bf16x8*)(lds + PG8_SB(b, h) + boff + n * 2048 + k * 1024); } while (0)
#define PG8_MMA(ai, bj, At, Bt) do { __builtin_amdgcn_s_setprio(1); _Pragma("unroll") for (int m = 0; m < 4; ++m) _Pragma("unroll") for (int n = 0; n < 2; ++n) _Pragma("unroll") for (int k = 0; k < 2; ++k) \
        acc[ai][bj][m][n] = __builtin_amdgcn_mfma_f32_16x16x32_bf16(Bt[n][k], At[m][k], acc[ai][bj][m][n], 0, 0, 0); __builtin_amdgcn_s_setprio(0); } while (0)
#define PG8_WAIT_V(n) asm volatile("s_waitcnt vmcnt(" #n ")" ::: "memory")
#define PG8_WAIT_L(n) asm volatile("s_waitcnt lgkmcnt(" #n ")" ::: "memory")
#define PG8_BAR __builtin_amdgcn_s_barrier()
#define PG8_SCHED __builtin_amdgcn_sched_barrier(0)
    Unit cur, nxt; int ui = 0;
    if (!S.next(0, cur)) return;
    f32x4 acc[2][2][4][2];
#pragma unroll
    for (int a = 0; a < 2; ++a)
#pragma unroll
        for (int b = 0; b < 2; ++b)
#pragma unroll
            for (int m = 0; m < 4; ++m)
#pragma unroll
                for (int n = 0; n < 2; ++n) acc[a][b][m][n] = (f32x4){0.f, 0.f, 0.f, 0.f};
    bf16x8 At[4][2], B0[2][2], B1[2][2];
    const char* cA = (const char*)g.A + (size_t)cur.pm * tstep; const char* cB = (const char*)g.Bt + (size_t)cur.pn * tstep;
    S.a_ready(cur);
    if constexpr (SP2) {
        PG8_STAGE(PG8_SB(0, 0), cB, voffB); PG8_STAGE(PG8_SB(0, 1), cB + hstep, voffB); PG8_STAGE(PG8_SA(0, 0), cA, voffA); PG8_STAGE(PG8_SA(0, 1), cA + hstep, voffA);
        if (wr == 1) PG8_BAR;
        PG8_WAIT_V(2); PG8_BAR;
        PG8_STAGE(PG8_SB(1, 0), cB + kstep, voffB); PG8_STAGE(PG8_SA(1, 0), cA + kstep, voffA); PG8_STAGE(PG8_SB(1, 1), cB + hstep + kstep, voffB);
        PG8_WAIT_V(6); PG8_BAR;
    } else {
        PG8_STAGE(PG8_SB(0, 0), cB, voffB); PG8_STAGE(PG8_SA(0, 0), cA, voffA); PG8_STAGE(PG8_SB(0, 1), cB + hstep, voffB); PG8_STAGE(PG8_SA(0, 1), cA + hstep, voffA);
        if (wr == 1) PG8_BAR;
        PG8_WAIT_V(4); PG8_BAR;
        PG8_STAGE(PG8_SB(1, 0), cB + kstep, voffB); PG8_STAGE(PG8_SA(1, 0), cA + kstep, voffA); PG8_STAGE(PG8_SB(1, 1), cB + hstep + kstep, voffB);
        PG8_WAIT_V(6); PG8_BAR;
    }
    for (;;) {
        const bool has_next = S.next(ui + 1, nxt);
        const char* nA = has_next ? (const char*)g.A + (size_t)nxt.pm * tstep : cA; const char* nB = has_next ? (const char*)g.Bt + (size_t)nxt.pn * tstep : cB;
        for (int t = 0; t < nt; t += 2) {
            const bool last = (t == nt - 2);
            const char* a1 = cA + (size_t)(t + 1) * kstep;
            const char* a2 = last ? nA : cA + (size_t)(t + 2) * kstep; const char* b2 = last ? nB : cB + (size_t)(t + 2) * kstep;
            const char* a3 = a2 + kstep; const char* b3 = b2 + kstep;
            if (last && has_next) S.a_ready(nxt);
            if constexpr (SP2) {
            PG8_LDB(B0, 0, 0); PG8_LDB(B1, 0, 1); PG8_SCHED; PG8_LDA(At, 0, 0); PG8_STAGE(PG8_SA(1, 1), a1 + hstep, voffA);
            PG8_WAIT_V(8); PG8_WAIT_L(0); PG8_BAR; PG8_MMA(0, 0, At, B0); PG8_MMA(0, 1, At, B1); PG8_BAR; PG8_SCHED;
            PG8_LDA(At, 0, 1); PG8_STAGE(PG8_SB(0, 0), b2, voffB); PG8_STAGE(PG8_SB(0, 1), b2 + hstep, voffB); PG8_STAGE(PG8_SA(0, 0), a2, voffA);
            PG8_WAIT_V(8); PG8_WAIT_L(0); PG8_BAR; PG8_MMA(1, 0, At, B0); PG8_MMA(1, 1, At, B1); PG8_BAR; PG8_SCHED;
            PG8_LDB(B0, 1, 0); PG8_LDB(B1, 1, 1); PG8_SCHED; PG8_LDA(At, 1, 0); PG8_STAGE(PG8_SA(0, 1), a2 + hstep, voffA);
            PG8_WAIT_V(8); PG8_WAIT_L(0); PG8_BAR; PG8_MMA(0, 0, At, B0); PG8_MMA(0, 1, At, B1); PG8_BAR; PG8_SCHED;
            PG8_LDA(At, 1, 1); PG8_STAGE(PG8_SB(1, 0), b3, voffB); PG8_STAGE(PG8_SB(1, 1), b3 + hstep, voffB); PG8_STAGE(PG8_SA(1, 0), a3, voffA);
            PG8_WAIT_V(8); PG8_WAIT_L(0); PG8_BAR; PG8_MMA(1, 0, At, B0); PG8_MMA(1, 1, At, B1); PG8_BAR; PG8_SCHED;
            } else {
            PG8_LDB(B0, 0, 0); PG8_SCHED; PG8_LDA(At, 0, 0); PG8_STAGE(PG8_SA(1, 1), a1 + hstep, voffA);
            PG8_WAIT_L(8); PG8_BAR; PG8_WAIT_L(0); PG8_MMA(0, 0, At, B0); PG8_BAR; PG8_SCHED;
            PG8_LDB(B1, 0, 1); PG8_STAGE(PG8_SB(0, 0), b2, voffB);
            PG8_BAR; PG8_WAIT_L(0); PG8_MMA(0, 1, At, B1); PG8_BAR;
            PG8_LDA(At, 0, 1); PG8_STAGE(PG8_SA(0, 0), a2, voffA);
            PG8_BAR; PG8_WAIT_L(0); PG8_MMA(1, 0, At, B0); PG8_BAR; PG8_SCHED;
            PG8_STAGE(PG8_SB(0, 1), b2 + hstep, voffB);
            PG8_WAIT_V(6); PG8_BAR; PG8_MMA(1, 1, At, B1); PG8_BAR;
            PG8_LDB(B0, 1, 0); PG8_SCHED; PG8_LDA(At, 1, 0); PG8_STAGE(PG8_SA(0, 1), a2 + hstep, voffA);
            PG8_WAIT_L(8); PG8_BAR; PG8_WAIT_L(0); PG8_MMA(0, 0, At, B0); PG8_BAR; PG8_SCHED;
            PG8_LDB(B1, 1, 1); PG8_STAGE(PG8_SB(1, 0), b3, voffB);
            PG8_BAR; PG8_WAIT_L(0); PG8_MMA(0, 1, At, B1); PG8_BAR;
            PG8_LDA(At, 1, 1); PG8_STAGE(PG8_SA(1, 0), a3, voffA);
            PG8_BAR; PG8_WAIT_L(0); PG8_MMA(1, 0, At, B0); PG8_BAR; PG8_SCHED;
            PG8_STAGE(PG8_SB(1, 1), b3 + hstep, voffB);
            PG8_WAIT_V(6); PG8_BAR; PG8_MMA(1, 1, At, B1); PG8_BAR;
            }
        }
        if constexpr (ALIGN_EPI) { if (wr == 0) PG8_BAR; }
        if constexpr (!Epi::AFTER_DRAIN) { E(acc, cur, wr, wc, fr, fq); S.done(cur); }
        if (!has_next) break;
#pragma unroll
        for (int a = 0; a < 2; ++a)
#pragma unroll
            for (int b = 0; b < 2; ++b)
#pragma unroll
                for (int m = 0; m < 4; ++m)
#pragma unroll
                    for (int n = 0; n < 2; ++n) acc[a][b][m][n] = (f32x4){0.f, 0.f, 0.f, 0.f};
        cur = nxt; cA = nA; cB = nB; ++ui;
        if constexpr (ALIGN_EPI) { if (wr == 1) PG8_BAR; }
    }
    PG8_WAIT_V(0);
    if constexpr (!ALIGN_EPI) { if (wr == 0) PG8_BAR; }
    PG8_BAR;
    if constexpr (Epi::AFTER_DRAIN) { E.fused(acc, cur, wr, wc, fr, fq, lds, wid, lane); S.done(cur); }
#undef PG8_SA
#undef PG8_SB
#undef PG8_STAGE
#undef PG8_LDA
#undef PG8_LDB
#undef PG8_MMA
#undef PG8_WAIT_V
#undef PG8_WAIT_L
#undef PG8_BAR
#undef PG8_SCHED
}
}
namespace pg8 {
__device__ __forceinline__ float silu_f(float v) { return v * __builtin_amdgcn_rcpf(1.0f + __expf(-v)); }
struct EpiF32 {
    static constexpr bool PERM = false, AFTER_DRAIN = false;
    float* C; int ldc;
    __device__ __forceinline__ void operator()(const f32x4 (&acc)[2][2][4][2], const Unit& u, int wr, int wc, int fr, int fq) const {
        const int row0 = u.pm * BM + wr * 64 + fr, col0 = u.pn * BM + wc * 32 + 4 * fq;
#pragma unroll
        for (int ai = 0; ai < 2; ++ai)
#pragma unroll
            for (int m = 0; m < 4; ++m) { float* rowp = C + (size_t)(row0 + ai * HALF + m * 16) * ldc + col0;
#pragma unroll
                for (int bj = 0; bj < 2; ++bj)
#pragma unroll
                    for (int n = 0; n < 2; ++n) *(f32x4*)(rowp + bj * HALF + n * 16) = acc[ai][bj][m][n]; }
    }
};
struct EpiSwiglu {
    static constexpr bool PERM = true, AFTER_DRAIN = false;
    bf16_t* O; int ldc;
    __device__ __forceinline__ void operator()(const f32x4 (&acc)[2][2][4][2], const Unit& u, int wr, int wc, int fr, int fq) const {
        const int row0 = u.pm * BM + wr * 64 + fr, col0 = u.pn * HALF + wc * 32 + 8 * fq;
#pragma unroll
        for (int ai = 0; ai < 2; ++ai)
#pragma unroll
            for (int m = 0; m < 4; ++m) { bf16_t* rowp = O + (size_t)(row0 + ai * HALF + m * 16) * ldc + col0;
                const f32x4 g0 = acc[ai][0][m][0], g1 = acc[ai][0][m][1], u0 = acc[ai][1][m][0], u1 = acc[ai][1][m][1];
                u32x4 w;
                w.x = cvt_pk_bf16(silu_f(g0[0]) * u0[0], silu_f(g0[1]) * u0[1]); w.y = cvt_pk_bf16(silu_f(g0[2]) * u0[2], silu_f(g0[3]) * u0[3]);
                w.z = cvt_pk_bf16(silu_f(g1[0]) * u1[0], silu_f(g1[1]) * u1[1]); w.w = cvt_pk_bf16(silu_f(g1[2]) * u1[2], silu_f(g1[3]) * u1[3]);
                *(u32x4*)rowp = w; }
    }
};
struct EpiMix {
    static constexpr bool PERM = true, AFTER_DRAIN = false;
    bf16_t* Z; bf16_t* XBC; float* DT;
    __device__ __forceinline__ void operator()(const f32x4 (&acc)[2][2][4][2], const Unit& u, int wr, int wc, int fr, int fq) const {
        const int row0 = u.pm * BM + wr * 64 + fr;
        if (u.pn < 10) {
            bf16_t* base; int ldc, colt;
            if (u.pn < 4) { base = Z; ldc = 1024; colt = u.pn * BM; } else { base = XBC; ldc = 1536; colt = (u.pn - 4) * BM; }
            const int col0 = colt + wc * 32 + 8 * fq;
#pragma unroll
            for (int ai = 0; ai < 2; ++ai)
#pragma unroll
                for (int m = 0; m < 4; ++m) { bf16_t* rowp = base + (size_t)(row0 + ai * HALF + m * 16) * ldc + col0;
#pragma unroll
                    for (int bj = 0; bj < 2; ++bj) { const f32x4 v0 = acc[ai][bj][m][0], v1 = acc[ai][bj][m][1];
                        u32x4 w; w.x = cvt_pk_bf16(v0[0], v0[1]); w.y = cvt_pk_bf16(v0[2], v0[3]); w.z = cvt_pk_bf16(v1[0], v1[1]); w.w = cvt_pk_bf16(v1[2], v1[3]);
                        *(u32x4*)(rowp + bj * HALF) = w; } }
        } else if (wc == 0 && fq < 2) {
#pragma unroll
            for (int ai = 0; ai < 2; ++ai)
#pragma unroll
                for (int m = 0; m < 4; ++m) { float* rowp = DT + (size_t)(row0 + ai * HALF + m * 16) * 16 + 8 * fq;
                    *(f32x4*)rowp = acc[ai][0][m][0]; *(f32x4*)(rowp + 4) = acc[ai][0][m][1]; }
        }
    }
};
}
#include <hip/hip_bf16.h>
#include <cmath>
namespace attn_body {
using bf16=__hip_bfloat16;
using bf16x8=__attribute__((ext_vector_type(8)))short;
using s16x4=__attribute__((ext_vector_type(4)))short;
using f32x16=__attribute__((ext_vector_type(16)))float;
using u32x4=__attribute__((ext_vector_type(4)))unsigned;
constexpr int BATCH=2,NHEAD=16,SEQ=8192,D=64,DM=NHEAD*D;
constexpr int NW=8,QBLK=32,QB=QBLK*NW,KVBLK=64,NQB=SEQ/QB;
constexpr int ATTN_PITCH=DM, ATTN_UNIT_ROWS=QB, OPITCH=2048, OCOL0=1024;
__device__ __forceinline__ int crow(int r,int hi){return (r&3)+8*(r>>2)+4*hi;}
#define SBAR() __builtin_amdgcn_sched_barrier(0)
__device__ __forceinline__ void cmask(f32x16&p0,f32x16&p1,int jb,int qrel,int hi){
  const float NEG=-INFINITY; int kb=64*jb+4*hi;
  #pragma unroll
  for(int r=0;r<16;++r){int kv=kb+(r&3)+8*(r>>2); if(kv>qrel)p0[r]=NEG; if(kv+32>qrel)p1[r]=NEG;}
}

constexpr int BT_N=704;
__device__ __forceinline__ void bmask(f32x16&p0,f32x16&p1,int jb,int qrel,int hi,const float*bt){
  const float NEG=-INFINITY; const int brel=qrel-64*jb-4*hi; const float*bp=bt+(brel+256);
  #pragma unroll
  for(int r=0;r<16;++r){const int c0=(r&3)+8*(r>>2);
    const float b0=bp[-c0], b1=bp[-c0-32];
    p0[r]=(brel<c0)?NEG:p0[r]+b0; p1[r]=(brel<c0+32)?NEG:p1[r]+b1;}
}
constexpr int NSLOT=3, SLOTB=8192;
constexpr int LDS_K=0, LDS_V=NSLOT*SLOTB, LDS_WS=2*NSLOT*SLOTB, LDS_OST=LDS_WS+NW*64*4, LDS_BYTES=LDS_OST+NW*4096, LDS_OSTA=86016, LDS_BTAB=LDS_OSTA+NW*4096, LDS_TOTAL=LDS_BTAB+704*4;
constexpr float C2=0.125f*1.4426950408889634f;
__device__ __forceinline__ void glds16(const void*gsrc,unsigned lds_dst){unsigned keep;
  asm volatile("s_mov_b32 %0, m0\n\ts_mov_b32 m0, %2\n\ts_nop 0\n\tglobal_load_lds_dwordx4 %1, off\n\ts_mov_b32 m0, %0":"=&s"(keep):"v"(gsrc),"s"(lds_dst):"memory");}
__device__ __forceinline__ float max3f(float a,float b,float c){float r;asm("v_max3_f32 %0, %1, %2, %3":"=v"(r):"v"(a),"v"(b),"v"(c));return r;}
__device__ __forceinline__ float max2f(float a,float b){float r;asm("v_max_f32_e32 %0, %1, %2":"=v"(r):"v"(a),"v"(b));return r;}
__device__ __forceinline__ float fadd_s(float a,float b){float r;asm("v_add_f32_e32 %0, %1, %2":"=v"(r):"v"(a),"v"(b));return r;}
__device__ __forceinline__ float fsub_s(float a,float b){float r;asm("v_sub_f32_e32 %0, %1, %2":"=v"(r):"v"(a),"v"(b));return r;}
typedef float f32x2_t __attribute__((ext_vector_type(2))); typedef __bf16 bf16x2_t __attribute__((ext_vector_type(2)));
__device__ __forceinline__ unsigned cvtpk_s(float lo,float hi){f32x2_t v={lo,hi};bf16x2_t b=__builtin_convertvector(v,bf16x2_t);return __builtin_bit_cast(unsigned,b);}
#define WAIT_BAR(N) asm volatile("s_waitcnt vmcnt(" #N ") lgkmcnt(0)\n\ts_barrier":::"memory")

__device__ __forceinline__ void qkt(f32x16&p0,f32x16&p1,const char*Kslot,const bf16x8*qr,const f32x16&negm,int r32,int hi){
  const char*kb=Kslot+hi*1024+r32*16;
  #pragma unroll
  for(int d0=0;d0<4;++d0){
    const bf16x8 b0=*reinterpret_cast<const bf16x8*>(kb+d0*2048);
    const bf16x8 b1=*reinterpret_cast<const bf16x8*>(kb+d0*2048+512);
    if(d0==0){p0=__builtin_amdgcn_mfma_f32_32x32x16_bf16(b0,qr[0],negm,0,0,0);p1=__builtin_amdgcn_mfma_f32_32x32x16_bf16(b1,qr[0],negm,0,0,0);}
    else{p0=__builtin_amdgcn_mfma_f32_32x32x16_bf16(b0,qr[d0],p0,0,0,0);p1=__builtin_amdgcn_mfma_f32_32x32x16_bf16(b1,qr[d0],p1,0,0,0);}}
}
typedef __attribute__((address_space(3))) const char* lds_cptr;
typedef short v4i16_t __attribute__((ext_vector_type(4)));
__device__ __forceinline__ void kload8(bf16x8*kf,lds_cptr kp){
  kf[0]=*(const __attribute__((address_space(3))) bf16x8*)(kp);      kf[1]=*(const __attribute__((address_space(3))) bf16x8*)(kp+512);
  kf[2]=*(const __attribute__((address_space(3))) bf16x8*)(kp+2048); kf[3]=*(const __attribute__((address_space(3))) bf16x8*)(kp+2560);
  kf[4]=*(const __attribute__((address_space(3))) bf16x8*)(kp+4096); kf[5]=*(const __attribute__((address_space(3))) bf16x8*)(kp+4608);
  kf[6]=*(const __attribute__((address_space(3))) bf16x8*)(kp+6144); kf[7]=*(const __attribute__((address_space(3))) bf16x8*)(kp+6656);
}
__device__ __forceinline__ void kload2(bf16x8*kf,lds_cptr kp,int j){ kf[2*j]=*(const __attribute__((address_space(3))) bf16x8*)(kp+j*2048); kf[2*j+1]=*(const __attribute__((address_space(3))) bf16x8*)(kp+j*2048+512); }
__device__ __forceinline__ s16x4 vtr(lds_cptr p){ return __builtin_bit_cast(s16x4,__builtin_amdgcn_ds_read_tr16_b64_v4i16((__attribute__((address_space(3))) v4i16_t*)p)); }
__device__ __forceinline__ float rowmax(const f32x16&p0,const f32x16&p1){
  float a=max3f(p0[0],p0[1],p1[0]),b=max3f(p0[2],p0[3],p1[1]);a=max3f(a,p1[2],p1[3]);
  #pragma unroll
  for(int r=4;r<16;r+=4){a=max3f(a,p0[r],p0[r+1]);b=max3f(b,p0[r+2],p0[r+3]);a=max3f(a,p1[r],p1[r+1]);b=max3f(b,p1[r+2],p1[r+3]);}
  const float m=max2f(a,b);
  auto rr=__builtin_amdgcn_permlane32_swap(__float_as_uint(m),__float_as_uint(m),false,false);
  return max2f(__uint_as_float(rr[0]),__uint_as_float(rr[1]));
}
__device__ __forceinline__ void pv(f32x16*o,int vb,bf16x8 pa0,bf16x8 pa1,bf16x8 pa2,bf16x8 pa3){
  #pragma unroll
  for(int d0=0;d0<2;++d0){s16x4 lo[4],hi[4];
    #pragma unroll
    for(int ks=0;ks<4;++ks){
      asm volatile("ds_read_b64_tr_b16 %0,%1 offset:%c2":"=&v"(lo[ks]):"v"(vb),"i"(d0*4096+ks*1024):"memory");
      asm volatile("ds_read_b64_tr_b16 %0,%1 offset:%c2":"=&v"(hi[ks]):"v"(vb),"i"(d0*4096+ks*1024+512):"memory");}
    asm volatile("s_waitcnt lgkmcnt(0)":::"memory");SBAR();
    #define PK(k) (bf16x8){lo[k][0],lo[k][1],lo[k][2],lo[k][3],hi[k][0],hi[k][1],hi[k][2],hi[k][3]}
    o[d0]=__builtin_amdgcn_mfma_f32_32x32x16_bf16(pa0,PK(0),o[d0],0,0,0);
    o[d0]=__builtin_amdgcn_mfma_f32_32x32x16_bf16(pa1,PK(1),o[d0],0,0,0);
    o[d0]=__builtin_amdgcn_mfma_f32_32x32x16_bf16(pa2,PK(2),o[d0],0,0,0);
    o[d0]=__builtin_amdgcn_mfma_f32_32x32x16_bf16(pa3,PK(3),o[d0],0,0,0);
    #undef PK
  }
}

#ifndef ATTN_STORE16
#define ATTN_STORE16(p,v) (*(u32x4*)(p)=(v))
#endif
template<int THRL> __device__ __forceinline__ void attn_unit(int b,int hq,int hv,int qb,int pass,float lam,const float*btab,const bf16*Q,const bf16*__restrict__ K,const bf16*__restrict__ V,bf16*O,char*shm){
  const int tid=threadIdx.x,lane=tid&63,r32=lane&31,hi=lane>>5; const int wid=__builtin_amdgcn_readfirstlane(tid>>6);
  const long rowbase=(long)b*SEQ; const int q0=qb*QB;
  const bf16*Qw=Q+(rowbase+q0+wid*QBLK)*DM+hq*D;
  const bf16*Kh=K+rowbase*DM+hq*D,*Vh=V+rowbase*DM+hv*D;
  const unsigned lds0=(unsigned)(uintptr_t)shm;
  float*wsf=(float*)(shm+LDS_WS)+wid*64;
  const bf16*ksrc=Kh+(long)lane*DM+wid*8;
  const bf16*vsrc=Vh+(long)(16*(wid&3)+(lane>>2))*DM+(wid>>2)*32+(lane&3)*8;
  const unsigned kdst=lds0+LDS_K+wid*1024, vdst=lds0+LDS_V+wid*1024;
  #define DMA_K(t,slot) glds16(ksrc+(long)(t)*KVBLK*DM,(unsigned)__builtin_amdgcn_readfirstlane(kdst+(slot)))
  #define DMA_V(t,slot) glds16(vsrc+(long)(t)*KVBLK*DM,(unsigned)__builtin_amdgcn_readfirstlane(vdst+(slot)))
  const int vb0=(int)(lds0+LDS_V)+((lane>>4)&1)*32+(lane&3)*8+(4*hi+((lane&15)>>2))*64;
  const char*Kbase=shm+LDS_K; bf16x8 kf[8];
  const lds_cptr shm3=(lds_cptr)shm; const lds_cptr kp0=shm3+LDS_K+hi*1024+r32*16; const lds_cptr vp0=shm3+LDS_V+((lane>>4)&1)*32+(lane&3)*8+(4*hi+((lane&15)>>2))*64;
  const int NT=(q0+QB)/KVBLK;
  DMA_K(0,0);DMA_V(0,0);DMA_K(1,SLOTB);
  bf16x8 qr[4];
  #pragma unroll
  for(int d0=0;d0<4;++d0)qr[d0]=*reinterpret_cast<const bf16x8*>(&Qw[(long)r32*DM+d0*16+hi*8]);
  float mhat=0.f,l_reg=0.f;f32x16 o[2];o[0]=f32x16{};o[1]=f32x16{};f32x16 negm=f32x16{};asm volatile("":"+v"(negm));
  const int qrel=wid*QBLK+r32;
  #define CMASK(P0,P1,t) do{int jb_=(t)-(NT-4); if(jb_>=-2)bmask(P0,P1,jb_,qrel,hi,btab);}while(0)
  bool resc=false;
  #define START(P0,P1) do{ const float rm=rowmax(P0,P1); resc=false; \
    { const float dl=rm; mhat=fadd_s(mhat,dl); \
      _Pragma("unroll") for(int r=0;r<16;++r){P0[r]=fsub_s(P0[r],dl);P1[r]=fsub_s(P1[r],dl);} \
      _Pragma("unroll") for(int r=0;r<16;++r)negm[r]=-mhat; asm volatile("":"+v"(negm)); } \
    _Pragma("unroll") for(int r=0;r<16;++r)P0[r]=__builtin_amdgcn_exp2f(P0[r]); }while(0)
  #define RESC() do{ if(resc){ asm volatile("s_waitcnt lgkmcnt(0)":::"memory"); \
      _Pragma("unroll") for(int d_=0;d_<2;++d_) _Pragma("unroll") for(int r=0;r<16;++r)o[d_][r]*=wsf[crow(r,hi)]; } }while(0)
  f32x16 pA0,pA1,pB0,pB1;
  int sl_prev=0,sl_cur=0,sl_next=SLOTB;
  #define ROT() do{sl_prev=sl_cur;sl_cur=sl_next;sl_next=(sl_next==(NSLOT-1)*SLOTB)?0:sl_next+SLOTB;}while(0)
  DMA_K(2,2*SLOTB);
  WAIT_BAR(3);
  qkt(pA0,pA1,Kbase,qr,negm,r32,hi);asm volatile("s_nop 15\n\ts_nop 7":"+v"(pA0),"+v"(pA1));CMASK(pA0,pA1,0);
  START(pA0,pA1);
  _Pragma("unroll") for(int r=0;r<16;++r)pA1[r]=__builtin_amdgcn_exp2f(pA1[r]);
  WAIT_BAR(0);
  DMA_K(3,0);DMA_V(1,SLOTB);
  ROT();
  kload8(kf,kp0+sl_cur);
  WAIT_BAR(2);
  s16x4 vlo[8],vhi[8]; u32x4 pw0,pw1,pw2,pw3;
  #define PKW(P,B) cvtpk_s(P[B],P[B+1])
  #define PAF(k) __builtin_bit_cast(bf16x8,pw##k)
  #define VFR(i) (bf16x8){vlo[i][0],vlo[i][1],vlo[i][2],vlo[i][3],vhi[i][0],vhi[i][1],vhi[i][2],vhi[i][3]}
  #define PIN(x) asm volatile("":"+v"(x))
  #define MX3(a,b,c) __builtin_fmaxf(__builtin_fmaxf((a),(b)),(c))
  #define GAPA(MF,A0,A1,A2,A3,W0,W1,PW) do{ MF; sacc+=A0; sacc+=A1; sacc+=A2; sacc+=A3; PIN(sacc); W0; W1; PIN(PW); SBAR(); }while(0)
  #define EX(v) __builtin_amdgcn_exp2f(v)
  #define GAPB(MF,X,B) do{ MF; X[B]=EX(X[B]); X[B+1]=EX(X[B+1]); X[B+2]=EX(X[B+2]); X[B+3]=EX(X[B+3]); PIN(X); SBAR(); }while(0)
  #define VRD(i) do{ vlo[i]=vtr(vp_+(((i)>>2)*4096+((i)&3)*1024)); vhi[i]=vtr(vp_+(((i)>>2)*4096+((i)&3)*1024+512)); }while(0)
  #define KRD(G,j) do{ if(G){ kload2(kf,kp0+sl_next,j); SBAR(); } }while(0)
  #define STEP(C0,C1,P0,P1,t,GK,GV,GL) do{ SBAR(); \
    const lds_cptr vp_=vp0+sl_prev; \
    VRD(0); SBAR(); float sacc=(P0[0]+P0[1]); \
    GAPA(C0=__builtin_amdgcn_mfma_f32_32x32x16_bf16(kf[0],qr[0],negm,0,0,0), P0[2],P0[3],P0[4],P0[5],     pw0[0]=PKW(P0,0), pw0[1]=PKW(P0,2), pw0); \
    VRD(4); SBAR(); GAPA(C1=__builtin_amdgcn_mfma_f32_32x32x16_bf16(kf[1],qr[0],negm,0,0,0), P0[6],P0[7],P0[8],P0[9],     pw0[2]=PKW(P0,4), pw0[3]=PKW(P0,6), pw0); \
    VRD(1); SBAR(); GAPA(C0=__builtin_amdgcn_mfma_f32_32x32x16_bf16(kf[2],qr[1],C0,0,0,0),   P0[10],P0[11],P0[12],P0[13], pw1[0]=PKW(P0,8), pw1[1]=PKW(P0,10), pw1); \
    VRD(5); SBAR(); GAPA(C1=__builtin_amdgcn_mfma_f32_32x32x16_bf16(kf[3],qr[1],C1,0,0,0),   P0[14],P0[15],P1[0],P1[1],   pw1[2]=PKW(P0,12),pw1[3]=PKW(P0,14), pw1); \
    VRD(2); SBAR(); GAPA(C0=__builtin_amdgcn_mfma_f32_32x32x16_bf16(kf[4],qr[2],C0,0,0,0),   P1[2],P1[3],P1[4],P1[5],     pw2[0]=PKW(P1,0), pw2[1]=PKW(P1,2), pw2); \
    VRD(6); SBAR(); GAPA(C1=__builtin_amdgcn_mfma_f32_32x32x16_bf16(kf[5],qr[2],C1,0,0,0),   P1[6],P1[7],P1[8],P1[9],     pw2[2]=PKW(P1,4), pw2[3]=PKW(P1,6), pw2); \
    VRD(3); SBAR(); GAPA(C0=__builtin_amdgcn_mfma_f32_32x32x16_bf16(kf[6],qr[3],C0,0,0,0),   P1[10],P1[11],P1[12],P1[13], pw3[0]=PKW(P1,8), pw3[1]=PKW(P1,10), pw3); \
    VRD(7); SBAR(); GAPA(C1=__builtin_amdgcn_mfma_f32_32x32x16_bf16(kf[7],qr[3],C1,0,0,0),   P1[14],P1[15],0.f,0.f,       pw3[2]=PKW(P1,12),pw3[3]=PKW(P1,14), pw3); \
    l_reg+=sacc; \
    if(GK){DMA_K((t)+3,sl_cur);} if(GV){DMA_V((t)+1,sl_next);} \
    CMASK(C0,C1,t); \
    { float a=MX3(C0[0],C0[1],C1[0]),b=MX3(C0[2],C0[3],C1[1]); a=MX3(a,C1[2],C1[3]); \
      _Pragma("unroll") for(int r=4;r<16;r+=4){a=MX3(a,C0[r],C0[r+1]);b=MX3(b,C0[r+2],C0[r+3]);a=MX3(a,C1[r],C1[r+1]);b=MX3(b,C1[r+2],C1[r+3]);} \
      float rm=__builtin_fmaxf(a,b); { auto rr=__builtin_amdgcn_permlane32_swap(__float_as_uint(rm),__float_as_uint(rm),false,false); rm=__builtin_fmaxf(__uint_as_float(rr[0]),__uint_as_float(rr[1])); } \
      resc=false; \
      if(__builtin_expect(__any(rm>(float)THRL),0)){ const float dl=__builtin_fmaxf(rm,0.f); mhat+=dl; \
        _Pragma("unroll") for(int r=0;r<16;++r){C0[r]-=dl;C1[r]-=dl;} \
        _Pragma("unroll") for(int r=0;r<16;++r)negm[r]=-mhat; asm volatile("":"+v"(negm)); \
        const float f=__builtin_amdgcn_exp2f(-dl); l_reg*=f; if(hi==0)wsf[r32]=f; resc=true; } } \
    SBAR(); \
    GAPB(o[0]=__builtin_amdgcn_mfma_f32_32x32x16_bf16(PAF(0),VFR(0),o[0],0,0,0), C0,0); \
    GAPB(o[1]=__builtin_amdgcn_mfma_f32_32x32x16_bf16(PAF(0),VFR(4),o[1],0,0,0), C0,4); \
    KRD(GL,0); GAPB(o[0]=__builtin_amdgcn_mfma_f32_32x32x16_bf16(PAF(1),VFR(1),o[0],0,0,0), C0,8); \
    KRD(GL,1); GAPB(o[1]=__builtin_amdgcn_mfma_f32_32x32x16_bf16(PAF(1),VFR(5),o[1],0,0,0), C0,12); \
    KRD(GL,2); GAPB(o[0]=__builtin_amdgcn_mfma_f32_32x32x16_bf16(PAF(2),VFR(2),o[0],0,0,0), C1,0); \
    KRD(GL,3); GAPB(o[1]=__builtin_amdgcn_mfma_f32_32x32x16_bf16(PAF(2),VFR(6),o[1],0,0,0), C1,4); \
    GAPB(o[0]=__builtin_amdgcn_mfma_f32_32x32x16_bf16(PAF(3),VFR(3),o[0],0,0,0), C1,8); \
    GAPB(o[1]=__builtin_amdgcn_mfma_f32_32x32x16_bf16(PAF(3),VFR(7),o[1],0,0,0), C1,12); \
    }while(0)
  int t=1;
  #undef CMASK
  #define CMASK(P0,P1,t) do{}while(0)
  for(;t+7<NT;t+=2){
    STEP(pB0,pB1,pA0,pA1,t,true,true,true);     WAIT_BAR(2); RESC(); ROT();
    STEP(pA0,pA1,pB0,pB1,t+1,true,true,true);   WAIT_BAR(2); RESC(); ROT();
  }
  #undef CMASK
  #define CMASK(P0,P1,t) do{int jb_=(t)-(NT-4); if(jb_>=-2)bmask(P0,P1,jb_,qrel,hi,btab);}while(0)
  #define ENDW(tt) do{ if((tt)+3<NT){WAIT_BAR(2);} else if((tt)+2<NT){WAIT_BAR(1);} else {WAIT_BAR(0);} }while(0)
  for(;t+1<NT;t+=2){
    STEP(pB0,pB1,pA0,pA1,t,(t+3<NT),(t+1<NT),(t+1<NT));       ENDW(t);   RESC(); ROT();
    STEP(pA0,pA1,pB0,pB1,t+1,(t+4<NT),(t+2<NT),(t+2<NT));     ENDW(t+1); RESC(); ROT();
  }
  STEP(pB0,pB1,pA0,pA1,NT-1,false,false,false); RESC();
  { float sacc=pB0[0]+pB0[1]; _Pragma("unroll") for(int r=2;r<16;++r)sacc+=pB0[r]; _Pragma("unroll") for(int r=0;r<16;++r)sacc+=pB1[r]; l_reg+=sacc;
    pw0=(u32x4){PKW(pB0,0),PKW(pB0,2),PKW(pB0,4),PKW(pB0,6)};pw1=(u32x4){PKW(pB0,8),PKW(pB0,10),PKW(pB0,12),PKW(pB0,14)};pw2=(u32x4){PKW(pB1,0),PKW(pB1,2),PKW(pB1,4),PKW(pB1,6)};pw3=(u32x4){PKW(pB1,8),PKW(pB1,10),PKW(pB1,12),PKW(pB1,14)};
    SBAR(); pv(o,vb0+sl_cur,PAF(0),PAF(1),PAF(2),PAF(3)); }
  #undef PKW
  #undef PAF
  #undef VFR
  #undef PIN
  #undef MX3
  #undef GAPA
  #undef GAPB
  #undef EX
  #undef VRD
  #undef KRD
  #undef STEP
  #undef ENDW
  {auto rr=__builtin_amdgcn_permlane32_swap(__float_as_uint(l_reg),__float_as_uint(l_reg),false,false);l_reg=__uint_as_float(rr[0])+__uint_as_float(rr[1]);}
  if(hi==0)wsf[32+r32]=l_reg;asm volatile("s_waitcnt lgkmcnt(0)":::"memory");
  float rli[16];
  #pragma unroll
  for(int r=0;r<16;++r)rli[r]=__builtin_amdgcn_rcpf(wsf[32+crow(r,hi)]);
  bf16*Ow=O+(rowbase+q0+wid*QBLK)*OPITCH+OCOL0+hv*D;
  { bf16*stg=(bf16*)(shm+LDS_OST)+wid*2048; bf16*stga=(bf16*)(shm+LDS_OSTA)+wid*2048;
    #pragma unroll
    for(int r=0;r<16;++r){const int orow=crow(r,hi);
      #pragma unroll
      for(int d0=0;d0<2;++d0){const int ix=orow*64+d0*32+r32; const float ov=o[d0][r]*rli[r]; if(pass==0)stga[ix]=__float2bfloat16(ov); else stg[ix]=__float2bfloat16(__bfloat162float(stga[ix])-lam*ov);}}
    asm volatile("s_waitcnt lgkmcnt(0)":::"memory");
    #pragma unroll
    for(int i=0;i<4;++i){const int row=i*8+(lane>>3),ch=lane&7; if(pass!=0){const u32x4 v=*(const u32x4*)(stg+row*64+ch*8); ATTN_STORE16(Ow+(long)row*OPITCH+ch*8,v);}} }
  asm volatile("s_waitcnt lgkmcnt(0)\n\ts_barrier":::"memory");
  #undef DMA_K
  #undef DMA_V
  #undef CMASK
  #undef START
  #undef RESC
  #undef ROT
}
constexpr int ATTN_LDS_BYTES=LDS_BYTES;
struct AttnTensors { const bf16* Q; const bf16* K; const bf16* V; bf16* O; float lam; const float* relb; };
struct AttnUnit { int bh; int qb; };
struct StaticOrder {
  int vcu;
  __device__ __forceinline__ explicit StaticOrder(int grid,int block):vcu((block%8)*(grid/8)+block/8){}
  __device__ __forceinline__ bool next(int i,AttnUnit&u)const{ if(i>=4)return false; const int s=vcu&7; u.bh=vcu>>3; u.qb=(i==0)?s:(i==1)?15-s:(i==2)?16+s:31-s; return true; }
  __device__ __forceinline__ void a_ready(const AttnUnit&)const{}
  __device__ __forceinline__ void done(const AttnUnit&)const{}
};
template<class Sched,int THRL=8> __device__ __forceinline__ void attn_phase(char*lds,const AttnTensors&T,const Sched&S){
  AttnUnit u;
  for(int i=0;S.next(i,u);++i){ S.a_ready(u); const int b_=u.bh/NHEAD,hp_=u.bh%NHEAD; float*bt_=(float*)(lds+LDS_BTAB);
    for(int t_=threadIdx.x;t_<BT_N;t_+=NW*64){ const int rel=t_-256; float v_=0.f;
      if(rel>=0&&rel<113){ int bk=rel; if(rel>=16){ bk=16+(int)(logf((float)rel*(1.0f/16.0f))/logf(8.0f)*16.0f); bk=bk>31?31:bk; } v_=(T.relb[bk*8+(hp_>>1)]-T.relb[31*8+(hp_>>1)])*1.4426950408889634f; }
      bt_[t_]=v_; }
    asm volatile("s_waitcnt lgkmcnt(0)\n\ts_barrier":::"memory");
    for(int pass=0;pass<2;++pass) attn_unit<THRL>(b_,(hp_&~1)+pass,hp_,u.qb,pass,T.lam,bt_,T.Q,T.K,T.V,T.O,lds); S.done(u); }
}
#undef SBAR
#undef WAIT_BAR
}
constexpr int NWAVES = 8;
constexpr int BATCH = 2, SEQ = 8192, DM = 1024, M = BATCH * SEQ;
constexpr int DFF = 2816, NGU = 2 * DFF;
constexpr int NQKV = 3072;
constexpr int NMIX = 2816;
constexpr int NIN = NQKV + NMIX;
constexpr int IN_WIDTH = 5648;
constexpr int KOUT = 2048;
constexpr int NMOD = 9 * DM;
constexpr int NCHUNK = SEQ / 128, NBC = BATCH * NCHUNK;
constexpr float EPS = 1e-6f;
constexpr float LAM_INIT = 0.2f;
constexpr float LOG2E = 1.4426950408889634f;

constexpr size_t MiB = 1u << 20;
constexpr size_t WS_CTL = 0, CTL_ZERO_BYTES = 64 * 1024;
constexpr size_t WS_MOD = 1 * MiB;
constexpr size_t WS_DTRAW = 2 * MiB;
constexpr size_t WS_DTS = 3 * MiB;
constexpr size_t WS_AC = 4 * MiB;
constexpr size_t WS_CDEC = 5 * MiB;
constexpr size_t WS_WA = 6 * MiB;
constexpr size_t WS_WB = 18 * MiB;
constexpr size_t WS_H = 24 * MiB;
constexpr size_t WS_U = 56 * MiB;
constexpr size_t WS_ACT = WS_U, WS_D = WS_U + 88 * MiB;
constexpr size_t WS_Q = WS_U, WS_K = WS_U + 32 * MiB, WS_V = WS_U + 64 * MiB;
constexpr size_t WS_YCAT = WS_U + 96 * MiB;
constexpr size_t WS_Z = WS_U, WS_XBC = WS_U + 32 * MiB;
constexpr size_t WS_BT = WS_U + 80 * MiB, WS_CM = WS_U + 88 * MiB;
constexpr size_t WS_XT = WS_U + 160 * MiB, WS_BM = WS_U + 192 * MiB;
constexpr size_t WS_ST = WS_H;
constexpr size_t WS_D2 = WS_U;
constexpr size_t WS_END = 256 * MiB;
static_assert(WS_BM + 8 * MiB <= WS_END && WS_D + 64 * MiB <= WS_END && WS_YCAT + 64 * MiB <= WS_XT && WS_CM + 8 * MiB <= WS_YCAT && WS_XBC + 48 * MiB <= WS_BT, "d_ws map");

constexpr int RING_OFF = 0, RING_BYTES = 131072;
constexpr int LDSCTL_OFF = RING_BYTES, MISC_OFF = LDSCTL_OFF + 320;
constexpr int LDS_BYTES = 147456;
static_assert(attn_body::LDS_TOTAL <= RING_BYTES, "attention scratch inside the ring region");

#define GAS __attribute__((address_space(1)))
#define LAS __attribute__((address_space(3)))
typedef unsigned short bf16;
typedef unsigned v4u __attribute__((ext_vector_type(4)));
typedef unsigned v2u __attribute__((ext_vector_type(2)));
typedef float f32x4 __attribute__((ext_vector_type(4)));
typedef float f32x16 __attribute__((ext_vector_type(16)));
typedef short bf16x8 __attribute__((ext_vector_type(8)));
typedef GAS unsigned gu32;
#define RLX_AGENT __ATOMIC_RELAXED, __HIP_MEMORY_SCOPE_AGENT
#define LDS_WAIT() asm volatile("s_waitcnt lgkmcnt(0)" ::: "memory")
#define VM_WAIT() asm volatile("s_waitcnt vmcnt(0)" ::: "memory")
__device__ __forceinline__ unsigned f2bf(float f) { unsigned u = __builtin_bit_cast(unsigned, f); return (u + 0x7fffu + ((u >> 16) & 1u)) >> 16; }
__device__ __forceinline__ unsigned pk2(float lo, float hi) { return f2bf(lo) | (f2bf(hi) << 16); }
__device__ __forceinline__ float bf2f(unsigned short h) { return __builtin_bit_cast(float, (unsigned)h << 16); }
__device__ __forceinline__ float bflo(unsigned w) { return __builtin_bit_cast(float, w << 16); }
__device__ __forceinline__ float bfhi(unsigned w) { return __builtin_bit_cast(float, w & 0xffff0000u); }
__device__ __forceinline__ float silu(float v) { return v / (1.0f + __expf(-v)); }
__device__ __forceinline__ int crow(int r, int hi) { return (r & 3) + 8 * (r >> 2) + 4 * hi; }
#define MFMA32(a, b, c) __builtin_amdgcn_mfma_f32_32x32x16_bf16(a, b, c, 0, 0, 0)

#define XB_TMO      128
#define XB_XCNT(j)  (256  + 64 * (j))
#define XB_XSUB(j)  (1280 + 64 * (j))
#define XB_XGEN(j)  (2304 + 64 * (j))
#define XB_TOP      3328
#define XB_TOPGEN   3392
#define XCD_BAR_WORDS 3456
#define XB_SPIN_CAP (1u << 18)
constexpr int CW_BAR = 4096;
static_assert((CW_BAR + XCD_BAR_WORDS) * 4 <= (int)CTL_ZERO_BYTES, "barrier words inside the memset region");
__device__ __forceinline__ unsigned xb_ld(unsigned* p)              { return __hip_atomic_load(p, __ATOMIC_RELAXED, __HIP_MEMORY_SCOPE_AGENT); }
__device__ __forceinline__ unsigned xb_add(unsigned* p, unsigned v) { return __hip_atomic_fetch_add(p, v, __ATOMIC_RELAXED, __HIP_MEMORY_SCOPE_AGENT); }
__device__ __forceinline__ unsigned xb_xcc_id() { return (unsigned)__builtin_amdgcn_s_getreg((3 << 11) | 20) & 0xFu; }
#define XB_SPIN(cond, bar) do { unsigned _sp = 0; while (cond) { __builtin_amdgcn_s_sleep(1); \
    if ((++_sp & 255u) == 0u) { if (xb_ld(&(bar)[XB_TMO])) break; if (_sp > XB_SPIN_CAP) { atomicAdd(&(bar)[XB_TMO], 1u); break; } } } } while (0)
struct XcdBarrier { unsigned* bar; unsigned x; volatile LAS unsigned* st; };
__device__ __forceinline__ XcdBarrier xcd_barrier_post(unsigned* bar, volatile LAS unsigned* st) {
    XcdBarrier b; b.bar = bar; b.x = xb_xcc_id(); b.st = st;
    if (threadIdx.x == 0) (void)xb_add(&bar[XB_XCNT(b.x)], 1u);
    return b;
}
__device__ __forceinline__ void xcd_barrier_complete(unsigned* bar, unsigned x, unsigned& nloc, unsigned& nx) {
    const unsigned G = gridDim.x * gridDim.y * gridDim.z;
    unsigned sum, cnt, mine, sp = 0u;
    for (;;) {
        sum = 0u; cnt = 0u; mine = 0u;
#pragma unroll
        for (unsigned j = 0; j < 16; ++j) { const unsigned c = xb_ld(&bar[XB_XCNT(j)]); sum += c; cnt += (c > 0u) ? 1u : 0u; mine = (j == x) ? c : mine; }
        if (sum == G) break;
        __builtin_amdgcn_s_sleep(1);
        if ((++sp & 255u) == 0u) { if (xb_ld(&bar[XB_TMO])) break; if (sp > XB_SPIN_CAP) { atomicAdd(&bar[XB_TMO], 1u); break; } }
    }
    nloc = mine > 0u ? mine : 1u; nx = cnt > 0u ? cnt : 1u;
}
__device__ __forceinline__ void xcd_barrier(const XcdBarrier& b) {
    asm volatile("s_waitcnt vmcnt(0)" ::: "memory");
    __syncthreads();
    if (threadIdx.x == 0) {
        unsigned* bar = b.bar;
        __builtin_amdgcn_s_waitcnt(0);
        unsigned nloc = b.st[0], nx = b.st[1];
        if (nloc == 0u) { xcd_barrier_complete(bar, b.x, nloc, nx); b.st[0] = nloc; b.st[1] = nx; }
        const unsigned old = xb_add(&bar[XB_XSUB(b.x)], 1u);
        const unsigned gen = old / nloc;
        if (old + 1u == (gen + 1u) * nloc) {
            __builtin_amdgcn_fence(__ATOMIC_RELEASE, "agent");
            asm volatile("s_waitcnt vmcnt(0)" ::: "memory");
            const unsigned og = xb_add(&bar[XB_TOP], 1u);
            const unsigned tg = og / nx;
            if (og + 1u == (tg + 1u) * nx) xb_add(&bar[XB_TOPGEN], 1u);
            else XB_SPIN(xb_ld(&bar[XB_TOPGEN]) == tg, bar);
            __builtin_amdgcn_fence(__ATOMIC_ACQUIRE, "agent");
            xb_add(&bar[XB_XGEN(b.x)], 1u);
            asm volatile("s_waitcnt vmcnt(0)" ::: "memory");
        } else {
            XB_SPIN(xb_ld(&bar[XB_XGEN(b.x)]) == gen, bar);
            __builtin_amdgcn_fence(__ATOMIC_ACQUIRE, "agent");
            asm volatile("s_waitcnt vmcnt(0)" ::: "memory");
        }
    }
    __syncthreads();
}

struct Frame {
    LAS unsigned char* lds;
    int tid, lane, wave;
    int vcu, G;
    int gw, NGW;
};
__device__ __forceinline__ float wave_sum(float v) {
#pragma unroll
    for (int o = 1; o < 64; o <<= 1) v += __shfl_xor(v, o);
    return v;
}
__device__ __forceinline__ void tr_item(const float* W, int N, int n0, int k0, bf16* WT, int K, int drow0, int nvalid, LAS float* scr, int lane) {
#pragma unroll 8
    for (int i = 0; i < 32; ++i) { const int kk = 2 * i + (lane >> 5); scr[kk * 33 + (lane & 31)] = W[(size_t)(k0 + kk) * N + n0 + (lane & 31)]; }
    LDS_WAIT(); asm volatile("" ::: "memory");
    const int c = lane & 7;
#pragma unroll
    for (int j = 0; j < 4; ++j) { const int n = (lane >> 3) + 8 * j; const LAS float* s = scr + (8 * c) * 33 + n;
        v4u o; o.x = pk2(s[0 * 33], s[1 * 33]); o.y = pk2(s[2 * 33], s[3 * 33]); o.z = pk2(s[4 * 33], s[5 * 33]); o.w = pk2(s[6 * 33], s[7 * 33]);
        if (n >= nvalid) o = (v4u){0u, 0u, 0u, 0u};
        *(GAS v4u*)(WT + (size_t)(drow0 + n) * K + k0 + 8 * c) = o; }
    LDS_WAIT(); asm volatile("" ::: "memory");
}
__device__ __forceinline__ void convert_ffn(Frame& F, const float* Wg, const float* Wu, const float* Wd, bf16* WA, bf16* WB) {
    LAS float* scr = (LAS float*)(F.lds + RING_OFF + F.wave * 16384);
    constexpr int NB = DFF / 32, I_G = (DM / 64) * NB, I_D = (DFF / 64) * (DM / 32);
    for (int it = F.gw; it < 2 * I_G + I_D; it += F.NGW) {
        int r = it;
        if (r < 2 * I_G) { const int up = r >= I_G; if (up) r -= I_G; const int kb = r / NB, nb = r % NB, n0 = 32 * nb;
            tr_item(up ? Wu : Wg, DFF, n0, 64 * kb, WA, DM, (n0 >> 7) * 256 + (n0 & 127) + (up ? 128 : 0), 32, scr, F.lane); continue; }
        r -= 2 * I_G; { const int kb = r / (DM / 32), nb = r % (DM / 32); tr_item(Wd, DM, 32 * nb, 64 * kb, WB, DFF, 32 * nb, 32, scr, F.lane); }
    }
}
__device__ __forceinline__ void convert_mix(Frame& F, const float* Win, const float* Wout, bf16* WA, bf16* WB) {
    LAS float* scr = (LAS float*)(F.lds + RING_OFF + F.wave * 16384);
    constexpr int NB_IN = 177, I_IN = (DM / 64) * NB_IN, I_OUT = (KOUT / 64) * (DM / 32);
    for (int it = F.gw; it < I_IN + I_OUT; it += F.NGW) {
        int r = it;
        if (r < I_IN) { const int kb = r / NB_IN; int nb = r % NB_IN; int src, dst, nv = 32;
            if (nb < 32) { src = 0 + 32 * nb; dst = 3072 + 32 * nb; }
            else if (nb < 80) { nb -= 32; src = 1024 + 32 * nb; dst = 4096 + 32 * nb; }
            else if (nb < 81) { src = 2560; dst = 5632; nv = 16; }
            else if (nb < 113) { nb -= 81; src = 2576 + 32 * nb; dst = 0 + 32 * nb; }
            else if (nb < 145) { nb -= 113; src = 3600 + 32 * nb; dst = 1024 + 32 * nb; }
            else { nb -= 145; src = 4624 + 32 * nb; dst = 2048 + 32 * nb; }
            tr_item(Win, IN_WIDTH, src, 64 * kb, WA, DM, dst, nv, scr, F.lane); continue; }
        r -= I_IN; { const int kb = r / (DM / 32), nb = r % (DM / 32); tr_item(Wout, DM, 32 * nb, 64 * kb, WB, KOUT, 32 * nb, 32, scr, F.lane); }
    }
    { GAS v4u* z = (GAS v4u*)(WA + (size_t)5664 * DM); const int n16 = 224 * DM * 2 / 16;
      for (int i = F.gw * 64 + F.lane; i < n16; i += F.NGW * 64) z[i] = (v4u){0u, 0u, 0u, 0u}; }
}
__device__ __forceinline__ void mod_gemv(Frame& F, const float* c, const float* w_ada, const float* b_ada, float* mod) {
    LAS float* cs = (LAS float*)(F.lds + RING_OFF);
    LAS float* red = cs + 2048;
    __syncthreads();
    for (int i = F.tid; i < 2 * DM; i += NWAVES * 64) cs[i] = silu(c[i]);
    __syncthreads();
    for (int u = blockIdx.x; u < NMOD / 64; u += F.G) {
        const int col = 64 * u + F.lane; float a0 = 0.f, a1 = 0.f;
        const float* wp = w_ada + (size_t)(128 * F.wave) * NMOD + col;
#pragma unroll 16
        for (int k = 0; k < 128; ++k) { const float w = wp[(size_t)k * NMOD]; a0 += cs[128 * F.wave + k] * w; a1 += cs[DM + 128 * F.wave + k] * w; }
        red[(F.wave * 2 + 0) * 64 + F.lane] = a0; red[(F.wave * 2 + 1) * 64 + F.lane] = a1;
        __syncthreads();
        if (F.tid < 128) { const int b = F.tid >> 6, l = F.tid & 63; float s = b_ada[64 * u + l];
#pragma unroll
            for (int w = 0; w < 8; ++w) s += red[(w * 2 + b) * 64 + l];
            mod[b * NMOD + 64 * u + l] = s; }
        __syncthreads();
    }
}

struct Row16 { f32x4 v[4]; };
__device__ __forceinline__ Row16 ld_row(const float* p, int lane) { Row16 r; const GAS f32x4* q = (const GAS f32x4*)p + lane;
#pragma unroll
    for (int j = 0; j < 4; ++j) r.v[j] = q[64 * j];
    return r; }
__device__ __forceinline__ float row_ssq(const Row16& r) { float s = 0.f;
#pragma unroll
    for (int j = 0; j < 4; ++j) s += (r.v[j].x * r.v[j].x + r.v[j].y * r.v[j].y) + (r.v[j].z * r.v[j].z + r.v[j].w * r.v[j].w);
    return wave_sum(s); }
__device__ __forceinline__ void adaln_store(const Row16& x, float rstd, const float* g, const float* sc, const float* s, bf16* out, int lane) {
    const Row16 G = ld_row(g, lane), SC = ld_row(sc, lane), S = ld_row(s, lane);
    GAS unsigned long long* o8 = (GAS unsigned long long*)out + lane;
#pragma unroll
    for (int j = 0; j < 4; ++j) { const f32x4 h = x.v[j] * rstd * G.v[j] * (SC.v[j] + 1.0f) + S.v[j];
        o8[64 * j] = (unsigned long long)pk2(h.x, h.y) | ((unsigned long long)pk2(h.z, h.w) << 32); }
}
__device__ __forceinline__ void rows_first(Frame& F, const float* x, const float* pre_g, const float* mod, int sidx, bf16* H) {
    for (int m = F.gw; m < M; m += F.NGW) { const float* mb = mod + (m >= SEQ ? NMOD : 0);
        const Row16 xr = ld_row(x + (size_t)m * DM, F.lane); const float rstd = rsqrtf(row_ssq(xr) * (1.f / DM) + EPS);
        adaln_store(xr, rstd, pre_g, mb + (sidx + 1) * DM, mb + sidx * DM, H + (size_t)m * DM, F.lane); }
}
template <bool NEXT> __device__ __forceinline__ void rows_res(Frame& F, const float* xin, const float* Dm, const float* post_g, const float* mod, int gidx, float gscale, float* xo,
                                                              const float* pre_g, int sidx, bf16* H) {
    for (int m = F.gw; m < M; m += F.NGW) { const float* mb = mod + (m >= SEQ ? NMOD : 0);
        Row16 xr = ld_row(xin + (size_t)m * DM, F.lane); const Row16 d = ld_row(Dm + (size_t)m * DM, F.lane);
        const float rd = rsqrtf(row_ssq(d) * (1.f / DM) + EPS) * gscale;
        const Row16 PG = ld_row(post_g, F.lane), GT = ld_row(mb + gidx * DM, F.lane);
        GAS f32x4* o = (GAS f32x4*)(xo + (size_t)m * DM) + F.lane;
#pragma unroll
        for (int j = 0; j < 4; ++j) { xr.v[j] = xr.v[j] + GT.v[j] * (d.v[j] * rd * PG.v[j]); o[64 * j] = xr.v[j]; }
        if (NEXT) { const float rstd = rsqrtf(row_ssq(xr) * (1.f / DM) + EPS);
            adaln_store(xr, rstd, pre_g, mb + (sidx + 1) * DM, mb + sidx * DM, H + (size_t)m * DM, F.lane); } }
}
__device__ __forceinline__ void conv_phase(Frame& F, const bf16* XBC, const float* dtraw, const float* conv_w, const float* conv_b, const float* dt_bias, const float* a_log,
                                           bf16* XT, bf16* Bm, bf16* BTm, bf16* Cm, float* DTS, float* AC, float* CDEC) {
    LAS float* raw = (LAS float*)(F.lds + RING_OFF);
    constexpr int NITEM = NBC * 24;
    for (int it = blockIdx.x; it < NITEM + NBC; it += F.G) {
        __syncthreads();
        if (it < NITEM) {
            const int bc = it / 24, blk = it % 24, c = bc % NCHUNK; const size_t t0 = (size_t)bc * 128;
            const int ch0 = blk * 64;
            for (int idx = F.tid; idx < 131 * 8; idx += NWAVES * 64) { const int row = idx >> 3, c8 = idx & 7;
                v4u w = (v4u){0u, 0u, 0u, 0u};
                if (row >= 3 || c > 0) w = *(const GAS v4u*)(XBC + (t0 + row - 3) * 1536 + ch0 + c8 * 8);
                LAS float* d = raw + row * 65 + c8 * 8;
                d[0] = bflo(w.x); d[1] = bfhi(w.x); d[2] = bflo(w.y); d[3] = bfhi(w.y); d[4] = bflo(w.z); d[5] = bfhi(w.z); d[6] = bflo(w.w); d[7] = bfhi(w.w); }
            __syncthreads();
            if (blk < 20) {
                const int p = F.tid >> 3, o = F.tid & 7; const int ch = ch0 + p;
                const float w0 = conv_w[ch], w1 = conv_w[1536 + ch], w2 = conv_w[2 * 1536 + ch], w3 = conv_w[3 * 1536 + ch], cb = conv_b[ch];
                bf16* dst;
                if (blk < 16) dst = XT + (((size_t)bc * 16 + blk) * 64 + p) * 128;
                else { const int bb = blk - 16; dst = BTm + (((size_t)bc * 2 + (bb >> 1)) * 128 + (bb & 1) * 64 + p) * 128; }
#pragma unroll
                for (int oo = 0; oo < 2; ++oo) { const int j0 = 8 * (o + 8 * oo); float a[8];
#pragma unroll
                    for (int jj = 0; jj < 8; ++jj) { const LAS float* r = raw + (j0 + jj) * 65 + p; a[jj] = silu(cb + w0 * r[0] + w1 * r[65] + w2 * r[130] + w3 * r[195]); }
                    v4u w; w.x = pk2(a[0], a[1]); w.y = pk2(a[2], a[3]); w.z = pk2(a[4], a[5]); w.w = pk2(a[6], a[7]);
                    *(GAS v4u*)(dst + j0) = w; }
            }
            if (blk >= 16) {
                const int j = F.tid >> 2, q = F.tid & 3; const int bb = (blk - 16) & 3;
                bf16* dst = (blk < 20 ? Bm : Cm) + (((size_t)bc * 2 + (bb >> 1)) * 128 + j) * 128 + (bb & 1) * 64 + q * 16;
#pragma unroll
                for (int hh = 0; hh < 2; ++hh) { float a[8];
#pragma unroll
                    for (int e = 0; e < 8; ++e) { const int p = q * 16 + hh * 8 + e, ch = ch0 + p; const LAS float* r = raw + j * 65 + p;
                        a[e] = silu(conv_b[ch] + conv_w[ch] * r[0] + conv_w[1536 + ch] * r[65] + conv_w[2 * 1536 + ch] * r[130] + conv_w[3 * 1536 + ch] * r[195]); }
                    v4u w; w.x = pk2(a[0], a[1]); w.y = pk2(a[2], a[3]); w.z = pk2(a[4], a[5]); w.w = pk2(a[6], a[7]);
                    *(GAS v4u*)(dst + hh * 8) = w; }
            }
        } else {
            const int bc = it - NITEM; const size_t t0 = (size_t)bc * 128;
            LAS float* dtl = raw;
            { const int j = F.tid >> 2, h0 = (F.tid & 3) * 4; const f32x4 r = *(const GAS f32x4*)(dtraw + (t0 + j) * 16 + h0);
#pragma unroll
              for (int e = 0; e < 4; ++e) { const float xv = r[e] + dt_bias[h0 + e]; const float dt = xv > 20.f ? xv : log1pf(__expf(xv)); dtl[(h0 + e) * 128 + j] = dt; DTS[((size_t)bc * 16 + h0 + e) * 128 + j] = dt; } }
            __syncthreads();
#pragma unroll
            for (int hh = 0; hh < 2; ++hh) { const int h = 2 * F.wave + hh; const float a = -__expf(a_log[h]);
                const float v0 = dtl[h * 128 + 2 * F.lane] * a, v1 = dtl[h * 128 + 2 * F.lane + 1] * a; const float s = v0 + v1; float inc = s;
#pragma unroll
                for (int o = 1; o < 64; o <<= 1) { const float t = __shfl_up(inc, o); if (F.lane >= o) inc += t; }
                const float ex = inc - s; float* acp = AC + ((size_t)bc * 16 + h) * 128 + 2 * F.lane; acp[0] = ex + v0; acp[1] = ex + v0 + v1;
                if (F.lane == 63) CDEC[bc * 16 + h] = __expf(inc); }
        }
    }
}
__device__ __forceinline__ bf16x8 scale8(v4u w, const float* s) {
    v4u o; o.x = pk2(bflo(w.x) * s[0], bfhi(w.x) * s[1]); o.y = pk2(bflo(w.y) * s[2], bfhi(w.y) * s[3]); o.z = pk2(bflo(w.z) * s[4], bfhi(w.z) * s[5]); o.w = pk2(bflo(w.w) * s[6], bfhi(w.w) * s[7]);
    return __builtin_bit_cast(bf16x8, o); }
__device__ __forceinline__ void ssd_states(Frame& F, const bf16* XT, const bf16* BTm, const float* DTS, const float* AC, bf16* ST) {
    const int r32 = F.lane & 31, hi = F.lane >> 5;
    for (int it = F.gw; it < NBC * 16; it += F.NGW) { const int bc = it >> 4, h = it & 15, g = h >> 3;
        const bf16* xt = XT + (size_t)it * 64 * 128; const bf16* bt = BTm + ((size_t)bc * 2 + g) * 128 * 128;
        const float* dt = DTS + (size_t)it * 128; const float* ac = AC + (size_t)it * 128; const float acl = ac[127];
        f32x16 acc[2][4];
#pragma unroll
        for (int a = 0; a < 2; ++a)
#pragma unroll
            for (int b = 0; b < 4; ++b) acc[a][b] = f32x16{};
#pragma unroll 2
        for (int ks = 0; ks < 8; ++ks) { const int j0 = 16 * ks + 8 * hi; float wv[8];
            { const f32x4 d0 = *(const GAS f32x4*)(dt + j0), d1 = *(const GAS f32x4*)(dt + j0 + 4), a0 = *(const GAS f32x4*)(ac + j0), a1 = *(const GAS f32x4*)(ac + j0 + 4);
#pragma unroll
              for (int e = 0; e < 4; ++e) { wv[e] = d0[e] * __expf(acl - a0[e]); wv[4 + e] = d1[e] * __expf(acl - a1[e]); } }
            bf16x8 af[2], bf[4];
#pragma unroll
            for (int pb = 0; pb < 2; ++pb) af[pb] = scale8(*(const GAS v4u*)(xt + (size_t)(32 * pb + r32) * 128 + j0), wv);
#pragma unroll
            for (int nb = 0; nb < 4; ++nb) bf[nb] = __builtin_bit_cast(bf16x8, *(const GAS v4u*)(bt + (size_t)(32 * nb + r32) * 128 + j0));
#pragma unroll
            for (int pb = 0; pb < 2; ++pb)
#pragma unroll
                for (int nb = 0; nb < 4; ++nb) acc[pb][nb] = MFMA32(af[pb], bf[nb], acc[pb][nb]);
        }
        bf16* st = ST + (size_t)it * 64 * 128;
#pragma unroll
        for (int pb = 0; pb < 2; ++pb)
#pragma unroll
            for (int nb = 0; nb < 4; ++nb)
#pragma unroll
                for (int r = 0; r < 16; ++r) st[(size_t)(32 * pb + crow(r, hi)) * 128 + 32 * nb + r32] = (bf16)f2bf(acc[pb][nb][r]);
    }
}
__device__ __forceinline__ void ssd_scan(Frame& F, bf16* ST, const float* CDEC) {
    constexpr int PER_B = 16 * 64 * 128 / 2;
    for (int T = blockIdx.x * (NWAVES * 64) + F.tid; T < BATCH * PER_B; T += F.G * NWAVES * 64) { const int b = T / PER_B, e = T % PER_B, h = e / (64 * 128 / 2);
        GAS unsigned* p = (GAS unsigned*)ST + (size_t)b * NCHUNK * PER_B + e; unsigned v[NCHUNK];
#pragma unroll
        for (int c = 0; c < NCHUNK; ++c) v[c] = p[(size_t)c * PER_B];
        float r0 = 0.f, r1 = 0.f;
#pragma unroll
        for (int c = 0; c < NCHUNK; ++c) { const float dec = CDEC[(b * NCHUNK + c) * 16 + h]; p[(size_t)c * PER_B] = pk2(r0, r1); r0 = r0 * dec + bflo(v[c]); r1 = r1 * dec + bfhi(v[c]); }
    }
}
__device__ __forceinline__ void ssd_out(Frame& F, const bf16* XT, const bf16* Bm, const bf16* Cm, const bf16* ST, const float* DTS, const float* AC, const bf16* Z,
                                        const float* d_skip, const float* norm_g, bf16* YCAT) {
    LAS float* CBs = (LAS float*)(F.lds + RING_OFF);
    LAS float* acl = CBs + 128 * 132;
    LAS float* dtl = acl + 8 * 128;
    LAS float* red = dtl + 8 * 128;
    LAS float* rsd = red + 8 * 32;
    const int r32 = F.lane & 31, hi = F.lane >> 5, w = F.wave;
    for (int it = blockIdx.x; it < NBC * 2; it += F.G) { const int bc = it >> 1, g = it & 1, h = 8 * g + w; const size_t t0 = (size_t)bc * 128;
        __syncthreads();
        for (int i = F.tid; i < 1024; i += NWAVES * 64) { acl[i] = AC[((size_t)bc * 16 + 8 * g) * 128 + i]; dtl[i] = DTS[((size_t)bc * 16 + 8 * g) * 128 + i]; }
        const bf16* cm = Cm + (size_t)it * 128 * 128; const bf16* bm = Bm + (size_t)it * 128 * 128;
#pragma unroll 1
        for (int tt = 0; tt < 2; ++tt) { const int ib = (2 * w + tt) >> 2, jb = (2 * w + tt) & 3;
            if (jb <= ib) { f32x16 c = f32x16{};
#pragma unroll 2
                for (int ks = 0; ks < 8; ++ks) { const int n0 = 16 * ks + 8 * hi;
                    const bf16x8 a = __builtin_bit_cast(bf16x8, *(const GAS v4u*)(cm + (size_t)(32 * ib + r32) * 128 + n0));
                    const bf16x8 b = __builtin_bit_cast(bf16x8, *(const GAS v4u*)(bm + (size_t)(32 * jb + r32) * 128 + n0));
                    c = MFMA32(a, b, c); }
#pragma unroll
                for (int r = 0; r < 16; ++r) CBs[(32 * ib + crow(r, hi)) * 132 + 32 * jb + r32] = c[r]; } }
        __syncthreads();
        const bf16* xt = XT + ((size_t)bc * 16 + h) * 64 * 128; const bf16* hin = ST + ((size_t)bc * 16 + h) * 64 * 128;
        const LAS float* ach = acl + w * 128; const LAS float* dth = dtl + w * 128;
        const float dsk = d_skip[h]; const float gn0 = norm_g[h * 64 + r32], gn1 = norm_g[h * 64 + 32 + r32];
#pragma unroll 1
        for (int ib = 0; ib < 4; ++ib) { const int i = 32 * ib + r32; const float aci = ach[i];
            f32x16 acc0 = f32x16{}, acc1 = f32x16{};
#pragma unroll 1
            for (int ks = 0; ks < 2 * ib + 2; ++ks) { const int j0 = 16 * ks + 8 * hi; float m[8];
                { const f32x4 c0 = *(const LAS f32x4*)(CBs + i * 132 + j0), c1 = *(const LAS f32x4*)(CBs + i * 132 + j0 + 4);
                  const f32x4 a0 = *(const LAS f32x4*)(ach + j0), a1 = *(const LAS f32x4*)(ach + j0 + 4), d0 = *(const LAS f32x4*)(dth + j0), d1 = *(const LAS f32x4*)(dth + j0 + 4);
#pragma unroll
                  for (int e = 0; e < 4; ++e) { m[e] = (j0 + e <= i) ? c0[e] * __expf(aci - a0[e]) * d0[e] : 0.f; m[4 + e] = (j0 + 4 + e <= i) ? c1[e] * __expf(aci - a1[e]) * d1[e] : 0.f; } }
                v4u pw; pw.x = pk2(m[0], m[1]); pw.y = pk2(m[2], m[3]); pw.z = pk2(m[4], m[5]); pw.w = pk2(m[6], m[7]);
                const bf16x8 af = __builtin_bit_cast(bf16x8, pw);
                const bf16x8 b0 = __builtin_bit_cast(bf16x8, *(const GAS v4u*)(xt + (size_t)r32 * 128 + j0)), b1 = __builtin_bit_cast(bf16x8, *(const GAS v4u*)(xt + (size_t)(32 + r32) * 128 + j0));
                acc0 = MFMA32(af, b0, acc0); acc1 = MFMA32(af, b1, acc1); }
            { const float ei = __expf(aci); float es[8];
#pragma unroll
              for (int e = 0; e < 8; ++e) es[e] = ei;
#pragma unroll 2
              for (int ks = 0; ks < 8; ++ks) { const int n0 = 16 * ks + 8 * hi;
                const bf16x8 af = scale8(*(const GAS v4u*)(cm + (size_t)i * 128 + n0), es);
                const bf16x8 b0 = __builtin_bit_cast(bf16x8, *(const GAS v4u*)(hin + (size_t)r32 * 128 + n0)), b1 = __builtin_bit_cast(bf16x8, *(const GAS v4u*)(hin + (size_t)(32 + r32) * 128 + n0));
                acc0 = MFMA32(af, b0, acc0); acc1 = MFMA32(af, b1, acc1); } }
#pragma unroll
            for (int r4 = 0; r4 < 4; ++r4) { const int il = 8 * r4 + 4 * hi, i0 = 32 * ib + il; float ss[4];
                const v2u xw0 = *(const GAS v2u*)(xt + (size_t)r32 * 128 + i0), xw1 = *(const GAS v2u*)(xt + (size_t)(32 + r32) * 128 + i0);
                const float xv0[4] = {bflo(xw0.x), bfhi(xw0.x), bflo(xw0.y), bfhi(xw0.y)}, xv1[4] = {bflo(xw1.x), bfhi(xw1.x), bflo(xw1.y), bfhi(xw1.y)};
#pragma unroll
                for (int e = 0; e < 4; ++e) { const bf16* zp = Z + (t0 + i0 + e) * 1024 + h * 64 + r32;
                    const float y0 = (acc0[4 * r4 + e] + dsk * xv0[e]) * silu(bf2f(zp[0])), y1 = (acc1[4 * r4 + e] + dsk * xv1[e]) * silu(bf2f(zp[32]));
                    acc0[4 * r4 + e] = y0; acc1[4 * r4 + e] = y1; ss[e] = y0 * y0 + y1 * y1; }
#pragma unroll
                for (int e = 0; e < 4; ++e) { float s = ss[e];
#pragma unroll
                    for (int o = 1; o < 32; o <<= 1) s += __shfl_xor(s, o);
                    if (r32 == 0) red[w * 32 + il + e] = s; } }
            __syncthreads();
            if (F.tid < 32) { float s = 0.f;
#pragma unroll
                for (int ww = 0; ww < 8; ++ww) s += red[ww * 32 + F.tid];
                rsd[F.tid] = rsqrtf(s * (1.f / 512.f) + EPS); }
            __syncthreads();
#pragma unroll
            for (int r = 0; r < 16; ++r) { const int il = crow(r, hi); const float rs = rsd[il]; bf16* yp = YCAT + (t0 + 32 * ib + il) * 2048 + h * 64 + r32;
                yp[0] = (bf16)f2bf(acc0[r] * rs * gn0); yp[32] = (bf16)f2bf(acc1[r] * rs * gn1); }
        }
    }
}
__device__ __forceinline__ void attn_subln(Frame& F, bf16* YCAT, const float* subln_g) {
    const int d0 = (F.lane & 7) * 16; float gq[16];
#pragma unroll
    for (int e = 0; e < 16; ++e) gq[e] = subln_g[d0 + e] * (1.0f - LAM_INIT);
    for (int m = F.gw; m < M; m += F.NGW) { GAS v4u* p = (GAS v4u*)(YCAT + (size_t)m * 2048 + 1024 + F.lane * 16);
        const v4u a = p[0], b = p[1]; float v[16] = {bflo(a.x), bfhi(a.x), bflo(a.y), bfhi(a.y), bflo(a.z), bfhi(a.z), bflo(a.w), bfhi(a.w), bflo(b.x), bfhi(b.x), bflo(b.y), bfhi(b.y), bflo(b.z), bfhi(b.z), bflo(b.w), bfhi(b.w)};
        float s = 0.f;
#pragma unroll
        for (int e = 0; e < 16; ++e) s += v[e] * v[e];
        s += __shfl_xor(s, 1); s += __shfl_xor(s, 2); s += __shfl_xor(s, 4);
        const float rs = rsqrtf(s * (1.f / 128.f) + EPS);
#pragma unroll
        for (int e = 0; e < 16; ++e) v[e] *= rs * gq[e];
        v4u oa, ob; oa.x = pk2(v[0], v[1]); oa.y = pk2(v[2], v[3]); oa.z = pk2(v[4], v[5]); oa.w = pk2(v[6], v[7]); ob.x = pk2(v[8], v[9]); ob.y = pk2(v[10], v[11]); ob.z = pk2(v[12], v[13]); ob.w = pk2(v[14], v[15]);
        p[0] = oa; p[1] = ob; }
}
#ifndef MK_PER_PHASE
#define MK_PER_PHASE 1
#endif
#ifndef MK_CG_SYNC
#define MK_CG_SYNC 1
#endif
constexpr int N_PHASES = 17;
struct Args { const float* in[30]; float* out; unsigned char* ws; int ph_lo, ph_hi; };
enum InIdx { I_X = 0, I_C, I_WADA, I_BADA, I_F1PRE, I_F1POST, I_F1WG, I_F1WU, I_F1WD, I_MPRE, I_MPOST, I_WIN, I_CONVW, I_CONVB, I_DTB, I_ALOG, I_DSKIP, I_SSDG,
             I_LQ1, I_LK1, I_LQ2, I_LK2, I_SUBLN, I_WOUT, I_F2PRE, I_F2POST, I_F2WG, I_F2WU, I_F2WD, I_RELB };

__global__ void __launch_bounds__(NWAVES * 64, 2) layer_fwd(Args args) {
    extern __shared__ __attribute__((aligned(16))) unsigned char lds[];
    Frame F;
    F.lds = (LAS unsigned char*)lds;
    F.tid = threadIdx.x; F.lane = F.tid & 63; F.wave = __builtin_amdgcn_readfirstlane(F.tid >> 6);
    F.G = gridDim.x; { const int bx = blockIdx.x; F.vcu = (F.G % 8 == 0) ? (bx % 8) * (F.G / 8) + bx / 8 : bx; }
    F.gw = F.vcu * NWAVES + F.wave; F.NGW = F.G * NWAVES;
    unsigned char* ws = args.ws;
#define MOD ((float*)(ws + WS_MOD))
#define DTRAW ((float*)(ws + WS_DTRAW))
#define DTS ((float*)(ws + WS_DTS))
#define ACm ((float*)(ws + WS_AC))
#define CDEC ((float*)(ws + WS_CDEC))
#define WA ((bf16*)(ws + WS_WA))
#define WB ((bf16*)(ws + WS_WB))
#define H ((bf16*)(ws + WS_H))
#define ACT ((bf16*)(ws + WS_ACT))
#define Dm ((float*)(ws + WS_D))
#define Qb ((bf16*)(ws + WS_Q))
#define Kb ((bf16*)(ws + WS_K))
#define Vb ((bf16*)(ws + WS_V))
#define YCAT ((bf16*)(ws + WS_YCAT))
#define Zb ((bf16*)(ws + WS_Z))
#define XBC ((bf16*)(ws + WS_XBC))
#define XT ((bf16*)(ws + WS_XT))
#define Bm ((bf16*)(ws + WS_BM))
#define BTm ((bf16*)(ws + WS_BT))
#define Cm ((bf16*)(ws + WS_CM))
#define ST ((bf16*)(ws + WS_ST))
#define D2 ((float*)(ws + WS_D2))
    float* out = args.out;
#if MK_CG_SYNC
    cg::grid_group grid = cg::this_grid();
#define GRID_BAR() grid.sync()
#else
    for (int u = F.tid; u < (LDS_BYTES - LDSCTL_OFF) / 4; u += NWAVES * 64) ((LAS unsigned*)(F.lds + LDSCTL_OFF))[u] = 0u;
    __syncthreads();
    XcdBarrier bar = xcd_barrier_post((unsigned*)(ws + WS_CTL) + CW_BAR, (volatile LAS unsigned*)(F.lds + MISC_OFF) + 8);
#define GRID_BAR() xcd_barrier(bar)
#endif
    const int lo = args.ph_lo, hi = args.ph_hi;
#ifndef PH_MASK
#define PH_MASK 0x1FFFF
#endif
#define IN(k) (((PH_MASK >> (k)) & 1) && lo <= (k) && (k) < hi)
#define SEAM(k) do { if (IN(k) && IN((k) + 1)) GRID_BAR(); } while (0)

    if (IN(0)) { convert_ffn(F, args.in[I_F1WG], args.in[I_F1WU], args.in[I_F1WD], WA, WB); mod_gemv(F, args.in[I_C], args.in[I_WADA], args.in[I_BADA], MOD); }
    SEAM(0);
    if (IN(1)) rows_first(F, args.in[I_X], args.in[I_F1PRE], MOD, 0, H);
    SEAM(1);
    if (IN(2)) { pg8::Gemm g{H, WA, M, NGU, DM}; pg8::StaticOrder S; S.init(M, NGU, F.G, (int)blockIdx.x); pg8::EpiSwiglu E{ACT, DFF};
        pg8::gemm_phase<pg8::EpiSwiglu, pg8::StaticOrder, true, true>(F.lds + RING_OFF, g, S, E); }
    SEAM(2);
    if (IN(3)) { pg8::Gemm g{ACT, WB, M, DM, DFF}; pg8::StaticOrder S; S.init(M, DM, F.G, (int)blockIdx.x); pg8::EpiF32 E{Dm, DM};
        pg8::gemm_phase<pg8::EpiF32, pg8::StaticOrder, true, true>(F.lds + RING_OFF, g, S, E); }
    SEAM(3);
    if (IN(4)) { rows_res<true>(F, args.in[I_X], Dm, args.in[I_F1POST], MOD, 2, 0.5f, out, args.in[I_MPRE], 3, H); convert_mix(F, args.in[I_WIN], args.in[I_WOUT], WA, WB); }
    SEAM(4);
    if (IN(5)) { pg8::Gemm g{H, WA, M, NQKV, DM}; pg8::StaticOrder S; S.init(M, NQKV, F.G, (int)blockIdx.x);
        pg8::EpiBf16<0> E{Qb, DM, nullptr, DM, (size_t)(WS_K - WS_Q) / 2, attn_body::C2};
        pg8::gemm_phase<pg8::EpiBf16<0>, pg8::StaticOrder, true, true>(F.lds + RING_OFF, g, S, E); }
    SEAM(5);
    if (IN(6)) {
        float lam;
        { const float q1 = args.in[I_LQ1][F.lane] * args.in[I_LK1][F.lane], q2 = args.in[I_LQ2][F.lane] * args.in[I_LK2][F.lane];
          lam = __expf(wave_sum(q1)) - __expf(wave_sum(q2)) + LAM_INIT; lam = __builtin_bit_cast(float, __builtin_amdgcn_readfirstlane(__builtin_bit_cast(int, lam))); }
        const attn_body::AttnTensors AT{(const attn_body::bf16*)Qb, (const attn_body::bf16*)Kb, (const attn_body::bf16*)Vb, (attn_body::bf16*)YCAT, lam, args.in[I_RELB]};
        const attn_body::StaticOrder S((int)F.G, (int)blockIdx.x);
        attn_body::attn_phase<attn_body::StaticOrder>((char*)lds + RING_OFF, AT, S);
    }
    SEAM(6);
    if (IN(7)) { pg8::Gemm g{H, WA + (size_t)NQKV * DM, M, NMIX, DM}; pg8::StaticOrder S; S.init(M, NMIX, F.G, (int)blockIdx.x); pg8::EpiMix E{Zb, XBC, DTRAW};
        pg8::gemm_phase<pg8::EpiMix, pg8::StaticOrder, true, true>(F.lds + RING_OFF, g, S, E); }
    SEAM(7);
    if (IN(8)) conv_phase(F, XBC, DTRAW, args.in[I_CONVW], args.in[I_CONVB], args.in[I_DTB], args.in[I_ALOG], XT, Bm, BTm, Cm, DTS, ACm, CDEC);
    SEAM(8);
    if (IN(9)) ssd_states(F, XT, BTm, DTS, ACm, ST);
    SEAM(9);
    if (IN(10)) ssd_scan(F, ST, CDEC);
    SEAM(10);
    if (IN(11)) { ssd_out(F, XT, Bm, Cm, ST, DTS, ACm, Zb, args.in[I_DSKIP], args.in[I_SSDG], YCAT); attn_subln(F, YCAT, args.in[I_SUBLN]); }
    SEAM(11);
    if (IN(12)) { pg8::Gemm g{YCAT, WB, M, DM, KOUT}; pg8::StaticOrder S; S.init(M, DM, F.G, (int)blockIdx.x); pg8::EpiF32 E{D2, DM};
        pg8::gemm_phase<pg8::EpiF32, pg8::StaticOrder, true, true>(F.lds + RING_OFF, g, S, E); }
    SEAM(12);
    if (IN(13)) { rows_res<true>(F, out, D2, args.in[I_MPOST], MOD, 5, 1.0f, out, args.in[I_F2PRE], 6, H); convert_ffn(F, args.in[I_F2WG], args.in[I_F2WU], args.in[I_F2WD], WA, WB); }
    SEAM(13);
    if (IN(14)) { pg8::Gemm g{H, WA, M, NGU, DM}; pg8::StaticOrder S; S.init(M, NGU, F.G, (int)blockIdx.x); pg8::EpiSwiglu E{ACT, DFF};
        pg8::gemm_phase<pg8::EpiSwiglu, pg8::StaticOrder, true, true>(F.lds + RING_OFF, g, S, E); }
    SEAM(14);
    if (IN(15)) { pg8::Gemm g{ACT, WB, M, DM, DFF}; pg8::StaticOrder S; S.init(M, DM, F.G, (int)blockIdx.x); pg8::EpiF32 E{Dm, DM};
        pg8::gemm_phase<pg8::EpiF32, pg8::StaticOrder, true, true>(F.lds + RING_OFF, g, S, E); }
    SEAM(15);
    if (IN(16)) rows_res<false>(F, out, Dm, args.in[I_F2POST], MOD, 8, 0.5f, out, nullptr, 0, nullptr);
#undef IN
#undef SEAM
}

extern "C" void kernel_launch(void* const* d_in, const int* in_sizes, int n_in, void* d_out, int out_size, void* d_ws, size_t ws_size, hipStream_t stream) {
    static int grid = 0;
    if (grid == 0) {
        if (n_in != 30 || in_sizes[0] != M * DM || out_size != M * DM || ws_size < WS_END) { fprintf(stderr, "kernel_launch: unexpected shapes (n_in %d, in0 %d, out %d, ws %zu); nothing launched\n", n_in, n_in > 0 ? in_sizes[0] : -1, out_size, ws_size); grid = -1; return; }
        int dev = 0, cus = 0, per_cu = 0;
        if (hipGetDevice(&dev) != hipSuccess || hipDeviceGetAttribute(&cus, hipDeviceAttributeMultiprocessorCount, dev) != hipSuccess) { grid = -1; return; }
        if (hipFuncSetAttribute((const void*)layer_fwd, hipFuncAttributeMaxDynamicSharedMemorySize, LDS_BYTES) != hipSuccess) { fprintf(stderr, "kernel_launch: hipFuncSetAttribute failed\n"); grid = -1; return; }
        if (hipOccupancyMaxActiveBlocksPerMultiprocessor(&per_cu, (const void*)layer_fwd, NWAVES * 64, LDS_BYTES) != hipSuccess || per_cu < 1) { fprintf(stderr, "kernel_launch: occupancy query says %d blocks per CU\n", per_cu); per_cu = 1; }
        (void)hipGetLastError();
        grid = cus;
        if (grid % 8 != 0 || grid > 256) fprintf(stderr, "kernel_launch: note: %d CUs\n", grid);
    }
    if (grid < 0) return;
    (void)hipMemsetAsync((char*)d_ws + WS_CTL, 0, CTL_ZERO_BYTES, stream);
    Args a{};
    for (int i = 0; i < 30; ++i) a.in[i] = (const float*)d_in[i];
    a.out = (float*)d_out; a.ws = (unsigned char*)d_ws;
#if MK_PER_PHASE
    for (int p = 0; p < N_PHASES; ++p) { a.ph_lo = p; a.ph_hi = p + 1; void* kargs[] = {&a};
        hipError_t e = hipLaunchCooperativeKernel((const void*)layer_fwd, dim3(grid), dim3(NWAVES * 64), kargs, LDS_BYTES, stream);
        if (e != hipSuccess) { fprintf(stderr, "kernel_launch: phase %d launch failed: %s\n", p, hipGetErrorString(e)); break; } }
#else
    a.ph_lo = 0; a.ph_hi = N_PHASES; void* kargs[] = {&a};
    hipError_t e = hipLaunchCooperativeKernel((const void*)layer_fwd, dim3(grid), dim3(NWAVES * 64), kargs, LDS_BYTES, stream);
    if (e != hipSuccess) fprintf(stderr, "kernel_launch: cooperative launch failed: %s (grid %d)\n", hipGetErrorString(e), grid);
#endif
}
```

```cpp
#include <hip/hip_runtime.h>
#include <hip/hip_cooperative_groups.h>
#include <hip/hip_bf16.h>
#include <cstdio>
#include <cstdint>
#include <cmath>
namespace cg = cooperative_groups;
namespace pg8 {
#define PG8_LAS __attribute__((address_space(3)))
typedef unsigned short bf16_t;
typedef short bf16x8 __attribute__((ext_vector_type(8)));
typedef float f32x4 __attribute__((ext_vector_type(4)));
typedef unsigned u32x4 __attribute__((ext_vector_type(4)));
constexpr int BM = 256, BK = 64, HALF = 128, HTB = HALF * BK * 2  , STAGE_BYTES = 8 * HTB, NXCD = 8, WGM = 8;

__host__ __device__ __forceinline__ int lds_byte(int r, int c) { const int st = (r >> 4) * 2 + (c >> 5), rr = r & 15, cc = c & 31, ob = rr * 64 + cc * 2; return st * 1024 + (ob ^ (((ob >> 9) & 1) << 5)); }
__host__ __device__ __forceinline__ void stage_rc(int b, int& R, int& C) { const int st = b / 1024, sb = b % 1024, swz = sb ^ (((sb >> 9) & 1) << 5); R = (st >> 1) * 16 + swz / 64; C = (st & 1) * 32 + (swz % 64) / 2; }
__host__ __device__ __forceinline__ int perm32(int rho) { const int n = rho >> 4, i = rho & 15; return 8 * (i >> 2) + 4 * n + (i & 3); }

struct Unit { int pm, pn; };
struct Gemm { const bf16_t* A; const bf16_t* Bt; int M, N, K; };

struct StaticOrder {
    int nM, nN, nwg, G, c;
    __host__ __device__ void init(int M, int N, int G_, int c_) { nM = M / BM; nN = N / BM; nwg = nM * nN; G = G_; c = c_; }
    __host__ __device__ bool next(int i, Unit& u) const {
        const long L = (long)i * G + c; if (L >= nwg) return false;
        int wgid = (int)L; { const int q = nwg / NXCD, r = nwg % NXCD, xcd = wgid % NXCD, off = wgid / NXCD; wgid = (xcd < r ? xcd * (q + 1) : r * (q + 1) + (xcd - r) * q) + off; }
        const int nig = WGM * nN, gid = wgid / nig, fm = gid * WGM, gsz = (nM - fm) < WGM ? (nM - fm) : WGM;
        u.pm = fm + ((wgid % nig) % gsz); u.pn = (wgid % nig) / gsz; return true;
    }
    __device__ __forceinline__ void a_ready(const Unit&) const {}
    __device__ __forceinline__ void done(const Unit&) const {}
};

__device__ __forceinline__ unsigned cvt_pk_bf16(float lo, float hi) { unsigned r; asm volatile("v_cvt_pk_bf16_f32 %0, %1, %2" : "=v"(r) : "v"(lo), "v"(hi)); return r; }
typedef float f32x2 __attribute__((ext_vector_type(2)));
__device__ __forceinline__ f32x2 gelu_pk(f32x2 v) {
    const f32x2 av = __builtin_elementwise_abs(v), d = av * 0.2316418882f + 1.0f;
    f32x2 t; t.x = __builtin_amdgcn_rcpf(d.x); t.y = __builtin_amdgcn_rcpf(d.y);
    f32x2 q = t * 0.5307027145f + (-0.7265760135f); q = q * t + 0.7107068705f; q = q * t + (-0.142248368f); q = q * t + 0.127414796f; q = q * t;
    const f32x2 s = (v * v) * (-0.72134752044f);
    f32x2 e; e.x = __builtin_amdgcn_exp2f(s.x); e.y = __builtin_amdgcn_exp2f(s.y);
    const f32x2 m = v * (q * e), r = v - m;
    f32x2 o; o.x = v.x < 0.f ? m.x : r.x; o.y = v.y < 0.f ? m.y : r.y; return o;
}

template <int ACT  > struct EpiBf16 {
    static constexpr bool PERM = true, AFTER_DRAIN = false; static_assert(ACT == 0 || ACT == 1, "EpiBf16: ACT is 0 (none) or 1 (gelu_pk)");
    bf16_t* O; int ldc; const float* bias; int split_cols; size_t split_stride; float scale0;
    __device__ __forceinline__ void operator()(const f32x4 (&acc)[2][2][4][2], const Unit& u, int wr, int wc, int fr, int fq) const {
        const int row0 = u.pm * BM + wr * 64 + fr; int colt = u.pn * BM; bf16_t* base = O;
        float sc = 1.f; if (split_cols) { const int t = colt / split_cols; base += (size_t)t * split_stride; colt -= t * split_cols; if (t == 0) sc = scale0; }
        const int col0 = colt + wc * 32 + 8 * fq, bcol0 = u.pn * BM + wc * 32 + 8 * fq;
        f32x4 bv[2][2];
#pragma unroll
        for (int bj = 0; bj < 2; ++bj)
#pragma unroll
            for (int n = 0; n < 2; ++n) bv[bj][n] = bias ? *(const f32x4*)(bias + bcol0 + bj * HALF + 4 * n) : (f32x4){0.f, 0.f, 0.f, 0.f};
#pragma unroll
        for (int ai = 0; ai < 2; ++ai)
#pragma unroll
            for (int m = 0; m < 4; ++m) { bf16_t* rowp = base + (size_t)(row0 + ai * HALF + m * 16) * ldc + col0;
#pragma unroll
                for (int bj = 0; bj < 2; ++bj) { f32x4 v0 = acc[ai][bj][m][0] + bv[bj][0], v1 = acc[ai][bj][m][1] + bv[bj][1];
                    if (ACT == 1) { f32x2 a = gelu_pk((f32x2){v0[0], v0[1]}), b = gelu_pk((f32x2){v0[2], v0[3]}), c = gelu_pk((f32x2){v1[0], v1[1]}), d = gelu_pk((f32x2){v1[2], v1[3]});
                        v0 = (f32x4){a.x, a.y, b.x, b.y}; v1 = (f32x4){c.x, c.y, d.x, d.y}; }
                    v0 = v0 * sc; v1 = v1 * sc; u32x4 w; w.x = cvt_pk_bf16(v0[0], v0[1]); w.y = cvt_pk_bf16(v0[2], v0[3]); w.z = cvt_pk_bf16(v1[0], v1[1]); w.w = cvt_pk_bf16(v1[2], v1[3]);
                    *(u32x4*)(rowp + bj * HALF) = w; } }
    }
};

struct PanelStats {
    unsigned* xbuf;
    unsigned* cnt;
    unsigned* tmo;
    int ntn; float eps;
    unsigned code;
    __device__ __forceinline__ bool run(const f32x4 (&v)[2][2][4][2], const Unit& u, int wr, int wc, int fr, int fq, PG8_LAS unsigned char* lds, int wid, int lane) const {
        typedef float f32x2v __attribute__((ext_vector_type(2)));
        PG8_LAS f32x2v* P = (PG8_LAS f32x2v*)lds;
        PG8_LAS f32x2v* S = (PG8_LAS f32x2v*)(lds + 8192);
        PG8_LAS unsigned* flag = (PG8_LAS unsigned*)(lds + 8192 + 2048);
#pragma unroll
        for (int ai = 0; ai < 2; ++ai)
#pragma unroll
            for (int m = 0; m < 4; ++m) {
                float s = 0.f;
#pragma unroll
                for (int bj = 0; bj < 2; ++bj)
#pragma unroll
                    for (int n = 0; n < 2; ++n) { const f32x4 x = v[ai][bj][m][n]; s += (x[0] + x[1]) + (x[2] + x[3]); }
                s += __shfl_xor(s, 16); s += __shfl_xor(s, 32);
                const float mw = s * (1.0f / 64.0f); float q = 0.f;
#pragma unroll
                for (int bj = 0; bj < 2; ++bj)
#pragma unroll
                    for (int n = 0; n < 2; ++n) { const f32x4 d = v[ai][bj][m][n] - mw; q += (d[0] * d[0] + d[1] * d[1]) + (d[2] * d[2] + d[3] * d[3]); }
                q += __shfl_xor(q, 16); q += __shfl_xor(q, 32);
                if (fq == 0) P[(ai * HALF + wr * 64 + m * 16 + fr) * 4 + wc] = (f32x2v){mw, q};
            }
        asm volatile("s_waitcnt lgkmcnt(0)" ::: "memory"); __builtin_amdgcn_s_barrier(); asm volatile("" ::: "memory");
#if defined(BROKEN_EXCHANGE_NO_WAIT)
#warning BROKEN CONTROL BUILD: the row-statistics exchange does not wait; results are wrong by design
        if (blockIdx.x >= 64) { const long long t0_ = clock64(); while (clock64() - t0_ < 60000) __builtin_amdgcn_s_sleep(8); }
#endif
        const int row = wid * 32 + (lane & 31);
        if (lane < 32) {
            const f32x2v a = P[row * 4 + 0], b = P[row * 4 + 1], c = P[row * 4 + 2], d = P[row * 4 + 3];
            const float mt = (a.x + b.x + c.x + d.x) * 0.25f;
            const float da = a.x - mt, db = b.x - mt, dc = c.x - mt, dd = d.x - mt;
            const float m2 = (a.y + b.y) + (c.y + d.y) + 64.0f * ((da * da + db * db) + (dc * dc + dd * dd));
            unsigned long long* slot = (unsigned long long*)xbuf + ((size_t)(u.pm * BM + row) * 4 + u.pn);
            __hip_atomic_store(slot, ((unsigned long long)__float_as_uint(m2) << 32) | __float_as_uint(mt), __ATOMIC_RELAXED, __HIP_MEMORY_SCOPE_AGENT);
        }
        asm volatile("s_waitcnt vmcnt(0)" ::: "memory");
        if (lane == 0) __hip_atomic_fetch_add(cnt + 64 * u.pm, 1u, __ATOMIC_RELAXED, __HIP_MEMORY_SCOPE_AGENT);
        if (wid == 0) {
            bool dead = false; const unsigned long long t0 = __builtin_amdgcn_s_memrealtime(); const unsigned want = 8u * (unsigned)ntn;
            for (;;) {
#if defined(BROKEN_EXCHANGE_NO_WAIT)
                break;
#endif
                if ((unsigned)__builtin_amdgcn_readfirstlane(__hip_atomic_load(cnt + 64 * u.pm, __ATOMIC_RELAXED, __HIP_MEMORY_SCOPE_AGENT)) >= want) break;
                if (__builtin_amdgcn_s_memrealtime() - t0 > 2000000ull) {
                    if (lane == 0) { unsigned expect = 0u; __hip_atomic_compare_exchange_strong(tmo + 1, &expect, code | (unsigned)(u.pm & 0xff), __ATOMIC_RELAXED, __ATOMIC_RELAXED, __HIP_MEMORY_SCOPE_AGENT);
                                     __hip_atomic_store(tmo, 1u, __ATOMIC_RELAXED, __HIP_MEMORY_SCOPE_AGENT); }
                    dead = true; break; }
                __builtin_amdgcn_s_sleep(2);
            }
            __builtin_amdgcn_fence(__ATOMIC_ACQUIRE, "agent");
            if (lane == 0) flag[0] = dead ? 1u : 0u;
        }
        asm volatile("s_waitcnt vmcnt(0) lgkmcnt(0)" ::: "memory"); __builtin_amdgcn_s_barrier(); asm volatile("" ::: "memory");
        const bool bad = flag[0] != 0u;
        if (lane < 32) {
            const unsigned long long* slot = (const unsigned long long*)xbuf + (size_t)(u.pm * BM + row) * 4; float mt[4], m2[4]; float ms = 0.f;
#pragma unroll
            for (int t = 0; t < 4; ++t) { if (t < ntn) { const unsigned long long w = __hip_atomic_load(slot + t, __ATOMIC_RELAXED, __HIP_MEMORY_SCOPE_AGENT); mt[t] = __uint_as_float((unsigned)w); m2[t] = __uint_as_float((unsigned)(w >> 32)); } else { mt[t] = 0.f; m2[t] = 0.f; } ms += mt[t]; }
            const float mean = ms / (float)ntn; float q = 0.f;
#pragma unroll
            for (int t = 0; t < 4; ++t) if (t < ntn) { const float dm = mt[t] - mean; q += m2[t] + 256.0f * dm * dm; }
            S[row] = (f32x2v){mean, 1.0f / sqrtf(q / (256.0f * (float)ntn) + eps)};
        }
        asm volatile("s_waitcnt lgkmcnt(0)" ::: "memory"); __builtin_amdgcn_s_barrier(); asm volatile("" ::: "memory");
        return bad;
    }
};
struct EpiLnRes {
    static constexpr bool PERM = false, AFTER_DRAIN = true;
    const float* base; float* out; int ldc; const float* bias; PanelStats st; unsigned poison;
    __device__ __forceinline__ void fused(f32x4 (&acc)[2][2][4][2], const Unit& u, int wr, int wc, int fr, int fq, PG8_LAS unsigned char* lds, int wid, int lane) const {
        typedef float f32x2v __attribute__((ext_vector_type(2)));
        const PG8_LAS f32x2v* S = (const PG8_LAS f32x2v*)(lds + 8192);
        const int col0 = u.pn * BM + wc * 32 + 4 * fq;
#pragma unroll
        for (int bj = 0; bj < 2; ++bj)
#pragma unroll
            for (int n = 0; n < 2; ++n) { const f32x4 bv = bias ? *(const f32x4*)(bias + col0 + bj * HALF + n * 16) : (f32x4){0.f, 0.f, 0.f, 0.f};
#pragma unroll
                for (int ai = 0; ai < 2; ++ai)
#pragma unroll
                    for (int m = 0; m < 4; ++m) acc[ai][bj][m][n] += bv; }
        f32x4 pre[4][2][2];
#pragma unroll
        for (int m = 0; m < 4; ++m) { const size_t off = (size_t)(u.pm * BM + wr * 64 + m * 16 + fr) * ldc + col0;
#pragma unroll
            for (int bj = 0; bj < 2; ++bj)
#pragma unroll
                for (int n = 0; n < 2; ++n) pre[m][bj][n] = *(const f32x4*)(base + off + bj * HALF + n * 16); }
        const bool bad = st.run(acc, u, wr, wc, fr, fq, lds, wid, lane) || poison != 0u;
        const float qnan = __builtin_nanf("");
#pragma unroll
        for (int ai = 0; ai < 2; ++ai)
#pragma unroll
            for (int m = 0; m < 4; ++m) { const int r = ai * HALF + wr * 64 + m * 16 + fr; const f32x2v sr = S[r]; const size_t off = (size_t)(u.pm * BM + r) * ldc + col0;
#pragma unroll
                for (int bj = 0; bj < 2; ++bj)
#pragma unroll
                    for (int n = 0; n < 2; ++n) { const f32x4 bs = ai == 0 ? pre[m][bj][n] : *(const f32x4*)(base + off + bj * HALF + n * 16); f32x4 o = bs + (acc[ai][bj][m][n] - sr.x) * sr.y;
                        if (bad) o = (f32x4){qnan, qnan, qnan, qnan}; *(f32x4*)(out + off + bj * HALF + n * 16) = o; }
                if (m & 1) asm volatile("" ::: "memory"); }
    }
};
struct EpiLnResLn {
    static constexpr bool PERM = false, AFTER_DRAIN = true;
    const float* base; float* out; bf16_t* xn; int ldc; const float* bias; PanelStats st1, st2; unsigned poison;
    __device__ __forceinline__ void fused(f32x4 (&acc)[2][2][4][2], const Unit& u, int wr, int wc, int fr, int fq, PG8_LAS unsigned char* lds, int wid, int lane) const {
        typedef float f32x2v __attribute__((ext_vector_type(2))); typedef unsigned u32x2v __attribute__((ext_vector_type(2)));
        const PG8_LAS f32x2v* S = (const PG8_LAS f32x2v*)(lds + 8192);
        const int col0 = u.pn * BM + wc * 32 + 4 * fq;
#pragma unroll
        for (int bj = 0; bj < 2; ++bj)
#pragma unroll
            for (int n = 0; n < 2; ++n) { const f32x4 bv = bias ? *(const f32x4*)(bias + col0 + bj * HALF + n * 16) : (f32x4){0.f, 0.f, 0.f, 0.f};
#pragma unroll
                for (int ai = 0; ai < 2; ++ai)
#pragma unroll
                    for (int m = 0; m < 4; ++m) acc[ai][bj][m][n] += bv; }
        bool bad = st1.run(acc, u, wr, wc, fr, fq, lds, wid, lane) || poison != 0u;
        const float qnan = __builtin_nanf("");
#pragma unroll
        for (int ai = 0; ai < 2; ++ai)
#pragma unroll
            for (int m = 0; m < 4; ++m) { const int r = ai * HALF + wr * 64 + m * 16 + fr; const f32x2v sr = S[r]; const size_t off = (size_t)(u.pm * BM + r) * ldc + col0;
#pragma unroll
                for (int bj = 0; bj < 2; ++bj)
#pragma unroll
                    for (int n = 0; n < 2; ++n) { const f32x4 bs = *(const f32x4*)(base + off + bj * HALF + n * 16); acc[ai][bj][m][n] = bs + (acc[ai][bj][m][n] - sr.x) * sr.y; }
                asm volatile("" : "+v"(acc[ai][0][m][0]), "+v"(acc[ai][0][m][1]), "+v"(acc[ai][1][m][0]), "+v"(acc[ai][1][m][1]));
                if (m & 1) asm volatile("" ::: "memory"); }
        const bool bad1 = bad;
        bad = st2.run(acc, u, wr, wc, fr, fq, lds, wid, lane) || bad;
#pragma unroll
        for (int ai = 0; ai < 2; ++ai)
#pragma unroll
            for (int m = 0; m < 4; ++m) { const int r = ai * HALF + wr * 64 + m * 16 + fr; const f32x2v sr = S[r]; const size_t off = (size_t)(u.pm * BM + r) * ldc + col0;
#pragma unroll
                for (int bj = 0; bj < 2; ++bj)
#pragma unroll
                    for (int n = 0; n < 2; ++n) { const f32x4 x1 = acc[ai][bj][m][n]; *(f32x4*)(out + off + bj * HALF + n * 16) = bad1 ? (f32x4){qnan, qnan, qnan, qnan} : x1;
                        const f32x4 o = (x1 - sr.x) * sr.y; u32x2v w; w.x = cvt_pk_bf16(o[0], o[1]); w.y = cvt_pk_bf16(o[2], o[3]);
                        if (bad) { w.x = 0x7fc07fc0u; w.y = 0x7fc07fc0u; } *(u32x2v*)(xn + off + bj * HALF + n * 16) = w; }
                asm volatile("" ::: "memory"); }
    }
};

template <class Epi, class Sched, bool ALIGN_EPI = false, bool SP2 = false>
__device__ __forceinline__ void gemm_phase(PG8_LAS unsigned char* lds, const Gemm g, const Sched& S, const Epi& E) {
    const int tid = threadIdx.x, wid = __builtin_amdgcn_readfirstlane(tid >> 6), lane = tid & 63, wr = wid >> 2, wc = wid & 3, fr = lane & 15, fq = lane >> 4;
    const int K = g.K, nt = K / BK;
    unsigned voffA[2], voffB[2];
#pragma unroll
    for (int i = 0; i < 2; ++i) { int R, C; stage_rc(tid * 16 + i * 8192, R, C); const int Rb = Epi::PERM ? ((R & ~31) + perm32(R & 31)) : R;
        voffA[i] = (unsigned)(R * K + C) * 2u; voffB[i] = (unsigned)(Rb * K + C) * 2u; }
    const size_t kstep = (size_t)(BK * 2);
    const size_t hstep = (size_t)HALF * K * 2;
    const size_t tstep = 2 * hstep;
    const unsigned ldsw = (unsigned)wid * 1024u;
    const int aoff = lds_byte(wr * 64 + fr, fq * 8), boff = lds_byte(wc * 32 + fr, fq * 8);
#define PG8_SA(b, h) (((b) * 2 + (h)) * HTB)
#define PG8_SB(b, h) ((4 + (b) * 2 + (h)) * HTB)
#define PG8_STAGE(bufoff, gbase, voff) do { _Pragma("unroll") for (int _i = 0; _i < 2; ++_i) \
        __builtin_amdgcn_global_load_lds((const unsigned*)((const char*)(gbase) + (voff)[_i]), (PG8_LAS unsigned*)(lds + (bufoff) + ldsw + _i * 8192), 16, 0, 0); } while (0)
#define PG8_LDA(dst, b, h) do { _Pragma("unroll") for (int m = 0; m < 4; ++m) _Pragma("unroll") for (int k = 0; k < 2; ++k) dst[m][k] = *(const PG8_LAS bf16x8*)(lds + PG8_SA(b, h) + aoff + m * 2048 + k * 1024); } while (0)
#define PG8_LDB(dst, b, h) do { _Pragma("unroll") for (int n = 0; n < 2; ++n) _Pragma("unroll") for (int k = 0; k < 2; ++k) dst[n][k] = *(const PG8_LAS bf16x8*)(lds + PG8_SB(b, h) + boff + n * 2048 + k * 1024); } while (0)
#define PG8_MMA(ai, bj, At, Bt) do { __builtin_amdgcn_s_setprio(1); _Pragma("unroll") for (int m = 0; m < 4; ++m) _Pragma("unroll") for (int n = 0; n < 2; ++n) _Pragma("unroll") for (int k = 0; k < 2; ++k) \
        acc[ai][bj][m][n] = __builtin_amdgcn_mfma_f32_16x16x32_bf16(Bt[n][k], At[m][k], acc[ai][bj][m][n], 0, 0, 0); __builtin_amdgcn_s_setprio(0); } while (0)
#define PG8_WAIT_V(n) asm volatile("s_waitcnt vmcnt(" #n ")" ::: "memory")
#define PG8_WAIT_L(n) asm volatile("s_waitcnt lgkmcnt(" #n ")" ::: "memory")
#define PG8_BAR __builtin_amdgcn_s_barrier()
#define PG8_SCHED __builtin_amdgcn_sched_barrier(0)
    Unit cur, nxt; int ui = 0;
    if (!S.next(0, cur)) return;
    f32x4 acc[2][2][4][2];
#pragma unroll
    for (int a = 0; a < 2; ++a)
#pragma unroll
        for (int b = 0; b < 2; ++b)
#pragma unroll
            for (int m = 0; m < 4; ++m)
#pragma unroll
                for (int n = 0; n < 2; ++n) acc[a][b][m][n] = (f32x4){0.f, 0.f, 0.f, 0.f};
    bf16x8 At[4][2], B0[2][2], B1[2][2];
    const char* cA = (const char*)g.A + (size_t)cur.pm * tstep; const char* cB = (const char*)g.Bt + (size_t)cur.pn * tstep;
    S.a_ready(cur);
    if constexpr (SP2) {
        PG8_STAGE(PG8_SB(0, 0), cB, voffB); PG8_STAGE(PG8_SB(0, 1), cB + hstep, voffB); PG8_STAGE(PG8_SA(0, 0), cA, voffA); PG8_STAGE(PG8_SA(0, 1), cA + hstep, voffA);
        if (wr == 1) PG8_BAR;
        PG8_WAIT_V(2); PG8_BAR;
        PG8_STAGE(PG8_SB(1, 0), cB + kstep, voffB); PG8_STAGE(PG8_SA(1, 0), cA + kstep, voffA); PG8_STAGE(PG8_SB(1, 1), cB + hstep + kstep, voffB);
        PG8_WAIT_V(6); PG8_BAR;
    } else {
        PG8_STAGE(PG8_SB(0, 0), cB, voffB); PG8_STAGE(PG8_SA(0, 0), cA, voffA); PG8_STAGE(PG8_SB(0, 1), cB + hstep, voffB); PG8_STAGE(PG8_SA(0, 1), cA + hstep, voffA);
        if (wr == 1) PG8_BAR;
        PG8_WAIT_V(4); PG8_BAR;
        PG8_STAGE(PG8_SB(1, 0), cB + kstep, voffB); PG8_STAGE(PG8_SA(1, 0), cA + kstep, voffA); PG8_STAGE(PG8_SB(1, 1), cB + hstep + kstep, voffB);
        PG8_WAIT_V(6); PG8_BAR;
    }
    for (;;) {
        const bool has_next = S.next(ui + 1, nxt);
        const char* nA = has_next ? (const char*)g.A + (size_t)nxt.pm * tstep : cA; const char* nB = has_next ? (const char*)g.Bt + (size_t)nxt.pn * tstep : cB;
        for (int t = 0; t < nt; t += 2) {
            const bool last = (t == nt - 2);
            const char* a1 = cA + (size_t)(t + 1) * kstep;
            const char* a2 = last ? nA : cA + (size_t)(t + 2) * kstep; const char* b2 = last ? nB : cB + (size_t)(t + 2) * kstep;
            const char* a3 = a2 + kstep; const char* b3 = b2 + kstep;
            if (last && has_next) S.a_ready(nxt);
            if constexpr (SP2) {
            PG8_LDB(B0, 0, 0); PG8_LDB(B1, 0, 1); PG8_SCHED; PG8_LDA(At, 0, 0); PG8_STAGE(PG8_SA(1, 1), a1 + hstep, voffA);
            PG8_WAIT_V(8); PG8_WAIT_L(0); PG8_BAR; PG8_MMA(0, 0, At, B0); PG8_MMA(0, 1, At, B1); PG8_BAR; PG8_SCHED;
            PG8_LDA(At, 0, 1); PG8_STAGE(PG8_SB(0, 0), b2, voffB); PG8_STAGE(PG8_SB(0, 1), b2 + hstep, voffB); PG8_STAGE(PG8_SA(0, 0), a2, voffA);
            PG8_WAIT_V(8); PG8_WAIT_L(0); PG8_BAR; PG8_MMA(1, 0, At, B0); PG8_MMA(1, 1, At, B1); PG8_BAR; PG8_SCHED;
            PG8_LDB(B0, 1, 0); PG8_LDB(B1, 1, 1); PG8_SCHED; PG8_LDA(At, 1, 0); PG8_STAGE(PG8_SA(0, 1), a2 + hstep, voffA);
            PG8_WAIT_V(8); PG8_WAIT_L(0); PG8_BAR; PG8_MMA(0, 0, At, B0); PG8_MMA(0, 1, At, B1); PG8_BAR; PG8_SCHED;
            PG8_LDA(At, 1, 1); PG8_STAGE(PG8_SB(1, 0), b3, voffB); PG8_STAGE(PG8_SB(1, 1), b3 + hstep, voffB); PG8_STAGE(PG8_SA(1, 0), a3, voffA);
            PG8_WAIT_V(8); PG8_WAIT_L(0); PG8_BAR; PG8_MMA(1, 0, At, B0); PG8_MMA(1, 1, At, B1); PG8_BAR; PG8_SCHED;
            } else {
            PG8_LDB(B0, 0, 0); PG8_SCHED; PG8_LDA(At, 0, 0); PG8_STAGE(PG8_SA(1, 1), a1 + hstep, voffA);
            PG8_WAIT_L(8); PG8_BAR; PG8_WAIT_L(0); PG8_MMA(0, 0, At, B0); PG8_BAR; PG8_SCHED;
            PG8_LDB(B1, 0, 1); PG8_STAGE(PG8_SB(0, 0), b2, voffB);
            PG8_BAR; PG8_WAIT_L(0); PG8_MMA(0, 1, At, B1); PG8_BAR;
            PG8_LDA(At, 0, 1); PG8_STAGE(PG8_SA(0, 0), a2, voffA);
            PG8_BAR; PG8_WAIT_L(0); PG8_MMA(1, 0, At, B0); PG8_BAR; PG8_SCHED;
            PG8_STAGE(PG8_SB(0, 1), b2 + hstep, voffB);
            PG8_WAIT_V(6); PG8_BAR; PG8_MMA(1, 1, At, B1); PG8_BAR;
            PG8_LDB(B0, 1, 0); PG8_SCHED; PG8_LDA(At, 1, 0); PG8_STAGE(PG8_SA(0, 1), a2 + hstep, voffA);
            PG8_WAIT_L(8); PG8_BAR; PG8_WAIT_L(0); PG8_MMA(0, 0, At, B0); PG8_BAR; PG8_SCHED;
            PG8_LDB(B1, 1, 1); PG8_STAGE(PG8_SB(1, 0), b3, voffB);
            PG8_BAR; PG8_WAIT_L(0); PG8_MMA(0, 1, At, B1); PG8_BAR;
            PG8_LDA(At, 1, 1); PG8_STAGE(PG8_SA(1, 0), a3, voffA);
            PG8_BAR; PG8_WAIT_L(0); PG8_MMA(1, 0, At, B0); PG8_BAR; PG8_SCHED;
            PG8_STAGE(PG8_SB(1, 1), b3 + hstep, voffB);
            PG8_WAIT_V(6); PG8_BAR; PG8_MMA(1, 1, At, B1); PG8_BAR;
            }
        }
        if constexpr (ALIGN_EPI) { if (wr == 0) PG8_BAR; }
        if constexpr (!Epi::AFTER_DRAIN) { E(acc, cur, wr, wc, fr, fq); S.done(cur); }
        if (!has_next) break;
#pragma unroll
        for (int a = 0; a < 2; ++a)
#pragma unroll
            for (int b = 0; b < 2; ++b)
#pragma unroll
                for (int m = 0; m < 4; ++m)
#pragma unroll
                    for (int n = 0; n < 2; ++n) acc[a][b][m][n] = (f32x4){0.f, 0.f, 0.f, 0.f};
        cur = nxt; cA = nA; cB = nB; ++ui;
        if constexpr (ALIGN_EPI) { if (wr == 1) PG8_BAR; }
    }
    PG8_WAIT_V(0);
    if constexpr (!ALIGN_EPI) { if (wr == 0) PG8_BAR; }
    PG8_BAR;
    if constexpr (Epi::AFTER_DRAIN) { E.fused(acc, cur, wr, wc, fr, fq, lds, wid, lane); S.done(cur); }
#undef PG8_SA
#undef PG8_SB
#undef PG8_STAGE
#undef PG8_LDA
#undef PG8_LDB
#undef PG8_MMA
#undef PG8_WAIT_V
#undef PG8_WAIT_L
#undef PG8_BAR
#undef PG8_SCHED
}
}
namespace pg8 {
__device__ __forceinline__ float silu_f(float v) { return v * __builtin_amdgcn_rcpf(1.0f + __expf(-v)); }
struct EpiF32 {
    static constexpr bool PERM = false, AFTER_DRAIN = false;
    float* C; int ldc;
    __device__ __forceinline__ void operator()(const f32x4 (&acc)[2][2][4][2], const Unit& u, int wr, int wc, int fr, int fq) const {
        const int row0 = u.pm * BM + wr * 64 + fr, col0 = u.pn * BM + wc * 32 + 4 * fq;
#pragma unroll
        for (int ai = 0; ai < 2; ++ai)
#pragma unroll
            for (int m = 0; m < 4; ++m) { float* rowp = C + (size_t)(row0 + ai * HALF + m * 16) * ldc + col0;
#pragma unroll
                for (int bj = 0; bj < 2; ++bj)
#pragma unroll
                    for (int n = 0; n < 2; ++n) *(f32x4*)(rowp + bj * HALF + n * 16) = acc[ai][bj][m][n]; }
    }
};
struct EpiSwiglu {
    static constexpr bool PERM = true, AFTER_DRAIN = false;
    bf16_t* O; int ldc;
    __device__ __forceinline__ void operator()(const f32x4 (&acc)[2][2][4][2], const Unit& u, int wr, int wc, int fr, int fq) const {
        const int row0 = u.pm * BM + wr * 64 + fr, col0 = u.pn * HALF + wc * 32 + 8 * fq;
#pragma unroll
        for (int ai = 0; ai < 2; ++ai)
#pragma unroll
            for (int m = 0; m < 4; ++m) { bf16_t* rowp = O + (size_t)(row0 + ai * HALF + m * 16) * ldc + col0;
                const f32x4 g0 = acc[ai][0][m][0], g1 = acc[ai][0][m][1], u0 = acc[ai][1][m][0], u1 = acc[ai][1][m][1];
                u32x4 w;
                w.x = cvt_pk_bf16(silu_f(g0[0]) * u0[0], silu_f(g0[1]) * u0[1]); w.y = cvt_pk_bf16(silu_f(g0[2]) * u0[2], silu_f(g0[3]) * u0[3]);
                w.z = cvt_pk_bf16(silu_f(g1[0]) * u1[0], silu_f(g1[1]) * u1[1]); w.w = cvt_pk_bf16(silu_f(g1[2]) * u1[2], silu_f(g1[3]) * u1[3]);
                *(u32x4*)rowp = w; }
    }
};
struct EpiMix {
    static constexpr bool PERM = true, AFTER_DRAIN = false;
    bf16_t* Z; bf16_t* XBC; float* DT;
    __device__ __forceinline__ void operator()(const f32x4 (&acc)[2][2][4][2], const Unit& u, int wr, int wc, int fr, int fq) const {
        const int row0 = u.pm * BM + wr * 64 + fr;
        if (u.pn < 10) {
            bf16_t* base; int ldc, colt;
            if (u.pn < 4) { base = Z; ldc = 1024; colt = u.pn * BM; } else { base = XBC; ldc = 1536; colt = (u.pn - 4) * BM; }
            const int col0 = colt + wc * 32 + 8 * fq;
#pragma unroll
            for (int ai = 0; ai < 2; ++ai)
#pragma unroll
                for (int m = 0; m < 4; ++m) { bf16_t* rowp = base + (size_t)(row0 + ai * HALF + m * 16) * ldc + col0;
#pragma unroll
                    for (int bj = 0; bj < 2; ++bj) { const f32x4 v0 = acc[ai][bj][m][0], v1 = acc[ai][bj][m][1];
                        u32x4 w; w.x = cvt_pk_bf16(v0[0], v0[1]); w.y = cvt_pk_bf16(v0[2], v0[3]); w.z = cvt_pk_bf16(v1[0], v1[1]); w.w = cvt_pk_bf16(v1[2], v1[3]);
                        *(u32x4*)(rowp + bj * HALF) = w; } }
        } else if (wc == 0 && fq < 2) {
#pragma unroll
            for (int ai = 0; ai < 2; ++ai)
#pragma unroll
                for (int m = 0; m < 4; ++m) { float* rowp = DT + (size_t)(row0 + ai * HALF + m * 16) * 16 + 8 * fq;
                    *(f32x4*)rowp = acc[ai][0][m][0]; *(f32x4*)(rowp + 4) = acc[ai][0][m][1]; }
        }
    }
};
struct EpiQKV {
    static constexpr bool PERM = true, AFTER_DRAIN = false;
    bf16_t* O; int ldc; size_t split_stride; float scale0; unsigned* kmax;
    __device__ __forceinline__ void operator()(const f32x4 (&acc)[2][2][4][2], const Unit& u, int wr, int wc, int fr, int fq) const {
        const int row0 = u.pm * BM + wr * 64 + fr; int colt = u.pn * BM; const int t = colt / 1024; bf16_t* base = O + (size_t)t * split_stride; colt -= t * 1024;
        const float sc = (t == 0) ? scale0 : 1.f; const int col0 = colt + wc * 32 + 8 * fq;
        float km[2] = {0.f, 0.f};
#pragma unroll
        for (int ai = 0; ai < 2; ++ai)
#pragma unroll
            for (int m = 0; m < 4; ++m) { bf16_t* rowp = base + (size_t)(row0 + ai * HALF + m * 16) * ldc + col0;
#pragma unroll
                for (int bj = 0; bj < 2; ++bj) { const f32x4 v0 = acc[ai][bj][m][0] * sc, v1 = acc[ai][bj][m][1] * sc;
                    u32x4 w; w.x = cvt_pk_bf16(v0[0], v0[1]); w.y = cvt_pk_bf16(v0[2], v0[3]); w.z = cvt_pk_bf16(v1[0], v1[1]); w.w = cvt_pk_bf16(v1[2], v1[3]);
                    *(u32x4*)(rowp + bj * HALF) = w;
                    if (t == 1) { float s = 0.f;
#pragma unroll
                        for (int e = 0; e < 4; ++e) { const float lo = __builtin_bit_cast(float, w[e] << 16), hi = __builtin_bit_cast(float, w[e] & 0xffff0000u); s += lo * lo + hi * hi; }
                        s += __shfl_xor(s, 16); s += __shfl_xor(s, 32); km[bj] = __builtin_fmaxf(km[bj], s); } } }
        if (t == 1) {
#pragma unroll
            for (int bj = 0; bj < 2; ++bj) { float v = km[bj];
                v = __builtin_fmaxf(v, __shfl_xor(v, 1)); v = __builtin_fmaxf(v, __shfl_xor(v, 2)); v = __builtin_fmaxf(v, __shfl_xor(v, 4)); v = __builtin_fmaxf(v, __shfl_xor(v, 8));
                if ((fr | fq) == 0) { const int b = u.pm >> 5, head = (colt >> 7) + bj; atomicMax(kmax + (((b * 8 + head) * 2 + (wc >> 1)) * 2 + (wc & 1)), __builtin_bit_cast(unsigned, v)); } } }
    }
};
}
#include <hip/hip_bf16.h>
#include <cmath>
namespace attn_body {
using bf16=__hip_bfloat16;
using bf16x8=__attribute__((ext_vector_type(8)))short;
using s16x4=__attribute__((ext_vector_type(4)))short;
using f32x16=__attribute__((ext_vector_type(16)))float;
using u32x4=__attribute__((ext_vector_type(4)))unsigned;
constexpr int BATCH=2,NHEAD=16,SEQ=8192,D=64,DM=NHEAD*D;
constexpr int NW=8,QBLK=32,QB=QBLK*NW,KVBLK=64,NQB=SEQ/QB;
constexpr int ATTN_PITCH=DM, ATTN_UNIT_ROWS=QB, OPITCH=2048, OCOL0=1024;
__device__ __forceinline__ int crow(int r,int hi){return (r&3)+8*(r>>2)+4*hi;}
#define SBAR() __builtin_amdgcn_sched_barrier(0)
__device__ __forceinline__ void cmask(f32x16&p0,f32x16&p1,int jb,int qrel,int hi){
  const float NEG=-INFINITY; int kb=64*jb+4*hi;
  #pragma unroll
  for(int r=0;r<16;++r){int kv=kb+(r&3)+8*(r>>2); if(kv>qrel)p0[r]=NEG; if(kv+32>qrel)p1[r]=NEG;}
}

constexpr int BT_N=704;
__device__ __forceinline__ void bmask(f32x16&p0,f32x16&p1,int jb,int qrel,int hi,const float*bt){
  const float NEG=-INFINITY; const int brel=qrel-64*jb-4*hi; const float*bp=bt+(brel+256);
  #pragma unroll
  for(int r=0;r<16;++r){const int c0=(r&3)+8*(r>>2);
    const float b0=bp[-c0], b1=bp[-c0-32];
    p0[r]=(brel<c0)?NEG:p0[r]+b0; p1[r]=(brel<c0+32)?NEG:p1[r]+b1;
    if((r&3)==3)SBAR();}
}
constexpr int NSLOT=3, SLOTB=8192;
constexpr int LDS_K=0, LDS_V=NSLOT*SLOTB, LDS_WS=2*NSLOT*SLOTB, LDS_OST=LDS_WS+NW*64*4, LDS_BYTES=LDS_OST+NW*4096, LDS_OSTA=86016, LDS_BTAB=LDS_OSTA+NW*4096, LDS_TOTAL=LDS_BTAB+704*4;
constexpr float C2=0.125f*1.4426950408889634f;
__device__ __forceinline__ void glds16(const void*gsrc,unsigned lds_dst){unsigned keep;
  asm volatile("s_mov_b32 %0, m0\n\ts_mov_b32 m0, %2\n\ts_nop 0\n\tglobal_load_lds_dwordx4 %1, off\n\ts_mov_b32 m0, %0":"=&s"(keep):"v"(gsrc),"s"(lds_dst):"memory");}
__device__ __forceinline__ float max3f(float a,float b,float c){float r;asm("v_max3_f32 %0, %1, %2, %3":"=v"(r):"v"(a),"v"(b),"v"(c));return r;}
__device__ __forceinline__ float max2f(float a,float b){float r;asm("v_max_f32_e32 %0, %1, %2":"=v"(r):"v"(a),"v"(b));return r;}
__device__ __forceinline__ float fadd_s(float a,float b){float r;asm("v_add_f32_e32 %0, %1, %2":"=v"(r):"v"(a),"v"(b));return r;}
__device__ __forceinline__ float fsub_s(float a,float b){float r;asm("v_sub_f32_e32 %0, %1, %2":"=v"(r):"v"(a),"v"(b));return r;}
typedef float f32x2_t __attribute__((ext_vector_type(2))); typedef __bf16 bf16x2_t __attribute__((ext_vector_type(2)));
__device__ __forceinline__ unsigned cvtpk_s(float lo,float hi){f32x2_t v={lo,hi};bf16x2_t b=__builtin_convertvector(v,bf16x2_t);return __builtin_bit_cast(unsigned,b);}
#define WAIT_BAR(N) asm volatile("s_waitcnt vmcnt(" #N ") lgkmcnt(0)\n\ts_barrier":::"memory")

__device__ __forceinline__ void qkt(f32x16&p0,f32x16&p1,const char*Kslot,const bf16x8*qr,const f32x16&negm,int r32,int hi){
  const char*kb=Kslot+hi*1024+r32*16;
  #pragma unroll
  for(int d0=0;d0<4;++d0){
    const bf16x8 b0=*reinterpret_cast<const bf16x8*>(kb+d0*2048);
    const bf16x8 b1=*reinterpret_cast<const bf16x8*>(kb+d0*2048+512);
    if(d0==0){p0=__builtin_amdgcn_mfma_f32_32x32x16_bf16(b0,qr[0],negm,0,0,0);p1=__builtin_amdgcn_mfma_f32_32x32x16_bf16(b1,qr[0],negm,0,0,0);}
    else{p0=__builtin_amdgcn_mfma_f32_32x32x16_bf16(b0,qr[d0],p0,0,0,0);p1=__builtin_amdgcn_mfma_f32_32x32x16_bf16(b1,qr[d0],p1,0,0,0);}}
}
typedef __attribute__((address_space(3))) const char* lds_cptr;
typedef short v4i16_t __attribute__((ext_vector_type(4)));
__device__ __forceinline__ void kload8(bf16x8*kf,lds_cptr kp){
  kf[0]=*(const __attribute__((address_space(3))) bf16x8*)(kp);      kf[1]=*(const __attribute__((address_space(3))) bf16x8*)(kp+512);
  kf[2]=*(const __attribute__((address_space(3))) bf16x8*)(kp+2048); kf[3]=*(const __attribute__((address_space(3))) bf16x8*)(kp+2560);
  kf[4]=*(const __attribute__((address_space(3))) bf16x8*)(kp+4096); kf[5]=*(const __attribute__((address_space(3))) bf16x8*)(kp+4608);
  kf[6]=*(const __attribute__((address_space(3))) bf16x8*)(kp+6144); kf[7]=*(const __attribute__((address_space(3))) bf16x8*)(kp+6656);
}
__device__ __forceinline__ void kload2(bf16x8*kf,lds_cptr kp,int j){ kf[2*j]=*(const __attribute__((address_space(3))) bf16x8*)(kp+j*2048); kf[2*j+1]=*(const __attribute__((address_space(3))) bf16x8*)(kp+j*2048+512); }
__device__ __forceinline__ s16x4 vtr(lds_cptr p){ return __builtin_bit_cast(s16x4,__builtin_amdgcn_ds_read_tr16_b64_v4i16((__attribute__((address_space(3))) v4i16_t*)p)); }
__device__ __forceinline__ float rowmax(const f32x16&p0,const f32x16&p1){
  float a=max3f(p0[0],p0[1],p1[0]),b=max3f(p0[2],p0[3],p1[1]);a=max3f(a,p1[2],p1[3]);
  #pragma unroll
  for(int r=4;r<16;r+=4){a=max3f(a,p0[r],p0[r+1]);b=max3f(b,p0[r+2],p0[r+3]);a=max3f(a,p1[r],p1[r+1]);b=max3f(b,p1[r+2],p1[r+3]);}
  const float m=max2f(a,b);
  auto rr=__builtin_amdgcn_permlane32_swap(__float_as_uint(m),__float_as_uint(m),false,false);
  return max2f(__uint_as_float(rr[0]),__uint_as_float(rr[1]));
}
__device__ __forceinline__ void pv(f32x16*o,int vb,bf16x8 pa0,bf16x8 pa1,bf16x8 pa2,bf16x8 pa3){
  #pragma unroll
  for(int d0=0;d0<2;++d0){s16x4 lo[4],hi[4];
    #pragma unroll
    for(int ks=0;ks<4;++ks){
      asm volatile("ds_read_b64_tr_b16 %0,%1 offset:%c2":"=&v"(lo[ks]):"v"(vb),"i"(d0*4096+ks*1024):"memory");
      asm volatile("ds_read_b64_tr_b16 %0,%1 offset:%c2":"=&v"(hi[ks]):"v"(vb),"i"(d0*4096+ks*1024+512):"memory");}
    asm volatile("s_waitcnt lgkmcnt(0)":::"memory");SBAR();
    #define PK(k) (bf16x8){lo[k][0],lo[k][1],lo[k][2],lo[k][3],hi[k][0],hi[k][1],hi[k][2],hi[k][3]}
    o[d0]=__builtin_amdgcn_mfma_f32_32x32x16_bf16(pa0,PK(0),o[d0],0,0,0);
    o[d0]=__builtin_amdgcn_mfma_f32_32x32x16_bf16(pa1,PK(1),o[d0],0,0,0);
    o[d0]=__builtin_amdgcn_mfma_f32_32x32x16_bf16(pa2,PK(2),o[d0],0,0,0);
    o[d0]=__builtin_amdgcn_mfma_f32_32x32x16_bf16(pa3,PK(3),o[d0],0,0,0);
    #undef PK
  }
}

#ifndef ATTN_STORE16
#define ATTN_STORE16(p,v) (*(u32x4*)(p)=(v))
#endif
template<int THRL> __device__ __forceinline__ void attn_unit(int b,int hq,int hv,int qb,int pass,float lam,const float*btab,const bf16*Q,const bf16*__restrict__ K,const bf16*__restrict__ V,bf16*O,char*shm){
  const int tid=threadIdx.x,lane=tid&63,r32=lane&31,hi=lane>>5; const int wid=__builtin_amdgcn_readfirstlane(tid>>6);
  const long rowbase=(long)b*SEQ; const int q0=qb*QB;
  const bf16*Qw=Q+(rowbase+q0+wid*QBLK)*DM+hq*D;
  const bf16*Kh=K+rowbase*DM+hq*D,*Vh=V+rowbase*DM+hv*D;
  const unsigned lds0=(unsigned)(uintptr_t)shm;
  float*wsf=(float*)(shm+LDS_WS)+wid*64;
  const bf16*ksrc=Kh+(long)lane*DM+wid*8;
  const bf16*vsrc=Vh+(long)(16*(wid&3)+(lane>>2))*DM+(wid>>2)*32+(lane&3)*8;
  const unsigned kdst=lds0+LDS_K+wid*1024, vdst=lds0+LDS_V+wid*1024;
  #define DMA_K(t,slot) glds16(ksrc+(long)(t)*KVBLK*DM,(unsigned)__builtin_amdgcn_readfirstlane(kdst+(slot)))
  #define DMA_V(t,slot) glds16(vsrc+(long)(t)*KVBLK*DM,(unsigned)__builtin_amdgcn_readfirstlane(vdst+(slot)))
  const int vb0=(int)(lds0+LDS_V)+((lane>>4)&1)*32+(lane&3)*8+(4*hi+((lane&15)>>2))*64;
  const char*Kbase=shm+LDS_K; bf16x8 kf[8];
  const lds_cptr shm3=(lds_cptr)shm; const lds_cptr kp0=shm3+LDS_K+hi*1024+r32*16; const lds_cptr vp0=shm3+LDS_V+((lane>>4)&1)*32+(lane&3)*8+(4*hi+((lane&15)>>2))*64;
  const int NT=(q0+QB)/KVBLK;
  DMA_K(0,0);DMA_V(0,0);DMA_K(1,SLOTB);
  bf16x8 qr[4];
  #pragma unroll
  for(int d0=0;d0<4;++d0)qr[d0]=*reinterpret_cast<const bf16x8*>(&Qw[(long)r32*DM+d0*16+hi*8]);
  float mhat=0.f,l_reg=0.f;f32x16 o[2];o[0]=f32x16{};o[1]=f32x16{};f32x16 negm=f32x16{};asm volatile("":"+v"(negm));
  const int qrel=wid*QBLK+r32;
  #define CMASK(P0,P1,t) do{int jb_=(t)-(NT-4); if(jb_>=-2)bmask(P0,P1,jb_,qrel,hi,btab);}while(0)
  bool resc=false;
  #define START(P0,P1) do{ const float rm=rowmax(P0,P1); resc=false; \
    { const float dl=rm; mhat=fadd_s(mhat,dl); \
      _Pragma("unroll") for(int r=0;r<16;++r){P0[r]=fsub_s(P0[r],dl);P1[r]=fsub_s(P1[r],dl);} \
      _Pragma("unroll") for(int r=0;r<16;++r)negm[r]=-mhat; asm volatile("":"+v"(negm)); } \
    _Pragma("unroll") for(int r=0;r<16;++r)P0[r]=__builtin_amdgcn_exp2f(P0[r]); }while(0)
  #define RESC() do{ if(resc){ asm volatile("s_waitcnt lgkmcnt(0)":::"memory"); \
      _Pragma("unroll") for(int d_=0;d_<2;++d_) _Pragma("unroll") for(int r=0;r<16;++r)o[d_][r]*=wsf[crow(r,hi)]; } }while(0)
  f32x16 pA0,pA1,pB0,pB1;
  int sl_prev=0,sl_cur=0,sl_next=SLOTB;
  #define ROT() do{sl_prev=sl_cur;sl_cur=sl_next;sl_next=(sl_next==(NSLOT-1)*SLOTB)?0:sl_next+SLOTB;}while(0)
  DMA_K(2,2*SLOTB);
  WAIT_BAR(3);
  qkt(pA0,pA1,Kbase,qr,negm,r32,hi);asm volatile("s_nop 15\n\ts_nop 7":"+v"(pA0),"+v"(pA1));CMASK(pA0,pA1,0);
  START(pA0,pA1);
  _Pragma("unroll") for(int r=0;r<16;++r)pA1[r]=__builtin_amdgcn_exp2f(pA1[r]);
  WAIT_BAR(0);
  DMA_K(3,0);DMA_V(1,SLOTB);
  ROT();
  kload8(kf,kp0+sl_cur);
  WAIT_BAR(2);
  s16x4 vlo[8],vhi[8]; u32x4 pw0,pw1,pw2,pw3;
  #define PKW(P,B) cvtpk_s(P[B],P[B+1])
  #define PAF(k) __builtin_bit_cast(bf16x8,pw##k)
  #define VFR(i) (bf16x8){vlo[i][0],vlo[i][1],vlo[i][2],vlo[i][3],vhi[i][0],vhi[i][1],vhi[i][2],vhi[i][3]}
  #define PIN(x) asm volatile("":"+v"(x))
  #define MX3(a,b,c) __builtin_fmaxf(__builtin_fmaxf((a),(b)),(c))
  #define GAPA(MF,A0,A1,A2,A3,W0,W1,PW) do{ MF; sacc+=A0; sacc+=A1; sacc+=A2; sacc+=A3; PIN(sacc); W0; W1; PIN(PW); SBAR(); }while(0)
  #define EX(v) __builtin_amdgcn_exp2f(v)
  #define GAPB(MF,X,B) do{ MF; X[B]=EX(X[B]); X[B+1]=EX(X[B+1]); X[B+2]=EX(X[B+2]); X[B+3]=EX(X[B+3]); PIN(X); SBAR(); }while(0)
  #define VRD(i) do{ vlo[i]=vtr(vp_+(((i)>>2)*4096+((i)&3)*1024)); vhi[i]=vtr(vp_+(((i)>>2)*4096+((i)&3)*1024+512)); }while(0)
  #define KRD(G,j) do{ if(G){ kload2(kf,kp0+sl_next,j); SBAR(); } }while(0)
  #define STEP(C0,C1,P0,P1,t,GK,GV,GL) do{ SBAR(); \
    const lds_cptr vp_=vp0+sl_prev; \
    VRD(0); SBAR(); float sacc=(P0[0]+P0[1]); \
    GAPA(C0=__builtin_amdgcn_mfma_f32_32x32x16_bf16(kf[0],qr[0],negm,0,0,0), P0[2],P0[3],P0[4],P0[5],     pw0[0]=PKW(P0,0), pw0[1]=PKW(P0,2), pw0); \
    VRD(4); SBAR(); GAPA(C1=__builtin_amdgcn_mfma_f32_32x32x16_bf16(kf[1],qr[0],negm,0,0,0), P0[6],P0[7],P0[8],P0[9],     pw0[2]=PKW(P0,4), pw0[3]=PKW(P0,6), pw0); \
    VRD(1); SBAR(); GAPA(C0=__builtin_amdgcn_mfma_f32_32x32x16_bf16(kf[2],qr[1],C0,0,0,0),   P0[10],P0[11],P0[12],P0[13], pw1[0]=PKW(P0,8), pw1[1]=PKW(P0,10), pw1); \
    VRD(5); SBAR(); GAPA(C1=__builtin_amdgcn_mfma_f32_32x32x16_bf16(kf[3],qr[1],C1,0,0,0),   P0[14],P0[15],P1[0],P1[1],   pw1[2]=PKW(P0,12),pw1[3]=PKW(P0,14), pw1); \
    VRD(2); SBAR(); GAPA(C0=__builtin_amdgcn_mfma_f32_32x32x16_bf16(kf[4],qr[2],C0,0,0,0),   P1[2],P1[3],P1[4],P1[5],     pw2[0]=PKW(P1,0), pw2[1]=PKW(P1,2), pw2); \
    VRD(6); SBAR(); GAPA(C1=__builtin_amdgcn_mfma_f32_32x32x16_bf16(kf[5],qr[2],C1,0,0,0),   P1[6],P1[7],P1[8],P1[9],     pw2[2]=PKW(P1,4), pw2[3]=PKW(P1,6), pw2); \
    VRD(3); SBAR(); GAPA(C0=__builtin_amdgcn_mfma_f32_32x32x16_bf16(kf[6],qr[3],C0,0,0,0),   P1[10],P1[11],P1[12],P1[13], pw3[0]=PKW(P1,8), pw3[1]=PKW(P1,10), pw3); \
    VRD(7); SBAR(); GAPA(C1=__builtin_amdgcn_mfma_f32_32x32x16_bf16(kf[7],qr[3],C1,0,0,0),   P1[14],P1[15],0.f,0.f,       pw3[2]=PKW(P1,12),pw3[3]=PKW(P1,14), pw3); \
    l_reg+=sacc; \
    if(GK){DMA_K((t)+3,sl_cur);} if(GV){DMA_V((t)+1,sl_next);} \
    CMASK(C0,C1,t); \
    { float a=MX3(C0[0],C0[1],C1[0]),b=MX3(C0[2],C0[3],C1[1]); a=MX3(a,C1[2],C1[3]); \
      _Pragma("unroll") for(int r=4;r<16;r+=4){a=MX3(a,C0[r],C0[r+1]);b=MX3(b,C0[r+2],C0[r+3]);a=MX3(a,C1[r],C1[r+1]);b=MX3(b,C1[r+2],C1[r+3]);} \
      float rm=__builtin_fmaxf(a,b); { auto rr=__builtin_amdgcn_permlane32_swap(__float_as_uint(rm),__float_as_uint(rm),false,false); rm=__builtin_fmaxf(__uint_as_float(rr[0]),__uint_as_float(rr[1])); } \
      resc=false; \
      if(__builtin_expect(__any(rm>(float)THRL),0)){ const float dl=__builtin_fmaxf(rm,0.f); mhat+=dl; \
        _Pragma("unroll") for(int r=0;r<16;++r){C0[r]-=dl;C1[r]-=dl;} \
        _Pragma("unroll") for(int r=0;r<16;++r)negm[r]=-mhat; asm volatile("":"+v"(negm)); \
        const float f=__builtin_amdgcn_exp2f(-dl); l_reg*=f; if(hi==0)wsf[r32]=f; resc=true; } } \
    SBAR(); \
    GAPB(o[0]=__builtin_amdgcn_mfma_f32_32x32x16_bf16(PAF(0),VFR(0),o[0],0,0,0), C0,0); \
    GAPB(o[1]=__builtin_amdgcn_mfma_f32_32x32x16_bf16(PAF(0),VFR(4),o[1],0,0,0), C0,4); \
    KRD(GL,0); GAPB(o[0]=__builtin_amdgcn_mfma_f32_32x32x16_bf16(PAF(1),VFR(1),o[0],0,0,0), C0,8); \
    KRD(GL,1); GAPB(o[1]=__builtin_amdgcn_mfma_f32_32x32x16_bf16(PAF(1),VFR(5),o[1],0,0,0), C0,12); \
    KRD(GL,2); GAPB(o[0]=__builtin_amdgcn_mfma_f32_32x32x16_bf16(PAF(2),VFR(2),o[0],0,0,0), C1,0); \
    KRD(GL,3); GAPB(o[1]=__builtin_amdgcn_mfma_f32_32x32x16_bf16(PAF(2),VFR(6),o[1],0,0,0), C1,4); \
    GAPB(o[0]=__builtin_amdgcn_mfma_f32_32x32x16_bf16(PAF(3),VFR(3),o[0],0,0,0), C1,8); \
    GAPB(o[1]=__builtin_amdgcn_mfma_f32_32x32x16_bf16(PAF(3),VFR(7),o[1],0,0,0), C1,12); \
    }while(0)
  int t=1;
  #undef CMASK
  #define CMASK(P0,P1,t) do{}while(0)
  for(;t+7<NT;t+=2){
    STEP(pB0,pB1,pA0,pA1,t,true,true,true);     WAIT_BAR(2); RESC(); ROT();
    STEP(pA0,pA1,pB0,pB1,t+1,true,true,true);   WAIT_BAR(2); RESC(); ROT();
  }
  #undef CMASK
  #define CMASK(P0,P1,t) do{int jb_=(t)-(NT-4); if(jb_>=-2)bmask(P0,P1,jb_,qrel,hi,btab);}while(0)
  #define ENDW(tt) do{ if((tt)+3<NT){WAIT_BAR(2);} else if((tt)+2<NT){WAIT_BAR(1);} else {WAIT_BAR(0);} }while(0)
  for(;t+1<NT;t+=2){
    STEP(pB0,pB1,pA0,pA1,t,(t+3<NT),(t+1<NT),(t+1<NT));       ENDW(t);   RESC(); ROT();
    STEP(pA0,pA1,pB0,pB1,t+1,(t+4<NT),(t+2<NT),(t+2<NT));     ENDW(t+1); RESC(); ROT();
  }
  STEP(pB0,pB1,pA0,pA1,NT-1,false,false,false); RESC();
  { float sacc=pB0[0]+pB0[1]; _Pragma("unroll") for(int r=2;r<16;++r)sacc+=pB0[r]; _Pragma("unroll") for(int r=0;r<16;++r)sacc+=pB1[r]; l_reg+=sacc;
    pw0=(u32x4){PKW(pB0,0),PKW(pB0,2),PKW(pB0,4),PKW(pB0,6)};pw1=(u32x4){PKW(pB0,8),PKW(pB0,10),PKW(pB0,12),PKW(pB0,14)};pw2=(u32x4){PKW(pB1,0),PKW(pB1,2),PKW(pB1,4),PKW(pB1,6)};pw3=(u32x4){PKW(pB1,8),PKW(pB1,10),PKW(pB1,12),PKW(pB1,14)};
    SBAR(); pv(o,vb0+sl_cur,PAF(0),PAF(1),PAF(2),PAF(3)); }
  #undef PKW
  #undef PAF
  #undef VFR
  #undef PIN
  #undef MX3
  #undef GAPA
  #undef GAPB
  #undef EX
  #undef VRD
  #undef KRD
  #undef STEP
  #undef ENDW
  {auto rr=__builtin_amdgcn_permlane32_swap(__float_as_uint(l_reg),__float_as_uint(l_reg),false,false);l_reg=__uint_as_float(rr[0])+__uint_as_float(rr[1]);}
  if(hi==0)wsf[32+r32]=l_reg;asm volatile("s_waitcnt lgkmcnt(0)":::"memory");
  float rli[16];
  #pragma unroll
  for(int r=0;r<16;++r)rli[r]=__builtin_amdgcn_rcpf(wsf[32+crow(r,hi)]);
  bf16*Ow=O+(rowbase+q0+wid*QBLK)*OPITCH+OCOL0+hv*D;
  { bf16*stg=(bf16*)(shm+LDS_OST)+wid*2048; bf16*stga=(bf16*)(shm+LDS_OSTA)+wid*2048;
    #pragma unroll
    for(int r=0;r<16;++r){const int orow=crow(r,hi);
      #pragma unroll
      for(int d0=0;d0<2;++d0){const int ix=orow*64+d0*32+r32; const float ov=o[d0][r]*rli[r]; if(pass==0)stga[ix]=__float2bfloat16(ov); else stg[ix]=__float2bfloat16(__bfloat162float(stga[ix])-lam*ov);}}
    asm volatile("s_waitcnt lgkmcnt(0)":::"memory");
    #pragma unroll
    for(int i=0;i<4;++i){const int row=i*8+(lane>>3),ch=lane&7; if(pass!=0){const u32x4 v=*(const u32x4*)(stg+row*64+ch*8); ATTN_STORE16(Ow+(long)row*OPITCH+ch*8,v);}} }
  asm volatile("s_waitcnt lgkmcnt(0)\n\ts_barrier":::"memory");
  #undef DMA_K
  #undef DMA_V
  #undef CMASK
  #undef START
  #undef RESC
  #undef ROT
}
constexpr int ATTN_LDS_BYTES=LDS_BYTES;
struct AttnTensors { const bf16* Q; const bf16* K; const bf16* V; bf16* O; float lam; const float* relb; };
struct AttnUnit { int bh; int qb; };
struct StaticOrder {
  int vcu;
  __device__ __forceinline__ explicit StaticOrder(int grid,int block):vcu((block%8)*(grid/8)+block/8){}
  __device__ __forceinline__ bool next(int i,AttnUnit&u)const{ if(i>=4)return false; const int s=vcu&7; u.bh=vcu>>3; u.qb=(i==0)?s:(i==1)?15-s:(i==2)?16+s:31-s; return true; }
  __device__ __forceinline__ void a_ready(const AttnUnit&)const{}
  __device__ __forceinline__ void done(const AttnUnit&)const{}
};
template<class Sched,int THRL=8> __device__ __forceinline__ void attn_phase(char*lds,const AttnTensors&T,const Sched&S){
  AttnUnit u;
  for(int i=0;S.next(i,u);++i){ S.a_ready(u); const int b_=u.bh/NHEAD,hp_=u.bh%NHEAD; float*bt_=(float*)(lds+LDS_BTAB);
    for(int t_=threadIdx.x;t_<BT_N;t_+=NW*64){ const int rel=t_-256; float v_=0.f;
      if(rel>=0&&rel<113){ int bk=rel; if(rel>=16){ bk=16+(int)(logf((float)rel*(1.0f/16.0f))/logf(8.0f)*16.0f); bk=bk>31?31:bk; } v_=(T.relb[bk*8+(hp_>>1)]-T.relb[31*8+(hp_>>1)])*1.4426950408889634f; }
      bt_[t_]=v_; }
    asm volatile("s_waitcnt lgkmcnt(0)\n\ts_barrier":::"memory");
    for(int pass=0;pass<2;++pass) attn_unit<THRL>(b_,(hp_&~1)+pass,hp_,u.qb,pass,T.lam,bt_,T.Q,T.K,T.V,T.O,lds); S.done(u); }
}
#undef SBAR
#undef WAIT_BAR
}
namespace attn2 {
using attn_body::bf16; using attn_body::bf16x8; using attn_body::s16x4; using attn_body::f32x16; using attn_body::u32x4; using attn_body::lds_cptr;
using attn_body::glds16; using attn_body::vtr; using attn_body::cvtpk_s; using attn_body::crow; using attn_body::BT_N;
constexpr int SEQ=8192,DM=1024,NW=8,QBLK=32,QB=256;
constexpr int KSLOT=8192,VSLOT=8192,NS=4,NSV=5;
constexpr int L_K=0,L_V=NS*KSLOT,L_WS=L_V+NSV*VSLOT,L_OST=0,L_BTAB=L_WS+NW*256,L_TOTAL=L_BTAB+BT_N*4;
static_assert(NW*8192<=L_WS,"O stage inside the ring region");
constexpr int OP=2048,OC0=1024;
#define SBAR() __builtin_amdgcn_sched_barrier(0)
#define WAIT_BAR(N) asm volatile("s_waitcnt vmcnt(" #N ") lgkmcnt(0)\n\ts_barrier":::"memory")
#define A2LAS __attribute__((address_space(3)))
__device__ __forceinline__ void bmask1(f32x16&p,int jb,int qrel,int hi,const float*bt){
  const float NEG=-INFINITY; const int brel=qrel-32*jb-4*hi; const float*bp=bt+(brel+256);
  #pragma unroll
  for(int r=0;r<16;++r){const int c0=(r&3)+8*(r>>2); const float b0=bp[-c0]; p[r]=(brel<c0)?NEG:p[r]+b0; if((r&3)==3)SBAR();}
}
__device__ __forceinline__ float rowmax1(const f32x16&p){
  #define MX3(a,b,c) __builtin_fmaxf(__builtin_fmaxf((a),(b)),(c))
  float a=MX3(p[0],p[1],p[2]),b=MX3(p[3],p[4],p[5]); a=MX3(a,p[6],p[7]); b=MX3(b,p[8],p[9]); a=MX3(a,p[10],p[11]); b=MX3(b,p[12],p[13]); a=MX3(a,p[14],p[15]);
  float m=__builtin_fmaxf(a,b); auto rr=__builtin_amdgcn_permlane32_swap(__float_as_uint(m),__float_as_uint(m),false,false);
  return __builtin_fmaxf(__uint_as_float(rr[0]),__uint_as_float(rr[1]));
  #undef MX3
}
template<int THRL> __device__ __forceinline__ void unit2(int b,int h,int qb,int pass,float lam,float kmax2,float bmax,const float*subg,const float*btab,const bf16*Q,const bf16*__restrict__ K,const bf16*__restrict__ V,bf16*O,char*shm){
  const int tid=threadIdx.x,lane=tid&63,r32=lane&31,hi=lane>>5; const int wid=__builtin_amdgcn_readfirstlane(tid>>6);
  const long rowbase=(long)b*SEQ; const int q0=qb*QB; const int hq=2*h+pass;
  const bf16*Qw=Q+(rowbase+q0+wid*QBLK)*DM+hq*64;
  const bf16*Kh=K+rowbase*DM+hq*64,*Vh=V+rowbase*DM+h*128;
  const unsigned lds0=(unsigned)(uintptr_t)shm;
  float*wsf=(float*)(shm+L_WS)+wid*64;
  const bf16*ksrc=Kh+(long)lane*DM+wid*8;
  const bf16*vsrc=Vh+(long)(16*(wid&1)+(lane>>2))*DM+(wid>>1)*32+(lane&3)*8;
  const unsigned kdst=lds0+L_K+wid*1024, vdst=lds0+L_V+wid*1024;
  #define DMA_K(T,slot) glds16(ksrc+(long)(T)*64*DM,(unsigned)__builtin_amdgcn_readfirstlane(kdst+(slot)))
  #define DMA_V(u,slot) glds16(vsrc+(long)(u)*32*DM,(unsigned)__builtin_amdgcn_readfirstlane(vdst+(slot)))
  const lds_cptr shm3=(lds_cptr)shm; const lds_cptr kp0=shm3+L_K+hi*1024+r32*16;
  const lds_cptr vp0=shm3+L_V+((lane>>4)&1)*32+(lane&3)*8+(4*hi+((lane&15)>>2))*64;
  const int NT2=(q0+QB)/32, NT=NT2/2;
  DMA_K(0,0);DMA_V(0,0);DMA_K(1,KSLOT);
  bf16x8 qr[4];
  #pragma unroll
  for(int d0=0;d0<4;++d0)qr[d0]=*reinterpret_cast<const bf16x8*>(&Qw[(long)r32*DM+d0*16+hi*8]);
  float l_reg=0.f;f32x16 o[4];o[0]=f32x16{};o[1]=f32x16{};o[2]=f32x16{};o[3]=f32x16{};
  f32x16 negm;
  { float q2=0.f;
    #pragma unroll
    for(int d0=0;d0<4;++d0)
      #pragma unroll
      for(int j=0;j<8;++j){ const float qv=__uint_as_float((unsigned)(unsigned short)qr[d0][j]<<16); q2+=qv*qv; }
    auto rr=__builtin_amdgcn_permlane32_swap(__float_as_uint(q2),__float_as_uint(q2),false,false); q2=__uint_as_float(rr[0])+__uint_as_float(rr[1]);
    const float mref=__builtin_sqrtf(q2*kmax2)*1.01f+bmax+0.0078125f;
    #pragma unroll
    for(int r=0;r<16;++r)negm[r]=-mref;
    asm volatile("":"+v"(negm)); }
  const int qrel=wid*QBLK+r32;
  f32x16 pA,pB; bf16x8 kf[4]; s16x4 vlo[8],vhi[8]; u32x4 pw0,pw1;
  int sv_prev=0,sv_cur=VSLOT,sv_n1=2*VSLOT,sv_n2=3*VSLOT,sv_sp=4*VSLOT;
  int sk_cur=0,sk_next=KSLOT,sk_nn=2*KSLOT,sk_sp=3*KSLOT;
  #define ROTV() do{const int t_=sv_prev;sv_prev=sv_cur;sv_cur=sv_n1;sv_n1=sv_n2;sv_n2=sv_sp;sv_sp=t_;}while(0)
  #define ROTK() do{const int t_=sk_cur;sk_cur=sk_next;sk_next=sk_nn;sk_nn=sk_sp;sk_sp=t_;}while(0)
  #define KLD(j,p) kf[j]=*(const A2LAS bf16x8*)((p)+(j)*2048)
  DMA_K(2,2*KSLOT);DMA_V(1,VSLOT);
  WAIT_BAR(4);
  { KLD(0,kp0);KLD(1,kp0);KLD(2,kp0);KLD(3,kp0);
    pA=__builtin_amdgcn_mfma_f32_32x32x16_bf16(kf[0],qr[0],negm,0,0,0); pA=__builtin_amdgcn_mfma_f32_32x32x16_bf16(kf[1],qr[1],pA,0,0,0);
    pA=__builtin_amdgcn_mfma_f32_32x32x16_bf16(kf[2],qr[2],pA,0,0,0); pA=__builtin_amdgcn_mfma_f32_32x32x16_bf16(kf[3],qr[3],pA,0,0,0);
    if(NT2==8)bmask1(pA,0,qrel,hi,btab);
    #pragma unroll
    for(int r=0;r<16;++r)pA[r]=__builtin_amdgcn_exp2f(pA[r]);
    KLD(0,kp0+512);KLD(1,kp0+512);KLD(2,kp0+512);KLD(3,kp0+512); }
  WAIT_BAR(0);
  #define PKW(P,B) cvtpk_s(P[B],P[B+1])
  #define PAF(k) __builtin_bit_cast(bf16x8,pw##k)
  #define VFR(i) (bf16x8){vlo[i][0],vlo[i][1],vlo[i][2],vlo[i][3],vhi[i][0],vhi[i][1],vhi[i][2],vhi[i][3]}
  #define PIN(x) asm volatile("":"+v"(x))
  #define MX3(a,b,c) __builtin_fmaxf(__builtin_fmaxf((a),(b)),(c))
  #define EX(v) __builtin_amdgcn_exp2f(v)
  #define GAPA(MF,A0,A1,A2,A3,W0,W1,PW) do{ MF; sacc+=A0; sacc+=A1; sacc+=A2; sacc+=A3; PIN(sacc); W0; W1; PIN(PW); SBAR(); }while(0)
  #define GAPB(MF,X,B) do{ MF; X[B]=EX(X[B]); X[B+1]=EX(X[B+1]); PIN(X); SBAR(); }while(0)
  #define VRD(i) do{ vlo[i]=vtr(vp_+(((i)>>1)*2048+((i)&1)*1024)); vhi[i]=vtr(vp_+(((i)>>1)*2048+((i)&1)*1024+512)); }while(0)
  #define KRD(G,j) do{ if(G){ KLD(j,kn_); SBAR(); } }while(0)
  #define MF32(a,b,c) __builtin_amdgcn_mfma_f32_32x32x16_bf16(a,b,c,0,0,0)
  #define SUB(C,P,u,ODD,GK,GV,GV2,GL,MASK,MIDW) do{ SBAR(); \
    const lds_cptr vp_=vp0+sv_prev; const lds_cptr kn_=kp0+((ODD)?sk_next:(sk_cur+512)); \
    VRD(0); SBAR(); float sacc=(P[0]+P[1]); \
    GAPA(C=MF32(kf[0],qr[0],negm), P[2],P[3],P[4],P[5],     pw0[0]=PKW(P,0), pw0[1]=PKW(P,2), pw0); \
    VRD(2); SBAR(); GAPA(C=MF32(kf[1],qr[1],C), P[6],P[7],P[8],P[9],     pw0[2]=PKW(P,4), pw0[3]=PKW(P,6), pw0); \
    VRD(1); SBAR(); GAPA(C=MF32(kf[2],qr[2],C), P[10],P[11],P[12],P[13], pw1[0]=PKW(P,8), pw1[1]=PKW(P,10), pw1); \
    VRD(3); SBAR(); GAPA(C=MF32(kf[3],qr[3],C), P[14],P[15],0.f,0.f,     pw1[2]=PKW(P,12),pw1[3]=PKW(P,14), pw1); \
    l_reg+=sacc; \
    if(ODD){ if(GV){DMA_V((u)+1,sv_n1);} if(GV2){DMA_V((u)+2,sv_n2);} if(GK){DMA_K(((u)>>1)+3,sk_sp);} } \
    if(MASK){ const int jb_=(u)-(NT2-8); if(jb_>=-4)bmask1(C,jb_,qrel,hi,btab); } \
    SBAR(); \
    if((MIDW)>=0 && wid>=4){ if((MIDW)==1){WAIT_BAR(1);}else{WAIT_BAR(0);} } \
    SBAR(); \
    VRD(4); SBAR(); GAPB(o[0]=MF32(PAF(0),VFR(0),o[0]), C,0); \
    VRD(6); SBAR(); GAPB(o[1]=MF32(PAF(0),VFR(2),o[1]), C,2); \
    VRD(5); SBAR(); GAPB(o[0]=MF32(PAF(1),VFR(1),o[0]), C,4); \
    VRD(7); SBAR(); GAPB(o[1]=MF32(PAF(1),VFR(3),o[1]), C,6); \
    KRD(GL,0); GAPB(o[2]=MF32(PAF(0),VFR(4),o[2]), C,8); \
    KRD(GL,1); GAPB(o[3]=MF32(PAF(0),VFR(6),o[3]), C,10); \
    KRD(GL,2); GAPB(o[2]=MF32(PAF(1),VFR(5),o[2]), C,12); \
    KRD(GL,3); GAPB(o[3]=MF32(PAF(1),VFR(7),o[3]), C,14); \
    }while(0)
  int u=1;
  for(;u+13<NT2;u+=2){
    SUB(pB,pA,u,true,true,true,true,true,false,-1); ROTV(); ROTK();
    SUB(pA,pB,u+1,false,false,false,false,true,false,1);   if(wid<4){WAIT_BAR(1);} ROTV();
  }
  for(;u+1<NT2;u+=2){
    const bool gk=((u>>1)+3<NT), gv2=(u+2<NT2);
    SUB(pB,pA,u,true,gk,true,gv2,true,true,-1); ROTV(); ROTK();
    { const int mw_=gk?1:0; SUB(pA,pB,u+1,false,false,false,false,gv2,true,mw_); if(wid<4){ if(gk){WAIT_BAR(1);}else{WAIT_BAR(0);} } } ROTV();
  }
  SUB(pB,pA,NT2-1,true,false,false,false,false,true,-1);
  { float sacc=pB[0]+pB[1];
    #pragma unroll
    for(int r=2;r<16;++r)sacc+=pB[r];
    l_reg+=sacc;
    pw0=(u32x4){PKW(pB,0),PKW(pB,2),PKW(pB,4),PKW(pB,6)};pw1=(u32x4){PKW(pB,8),PKW(pB,10),PKW(pB,12),PKW(pB,14)};
    SBAR(); const lds_cptr vp_=vp0+sv_cur;
    #pragma unroll
    for(int db=0;db<4;++db){ VRD(2*db); VRD(2*db+1); o[db]=MF32(PAF(0),VFR(2*db),o[db]); o[db]=MF32(PAF(1),VFR(2*db+1),o[db]); } }
  #undef PKW
  #undef PAF
  #undef VFR
  #undef PIN
  #undef MX3
  #undef EX
  #undef GAPA
  #undef GAPB
  #undef VRD
  #undef KRD
  #undef SUB
  asm volatile("s_waitcnt lgkmcnt(0)\n\ts_barrier":::"memory");
  {auto rr=__builtin_amdgcn_permlane32_swap(__float_as_uint(l_reg),__float_as_uint(l_reg),false,false);l_reg=__uint_as_float(rr[0])+__uint_as_float(rr[1]);}
  if(hi==0)wsf[32+r32]=l_reg;asm volatile("s_waitcnt lgkmcnt(0)":::"memory");
  float rli[16];
  #pragma unroll
  for(int r=0;r<16;++r)rli[r]=__builtin_amdgcn_rcpf(wsf[32+crow(r,hi)]);
  bf16*Ow=O+(rowbase+q0+wid*QBLK)*OP+OC0+h*128;
  { bf16*stg=(bf16*)(shm+L_OST)+wid*4096;
    #pragma unroll
    for(int r=0;r<16;++r){const int orow=crow(r,hi);
      #pragma unroll
      for(int db=0;db<4;++db)stg[orow*128+db*32+r32]=__float2bfloat16(o[db][r]*rli[r]);}
    asm volatile("s_waitcnt lgkmcnt(0)":::"memory");
    float sg[8];
    #pragma unroll
    for(int e=0;e<8;++e)sg[e]=subg[(lane&15)*8+e]*0.8f;
    #pragma unroll
    for(int i=0;i<8;++i){const int row=i*4+(lane>>4),ch=lane&15; u32x4 v=*(const u32x4*)(stg+row*128+ch*8); bf16*gp=Ow+(long)row*OP+ch*8;
      if(pass!=0){ const u32x4 a=*(const u32x4*)gp; u32x4 w; float d[8]; float ss=0.f;
        #pragma unroll
        for(int e=0;e<4;++e){ const float a0=__uint_as_float(a[e]<<16),a1=__uint_as_float(a[e]&0xffff0000u),b0=__uint_as_float(v[e]<<16),b1=__uint_as_float(v[e]&0xffff0000u); d[2*e]=a0-lam*b0; d[2*e+1]=a1-lam*b1; ss+=d[2*e]*d[2*e]+d[2*e+1]*d[2*e+1]; }
        ss+=__shfl_xor(ss,1); ss+=__shfl_xor(ss,2); ss+=__shfl_xor(ss,4); ss+=__shfl_xor(ss,8);
        const float rs=rsqrtf(ss*(1.f/128.f)+1e-6f);
        #pragma unroll
        for(int e=0;e<4;++e) w[e]=cvtpk_s(d[2*e]*rs*sg[2*e],d[2*e+1]*rs*sg[2*e+1]);
        v=w; }
      *(u32x4*)gp=v; } }
  asm volatile("s_waitcnt lgkmcnt(0)\n\ts_barrier":::"memory");
  #undef DMA_K
  #undef DMA_V
  #undef ROTV
  #undef ROTK
  #undef KLD
  #undef MF32
}
struct Tensors { const bf16* Q; const bf16* K; const bf16* V; bf16* O; float lam; const float* relb; const float* subg; const float* kmax; };
template<int THRL=8> __device__ __forceinline__ void phase(char*lds,const Tensors&T,int grid,int block){
  const int vcu=(block%8)*(grid/8)+block/8;
  for(int i=0;i<2;++i){ const int bh=vcu>>4,s=vcu&15,qb=(i==0)?s:31-s,b_=bh>>3,h_=bh&7; float*bt_=(float*)(lds+L_BTAB);
    for(int t_=threadIdx.x;t_<BT_N;t_+=NW*64){ const int rel=t_-256; float v_=0.f;
      if(rel>=0&&rel<113){ int bk=rel; if(rel>=16){ bk=16+(int)(logf((float)rel*(1.0f/16.0f))/logf(8.0f)*16.0f); bk=bk>31?31:bk; } v_=(T.relb[bk*8+h_]-T.relb[31*8+h_])*1.4426950408889634f; }
      bt_[t_]=v_; }
    asm volatile("s_waitcnt lgkmcnt(0)\n\ts_barrier":::"memory");
    float bmax=0.f;
    for(int bk=0;bk<31;++bk)bmax=__builtin_fmaxf(bmax,(T.relb[bk*8+h_]-T.relb[31*8+h_])*1.4426950408889634f);
    for(int pass=0;pass<2;++pass){ const float*kp_=T.kmax+((bh*2+pass)*2); const float kmax2=__hip_atomic_load(kp_,__ATOMIC_RELAXED,__HIP_MEMORY_SCOPE_AGENT)+__hip_atomic_load(kp_+1,__ATOMIC_RELAXED,__HIP_MEMORY_SCOPE_AGENT);
      unit2<THRL>(b_,h_,qb,pass,T.lam,kmax2,bmax,T.subg,bt_,T.Q,T.K,T.V,T.O,lds); } }
}
#undef SBAR
#undef WAIT_BAR
#undef A2LAS
}
constexpr int NWAVES = 8;
constexpr int BATCH = 2, SEQ = 8192, DM = 1024, M = BATCH * SEQ;
constexpr int DFF = 2816, NGU = 2 * DFF;
constexpr int NQKV = 3072;
constexpr int NMIX = 2816;
constexpr int NIN = NQKV + NMIX;
constexpr int IN_WIDTH = 5648;
constexpr int KOUT = 2048;
constexpr int NMOD = 9 * DM;
constexpr int NCHUNK = SEQ / 128, NBC = BATCH * NCHUNK;
constexpr float EPS = 1e-6f;
constexpr float LAM_INIT = 0.2f;
constexpr float LOG2E = 1.4426950408889634f;

constexpr size_t MiB = 1u << 20;
constexpr size_t WS_CTL = 0, CTL_ZERO_BYTES = 64 * 1024;
constexpr size_t WS_MOD = 1 * MiB;
constexpr size_t WS_DTRAW = 2 * MiB;
constexpr size_t WS_DTS = 3 * MiB;
constexpr size_t WS_AC = 4 * MiB;
constexpr size_t WS_CDEC = 5 * MiB;
constexpr size_t WS_WA = 6 * MiB;
constexpr size_t WS_WB = 18 * MiB;
constexpr size_t WS_H = 24 * MiB;
constexpr size_t WS_U = 56 * MiB;
constexpr size_t WS_ACT = WS_U, WS_D = WS_U + 88 * MiB;
constexpr size_t WS_Q = WS_U, WS_K = WS_U + 32 * MiB, WS_V = WS_U + 64 * MiB;
constexpr size_t WS_YCAT = WS_U + 96 * MiB;
constexpr size_t WS_Z = WS_U, WS_XBC = WS_U + 32 * MiB;
constexpr size_t WS_BT = WS_U + 80 * MiB, WS_CM = WS_U + 88 * MiB;
constexpr size_t WS_XT = WS_U + 160 * MiB, WS_BM = WS_U + 192 * MiB;
constexpr size_t WS_ST = WS_H;
constexpr size_t WS_D2 = WS_U;
constexpr size_t WS_X2 = WS_U + 152 * MiB;
constexpr size_t WS_END = 256 * MiB;
static_assert(WS_BM + 8 * MiB <= WS_END && WS_D + 64 * MiB <= WS_END && WS_YCAT + 64 * MiB <= WS_XT && WS_CM + 8 * MiB <= WS_YCAT && WS_XBC + 48 * MiB <= WS_BT, "d_ws map");

constexpr int RING_OFF = 0, RING_BYTES = 131072;
constexpr int LDSCTL_OFF = RING_BYTES, MISC_OFF = LDSCTL_OFF + 320;
constexpr int LDS_BYTES = 147456;
static_assert(attn_body::LDS_TOTAL <= RING_BYTES && attn2::L_TOTAL <= RING_BYTES, "attention scratch inside the ring region");

#define GAS __attribute__((address_space(1)))
#define LAS __attribute__((address_space(3)))
typedef unsigned short bf16;
typedef unsigned v4u __attribute__((ext_vector_type(4)));
typedef unsigned v2u __attribute__((ext_vector_type(2)));
typedef float f32x4 __attribute__((ext_vector_type(4)));
typedef float f32x16 __attribute__((ext_vector_type(16)));
typedef short bf16x8 __attribute__((ext_vector_type(8)));
typedef GAS unsigned gu32;
#define RLX_AGENT __ATOMIC_RELAXED, __HIP_MEMORY_SCOPE_AGENT
#define LDS_WAIT() asm volatile("s_waitcnt lgkmcnt(0)" ::: "memory")
#define VM_WAIT() asm volatile("s_waitcnt vmcnt(0)" ::: "memory")
__device__ __forceinline__ unsigned f2bf(float f) { unsigned u = __builtin_bit_cast(unsigned, f); return (u + 0x7fffu + ((u >> 16) & 1u)) >> 16; }
typedef float f32x2_p __attribute__((ext_vector_type(2))); typedef __bf16 bf16x2_p __attribute__((ext_vector_type(2)));
__device__ __forceinline__ unsigned pk2(float lo, float hi) { f32x2_p v = {lo, hi}; return __builtin_bit_cast(unsigned, __builtin_convertvector(v, bf16x2_p)); }
__device__ __forceinline__ float bf2f(unsigned short h) { return __builtin_bit_cast(float, (unsigned)h << 16); }
__device__ __forceinline__ float bflo(unsigned w) { return __builtin_bit_cast(float, w << 16); }
__device__ __forceinline__ float bfhi(unsigned w) { return __builtin_bit_cast(float, w & 0xffff0000u); }
__device__ __forceinline__ float silu(float v) { return v * __builtin_amdgcn_rcpf(1.0f + __expf(-v)); }
__device__ __forceinline__ int crow(int r, int hi) { return (r & 3) + 8 * (r >> 2) + 4 * hi; }
#define MFMA32(a, b, c) __builtin_amdgcn_mfma_f32_32x32x16_bf16(a, b, c, 0, 0, 0)

#define XB_TMO      128
#define XB_XCNT(j)  (256  + 64 * (j))
#define XB_XSUB(j)  (1280 + 64 * (j))
#define XB_XGEN(j)  (2304 + 64 * (j))
#define XB_TOP      3328
#define XB_TOPGEN   3392
#define XCD_BAR_WORDS 3456
#define XB_SPIN_CAP (1u << 18)
constexpr int CW_KMAX = 12288;
constexpr int CW_BAR = 4096;
static_assert((CW_BAR + XCD_BAR_WORDS) <= CW_KMAX && (CW_KMAX + 64) * 4 <= (int)CTL_ZERO_BYTES, "control words inside the memset region");
__device__ __forceinline__ unsigned xb_ld(unsigned* p)              { return __hip_atomic_load(p, __ATOMIC_RELAXED, __HIP_MEMORY_SCOPE_AGENT); }
__device__ __forceinline__ unsigned xb_add(unsigned* p, unsigned v) { return __hip_atomic_fetch_add(p, v, __ATOMIC_RELAXED, __HIP_MEMORY_SCOPE_AGENT); }
__device__ __forceinline__ unsigned xb_xcc_id() { return (unsigned)__builtin_amdgcn_s_getreg((3 << 11) | 20) & 0xFu; }
#define XB_SPIN(cond, bar) do { unsigned _sp = 0; while (cond) { __builtin_amdgcn_s_sleep(1); \
    if ((++_sp & 255u) == 0u) { if (xb_ld(&(bar)[XB_TMO])) break; if (_sp > XB_SPIN_CAP) { atomicAdd(&(bar)[XB_TMO], 1u); break; } } } } while (0)
struct XcdBarrier { unsigned* bar; unsigned x; volatile LAS unsigned* st; };
__device__ __forceinline__ XcdBarrier xcd_barrier_post(unsigned* bar, volatile LAS unsigned* st) {
    XcdBarrier b; b.bar = bar; b.x = xb_xcc_id(); b.st = st;
    if (threadIdx.x == 0) (void)xb_add(&bar[XB_XCNT(b.x)], 1u);
    return b;
}
__device__ __forceinline__ void xcd_barrier_complete(unsigned* bar, unsigned x, unsigned& nloc, unsigned& nx) {
    const unsigned G = gridDim.x * gridDim.y * gridDim.z;
    unsigned sum, cnt, mine, sp = 0u;
    for (;;) {
        sum = 0u; cnt = 0u; mine = 0u;
#pragma unroll
        for (unsigned j = 0; j < 16; ++j) { const unsigned c = xb_ld(&bar[XB_XCNT(j)]); sum += c; cnt += (c > 0u) ? 1u : 0u; mine = (j == x) ? c : mine; }
        if (sum == G) break;
        __builtin_amdgcn_s_sleep(1);
        if ((++sp & 255u) == 0u) { if (xb_ld(&bar[XB_TMO])) break; if (sp > XB_SPIN_CAP) { atomicAdd(&bar[XB_TMO], 1u); break; } }
    }
    nloc = mine > 0u ? mine : 1u; nx = cnt > 0u ? cnt : 1u;
}
__device__ __forceinline__ void xcd_barrier(const XcdBarrier& b) {
    asm volatile("s_waitcnt vmcnt(0)" ::: "memory");
    __syncthreads();
    if (threadIdx.x == 0) {
        unsigned* bar = b.bar;
        __builtin_amdgcn_s_waitcnt(0);
        unsigned nloc = b.st[0], nx = b.st[1];
        if (nloc == 0u) { xcd_barrier_complete(bar, b.x, nloc, nx); b.st[0] = nloc; b.st[1] = nx; }
        const unsigned old = xb_add(&bar[XB_XSUB(b.x)], 1u);
        const unsigned gen = old / nloc;
        if (old + 1u == (gen + 1u) * nloc) {
            __builtin_amdgcn_fence(__ATOMIC_RELEASE, "agent");
            asm volatile("s_waitcnt vmcnt(0)" ::: "memory");
            const unsigned og = xb_add(&bar[XB_TOP], 1u);
            const unsigned tg = og / nx;
            if (og + 1u == (tg + 1u) * nx) xb_add(&bar[XB_TOPGEN], 1u);
            else XB_SPIN(xb_ld(&bar[XB_TOPGEN]) == tg, bar);
            __builtin_amdgcn_fence(__ATOMIC_ACQUIRE, "agent");
            xb_add(&bar[XB_XGEN(b.x)], 1u);
            asm volatile("s_waitcnt vmcnt(0)" ::: "memory");
        } else {
            XB_SPIN(xb_ld(&bar[XB_XGEN(b.x)]) == gen, bar);
            __builtin_amdgcn_fence(__ATOMIC_ACQUIRE, "agent");
            asm volatile("s_waitcnt vmcnt(0)" ::: "memory");
        }
    }
    __syncthreads();
}

struct Frame {
    LAS unsigned char* lds;
    int tid, lane, wave;
    int vcu, G;
    int gw, NGW;
};
__device__ __forceinline__ float wave_sum(float v) {
#pragma unroll
    for (int o = 1; o < 64; o <<= 1) v += __shfl_xor(v, o);
    return v;
}
__device__ __forceinline__ void tr_item(const float* W, int N, int n0, int k0, bf16* WT, int K, int drow0, int nvalid, LAS float* scr, int lane) {
#pragma unroll 8
    for (int i = 0; i < 32; ++i) { const int kk = 2 * i + (lane >> 5); scr[kk * 33 + (lane & 31)] = W[(size_t)(k0 + kk) * N + n0 + (lane & 31)]; }
    LDS_WAIT(); asm volatile("" ::: "memory");
    const int c = lane & 7;
#pragma unroll
    for (int j = 0; j < 4; ++j) { const int n = (lane >> 3) + 8 * j; const LAS float* s = scr + (8 * c) * 33 + n;
        v4u o; o.x = pk2(s[0 * 33], s[1 * 33]); o.y = pk2(s[2 * 33], s[3 * 33]); o.z = pk2(s[4 * 33], s[5 * 33]); o.w = pk2(s[6 * 33], s[7 * 33]);
        if (n >= nvalid) o = (v4u){0u, 0u, 0u, 0u};
        *(GAS v4u*)(WT + (size_t)(drow0 + n) * K + k0 + 8 * c) = o; }
    LDS_WAIT(); asm volatile("" ::: "memory");
}
__device__ __forceinline__ void convert_gu_half(Frame& F, int w, int nw, const float* Wx, int up, bf16* WA) {
    LAS float* scr = (LAS float*)(F.lds + RING_OFF + F.wave * 16384);
    constexpr int NB = DFF / 32, I_G = (DM / 64) * NB;
    for (int r = w; r < I_G; r += nw) { const int kb = r / NB, nb = r % NB, n0 = 32 * nb;
        tr_item(Wx, DFF, n0, 64 * kb, WA, DM, (n0 >> 7) * 256 + (n0 & 127) + (up ? 128 : 0), 32, scr, F.lane); }
}
__device__ __forceinline__ void convert_down(Frame& F, int w, int nw, const float* Wd, bf16* WB) {
    LAS float* scr = (LAS float*)(F.lds + RING_OFF + F.wave * 16384);
    constexpr int I_D = (DFF / 64) * (DM / 32);
    for (int r = w; r < I_D; r += nw) { const int kb = r / (DM / 32), nb = r % (DM / 32); tr_item(Wd, DM, 32 * nb, 64 * kb, WB, DFF, 32 * nb, 32, scr, F.lane); }
}
template <bool WITH_DOWN> __device__ __forceinline__ void convert_ffn(Frame& F, const float* Wg, const float* Wu, const float* Wd, bf16* WA, bf16* WB) {
    LAS float* scr = (LAS float*)(F.lds + RING_OFF + F.wave * 16384);
    constexpr int NB = DFF / 32, I_G = (DM / 64) * NB, I_D = (DFF / 64) * (DM / 32);
    for (int it = F.gw; it < 2 * I_G + (WITH_DOWN ? I_D : 0); it += F.NGW) {
        int r = it;
        if (r < 2 * I_G) { const int up = r >= I_G; if (up) r -= I_G; const int kb = r / NB, nb = r % NB, n0 = 32 * nb;
            tr_item(up ? Wu : Wg, DFF, n0, 64 * kb, WA, DM, (n0 >> 7) * 256 + (n0 & 127) + (up ? 128 : 0), 32, scr, F.lane); continue; }
        r -= 2 * I_G; { const int kb = r / (DM / 32), nb = r % (DM / 32); tr_item(Wd, DM, 32 * nb, 64 * kb, WB, DFF, 32 * nb, 32, scr, F.lane); }
    }
}
__device__ __forceinline__ void convert_mix(Frame& F, int w, int nw, const float* Win, const float* Wout, bf16* WA, bf16* WB) {
    LAS float* scr = (LAS float*)(F.lds + RING_OFF + F.wave * 16384);
    constexpr int NB_IN = 177, I_IN = (DM / 64) * NB_IN, I_OUT = (KOUT / 64) * (DM / 32);
    for (int it = w; it < I_IN + I_OUT; it += nw) {
        int r = it;
        if (r < I_IN) { const int kb = r / NB_IN; int nb = r % NB_IN; int src, dst, nv = 32;
            if (nb < 32) { src = 0 + 32 * nb; dst = 3072 + 32 * nb; }
            else if (nb < 80) { nb -= 32; src = 1024 + 32 * nb; dst = 4096 + 32 * nb; }
            else if (nb < 81) { src = 2560; dst = 5632; nv = 16; }
            else if (nb < 113) { nb -= 81; src = 2576 + 32 * nb; dst = 0 + 32 * nb; }
            else if (nb < 145) { nb -= 113; src = 3600 + 32 * nb; dst = 1024 + 32 * nb; }
            else { nb -= 145; src = 4624 + 32 * nb; dst = 2048 + 32 * nb; }
            tr_item(Win, IN_WIDTH, src, 64 * kb, WA, DM, dst, nv, scr, F.lane); continue; }
        r -= I_IN; { const int kb = r / (DM / 32), nb = r % (DM / 32); tr_item(Wout, DM, 32 * nb, 64 * kb, WB, KOUT, 32 * nb, 32, scr, F.lane); }
    }
    { GAS v4u* z = (GAS v4u*)(WA + (size_t)5664 * DM); const int n16 = 224 * DM * 2 / 16;
      for (int i = w * 64 + F.lane; i < n16; i += nw * 64) z[i] = (v4u){0u, 0u, 0u, 0u}; }
}
__device__ __forceinline__ void mod_gemv(Frame& F, const float* c, const float* w_ada, const float* b_ada, float* mod) {
    LAS float* cs = (LAS float*)(F.lds + RING_OFF);
    LAS float* red = cs + 2048;
    __syncthreads();
    for (int i = F.tid; i < 2 * DM; i += NWAVES * 64) cs[i] = silu(c[i]);
    __syncthreads();
    for (int u = blockIdx.x; u < NMOD / 64; u += F.G) {
        const int col = 64 * u + F.lane; float a0 = 0.f, a1 = 0.f;
        const float* wp = w_ada + (size_t)(128 * F.wave) * NMOD + col;
#pragma unroll 16
        for (int k = 0; k < 128; ++k) { const float w = wp[(size_t)k * NMOD]; a0 += cs[128 * F.wave + k] * w; a1 += cs[DM + 128 * F.wave + k] * w; }
        red[(F.wave * 2 + 0) * 64 + F.lane] = a0; red[(F.wave * 2 + 1) * 64 + F.lane] = a1;
        __syncthreads();
        if (F.tid < 128) { const int b = F.tid >> 6, l = F.tid & 63; float s = b_ada[64 * u + l];
#pragma unroll
            for (int w = 0; w < 8; ++w) s += red[(w * 2 + b) * 64 + l];
            mod[b * NMOD + 64 * u + l] = s; }
        __syncthreads();
    }
}

struct Row16 { f32x4 v[4]; };
__device__ __forceinline__ Row16 ld_row(const float* p, int lane) { Row16 r; const GAS f32x4* q = (const GAS f32x4*)p + lane;
#pragma unroll
    for (int j = 0; j < 4; ++j) r.v[j] = q[64 * j];
    return r; }
__device__ __forceinline__ Row16 ld_row_bf(const bf16* p, int lane) { Row16 r; const GAS v2u* q = (const GAS v2u*)p + lane;
#pragma unroll
    for (int j = 0; j < 4; ++j) { const v2u w = q[64 * j]; r.v[j] = (f32x4){bflo(w.x), bfhi(w.x), bflo(w.y), bfhi(w.y)}; }
    return r; }
__device__ __forceinline__ float row_ssq_part(const Row16& r) { float s = 0.f;
#pragma unroll
    for (int j = 0; j < 4; ++j) s += (r.v[j].x * r.v[j].x + r.v[j].y * r.v[j].y) + (r.v[j].z * r.v[j].z + r.v[j].w * r.v[j].w);
    return s; }
__device__ __forceinline__ void st_row_bf(bf16* out, const Row16& h, int lane) { GAS unsigned long long* o8 = (GAS unsigned long long*)out + lane;
#pragma unroll
    for (int j = 0; j < 4; ++j) o8[64 * j] = (unsigned long long)pk2(h.v[j].x, h.v[j].y) | ((unsigned long long)pk2(h.v[j].z, h.v[j].w) << 32); }
constexpr int RW = 4;
__device__ __forceinline__ void rows_first(Frame& F, const float* x, const float* pre_g, const float* mod, int sidx, bf16* H) {
#pragma unroll 1
    for (int b = 0; b < BATCH; ++b) { const float* mb = mod + b * NMOD;
        Row16 A = ld_row(pre_g, F.lane); const Row16 SC = ld_row(mb + (sidx + 1) * DM, F.lane), S = ld_row(mb + sidx * DM, F.lane);
#pragma unroll
        for (int j = 0; j < 4; ++j) A.v[j] = A.v[j] * (SC.v[j] + 1.0f);
#pragma unroll 1
        for (int r = F.gw; r < SEQ; r += RW * F.NGW) { Row16 xr[RW]; size_t m[RW]; bool ok[RW];
#pragma unroll
            for (int q = 0; q < RW; ++q) { ok[q] = r + q * F.NGW < SEQ; m[q] = (size_t)b * SEQ + (ok[q] ? r + q * F.NGW : r); xr[q] = ld_row(x + m[q] * DM, F.lane); }
#pragma unroll
            for (int q = 0; q < RW; ++q) { const float rs = rsqrtf(wave_sum(row_ssq_part(xr[q])) * (1.f / DM) + EPS);
#pragma unroll
                for (int j = 0; j < 4; ++j) xr[q].v[j] = xr[q].v[j] * rs * A.v[j] + S.v[j];
                if (ok[q]) st_row_bf(H + m[q] * DM, xr[q], F.lane); } } }
}
template <bool NEXT, bool XIB, bool XOB> __device__ __forceinline__ void rows_res(Frame& F, const void* xin, const bf16* Dm, const float* post_g, const float* mod, int gidx, float gscale, void* xo,
                                                                                  const float* pre_g, int sidx, bf16* H) {
#pragma unroll 1
    for (int b = 0; b < BATCH; ++b) { const float* mb = mod + b * NMOD;
        Row16 PGT = ld_row(post_g, F.lane); { const Row16 GT = ld_row(mb + gidx * DM, F.lane);
#pragma unroll
            for (int j = 0; j < 4; ++j) PGT.v[j] = PGT.v[j] * GT.v[j] * gscale; }
        Row16 A, S;
        if (NEXT) { A = ld_row(pre_g, F.lane); const Row16 SC = ld_row(mb + (sidx + 1) * DM, F.lane); S = ld_row(mb + sidx * DM, F.lane);
#pragma unroll
            for (int j = 0; j < 4; ++j) A.v[j] = A.v[j] * (SC.v[j] + 1.0f); }
#pragma unroll 1
        for (int r = F.gw; r < SEQ; r += RW * F.NGW) { Row16 xr[RW], dr[RW]; size_t m[RW]; bool ok[RW];
#pragma unroll
            for (int q = 0; q < RW; ++q) { ok[q] = r + q * F.NGW < SEQ; m[q] = (size_t)b * SEQ + (ok[q] ? r + q * F.NGW : r);
                xr[q] = XIB ? ld_row_bf((const bf16*)xin + m[q] * DM, F.lane) : ld_row((const float*)xin + m[q] * DM, F.lane); dr[q] = ld_row_bf(Dm + m[q] * DM, F.lane); }
#pragma unroll
            for (int q = 0; q < RW; ++q) { const float qs = rsqrtf(wave_sum(row_ssq_part(dr[q])) * (1.f / DM) + EPS);
#pragma unroll
                for (int j = 0; j < 4; ++j) xr[q].v[j] = xr[q].v[j] + PGT.v[j] * (dr[q].v[j] * qs);
                if (ok[q]) { if (XOB) st_row_bf((bf16*)xo + m[q] * DM, xr[q], F.lane);
                    else { GAS f32x4* o = (GAS f32x4*)((float*)xo + m[q] * DM) + F.lane;
#pragma unroll
                        for (int j = 0; j < 4; ++j) o[64 * j] = xr[q].v[j]; } }
                if (NEXT) { const float rs = rsqrtf(wave_sum(row_ssq_part(xr[q])) * (1.f / DM) + EPS);
#pragma unroll
                    for (int j = 0; j < 4; ++j) xr[q].v[j] = xr[q].v[j] * rs * A.v[j] + S.v[j];
                    if (ok[q]) st_row_bf(H + m[q] * DM, xr[q], F.lane); } } } }
}
__device__ __forceinline__ float bf_elem(const v4u& w, int e) { const unsigned u = (e >> 1) == 0 ? w.x : (e >> 1) == 1 ? w.y : (e >> 1) == 2 ? w.z : w.w; return (e & 1) ? bfhi(u) : bflo(u); }
__device__ __forceinline__ void conv_item(int lane, int bc, int cg, const bf16* XBC, const float* conv_w, const float* conv_b, bf16* XT, bf16* Bm, bf16* BTm, bf16* Cm) {
    const int o = lane >> 2, q = lane & 3, c = bc % NCHUNK; const size_t t0 = (size_t)bc * 128;
    const int ch0 = cg * 32 + q * 8;
    v4u raw[11];
#pragma unroll
    for (int k = 0; k < 11; ++k) { const int row = 8 * o + k - 3; raw[k] = (v4u){0u, 0u, 0u, 0u};
        if (row >= 0 || c > 0) raw[k] = *(const GAS v4u*)(XBC + (size_t)((long)t0 + row) * 1536 + ch0); }
    float wk[4][8], cb[8];
#pragma unroll
    for (int k = 0; k < 4; ++k) { const f32x4 a = *(const GAS f32x4*)(conv_w + k * 1536 + ch0), b = *(const GAS f32x4*)(conv_w + k * 1536 + ch0 + 4);
#pragma unroll
        for (int e = 0; e < 4; ++e) { wk[k][e] = a[e]; wk[k][4 + e] = b[e]; } }
    { const f32x4 a = *(const GAS f32x4*)(conv_b + ch0), b = *(const GAS f32x4*)(conv_b + ch0 + 4);
#pragma unroll
      for (int e = 0; e < 4; ++e) { cb[e] = a[e]; cb[4 + e] = b[e]; } }
    float outv[8][8];
#pragma unroll
    for (int e = 0; e < 8; ++e) { float x[11];
#pragma unroll
        for (int k = 0; k < 11; ++k) x[k] = bf_elem(raw[k], e);
#pragma unroll
        for (int jj = 0; jj < 8; ++jj) outv[jj][e] = silu(cb[e] + wk[0][e] * x[jj] + wk[1][e] * x[jj + 1] + wk[2][e] * x[jj + 2] + wk[3][e] * x[jj + 3]); }
    if (cg < 40) {
        bf16* dst;
        if (cg < 32) dst = XT + (((size_t)bc * 16 + (cg >> 1)) * 64 + (cg & 1) * 32 + q * 8) * 128 + 8 * o;
        else { const int bb = cg - 32; dst = BTm + (((size_t)bc * 2 + (bb >> 2)) * 128 + (bb & 3) * 32 + q * 8) * 128 + 8 * o; }
#pragma unroll
        for (int e = 0; e < 8; ++e) { v4u w; w.x = pk2(outv[0][e], outv[1][e]); w.y = pk2(outv[2][e], outv[3][e]); w.z = pk2(outv[4][e], outv[5][e]); w.w = pk2(outv[6][e], outv[7][e]);
            *(GAS v4u*)(dst + (size_t)e * 128) = w; }
    }
    if (cg >= 32) {
        const int bb = (cg - 32) & 7; bf16* dst = (cg < 40 ? Bm : Cm) + (((size_t)bc * 2 + ((bb & 7) >> 2)) * 128 + 8 * o) * 128 + (bb & 3) * 32 + q * 8;
#pragma unroll
        for (int jj = 0; jj < 8; ++jj) { v4u w; w.x = pk2(outv[jj][0], outv[jj][1]); w.y = pk2(outv[jj][2], outv[jj][3]); w.z = pk2(outv[jj][4], outv[jj][5]); w.w = pk2(outv[jj][6], outv[jj][7]);
            *(GAS v4u*)(dst + (size_t)jj * 128) = w; }
    }
}
__device__ __forceinline__ void dt_item(int lane, int it, const float* dtraw, const float* dt_bias, const float* a_log, float* DTS, float* AC, float* CDEC) {
    const int bc = it >> 4, h = it & 15; const size_t t0 = (size_t)bc * 128;
    const float bias = dt_bias[h], a = -__expf(a_log[h]);
    const float x0 = dtraw[(t0 + 2 * lane) * 16 + h] + bias, x1 = dtraw[(t0 + 2 * lane + 1) * 16 + h] + bias;
    const float d0 = x0 > 20.f ? x0 : log1pf(__expf(x0)), d1 = x1 > 20.f ? x1 : log1pf(__expf(x1));
    float* dp = DTS + (size_t)it * 128 + 2 * lane; dp[0] = d0; dp[1] = d1;
    const float v0 = d0 * a, v1 = d1 * a, s = v0 + v1; float inc = s;
#pragma unroll
    for (int sh = 1; sh < 64; sh <<= 1) { const float t = __shfl_up(inc, sh); if (lane >= sh) inc += t; }
    const float ex = inc - s; float* acp = AC + (size_t)it * 128 + 2 * lane; acp[0] = ex + v0; acp[1] = ex + v0 + v1;
    if (lane == 63) CDEC[it] = __expf(inc);
}
__device__ __forceinline__ bf16x8 scale8(v4u w, const float* s) {
    v4u o; o.x = pk2(bflo(w.x) * s[0], bfhi(w.x) * s[1]); o.y = pk2(bflo(w.y) * s[2], bfhi(w.y) * s[3]); o.z = pk2(bflo(w.z) * s[4], bfhi(w.z) * s[5]); o.w = pk2(bflo(w.w) * s[6], bfhi(w.w) * s[7]);
    return __builtin_bit_cast(bf16x8, o); }
__device__ __forceinline__ void states_item(Frame& F, int it2, const bf16* XT, const bf16* BTm, const float* DTS, const float* AC, bf16* ST) {
    LAS float* wl = (LAS float*)(F.lds + RING_OFF + F.wave * 1024);
    { const int it = it2 >> 1, nh = it2 & 1, bc = it >> 4, h = it & 15, g = h >> 3;
        int lane_ = F.lane; asm volatile("" : "+v"(lane_));
        const int r32 = lane_ & 31, hi = lane_ >> 5;
        const bf16* xt = XT + (size_t)it * 64 * 128 + (size_t)r32 * 128 + 8 * hi; const bf16* bt = BTm + ((size_t)bc * 2 + g) * 128 * 128 + (size_t)(64 * nh + r32) * 128 + 8 * hi;
        { const float acl = AC[(size_t)it * 128 + 127]; const float2 d2 = *(const float2*)(DTS + (size_t)it * 128 + 2 * lane_), a2 = *(const float2*)(AC + (size_t)it * 128 + 2 * lane_);
          wl[2 * lane_] = d2.x * __expf(acl - a2.x); wl[2 * lane_ + 1] = d2.y * __expf(acl - a2.y); }
        f32x16 acc[2][2];
#pragma unroll
        for (int a = 0; a < 2; ++a) { acc[a][0] = f32x16{}; acc[a][1] = f32x16{}; }
#pragma unroll 1
        for (int kh = 0; kh < 2; ++kh) { v4u xa[4][2], ba[4][2];
#pragma unroll
            for (int ks = 0; ks < 4; ++ks)
#pragma unroll
                for (int b2 = 0; b2 < 2; ++b2) { xa[ks][b2] = *(const GAS v4u*)(xt + (size_t)(32 * b2) * 128 + 16 * (4 * kh + ks)); ba[ks][b2] = *(const GAS v4u*)(bt + (size_t)(32 * b2) * 128 + 16 * (4 * kh + ks)); }
#pragma unroll
            for (int ks = 0; ks < 4; ++ks) { float wv[8];
                { const f32x4 w0 = *(const LAS f32x4*)(wl + 16 * (4 * kh + ks) + 8 * hi), w1 = *(const LAS f32x4*)(wl + 16 * (4 * kh + ks) + 8 * hi + 4);
#pragma unroll
                  for (int e = 0; e < 4; ++e) { wv[e] = w0[e]; wv[4 + e] = w1[e]; } }
                bf16x8 xf[2];
#pragma unroll
                for (int pb = 0; pb < 2; ++pb) xf[pb] = scale8(xa[ks][pb], wv);
#pragma unroll
                for (int nb = 0; nb < 2; ++nb) { const bf16x8 bfv = __builtin_bit_cast(bf16x8, ba[ks][nb]);
#pragma unroll
                    for (int pb = 0; pb < 2; ++pb) acc[nb][pb] = MFMA32(bfv, xf[pb], acc[nb][pb]); } } }
        bf16* st = ST + (size_t)it * 64 * 128 + 64 * nh;
#pragma unroll
        for (int nb = 0; nb < 2; ++nb)
#pragma unroll
            for (int pb = 0; pb < 2; ++pb)
#pragma unroll
                for (int g4 = 0; g4 < 4; ++g4) { v2u w; w.x = pk2(acc[nb][pb][4 * g4], acc[nb][pb][4 * g4 + 1]); w.y = pk2(acc[nb][pb][4 * g4 + 2], acc[nb][pb][4 * g4 + 3]);
                    *(GAS v2u*)(st + (size_t)(32 * pb + r32) * 128 + 32 * nb + 8 * g4 + 4 * hi) = w; }
    }
}
__device__ __forceinline__ void ssd_conv_states(Frame& F, const bf16* XBC, const float* dtraw, const float* conv_w, const float* conv_b, const float* dt_bias, const float* a_log,
                                                bf16* XT, bf16* Bm, bf16* BTm, bf16* Cm, float* DTS, float* AC, float* CDEC, bf16* ST) {
    for (int pr = blockIdx.x; pr < NBC * 2; pr += F.G) { const int bc = pr >> 1, hh = pr & 1;
#pragma unroll 1
        for (int k = F.wave; k < 32; k += NWAVES) {
            if (k < 16) conv_item(F.lane, bc, 16 * hh + k, XBC, conv_w, conv_b, XT, Bm, BTm, Cm);
            else if (k < 20) conv_item(F.lane, bc, 32 + 4 * hh + (k - 16), XBC, conv_w, conv_b, XT, Bm, BTm, Cm);
            else if (k < 24) conv_item(F.lane, bc, 40 + 4 * hh + (k - 20), XBC, conv_w, conv_b, XT, Bm, BTm, Cm);
            else dt_item(F.lane, bc * 16 + 8 * hh + (k - 24), dtraw, dt_bias, a_log, DTS, AC, CDEC); }
        asm volatile("s_waitcnt vmcnt(0)" ::: "memory");
        if (F.tid == 0) { __builtin_amdgcn_fence(__ATOMIC_ACQUIRE, "agent"); asm volatile("s_waitcnt vmcnt(0)" ::: "memory"); }
        __syncthreads();
#pragma unroll 1
        for (int k = F.wave; k < 16; k += NWAVES) states_item(F, ((bc * 16 + 8 * hh + (k >> 1)) << 1) | (k & 1), XT, BTm, DTS, AC, ST);
        __syncthreads();
    }
}
__device__ __forceinline__ void ssd_scan(Frame& F, bf16* ST, const float* CDEC) {
    constexpr int PER_B = 16 * 64 * 128 / 2;
    for (int T = blockIdx.x * (NWAVES * 64) + F.tid; T < BATCH * PER_B; T += F.G * NWAVES * 64) { const int b = T / PER_B, e = T % PER_B, h = e / (64 * 128 / 2);
        GAS unsigned* p = (GAS unsigned*)ST + (size_t)b * NCHUNK * PER_B + e; unsigned v[NCHUNK];
#pragma unroll
        for (int c = 0; c < NCHUNK; ++c) v[c] = p[(size_t)c * PER_B];
        float r0 = 0.f, r1 = 0.f;
#pragma unroll
        for (int c = 0; c < NCHUNK; ++c) { const float dec = CDEC[(b * NCHUNK + c) * 16 + h]; p[(size_t)c * PER_B] = pk2(r0, r1); r0 = r0 * dec + bflo(v[c]); r1 = r1 * dec + bfhi(v[c]); }
    }
}
template <int PM  > __device__ __forceinline__ void ssd_out(Frame& F, const bf16* XT, const bf16* Bm, const bf16* Cm, const bf16* ST, const float* DTS, const float* AC, const bf16* Z,
                                        const float* d_skip, const float* norm_g, bf16* YCAT) {
    constexpr int CP = 136;
    LAS bf16* CmS = (LAS bf16*)(F.lds + RING_OFF);
    LAS bf16* BmS = CmS + 128 * CP;
    LAS float* CBs = (LAS float*)(BmS);
    LAS float* acl = (LAS float*)(F.lds + RING_OFF + 34816 + 67584);
    LAS float* dtl = acl + 8 * 128;
    LAS float* red = dtl + 8 * 128;
    LAS float* rsd = red + 8 * 128;
    for (int it = blockIdx.x; it < NBC * 2; it += F.G) {
        int lane_ = F.lane; asm volatile("" : "+v"(lane_));
        const int r32 = lane_ & 31, hi = lane_ >> 5, w = F.wave;
        const int bc = it >> 1, g = it & 1, h = 8 * g + w; const size_t t0 = (size_t)bc * 128;
        __syncthreads();
        { const GAS v4u* cg_ = (const GAS v4u*)(Cm + (size_t)it * 128 * 128); const GAS v4u* bg_ = (const GAS v4u*)(Bm + (size_t)it * 128 * 128);
#pragma unroll
          for (int q = 0; q < 4; ++q) { const int idx = F.tid + 512 * q, row = idx >> 4, c16 = idx & 15;
              const v4u cv = cg_[idx], bv = bg_[idx];
              *(LAS v4u*)(CmS + row * CP + c16 * 8) = cv; *(LAS v4u*)(BmS + row * CP + c16 * 8) = bv; }
          for (int i = F.tid; i < 1024; i += NWAVES * 64) { acl[i] = AC[((size_t)bc * 16 + 8 * g) * 128 + i] * LOG2E; dtl[i] = DTS[((size_t)bc * 16 + 8 * g) * 128 + i]; } }
        __syncthreads();
        { f32x16 cbt[2];
#pragma unroll
          for (int tt = 0; tt < 2; ++tt) { const int ib = (2 * w + tt) >> 2, jb = (2 * w + tt) & 3; cbt[tt] = f32x16{};
            if (jb <= ib) {
#pragma unroll
                for (int ks = 0; ks < 8; ++ks) { const int n0 = 16 * ks + 8 * hi;
                    const bf16x8 a = *(const LAS bf16x8*)(CmS + (32 * ib + r32) * CP + n0), b = *(const LAS bf16x8*)(BmS + (32 * jb + r32) * CP + n0);
                    cbt[tt] = MFMA32(a, b, cbt[tt]); } } }
          __syncthreads();
#pragma unroll
          for (int tt = 0; tt < 2; ++tt) { const int ib = (2 * w + tt) >> 2, jb = (2 * w + tt) & 3;
            if (jb <= ib) {
#pragma unroll
                for (int r = 0; r < 16; ++r) CBs[(32 * ib + crow(r, hi)) * 132 + 32 * jb + r32] = cbt[tt][r]; } } }
        __syncthreads();
        const LAS float* ach = acl + w * 128; const LAS float* dth = dtl + w * 128;
        const float dsk = d_skip[h];
        if (PM == 1) continue;
        const int prm = (r32 & 3) + 4 * ((r32 >> 3) & 1) + 8 * ((r32 >> 2) & 1) + 16 * (r32 >> 4);
        const bf16* xt = XT + ((size_t)bc * 16 + h) * 64 * 128 + (size_t)prm * 128 + 8 * hi; const bf16* hin = ST + ((size_t)bc * 16 + h) * 64 * 128 + (size_t)prm * 128 + 8 * hi;
        v4u hf[8][2], xf[8][2];
#pragma unroll
        for (int ks = 0; ks < 8; ++ks)
#pragma unroll
            for (int pb = 0; pb < 2; ++pb) { hf[ks][pb] = *(const GAS v4u*)(hin + (size_t)(32 * pb) * 128 + 16 * ks); xf[ks][pb] = *(const GAS v4u*)(xt + (size_t)(32 * pb) * 128 + 16 * ks); }
#pragma unroll 1
        for (int ib = 0; ib < 4; ++ib) { const int i = 32 * ib + r32; const float aci = ach[i];
            int hj = 8 * hi; asm volatile("" : "+v"(hj));
            const bf16* zp = Z + (t0 + i) * 1024 + h * 64 + 8 * hi; v4u zq[2][2];
#pragma unroll
            for (int pb = 0; pb < 2; ++pb)
#pragma unroll
                for (int g2 = 0; g2 < 2; ++g2) zq[pb][g2] = *(const GAS v4u*)(zp + 32 * pb + 16 * g2);
            f32x16 acc0 = f32x16{}, acc1 = f32x16{};
            { const float ei = __builtin_amdgcn_exp2f(aci); float es[8];
#pragma unroll
              for (int e = 0; e < 8; ++e) es[e] = ei;
#pragma unroll
              for (int ks = 0; ks < 8; ++ks) { const bf16x8 bfv = scale8(*(const LAS v4u*)(CmS + i * CP + 16 * ks + hj), es);
                acc0 = MFMA32(__builtin_bit_cast(bf16x8, hf[ks][0]), bfv, acc0); acc1 = MFMA32(__builtin_bit_cast(bf16x8, hf[ks][1]), bfv, acc1); } }
#pragma unroll
            for (int ks = 0; ks < 8; ++ks) if (ks < 2 * ib + 2) { const int j0 = 16 * ks + hj; float m[8];
                { const f32x4 c0 = *(const LAS f32x4*)(CBs + i * 132 + j0), c1 = *(const LAS f32x4*)(CBs + i * 132 + j0 + 4);
                  const f32x4 a0 = *(const LAS f32x4*)(ach + j0), a1 = *(const LAS f32x4*)(ach + j0 + 4), d0 = *(const LAS f32x4*)(dth + j0), d1 = *(const LAS f32x4*)(dth + j0 + 4);
#pragma unroll
                  for (int e = 0; e < 4; ++e) { m[e] = c0[e] * __builtin_amdgcn_exp2f(aci - a0[e]) * d0[e]; m[4 + e] = c1[e] * __builtin_amdgcn_exp2f(aci - a1[e]) * d1[e]; }
                  if (ks >= 2 * ib) {
#pragma unroll
                      for (int e = 0; e < 8; ++e) { m[e] = (j0 + e <= i) ? m[e] : 0.f; if (j0 + e == i) m[e] += dsk; } } }
                v4u pw; pw.x = pk2(m[0], m[1]); pw.y = pk2(m[2], m[3]); pw.z = pk2(m[4], m[5]); pw.w = pk2(m[6], m[7]);
                const bf16x8 mf = __builtin_bit_cast(bf16x8, pw);
                acc0 = MFMA32(__builtin_bit_cast(bf16x8, xf[ks][0]), mf, acc0); acc1 = MFMA32(__builtin_bit_cast(bf16x8, xf[ks][1]), mf, acc1); }
            float ss = 0.f;
#pragma unroll
            for (int pb = 0; pb < 2; ++pb)
#pragma unroll
                for (int g2 = 0; g2 < 2; ++g2) { const v4u z = zq[pb][g2]; const float zv[8] = {bflo(z.x), bfhi(z.x), bflo(z.y), bfhi(z.y), bflo(z.z), bfhi(z.z), bflo(z.w), bfhi(z.w)};
#pragma unroll
                    for (int e = 0; e < 8; ++e) { const float y = (pb ? acc1[8 * g2 + e] : acc0[8 * g2 + e]) * silu(zv[e]); ss += y * y; if (pb) acc1[8 * g2 + e] = y; else acc0[8 * g2 + e] = y; } }
            ss += __shfl_xor(ss, 32);
            if (PM == 2) { asm volatile("" :: "v"(ss)); continue; }
            if (hi == 0) red[w * 32 + r32] = ss;
            __syncthreads();
            if (F.tid < 32) { float s = 0.f;
#pragma unroll
                for (int ww = 0; ww < 8; ++ww) s += red[ww * 32 + F.tid];
                rsd[F.tid] = rsqrtf(s * (1.f / 512.f) + EPS); }
            __syncthreads();
            const float rs = rsd[r32]; const float* gp = norm_g + h * 64 + 8 * hi; bf16* yp = YCAT + (t0 + i) * 2048 + h * 64 + 8 * hi;
#pragma unroll
            for (int pb = 0; pb < 2; ++pb)
#pragma unroll
                for (int g2 = 0; g2 < 2; ++g2) { const f32x4 g0 = *(const GAS f32x4*)(gp + 32 * pb + 16 * g2), g1 = *(const GAS f32x4*)(gp + 32 * pb + 16 * g2 + 4); float y[8];
#pragma unroll
                    for (int e = 0; e < 8; ++e) y[e] = (pb ? acc1[8 * g2 + e] : acc0[8 * g2 + e]) * rs;
                    v4u o; o.x = pk2(y[0] * g0[0], y[1] * g0[1]); o.y = pk2(y[2] * g0[2], y[3] * g0[3]); o.z = pk2(y[4] * g1[0], y[5] * g1[1]); o.w = pk2(y[6] * g1[2], y[7] * g1[3]);
                    *(GAS v4u*)(yp + 32 * pb + 16 * g2) = o; }
        }
    }
}
__device__ __forceinline__ void subln_row(const v4u a, const v4u b, const float* gq, GAS v4u* p) {
    float v[16] = {bflo(a.x), bfhi(a.x), bflo(a.y), bfhi(a.y), bflo(a.z), bfhi(a.z), bflo(a.w), bfhi(a.w), bflo(b.x), bfhi(b.x), bflo(b.y), bfhi(b.y), bflo(b.z), bfhi(b.z), bflo(b.w), bfhi(b.w)};
    float s = 0.f;
#pragma unroll
    for (int e = 0; e < 16; ++e) s += v[e] * v[e];
    s += __shfl_xor(s, 1); s += __shfl_xor(s, 2); s += __shfl_xor(s, 4);
    const float rs = rsqrtf(s * (1.f / 128.f) + EPS);
#pragma unroll
    for (int e = 0; e < 16; ++e) v[e] *= rs * gq[e];
    v4u oa, ob; oa.x = pk2(v[0], v[1]); oa.y = pk2(v[2], v[3]); oa.z = pk2(v[4], v[5]); oa.w = pk2(v[6], v[7]); ob.x = pk2(v[8], v[9]); ob.y = pk2(v[10], v[11]); ob.z = pk2(v[12], v[13]); ob.w = pk2(v[14], v[15]);
    p[0] = oa; p[1] = ob; }
__device__ __forceinline__ void attn_subln(Frame& F, bf16* YCAT, const float* subln_g) {
    const int d0 = (F.lane & 7) * 16; float gq[16];
#pragma unroll
    for (int e = 0; e < 16; ++e) gq[e] = subln_g[d0 + e] * (1.0f - LAM_INIT);
#pragma unroll 1
    for (int m = F.gw; m < M; m += 2 * F.NGW) { const bool two = m + F.NGW < M; const int m1 = two ? m + F.NGW : m;
        GAS v4u* p0 = (GAS v4u*)(YCAT + (size_t)m * 2048 + 1024 + F.lane * 16); GAS v4u* p1 = (GAS v4u*)(YCAT + (size_t)m1 * 2048 + 1024 + F.lane * 16);
        const v4u a0 = p0[0], b0 = p0[1], a1 = p1[0], b1 = p1[1];
        subln_row(a0, b0, gq, p0); if (two) subln_row(a1, b1, gq, p1); }
}
#ifndef MK_PER_PHASE
#define MK_PER_PHASE 0
#endif
#ifndef MK_CG_SYNC
#define MK_CG_SYNC 0
#endif
constexpr int N_PHASES = 17;
#ifndef ATTN_FORM
#define ATTN_FORM 2
#endif
#ifndef PROBE_SSD_MODE
#define PROBE_SSD_MODE 0
#endif
#ifndef PROBE_EXTRA_BARS
#define PROBE_EXTRA_BARS 0
#endif
#ifndef PROBE_DUP
#define PROBE_DUP 0
#endif
struct Args { const float* in[30]; float* out; unsigned char* ws; int ph_lo, ph_hi; };
enum InIdx { I_X = 0, I_C, I_WADA, I_BADA, I_F1PRE, I_F1POST, I_F1WG, I_F1WU, I_F1WD, I_MPRE, I_MPOST, I_WIN, I_CONVW, I_CONVB, I_DTB, I_ALOG, I_DSKIP, I_SSDG,
             I_LQ1, I_LK1, I_LQ2, I_LK2, I_SUBLN, I_WOUT, I_F2PRE, I_F2POST, I_F2WG, I_F2WU, I_F2WD, I_RELB };

__global__ void __launch_bounds__(NWAVES * 64, 2) layer_fwd(Args args) {
    extern __shared__ __attribute__((aligned(16))) unsigned char lds[];
    Frame F;
    F.lds = (LAS unsigned char*)lds;
    F.tid = threadIdx.x; F.lane = F.tid & 63; F.wave = __builtin_amdgcn_readfirstlane(F.tid >> 6);
    F.G = gridDim.x; { const int bx = blockIdx.x; F.vcu = (F.G % 8 == 0) ? (bx % 8) * (F.G / 8) + bx / 8 : bx; }
    F.gw = F.vcu * NWAVES + F.wave; F.NGW = F.G * NWAVES;
    unsigned char* ws = args.ws;
#define MOD ((float*)(ws + WS_MOD))
#define DTRAW ((float*)(ws + WS_DTRAW))
#define DTS ((float*)(ws + WS_DTS))
#define ACm ((float*)(ws + WS_AC))
#define CDEC ((float*)(ws + WS_CDEC))
#define WA ((bf16*)(ws + WS_WA))
#define WB ((bf16*)(ws + WS_WB))
#define H ((bf16*)(ws + WS_H))
#define ACT ((bf16*)(ws + WS_ACT))
#define Dm ((bf16*)(ws + WS_D))
#define Qb ((bf16*)(ws + WS_Q))
#define Kb ((bf16*)(ws + WS_K))
#define Vb ((bf16*)(ws + WS_V))
#define YCAT ((bf16*)(ws + WS_YCAT))
#define Zb ((bf16*)(ws + WS_Z))
#define XBC ((bf16*)(ws + WS_XBC))
#define XT ((bf16*)(ws + WS_XT))
#define Bm ((bf16*)(ws + WS_BM))
#define BTm ((bf16*)(ws + WS_BT))
#define Cm ((bf16*)(ws + WS_CM))
#define ST ((bf16*)(ws + WS_ST))
#define D2 ((bf16*)(ws + WS_D2))
#define WC_IN ((bf16*)((unsigned char*)out + 32 * MiB))
#define WC_OUT ((bf16*)((unsigned char*)out + 32 * MiB) + (size_t)NIN * DM)
#define WC_GU2 (WC_OUT + (size_t)DM * KOUT)
#define WC_D2 (WC_GU2 + (size_t)NGU * DM)
#define X1B ((bf16*)out)
#define X2B ((bf16*)(ws + WS_X2))
    float* out = args.out;
#if MK_CG_SYNC
    cg::grid_group grid = cg::this_grid();
#define GRID_BAR() grid.sync()
#else
    for (int u = F.tid; u < (LDS_BYTES - LDSCTL_OFF) / 4; u += NWAVES * 64) ((LAS unsigned*)(F.lds + LDSCTL_OFF))[u] = 0u;
    __syncthreads();
    XcdBarrier bar = xcd_barrier_post((unsigned*)(ws + WS_CTL) + CW_BAR, (volatile LAS unsigned*)(F.lds + MISC_OFF) + 8);
#define GRID_BAR() xcd_barrier(bar)
#endif
    const int lo = args.ph_lo, hi = args.ph_hi;
#ifndef PH_MASK
#define PH_MASK 0x1FFFF
#endif
#define IN(k) (((PH_MASK >> (k)) & 1) && lo <= (k) && (k) < hi)
#define SEAM(k) do { if (IN(k) && IN((k) + 1)) GRID_BAR(); } while (0)
#define PHASE(k, ...) if (IN(k)) { const bool second_ = false; (void)second_; __VA_ARGS__ } if (((PROBE_DUP >> (k)) & 1) && IN(k)) { const bool second_ = true; (void)second_; GRID_BAR(); __VA_ARGS__ }

    PHASE(0,
        { if (F.G == 256) convert_ffn<false>(F, args.in[I_F1WG], args.in[I_F1WU], args.in[I_F1WD], WA, WB); else convert_ffn<true>(F, args.in[I_F1WG], args.in[I_F1WU], args.in[I_F1WD], WA, WB); mod_gemv(F, args.in[I_C], args.in[I_WADA], args.in[I_BADA], MOD); }
    )
    SEAM(0);
    PHASE(1,
        rows_first(F, args.in[I_X], args.in[I_F1PRE], MOD, 0, H);
    )
    SEAM(1);
    PHASE(2,
        { pg8::Gemm g{H, WA, M, NGU, DM}; pg8::StaticOrder S; S.init(M, NGU, F.G, (int)blockIdx.x); pg8::EpiSwiglu E{ACT, DFF};
        pg8::gemm_phase<pg8::EpiSwiglu, pg8::StaticOrder, true, true>(F.lds + RING_OFF, g, S, E);
        if (!second_ && F.G == 256 && blockIdx.x >= 128) convert_down(F, ((int)blockIdx.x - 128) * NWAVES + F.wave, 128 * NWAVES, args.in[I_F1WD], WB); }
    )
    SEAM(2);
    PHASE(3,
        { pg8::Gemm g{ACT, WB, M, DM, DFF}; pg8::StaticOrder S; S.init(M, DM, F.G, (int)blockIdx.x); pg8::EpiBf16<0> E{Dm, DM, nullptr, 0, 0, 1.f};
        pg8::gemm_phase<pg8::EpiBf16<0>, pg8::StaticOrder, true, true>(F.lds + RING_OFF, g, S, E); }
    )
    SEAM(3);
    PHASE(4,
        { rows_res<true, false, true>(F, args.in[I_X], Dm, args.in[I_F1POST], MOD, 2, 0.5f, X1B, args.in[I_MPRE], 3, H); convert_mix(F, F.gw, F.NGW, args.in[I_WIN], args.in[I_WOUT], WC_IN, WC_OUT); }
    )
    SEAM(4);
    PHASE(5,
        { pg8::Gemm g{H, WC_IN, M, NQKV, DM}; pg8::StaticOrder S; S.init(M, NQKV, F.G, (int)blockIdx.x);
        pg8::EpiQKV E{Qb, DM, (size_t)(WS_K - WS_Q) / 2, attn_body::C2, (unsigned*)(ws + WS_CTL) + CW_KMAX};
        pg8::gemm_phase<pg8::EpiQKV, pg8::StaticOrder, true, true>(F.lds + RING_OFF, g, S, E); }
    )
    SEAM(5);
    PHASE(6,
        float lam;
        { const float q1 = args.in[I_LQ1][F.lane] * args.in[I_LK1][F.lane], q2 = args.in[I_LQ2][F.lane] * args.in[I_LK2][F.lane];
          lam = __expf(wave_sum(q1)) - __expf(wave_sum(q2)) + LAM_INIT; lam = __builtin_bit_cast(float, __builtin_amdgcn_readfirstlane(__builtin_bit_cast(int, lam))); }
#if ATTN_FORM == 2
        const attn2::Tensors AT{(const attn_body::bf16*)Qb, (const attn_body::bf16*)Kb, (const attn_body::bf16*)Vb, (attn_body::bf16*)YCAT, lam, args.in[I_RELB], args.in[I_SUBLN], (const float*)((const unsigned*)(ws + WS_CTL) + CW_KMAX)};
        attn2::phase<8>((char*)lds + RING_OFF, AT, (int)F.G, (int)blockIdx.x);
#else
        const attn_body::AttnTensors AT{(const attn_body::bf16*)Qb, (const attn_body::bf16*)Kb, (const attn_body::bf16*)Vb, (attn_body::bf16*)YCAT, lam, args.in[I_RELB]};
        const attn_body::StaticOrder S((int)F.G, (int)blockIdx.x);
        attn_body::attn_phase<attn_body::StaticOrder>((char*)lds + RING_OFF, AT, S);
#endif
    )
    SEAM(6);
    PHASE(7,
        { pg8::Gemm g{H, WC_IN + (size_t)NQKV * DM, M, NMIX, DM}; pg8::StaticOrder S; S.init(M, NMIX, F.G, (int)blockIdx.x); pg8::EpiMix E{Zb, XBC, DTRAW};
        pg8::gemm_phase<pg8::EpiMix, pg8::StaticOrder, true, true>(F.lds + RING_OFF, g, S, E);
        if (!second_ && F.G == 256 && blockIdx.x >= 192) convert_gu_half(F, ((int)blockIdx.x - 192) * NWAVES + F.wave, 64 * NWAVES, args.in[I_F2WG], 0, WC_GU2); }
    )
    SEAM(7);
    PHASE(8,
        ssd_conv_states(F, XBC, DTRAW, args.in[I_CONVW], args.in[I_CONVB], args.in[I_DTB], args.in[I_ALOG], XT, Bm, BTm, Cm, DTS, ACm, CDEC, ST);
    )
    SEAM(9);
    PHASE(10,
        ssd_scan(F, ST, CDEC);
    )
    SEAM(10);
    PHASE(11,
        { if (!second_) { ssd_out<0>(F, XT, Bm, Cm, ST, DTS, ACm, Zb, args.in[I_DSKIP], args.in[I_SSDG], YCAT); if (ATTN_FORM != 2) attn_subln(F, YCAT, args.in[I_SUBLN]); }
          else ssd_out<PROBE_SSD_MODE>(F, XT, Bm, Cm, ST, DTS, ACm, Zb, args.in[I_DSKIP], args.in[I_SSDG], YCAT); }
    )
    SEAM(11);
    PHASE(12,
        { pg8::Gemm g{YCAT, WC_OUT, M, DM, KOUT}; pg8::StaticOrder S; S.init(M, DM, F.G, (int)blockIdx.x); pg8::EpiBf16<0> E{D2, DM, nullptr, 0, 0, 1.f};
        pg8::gemm_phase<pg8::EpiBf16<0>, pg8::StaticOrder, true, true>(F.lds + RING_OFF, g, S, E); }
    )
    SEAM(12);
    PHASE(13,
        { rows_res<true, true, true>(F, X1B, D2, args.in[I_MPOST], MOD, 5, 1.0f, X2B, args.in[I_F2PRE], 6, H); convert_gu_half(F, F.gw, F.NGW, args.in[I_F2WU], 1, WC_GU2);
          if (F.G != 256) { convert_gu_half(F, F.gw, F.NGW, args.in[I_F2WG], 0, WC_GU2); convert_down(F, F.gw, F.NGW, args.in[I_F2WD], WC_D2); } }
    )
    SEAM(13);
    PHASE(14,
        { pg8::Gemm g{H, WC_GU2, M, NGU, DM}; pg8::StaticOrder S; S.init(M, NGU, F.G, (int)blockIdx.x); pg8::EpiSwiglu E{ACT, DFF};
        pg8::gemm_phase<pg8::EpiSwiglu, pg8::StaticOrder, true, true>(F.lds + RING_OFF, g, S, E);
        if (!second_ && F.G == 256 && blockIdx.x >= 128) convert_down(F, ((int)blockIdx.x - 128) * NWAVES + F.wave, 128 * NWAVES, args.in[I_F2WD], WC_D2); }
    )
    SEAM(14);
    PHASE(15,
        { pg8::Gemm g{ACT, WC_D2, M, DM, DFF}; pg8::StaticOrder S; S.init(M, DM, F.G, (int)blockIdx.x); pg8::EpiBf16<0> E{Dm, DM, nullptr, 0, 0, 1.f};
        pg8::gemm_phase<pg8::EpiBf16<0>, pg8::StaticOrder, true, true>(F.lds + RING_OFF, g, S, E); }
    )
    SEAM(15);
    PHASE(16,
        rows_res<false, true, false>(F, X2B, Dm, args.in[I_F2POST], MOD, 8, 0.5f, out, nullptr, 0, nullptr);
    )
#if PROBE_EXTRA_BARS
    for (int q_ = 0; q_ < PROBE_EXTRA_BARS; ++q_) GRID_BAR();
#endif
#undef IN
#undef SEAM
}

extern "C" void kernel_launch(void* const* d_in, const int* in_sizes, int n_in, void* d_out, int out_size, void* d_ws, size_t ws_size, hipStream_t stream) {
    static int grid = 0;
    if (grid == 0) {
        if (n_in != 30 || in_sizes[0] != M * DM || out_size != M * DM || ws_size < WS_END) { fprintf(stderr, "kernel_launch: unexpected shapes (n_in %d, in0 %d, out %d, ws %zu); nothing launched\n", n_in, n_in > 0 ? in_sizes[0] : -1, out_size, ws_size); grid = -1; return; }
        int dev = 0, cus = 0, per_cu = 0;
        if (hipGetDevice(&dev) != hipSuccess || hipDeviceGetAttribute(&cus, hipDeviceAttributeMultiprocessorCount, dev) != hipSuccess) { grid = -1; return; }
        if (hipFuncSetAttribute((const void*)layer_fwd, hipFuncAttributeMaxDynamicSharedMemorySize, LDS_BYTES) != hipSuccess) { fprintf(stderr, "kernel_launch: hipFuncSetAttribute failed\n"); grid = -1; return; }
        if (hipOccupancyMaxActiveBlocksPerMultiprocessor(&per_cu, (const void*)layer_fwd, NWAVES * 64, LDS_BYTES) != hipSuccess || per_cu < 1) { fprintf(stderr, "kernel_launch: occupancy query says %d blocks per CU\n", per_cu); per_cu = 1; }
        (void)hipGetLastError();
        grid = cus;
        if (grid % 8 != 0 || grid > 256) fprintf(stderr, "kernel_launch: note: %d CUs\n", grid);
    }
    if (grid < 0) return;
    (void)hipMemsetAsync((char*)d_ws + WS_CTL, 0, CTL_ZERO_BYTES, stream);
    Args a{};
    for (int i = 0; i < 30; ++i) a.in[i] = (const float*)d_in[i];
    a.out = (float*)d_out; a.ws = (unsigned char*)d_ws;
#if MK_PER_PHASE
    for (int p = 0; p < N_PHASES; ++p) { a.ph_lo = p; a.ph_hi = p + 1; void* kargs[] = {&a};
        hipError_t e = hipLaunchCooperativeKernel((const void*)layer_fwd, dim3(grid), dim3(NWAVES * 64), kargs, LDS_BYTES, stream);
        if (e != hipSuccess) { fprintf(stderr, "kernel_launch: phase %d launch failed: %s\n", p, hipGetErrorString(e)); break; } }
#else
    a.ph_lo = 0; a.ph_hi = N_PHASES; void* kargs[] = {&a};
    hipError_t e = hipLaunchCooperativeKernel((const void*)layer_fwd, dim3(grid), dim3(NWAVES * 64), kargs, LDS_BYTES, stream);
    if (e != hipSuccess) fprintf(stderr, "kernel_launch: cooperative launch failed: %s (grid %d)\n", hipGetErrorString(e), grid);
#endif
}
```

```cpp
#include <hip/hip_runtime.h>
#include <hip/hip_cooperative_groups.h>
#include <hip/hip_bf16.h>
#include <cstdio>
#include <cstdint>
#include <cmath>
namespace cg = cooperative_groups;
namespace pg8 {
#define PG8_LAS __attribute__((address_space(3)))
typedef unsigned short bf16_t;
typedef short bf16x8 __attribute__((ext_vector_type(8)));
typedef float f32x4 __attribute__((ext_vector_type(4)));
typedef unsigned u32x4 __attribute__((ext_vector_type(4)));
constexpr int BM = 256, BK = 64, HALF = 128, HTB = HALF * BK * 2  , STAGE_BYTES = 8 * HTB, NXCD = 8, WGM = 8;

__host__ __device__ __forceinline__ int lds_byte(int r, int c) { const int st = (r >> 4) * 2 + (c >> 5), rr = r & 15, cc = c & 31, ob = rr * 64 + cc * 2; return st * 1024 + (ob ^ (((ob >> 9) & 1) << 5)); }
__host__ __device__ __forceinline__ void stage_rc(int b, int& R, int& C) { const int st = b / 1024, sb = b % 1024, swz = sb ^ (((sb >> 9) & 1) << 5); R = (st >> 1) * 16 + swz / 64; C = (st & 1) * 32 + (swz % 64) / 2; }
__host__ __device__ __forceinline__ int perm32(int rho) { const int n = rho >> 4, i = rho & 15; return 8 * (i >> 2) + 4 * n + (i & 3); }

struct Unit { int pm, pn; };
struct Gemm { const bf16_t* A; const bf16_t* Bt; int M, N, K; };

struct StaticOrder {
    int nM, nN, nwg, G, c;
    __host__ __device__ void init(int M, int N, int G_, int c_) { nM = M / BM; nN = N / BM; nwg = nM * nN; G = G_; c = c_; }
    __host__ __device__ bool next(int i, Unit& u) const {
        const long L = (long)i * G + c; if (L >= nwg) return false;
        int wgid = (int)L; { const int q = nwg / NXCD, r = nwg % NXCD, xcd = wgid % NXCD, off = wgid / NXCD; wgid = (xcd < r ? xcd * (q + 1) : r * (q + 1) + (xcd - r) * q) + off; }
        const int nig = WGM * nN, gid = wgid / nig, fm = gid * WGM, gsz = (nM - fm) < WGM ? (nM - fm) : WGM;
        u.pm = fm + ((wgid % nig) % gsz); u.pn = (wgid % nig) / gsz; return true;
    }
    __device__ __forceinline__ void a_ready(const Unit&) const {}
    __device__ __forceinline__ void done(const Unit&) const {}
};

__device__ __forceinline__ unsigned cvt_pk_bf16(float lo, float hi) { unsigned r; asm volatile("v_cvt_pk_bf16_f32 %0, %1, %2" : "=v"(r) : "v"(lo), "v"(hi)); return r; }
typedef float f32x2 __attribute__((ext_vector_type(2)));
__device__ __forceinline__ f32x2 gelu_pk(f32x2 v) {
    const f32x2 av = __builtin_elementwise_abs(v), d = av * 0.2316418882f + 1.0f;
    f32x2 t; t.x = __builtin_amdgcn_rcpf(d.x); t.y = __builtin_amdgcn_rcpf(d.y);
    f32x2 q = t * 0.5307027145f + (-0.7265760135f); q = q * t + 0.7107068705f; q = q * t + (-0.142248368f); q = q * t + 0.127414796f; q = q * t;
    const f32x2 s = (v * v) * (-0.72134752044f);
    f32x2 e; e.x = __builtin_amdgcn_exp2f(s.x); e.y = __builtin_amdgcn_exp2f(s.y);
    const f32x2 m = v * (q * e), r = v - m;
    f32x2 o; o.x = v.x < 0.f ? m.x : r.x; o.y = v.y < 0.f ? m.y : r.y; return o;
}

template <int ACT  > struct EpiBf16 {
    static constexpr bool PERM = true, AFTER_DRAIN = false; static_assert(ACT == 0 || ACT == 1, "EpiBf16: ACT is 0 (none) or 1 (gelu_pk)");
    bf16_t* O; int ldc; const float* bias; int split_cols; size_t split_stride; float scale0;
    __device__ __forceinline__ void operator()(const f32x4 (&acc)[2][2][4][2], const Unit& u, int wr, int wc, int fr, int fq) const {
        const int row0 = u.pm * BM + wr * 64 + fr; int colt = u.pn * BM; bf16_t* base = O;
        float sc = 1.f; if (split_cols) { const int t = colt / split_cols; base += (size_t)t * split_stride; colt -= t * split_cols; if (t == 0) sc = scale0; }
        const int col0 = colt + wc * 32 + 8 * fq, bcol0 = u.pn * BM + wc * 32 + 8 * fq;
        f32x4 bv[2][2];
#pragma unroll
        for (int bj = 0; bj < 2; ++bj)
#pragma unroll
            for (int n = 0; n < 2; ++n) bv[bj][n] = bias ? *(const f32x4*)(bias + bcol0 + bj * HALF + 4 * n) : (f32x4){0.f, 0.f, 0.f, 0.f};
#pragma unroll
        for (int ai = 0; ai < 2; ++ai)
#pragma unroll
            for (int m = 0; m < 4; ++m) { bf16_t* rowp = base + (size_t)(row0 + ai * HALF + m * 16) * ldc + col0;
#pragma unroll
                for (int bj = 0; bj < 2; ++bj) { f32x4 v0 = acc[ai][bj][m][0] + bv[bj][0], v1 = acc[ai][bj][m][1] + bv[bj][1];
                    if (ACT == 1) { f32x2 a = gelu_pk((f32x2){v0[0], v0[1]}), b = gelu_pk((f32x2){v0[2], v0[3]}), c = gelu_pk((f32x2){v1[0], v1[1]}), d = gelu_pk((f32x2){v1[2], v1[3]});
                        v0 = (f32x4){a.x, a.y, b.x, b.y}; v1 = (f32x4){c.x, c.y, d.x, d.y}; }
                    v0 = v0 * sc; v1 = v1 * sc; u32x4 w; w.x = cvt_pk_bf16(v0[0], v0[1]); w.y = cvt_pk_bf16(v0[2], v0[3]); w.z = cvt_pk_bf16(v1[0], v1[1]); w.w = cvt_pk_bf16(v1[2], v1[3]);
                    *(u32x4*)(rowp + bj * HALF) = w; } }
    }
};

struct PanelStats {
    unsigned* xbuf;
    unsigned* cnt;
    unsigned* tmo;
    int ntn; float eps;
    unsigned code;
    __device__ __forceinline__ bool run(const f32x4 (&v)[2][2][4][2], const Unit& u, int wr, int wc, int fr, int fq, PG8_LAS unsigned char* lds, int wid, int lane) const {
        typedef float f32x2v __attribute__((ext_vector_type(2)));
        PG8_LAS f32x2v* P = (PG8_LAS f32x2v*)lds;
        PG8_LAS f32x2v* S = (PG8_LAS f32x2v*)(lds + 8192);
        PG8_LAS unsigned* flag = (PG8_LAS unsigned*)(lds + 8192 + 2048);
#pragma unroll
        for (int ai = 0; ai < 2; ++ai)
#pragma unroll
            for (int m = 0; m < 4; ++m) {
                float s = 0.f;
#pragma unroll
                for (int bj = 0; bj < 2; ++bj)
#pragma unroll
                    for (int n = 0; n < 2; ++n) { const f32x4 x = v[ai][bj][m][n]; s += (x[0] + x[1]) + (x[2] + x[3]); }
                s += __shfl_xor(s, 16); s += __shfl_xor(s, 32);
                const float mw = s * (1.0f / 64.0f); float q = 0.f;
#pragma unroll
                for (int bj = 0; bj < 2; ++bj)
#pragma unroll
                    for (int n = 0; n < 2; ++n) { const f32x4 d = v[ai][bj][m][n] - mw; q += (d[0] * d[0] + d[1] * d[1]) + (d[2] * d[2] + d[3] * d[3]); }
                q += __shfl_xor(q, 16); q += __shfl_xor(q, 32);
                if (fq == 0) P[(ai * HALF + wr * 64 + m * 16 + fr) * 4 + wc] = (f32x2v){mw, q};
            }
        asm volatile("s_waitcnt lgkmcnt(0)" ::: "memory"); __builtin_amdgcn_s_barrier(); asm volatile("" ::: "memory");
#if defined(BROKEN_EXCHANGE_NO_WAIT)
#warning BROKEN CONTROL BUILD: the row-statistics exchange does not wait; results are wrong by design
        if (blockIdx.x >= 64) { const long long t0_ = clock64(); while (clock64() - t0_ < 60000) __builtin_amdgcn_s_sleep(8); }
#endif
        const int row = wid * 32 + (lane & 31);
        if (lane < 32) {
            const f32x2v a = P[row * 4 + 0], b = P[row * 4 + 1], c = P[row * 4 + 2], d = P[row * 4 + 3];
            const float mt = (a.x + b.x + c.x + d.x) * 0.25f;
            const float da = a.x - mt, db = b.x - mt, dc = c.x - mt, dd = d.x - mt;
            const float m2 = (a.y + b.y) + (c.y + d.y) + 64.0f * ((da * da + db * db) + (dc * dc + dd * dd));
            unsigned long long* slot = (unsigned long long*)xbuf + ((size_t)(u.pm * BM + row) * 4 + u.pn);
            __hip_atomic_store(slot, ((unsigned long long)__float_as_uint(m2) << 32) | __float_as_uint(mt), __ATOMIC_RELAXED, __HIP_MEMORY_SCOPE_AGENT);
        }
        asm volatile("s_waitcnt vmcnt(0)" ::: "memory");
        if (lane == 0) __hip_atomic_fetch_add(cnt + 64 * u.pm, 1u, __ATOMIC_RELAXED, __HIP_MEMORY_SCOPE_AGENT);
        if (wid == 0) {
            bool dead = false; const unsigned long long t0 = __builtin_amdgcn_s_memrealtime(); const unsigned want = 8u * (unsigned)ntn;
            for (;;) {
#if defined(BROKEN_EXCHANGE_NO_WAIT)
                break;
#endif
                if ((unsigned)__builtin_amdgcn_readfirstlane(__hip_atomic_load(cnt + 64 * u.pm, __ATOMIC_RELAXED, __HIP_MEMORY_SCOPE_AGENT)) >= want) break;
                if (__builtin_amdgcn_s_memrealtime() - t0 > 2000000ull) {
                    if (lane == 0) { unsigned expect = 0u; __hip_atomic_compare_exchange_strong(tmo + 1, &expect, code | (unsigned)(u.pm & 0xff), __ATOMIC_RELAXED, __ATOMIC_RELAXED, __HIP_MEMORY_SCOPE_AGENT);
                                     __hip_atomic_store(tmo, 1u, __ATOMIC_RELAXED, __HIP_MEMORY_SCOPE_AGENT); }
                    dead = true; break; }
                __builtin_amdgcn_s_sleep(2);
            }
            __builtin_amdgcn_fence(__ATOMIC_ACQUIRE, "agent");
            if (lane == 0) flag[0] = dead ? 1u : 0u;
        }
        asm volatile("s_waitcnt vmcnt(0) lgkmcnt(0)" ::: "memory"); __builtin_amdgcn_s_barrier(); asm volatile("" ::: "memory");
        const bool bad = flag[0] != 0u;
        if (lane < 32) {
            const unsigned long long* slot = (const unsigned long long*)xbuf + (size_t)(u.pm * BM + row) * 4; float mt[4], m2[4]; float ms = 0.f;
#pragma unroll
            for (int t = 0; t < 4; ++t) { if (t < ntn) { const unsigned long long w = __hip_atomic_load(slot + t, __ATOMIC_RELAXED, __HIP_MEMORY_SCOPE_AGENT); mt[t] = __uint_as_float((unsigned)w); m2[t] = __uint_as_float((unsigned)(w >> 32)); } else { mt[t] = 0.f; m2[t] = 0.f; } ms += mt[t]; }
            const float mean = ms / (float)ntn; float q = 0.f;
#pragma unroll
            for (int t = 0; t < 4; ++t) if (t < ntn) { const float dm = mt[t] - mean; q += m2[t] + 256.0f * dm * dm; }
            S[row] = (f32x2v){mean, 1.0f / sqrtf(q / (256.0f * (float)ntn) + eps)};
        }
        asm volatile("s_waitcnt lgkmcnt(0)" ::: "memory"); __builtin_amdgcn_s_barrier(); asm volatile("" ::: "memory");
        return bad;
    }
};
struct EpiLnRes {
    static constexpr bool PERM = false, AFTER_DRAIN = true;
    const float* base; float* out; int ldc; const float* bias; PanelStats st; unsigned poison;
    __device__ __forceinline__ void fused(f32x4 (&acc)[2][2][4][2], const Unit& u, int wr, int wc, int fr, int fq, PG8_LAS unsigned char* lds, int wid, int lane) const {
        typedef float f32x2v __attribute__((ext_vector_type(2)));
        const PG8_LAS f32x2v* S = (const PG8_LAS f32x2v*)(lds + 8192);
        const int col0 = u.pn * BM + wc * 32 + 4 * fq;
#pragma unroll
        for (int bj = 0; bj < 2; ++bj)
#pragma unroll
            for (int n = 0; n < 2; ++n) { const f32x4 bv = bias ? *(const f32x4*)(bias + col0 + bj * HALF + n * 16) : (f32x4){0.f, 0.f, 0.f, 0.f};
#pragma unroll
                for (int ai = 0; ai < 2; ++ai)
#pragma unroll
                    for (int m = 0; m < 4; ++m) acc[ai][bj][m][n] += bv; }
        f32x4 pre[4][2][2];
#pragma unroll
        for (int m = 0; m < 4; ++m) { const size_t off = (size_t)(u.pm * BM + wr * 64 + m * 16 + fr) * ldc + col0;
#pragma unroll
            for (int bj = 0; bj < 2; ++bj)
#pragma unroll
                for (int n = 0; n < 2; ++n) pre[m][bj][n] = *(const f32x4*)(base + off + bj * HALF + n * 16); }
        const bool bad = st.run(acc, u, wr, wc, fr, fq, lds, wid, lane) || poison != 0u;
        const float qnan = __builtin_nanf("");
#pragma unroll
        for (int ai = 0; ai < 2; ++ai)
#pragma unroll
            for (int m = 0; m < 4; ++m) { const int r = ai * HALF + wr * 64 + m * 16 + fr; const f32x2v sr = S[r]; const size_t off = (size_t)(u.pm * BM + r) * ldc + col0;
#pragma unroll
                for (int bj = 0; bj < 2; ++bj)
#pragma unroll
                    for (int n = 0; n < 2; ++n) { const f32x4 bs = ai == 0 ? pre[m][bj][n] : *(const f32x4*)(base + off + bj * HALF + n * 16); f32x4 o = bs + (acc[ai][bj][m][n] - sr.x) * sr.y;
                        if (bad) o = (f32x4){qnan, qnan, qnan, qnan}; *(f32x4*)(out + off + bj * HALF + n * 16) = o; }
                if (m & 1) asm volatile("" ::: "memory"); }
    }
};
struct EpiLnResLn {
    static constexpr bool PERM = false, AFTER_DRAIN = true;
    const float* base; float* out; bf16_t* xn; int ldc; const float* bias; PanelStats st1, st2; unsigned poison;
    __device__ __forceinline__ void fused(f32x4 (&acc)[2][2][4][2], const Unit& u, int wr, int wc, int fr, int fq, PG8_LAS unsigned char* lds, int wid, int lane) const {
        typedef float f32x2v __attribute__((ext_vector_type(2))); typedef unsigned u32x2v __attribute__((ext_vector_type(2)));
        const PG8_LAS f32x2v* S = (const PG8_LAS f32x2v*)(lds + 8192);
        const int col0 = u.pn * BM + wc * 32 + 4 * fq;
#pragma unroll
        for (int bj = 0; bj < 2; ++bj)
#pragma unroll
            for (int n = 0; n < 2; ++n) { const f32x4 bv = bias ? *(const f32x4*)(bias + col0 + bj * HALF + n * 16) : (f32x4){0.f, 0.f, 0.f, 0.f};
#pragma unroll
                for (int ai = 0; ai < 2; ++ai)
#pragma unroll
                    for (int m = 0; m < 4; ++m) acc[ai][bj][m][n] += bv; }
        bool bad = st1.run(acc, u, wr, wc, fr, fq, lds, wid, lane) || poison != 0u;
        const float qnan = __builtin_nanf("");
#pragma unroll
        for (int ai = 0; ai < 2; ++ai)
#pragma unroll
            for (int m = 0; m < 4; ++m) { const int r = ai * HALF + wr * 64 + m * 16 + fr; const f32x2v sr = S[r]; const size_t off = (size_t)(u.pm * BM + r) * ldc + col0;
#pragma unroll
                for (int bj = 0; bj < 2; ++bj)
#pragma unroll
                    for (int n = 0; n < 2; ++n) { const f32x4 bs = *(const f32x4*)(base + off + bj * HALF + n * 16); acc[ai][bj][m][n] = bs + (acc[ai][bj][m][n] - sr.x) * sr.y; }
                asm volatile("" : "+v"(acc[ai][0][m][0]), "+v"(acc[ai][0][m][1]), "+v"(acc[ai][1][m][0]), "+v"(acc[ai][1][m][1]));
                if (m & 1) asm volatile("" ::: "memory"); }
        const bool bad1 = bad;
        bad = st2.run(acc, u, wr, wc, fr, fq, lds, wid, lane) || bad;
#pragma unroll
        for (int ai = 0; ai < 2; ++ai)
#pragma unroll
            for (int m = 0; m < 4; ++m) { const int r = ai * HALF + wr * 64 + m * 16 + fr; const f32x2v sr = S[r]; const size_t off = (size_t)(u.pm * BM + r) * ldc + col0;
#pragma unroll
                for (int bj = 0; bj < 2; ++bj)
#pragma unroll
                    for (int n = 0; n < 2; ++n) { const f32x4 x1 = acc[ai][bj][m][n]; *(f32x4*)(out + off + bj * HALF + n * 16) = bad1 ? (f32x4){qnan, qnan, qnan, qnan} : x1;
                        const f32x4 o = (x1 - sr.x) * sr.y; u32x2v w; w.x = cvt_pk_bf16(o[0], o[1]); w.y = cvt_pk_bf16(o[2], o[3]);
                        if (bad) { w.x = 0x7fc07fc0u; w.y = 0x7fc07fc0u; } *(u32x2v*)(xn + off + bj * HALF + n * 16) = w; }
                asm volatile("" ::: "memory"); }
    }
};

template <class Epi, class Sched, bool ALIGN_EPI = false, bool SP2 = false>
__device__ __forceinline__ void gemm_phase(PG8_LAS unsigned char* lds, const Gemm g, const Sched& S, const Epi& E) {
    const int tid = threadIdx.x, wid = __builtin_amdgcn_readfirstlane(tid >> 6), lane = tid & 63, wr = wid >> 2, wc = wid & 3, fr = lane & 15, fq = lane >> 4;
    const int K = g.K, nt = K / BK;
    unsigned voffA[2], voffB[2];
#pragma unroll
    for (int i = 0; i < 2; ++i) { int R, C; stage_rc(tid * 16 + i * 8192, R, C); const int Rb = Epi::PERM ? ((R & ~31) + perm32(R & 31)) : R;
        voffA[i] = (unsigned)(R * K + C) * 2u; voffB[i] = (unsigned)(Rb * K + C) * 2u; }
    const size_t kstep = (size_t)(BK * 2);
    const size_t hstep = (size_t)HALF * K * 2;
    const size_t tstep = 2 * hstep;
    const unsigned ldsw = (unsigned)wid * 1024u;
    const int aoff = lds_byte(wr * 64 + fr, fq * 8), boff = lds_byte(wc * 32 + fr, fq * 8);
#define PG8_SA(b, h) (((b) * 2 + (h)) * HTB)
#define PG8_SB(b, h) ((4 + (b) * 2 + (h)) * HTB)
#define PG8_STAGE(bufoff, gbase, voff) do { _Pragma("unroll") for (int _i = 0; _i < 2; ++_i) \
        __builtin_amdgcn_global_load_lds((const unsigned*)((const char*)(gbase) + (voff)[_i]), (PG8_LAS unsigned*)(lds + (bufoff) + ldsw + _i * 8192), 16, 0, 0); } while (0)
#define PG8_LDA(dst, b, h) do { _Pragma("unroll") for (int m = 0; m < 4; ++m) _Pragma("unroll") for (int k = 0; k < 2; ++k) dst[m][k] = *(const PG8_LAS bf16x8*)(lds + PG8_SA(b, h) + aoff + m * 2048 + k * 1024); } while (0)
#define PG8_LDB(dst, b, h) do { _Pragma("unroll") for (int n = 0; n < 2; ++n) _Pragma("unroll") for (int k = 0; k < 2; ++k) dst[n][k] = *(const PG8_LAS bf16x8*)(lds + PG8_SB(b, h) + boff + n * 2048 + k * 1024); } while (0)
#define PG8_MMA(ai, bj, At, Bt) do { __builtin_amdgcn_s_setprio(1); _Pragma("unroll") for (int m = 0; m < 4; ++m) _Pragma("unroll") for (int n = 0; n < 2; ++n) _Pragma("unroll") for (int k = 0; k < 2; ++k) \
        acc[ai][bj][m][n] = __builtin_amdgcn_mfma_f32_16x16x32_bf16(Bt[n][k], At[m][k], acc[ai][bj][m][n], 0, 0, 0); __builtin_amdgcn_s_setprio(0); } while (0)
#define PG8_WAIT_V(n) asm volatile("s_waitcnt vmcnt(" #n ")" ::: "memory")
#define PG8_WAIT_L(n) asm volatile("s_waitcnt lgkmcnt(" #n ")" ::: "memory")
#define PG8_BAR __builtin_amdgcn_s_barrier()
#define PG8_SCHED __builtin_amdgcn_sched_barrier(0)
    Unit cur, nxt; int ui = 0;
    if (!S.next(0, cur)) return;
    f32x4 acc[2][2][4][2];
#pragma unroll
    for (int a = 0; a < 2; ++a)
#pragma unroll
        for (int b = 0; b < 2; ++b)
#pragma unroll
            for (int m = 0; m < 4; ++m)
#pragma unroll
                for (int n = 0; n < 2; ++n) acc[a][b][m][n] = (f32x4){0.f, 0.f, 0.f, 0.f};
    bf16x8 At[4][2], B0[2][2], B1[2][2];
    const char* cA = (const char*)g.A + (size_t)cur.pm * tstep; const char* cB = (const char*)g.Bt + (size_t)cur.pn * tstep;
    S.a_ready(cur);
    if constexpr (SP2) {
        PG8_STAGE(PG8_SB(0, 0), cB, voffB); PG8_STAGE(PG8_SB(0, 1), cB + hstep, voffB); PG8_STAGE(PG8_SA(0, 0), cA, voffA); PG8_STAGE(PG8_SA(0, 1), cA + hstep, voffA);
        if (wr == 1) PG8_BAR;
        PG8_WAIT_V(2); PG8_BAR;
        PG8_STAGE(PG8_SB(1, 0), cB + kstep, voffB); PG8_STAGE(PG8_SA(1, 0), cA + kstep, voffA); PG8_STAGE(PG8_SB(1, 1), cB + hstep + kstep, voffB);
        PG8_WAIT_V(6); PG8_BAR;
    } else {
        PG8_STAGE(PG8_SB(0, 0), cB, voffB); PG8_STAGE(PG8_SA(0, 0), cA, voffA); PG8_STAGE(PG8_SB(0, 1), cB + hstep, voffB); PG8_STAGE(PG8_SA(0, 1), cA + hstep, voffA);
        if (wr == 1) PG8_BAR;
        PG8_WAIT_V(4); PG8_BAR;
        PG8_STAGE(PG8_SB(1, 0), cB + kstep, voffB); PG8_STAGE(PG8_SA(1, 0), cA + kstep, voffA); PG8_STAGE(PG8_SB(1, 1), cB + hstep + kstep, voffB);
        PG8_WAIT_V(6); PG8_BAR;
    }
    for (;;) {
        const bool has_next = S.next(ui + 1, nxt);
        const char* nA = has_next ? (const char*)g.A + (size_t)nxt.pm * tstep : cA; const char* nB = has_next ? (const char*)g.Bt + (size_t)nxt.pn * tstep : cB;
        for (int t = 0; t < nt; t += 2) {
            const bool last = (t == nt - 2);
            const char* a1 = cA + (size_t)(t + 1) * kstep;
            const char* a2 = last ? nA : cA + (size_t)(t + 2) * kstep; const char* b2 = last ? nB : cB + (size_t)(t + 2) * kstep;
            const char* a3 = a2 + kstep; const char* b3 = b2 + kstep;
            if (last && has_next) S.a_ready(nxt);
            if constexpr (SP2) {
            PG8_LDB(B0, 0, 0); PG8_LDB(B1, 0, 1); PG8_SCHED; PG8_LDA(At, 0, 0); PG8_STAGE(PG8_SA(1, 1), a1 + hstep, voffA);
            PG8_WAIT_V(8); PG8_WAIT_L(0); PG8_BAR; PG8_MMA(0, 0, At, B0); PG8_MMA(0, 1, At, B1); PG8_BAR; PG8_SCHED;
            PG8_LDA(At, 0, 1); PG8_STAGE(PG8_SB(0, 0), b2, voffB); PG8_STAGE(PG8_SB(0, 1), b2 + hstep, voffB); PG8_STAGE(PG8_SA(0, 0), a2, voffA);
            PG8_WAIT_V(8); PG8_WAIT_L(0); PG8_BAR; PG8_MMA(1, 0, At, B0); PG8_MMA(1, 1, At, B1); PG8_BAR; PG8_SCHED;
            PG8_LDB(B0, 1, 0); PG8_LDB(B1, 1, 1); PG8_SCHED; PG8_LDA(At, 1, 0); PG8_STAGE(PG8_SA(0, 1), a2 + hstep, voffA);
            PG8_WAIT_V(8); PG8_WAIT_L(0); PG8_BAR; PG8_MMA(0, 0, At, B0); PG8_MMA(0, 1, At, B1); PG8_BAR; PG8_SCHED;
            PG8_LDA(At, 1, 1); PG8_STAGE(PG8_SB(1, 0), b3, voffB); PG8_STAGE(PG8_SB(1, 1), b3 + hstep, voffB); PG8_STAGE(PG8_SA(1, 0), a3, voffA);
            PG8_WAIT_V(8); PG8_WAIT_L(0); PG8_BAR; PG8_MMA(1, 0, At, B0); PG8_MMA(1, 1, At, B1); PG8_BAR; PG8_SCHED;
            } else {
            PG8_LDB(B0, 0, 0); PG8_SCHED; PG8_LDA(At, 0, 0); PG8_STAGE(PG8_SA(1, 1), a1 + hstep, voffA);
            PG8_WAIT_L(8); PG8_BAR; PG8_WAIT_L(0); PG8_MMA(0, 0, At, B0); PG8_BAR; PG8_SCHED;
            PG8_LDB(B1, 0, 1); PG8_STAGE(PG8_SB(0, 0), b2, voffB);
            PG8_BAR; PG8_WAIT_L(0); PG8_MMA(0, 1, At, B1); PG8_BAR;
            PG8_LDA(At, 0, 1); PG8_STAGE(PG8_SA(0, 0), a2, voffA);
            PG8_BAR; PG8_WAIT_L(0); PG8_MMA(1, 0, At, B0); PG8_BAR; PG8_SCHED;
            PG8_STAGE(PG8_SB(0, 1), b2 + hstep, voffB);
            PG8_WAIT_V(6); PG8_BAR; PG8_MMA(1, 1, At, B1); PG8_BAR;
            PG8_LDB(B0, 1, 0); PG8_SCHED; PG8_LDA(At, 1, 0); PG8_STAGE(PG8_SA(0, 1), a2 + hstep, voffA);
            PG8_WAIT_L(8); PG8_BAR; PG8_WAIT_L(0); PG8_MMA(0, 0, At, B0); PG8_BAR; PG8_SCHED;
            PG8_LDB(B1, 1, 1); PG8_STAGE(PG8_SB(1, 0), b3, voffB);
            PG8_BAR; PG8_WAIT_L(0); PG8_MMA(0, 1, At, B1); PG8_BAR;
            PG8_LDA(At, 1, 1); PG8_STAGE(PG8_SA(1, 0), a3, voffA);
            PG8_BAR; PG8_WAIT_L(0); PG8_MMA(1, 0, At, B0); PG8_BAR; PG8_SCHED;
            PG8_STAGE(PG8_SB(1, 1), b3 + hstep, voffB);
            PG8_WAIT_V(6); PG8_BAR; PG8_MMA(1, 1, At, B1); PG8_BAR;
            }
        }
        if constexpr (ALIGN_EPI) { if (wr == 0) PG8_BAR; }
        if constexpr (!Epi::AFTER_DRAIN) { E(acc, cur, wr, wc, fr, fq); S.done(cur); }
        if (!has_next) break;
#pragma unroll
        for (int a = 0; a < 2; ++a)
#pragma unroll
            for (int b = 0; b < 2; ++b)
#pragma unroll
                for (int m = 0; m < 4; ++m)
#pragma unroll
                    for (int n = 0; n < 2; ++n) acc[a][b][m][n] = (f32x4){0.f, 0.f, 0.f, 0.f};
        cur = nxt; cA = nA; cB = nB; ++ui;
        if constexpr (ALIGN_EPI) { if (wr == 1) PG8_BAR; }
    }
    PG8_WAIT_V(0);
    if constexpr (!ALIGN_EPI) { if (wr == 0) PG8_BAR; }
    PG8_BAR;
    if constexpr (Epi::AFTER_DRAIN) { E.fused(acc, cur, wr, wc, fr, fq, lds, wid, lane); S.done(cur); }
#undef PG8_SA
#undef PG8_SB
#undef PG8_STAGE
#undef PG8_LDA
#undef PG8_LDB
#undef PG8_MMA
#undef PG8_WAIT_V
#undef PG8_WAIT_L
#undef PG8_BAR
#undef PG8_SCHED
}
}
namespace pg8 {
__device__ __forceinline__ float silu_f(float v) { return v * __builtin_amdgcn_rcpf(1.0f + __expf(-v)); }
struct EpiF32 {
    static constexpr bool PERM = false, AFTER_DRAIN = false;
    float* C; int ldc;
    __device__ __forceinline__ void operator()(const f32x4 (&acc)[2][2][4][2], const Unit& u, int wr, int wc, int fr, int fq) const {
        const int row0 = u.pm * BM + wr * 64 + fr, col0 = u.pn * BM + wc * 32 + 4 * fq;
#pragma unroll
        for (int ai = 0; ai < 2; ++ai)
#pragma unroll
            for (int m = 0; m < 4; ++m) { float* rowp = C + (size_t)(row0 + ai * HALF + m * 16) * ldc + col0;
#pragma unroll
                for (int bj = 0; bj < 2; ++bj)
#pragma unroll
                    for (int n = 0; n < 2; ++n) *(f32x4*)(rowp + bj * HALF + n * 16) = acc[ai][bj][m][n]; }
    }
};
struct EpiSwiglu {
    static constexpr bool PERM = true, AFTER_DRAIN = false;
    bf16_t* O; int ldc;
    __device__ __forceinline__ void operator()(const f32x4 (&acc)[2][2][4][2], const Unit& u, int wr, int wc, int fr, int fq) const {
        const int row0 = u.pm * BM + wr * 64 + fr, col0 = u.pn * HALF + wc * 32 + 8 * fq;
#pragma unroll
        for (int ai = 0; ai < 2; ++ai)
#pragma unroll
            for (int m = 0; m < 4; ++m) { bf16_t* rowp = O + (size_t)(row0 + ai * HALF + m * 16) * ldc + col0;
                const f32x4 g0 = acc[ai][0][m][0], g1 = acc[ai][0][m][1], u0 = acc[ai][1][m][0], u1 = acc[ai][1][m][1];
                u32x4 w;
                w.x = cvt_pk_bf16(silu_f(g0[0]) * u0[0], silu_f(g0[1]) * u0[1]); w.y = cvt_pk_bf16(silu_f(g0[2]) * u0[2], silu_f(g0[3]) * u0[3]);
                w.z = cvt_pk_bf16(silu_f(g1[0]) * u1[0], silu_f(g1[1]) * u1[1]); w.w = cvt_pk_bf16(silu_f(g1[2]) * u1[2], silu_f(g1[3]) * u1[3]);
                *(u32x4*)rowp = w; }
    }
};
struct EpiMix {
    static constexpr bool PERM = true, AFTER_DRAIN = false;
    bf16_t* Z; bf16_t* XBC; float* DT;
    __device__ __forceinline__ void operator()(const f32x4 (&acc)[2][2][4][2], const Unit& u, int wr, int wc, int fr, int fq) const {
        const int row0 = u.pm * BM + wr * 64 + fr;
        if (u.pn < 10) {
            bf16_t* base; int ldc, colt;
            if (u.pn < 4) { base = Z; ldc = 1024; colt = u.pn * BM; } else { base = XBC; ldc = 1536; colt = (u.pn - 4) * BM; }
            const int col0 = colt + wc * 32 + 8 * fq;
#pragma unroll
            for (int ai = 0; ai < 2; ++ai)
#pragma unroll
                for (int m = 0; m < 4; ++m) { bf16_t* rowp = base + (size_t)(row0 + ai * HALF + m * 16) * ldc + col0;
#pragma unroll
                    for (int bj = 0; bj < 2; ++bj) { const f32x4 v0 = acc[ai][bj][m][0], v1 = acc[ai][bj][m][1];
                        u32x4 w; w.x = cvt_pk_bf16(v0[0], v0[1]); w.y = cvt_pk_bf16(v0[2], v0[3]); w.z = cvt_pk_bf16(v1[0], v1[1]); w.w = cvt_pk_bf16(v1[2], v1[3]);
                        *(u32x4*)(rowp + bj * HALF) = w; } }
        } else if (wc == 0 && fq < 2) {
#pragma unroll
            for (int ai = 0; ai < 2; ++ai)
#pragma unroll
                for (int m = 0; m < 4; ++m) { float* rowp = DT + (size_t)(row0 + ai * HALF + m * 16) * 16 + 8 * fq;
                    *(f32x4*)rowp = acc[ai][0][m][0]; *(f32x4*)(rowp + 4) = acc[ai][0][m][1]; }
        }
    }
};
struct EpiQKV {
    static constexpr bool PERM = true, AFTER_DRAIN = false;
    bf16_t* O; int ldc; size_t split_stride; float scale0; unsigned* kmax;
    __device__ __forceinline__ void operator()(const f32x4 (&acc)[2][2][4][2], const Unit& u, int wr, int wc, int fr, int fq) const {
        const int row0 = u.pm * BM + wr * 64 + fr; int colt = u.pn * BM; const int t = colt / 1024; bf16_t* base = O + (size_t)t * split_stride; colt -= t * 1024;
        const float sc = (t == 0) ? scale0 : 1.f; const int col0 = colt + wc * 32 + 8 * fq;
        float km[2] = {0.f, 0.f};
#pragma unroll
        for (int ai = 0; ai < 2; ++ai)
#pragma unroll
            for (int m = 0; m < 4; ++m) { bf16_t* rowp = base + (size_t)(row0 + ai * HALF + m * 16) * ldc + col0;
#pragma unroll
                for (int bj = 0; bj < 2; ++bj) { const f32x4 v0 = acc[ai][bj][m][0] * sc, v1 = acc[ai][bj][m][1] * sc;
                    u32x4 w; w.x = cvt_pk_bf16(v0[0], v0[1]); w.y = cvt_pk_bf16(v0[2], v0[3]); w.z = cvt_pk_bf16(v1[0], v1[1]); w.w = cvt_pk_bf16(v1[2], v1[3]);
                    *(u32x4*)(rowp + bj * HALF) = w;
                    if (t == 1) { float s = 0.f;
#pragma unroll
                        for (int e = 0; e < 4; ++e) { const float lo = __builtin_bit_cast(float, w[e] << 16), hi = __builtin_bit_cast(float, w[e] & 0xffff0000u); s += lo * lo + hi * hi; }
                        s += __shfl_xor(s, 16); s += __shfl_xor(s, 32); km[bj] = __builtin_fmaxf(km[bj], s); } } }
        if (t == 1) {
#pragma unroll
            for (int bj = 0; bj < 2; ++bj) { float v = km[bj];
                v = __builtin_fmaxf(v, __shfl_xor(v, 1)); v = __builtin_fmaxf(v, __shfl_xor(v, 2)); v = __builtin_fmaxf(v, __shfl_xor(v, 4)); v = __builtin_fmaxf(v, __shfl_xor(v, 8));
                if ((fr | fq) == 0) { const int b = u.pm >> 5, head = (colt >> 7) + bj; atomicMax(kmax + (((b * 8 + head) * 2 + (wc >> 1)) * 2 + (wc & 1)), __builtin_bit_cast(unsigned, v)); } } }
    }
};
}
#include <hip/hip_bf16.h>
#include <cmath>
namespace attn_body {
using bf16=__hip_bfloat16;
using bf16x8=__attribute__((ext_vector_type(8)))short;
using s16x4=__attribute__((ext_vector_type(4)))short;
using f32x16=__attribute__((ext_vector_type(16)))float;
using u32x4=__attribute__((ext_vector_type(4)))unsigned;
constexpr int BATCH=2,NHEAD=16,SEQ=8192,D=64,DM=NHEAD*D;
constexpr int NW=8,QBLK=32,QB=QBLK*NW,KVBLK=64,NQB=SEQ/QB;
constexpr int ATTN_PITCH=DM, ATTN_UNIT_ROWS=QB, OPITCH=2048, OCOL0=1024;
__device__ __forceinline__ int crow(int r,int hi){return (r&3)+8*(r>>2)+4*hi;}
#define SBAR() __builtin_amdgcn_sched_barrier(0)
__device__ __forceinline__ void cmask(f32x16&p0,f32x16&p1,int jb,int qrel,int hi){
  const float NEG=-INFINITY; int kb=64*jb+4*hi;
  #pragma unroll
  for(int r=0;r<16;++r){int kv=kb+(r&3)+8*(r>>2); if(kv>qrel)p0[r]=NEG; if(kv+32>qrel)p1[r]=NEG;}
}

constexpr int BT_N=704;
__device__ __forceinline__ void bmask(f32x16&p0,f32x16&p1,int jb,int qrel,int hi,const float*bt){
  const float NEG=-INFINITY; const int brel=qrel-64*jb-4*hi; const float*bp=bt+(brel+256);
  #pragma unroll
  for(int r=0;r<16;++r){const int c0=(r&3)+8*(r>>2);
    const float b0=bp[-c0], b1=bp[-c0-32];
    p0[r]=(brel<c0)?NEG:p0[r]+b0; p1[r]=(brel<c0+32)?NEG:p1[r]+b1;
    if((r&3)==3)SBAR();}
}
constexpr int NSLOT=3, SLOTB=8192;
constexpr int LDS_K=0, LDS_V=NSLOT*SLOTB, LDS_WS=2*NSLOT*SLOTB, LDS_OST=LDS_WS+NW*64*4, LDS_BYTES=LDS_OST+NW*4096, LDS_OSTA=86016, LDS_BTAB=LDS_OSTA+NW*4096, LDS_TOTAL=LDS_BTAB+704*4;
constexpr float C2=0.125f*1.4426950408889634f;
__device__ __forceinline__ void glds16(const void*gsrc,unsigned lds_dst){unsigned keep;
  asm volatile("s_mov_b32 %0, m0\n\ts_mov_b32 m0, %2\n\ts_nop 0\n\tglobal_load_lds_dwordx4 %1, off\n\ts_mov_b32 m0, %0":"=&s"(keep):"v"(gsrc),"s"(lds_dst):"memory");}
__device__ __forceinline__ float max3f(float a,float b,float c){float r;asm("v_max3_f32 %0, %1, %2, %3":"=v"(r):"v"(a),"v"(b),"v"(c));return r;}
__device__ __forceinline__ float max2f(float a,float b){float r;asm("v_max_f32_e32 %0, %1, %2":"=v"(r):"v"(a),"v"(b));return r;}
__device__ __forceinline__ float fadd_s(float a,float b){float r;asm("v_add_f32_e32 %0, %1, %2":"=v"(r):"v"(a),"v"(b));return r;}
__device__ __forceinline__ float fsub_s(float a,float b){float r;asm("v_sub_f32_e32 %0, %1, %2":"=v"(r):"v"(a),"v"(b));return r;}
typedef float f32x2_t __attribute__((ext_vector_type(2))); typedef __bf16 bf16x2_t __attribute__((ext_vector_type(2)));
__device__ __forceinline__ unsigned cvtpk_s(float lo,float hi){f32x2_t v={lo,hi};bf16x2_t b=__builtin_convertvector(v,bf16x2_t);return __builtin_bit_cast(unsigned,b);}
#define WAIT_BAR(N) asm volatile("s_waitcnt vmcnt(" #N ") lgkmcnt(0)\n\ts_barrier":::"memory")

__device__ __forceinline__ void qkt(f32x16&p0,f32x16&p1,const char*Kslot,const bf16x8*qr,const f32x16&negm,int r32,int hi){
  const char*kb=Kslot+hi*1024+r32*16;
  #pragma unroll
  for(int d0=0;d0<4;++d0){
    const bf16x8 b0=*reinterpret_cast<const bf16x8*>(kb+d0*2048);
    const bf16x8 b1=*reinterpret_cast<const bf16x8*>(kb+d0*2048+512);
    if(d0==0){p0=__builtin_amdgcn_mfma_f32_32x32x16_bf16(b0,qr[0],negm,0,0,0);p1=__builtin_amdgcn_mfma_f32_32x32x16_bf16(b1,qr[0],negm,0,0,0);}
    else{p0=__builtin_amdgcn_mfma_f32_32x32x16_bf16(b0,qr[d0],p0,0,0,0);p1=__builtin_amdgcn_mfma_f32_32x32x16_bf16(b1,qr[d0],p1,0,0,0);}}
}
typedef __attribute__((address_space(3))) const char* lds_cptr;
typedef short v4i16_t __attribute__((ext_vector_type(4)));
__device__ __forceinline__ void kload8(bf16x8*kf,lds_cptr kp){
  kf[0]=*(const __attribute__((address_space(3))) bf16x8*)(kp);      kf[1]=*(const __attribute__((address_space(3))) bf16x8*)(kp+512);
  kf[2]=*(const __attribute__((address_space(3))) bf16x8*)(kp+2048); kf[3]=*(const __attribute__((address_space(3))) bf16x8*)(kp+2560);
  kf[4]=*(const __attribute__((address_space(3))) bf16x8*)(kp+4096); kf[5]=*(const __attribute__((address_space(3))) bf16x8*)(kp+4608);
  kf[6]=*(const __attribute__((address_space(3))) bf16x8*)(kp+6144); kf[7]=*(const __attribute__((address_space(3))) bf16x8*)(kp+6656);
}
__device__ __forceinline__ void kload2(bf16x8*kf,lds_cptr kp,int j){ kf[2*j]=*(const __attribute__((address_space(3))) bf16x8*)(kp+j*2048); kf[2*j+1]=*(const __attribute__((address_space(3))) bf16x8*)(kp+j*2048+512); }
__device__ __forceinline__ s16x4 vtr(lds_cptr p){ return __builtin_bit_cast(s16x4,__builtin_amdgcn_ds_read_tr16_b64_v4i16((__attribute__((address_space(3))) v4i16_t*)p)); }
__device__ __forceinline__ float rowmax(const f32x16&p0,const f32x16&p1){
  float a=max3f(p0[0],p0[1],p1[0]),b=max3f(p0[2],p0[3],p1[1]);a=max3f(a,p1[2],p1[3]);
  #pragma unroll
  for(int r=4;r<16;r+=4){a=max3f(a,p0[r],p0[r+1]);b=max3f(b,p0[r+2],p0[r+3]);a=max3f(a,p1[r],p1[r+1]);b=max3f(b,p1[r+2],p1[r+3]);}
  const float m=max2f(a,b);
  auto rr=__builtin_amdgcn_permlane32_swap(__float_as_uint(m),__float_as_uint(m),false,false);
  return max2f(__uint_as_float(rr[0]),__uint_as_float(rr[1]));
}
__device__ __forceinline__ void pv(f32x16*o,int vb,bf16x8 pa0,bf16x8 pa1,bf16x8 pa2,bf16x8 pa3){
  #pragma unroll
  for(int d0=0;d0<2;++d0){s16x4 lo[4],hi[4];
    #pragma unroll
    for(int ks=0;ks<4;++ks){
      asm volatile("ds_read_b64_tr_b16 %0,%1 offset:%c2":"=&v"(lo[ks]):"v"(vb),"i"(d0*4096+ks*1024):"memory");
      asm volatile("ds_read_b64_tr_b16 %0,%1 offset:%c2":"=&v"(hi[ks]):"v"(vb),"i"(d0*4096+ks*1024+512):"memory");}
    asm volatile("s_waitcnt lgkmcnt(0)":::"memory");SBAR();
    #define PK(k) (bf16x8){lo[k][0],lo[k][1],lo[k][2],lo[k][3],hi[k][0],hi[k][1],hi[k][2],hi[k][3]}
    o[d0]=__builtin_amdgcn_mfma_f32_32x32x16_bf16(pa0,PK(0),o[d0],0,0,0);
    o[d0]=__builtin_amdgcn_mfma_f32_32x32x16_bf16(pa1,PK(1),o[d0],0,0,0);
    o[d0]=__builtin_amdgcn_mfma_f32_32x32x16_bf16(pa2,PK(2),o[d0],0,0,0);
    o[d0]=__builtin_amdgcn_mfma_f32_32x32x16_bf16(pa3,PK(3),o[d0],0,0,0);
    #undef PK
  }
}

#ifndef ATTN_STORE16
#define ATTN_STORE16(p,v) (*(u32x4*)(p)=(v))
#endif
template<int THRL> __device__ __forceinline__ void attn_unit(int b,int hq,int hv,int qb,int pass,float lam,const float*btab,const bf16*Q,const bf16*__restrict__ K,const bf16*__restrict__ V,bf16*O,char*shm){
  const int tid=threadIdx.x,lane=tid&63,r32=lane&31,hi=lane>>5; const int wid=__builtin_amdgcn_readfirstlane(tid>>6);
  const long rowbase=(long)b*SEQ; const int q0=qb*QB;
  const bf16*Qw=Q+(rowbase+q0+wid*QBLK)*DM+hq*D;
  const bf16*Kh=K+rowbase*DM+hq*D,*Vh=V+rowbase*DM+hv*D;
  const unsigned lds0=(unsigned)(uintptr_t)shm;
  float*wsf=(float*)(shm+LDS_WS)+wid*64;
  const bf16*ksrc=Kh+(long)lane*DM+wid*8;
  const bf16*vsrc=Vh+(long)(16*(wid&3)+(lane>>2))*DM+(wid>>2)*32+(lane&3)*8;
  const unsigned kdst=lds0+LDS_K+wid*1024, vdst=lds0+LDS_V+wid*1024;
  #define DMA_K(t,slot) glds16(ksrc+(long)(t)*KVBLK*DM,(unsigned)__builtin_amdgcn_readfirstlane(kdst+(slot)))
  #define DMA_V(t,slot) glds16(vsrc+(long)(t)*KVBLK*DM,(unsigned)__builtin_amdgcn_readfirstlane(vdst+(slot)))
  const int vb0=(int)(lds0+LDS_V)+((lane>>4)&1)*32+(lane&3)*8+(4*hi+((lane&15)>>2))*64;
  const char*Kbase=shm+LDS_K; bf16x8 kf[8];
  const lds_cptr shm3=(lds_cptr)shm; const lds_cptr kp0=shm3+LDS_K+hi*1024+r32*16; const lds_cptr vp0=shm3+LDS_V+((lane>>4)&1)*32+(lane&3)*8+(4*hi+((lane&15)>>2))*64;
  const int NT=(q0+QB)/KVBLK;
  DMA_K(0,0);DMA_V(0,0);DMA_K(1,SLOTB);
  bf16x8 qr[4];
  #pragma unroll
  for(int d0=0;d0<4;++d0)qr[d0]=*reinterpret_cast<const bf16x8*>(&Qw[(long)r32*DM+d0*16+hi*8]);
  float mhat=0.f,l_reg=0.f;f32x16 o[2];o[0]=f32x16{};o[1]=f32x16{};f32x16 negm=f32x16{};asm volatile("":"+v"(negm));
  const int qrel=wid*QBLK+r32;
  #define CMASK(P0,P1,t) do{int jb_=(t)-(NT-4); if(jb_>=-2)bmask(P0,P1,jb_,qrel,hi,btab);}while(0)
  bool resc=false;
  #define START(P0,P1) do{ const float rm=rowmax(P0,P1); resc=false; \
    { const float dl=rm; mhat=fadd_s(mhat,dl); \
      _Pragma("unroll") for(int r=0;r<16;++r){P0[r]=fsub_s(P0[r],dl);P1[r]=fsub_s(P1[r],dl);} \
      _Pragma("unroll") for(int r=0;r<16;++r)negm[r]=-mhat; asm volatile("":"+v"(negm)); } \
    _Pragma("unroll") for(int r=0;r<16;++r)P0[r]=__builtin_amdgcn_exp2f(P0[r]); }while(0)
  #define RESC() do{ if(resc){ asm volatile("s_waitcnt lgkmcnt(0)":::"memory"); \
      _Pragma("unroll") for(int d_=0;d_<2;++d_) _Pragma("unroll") for(int r=0;r<16;++r)o[d_][r]*=wsf[crow(r,hi)]; } }while(0)
  f32x16 pA0,pA1,pB0,pB1;
  int sl_prev=0,sl_cur=0,sl_next=SLOTB;
  #define ROT() do{sl_prev=sl_cur;sl_cur=sl_next;sl_next=(sl_next==(NSLOT-1)*SLOTB)?0:sl_next+SLOTB;}while(0)
  DMA_K(2,2*SLOTB);
  WAIT_BAR(3);
  qkt(pA0,pA1,Kbase,qr,negm,r32,hi);asm volatile("s_nop 15\n\ts_nop 7":"+v"(pA0),"+v"(pA1));CMASK(pA0,pA1,0);
  START(pA0,pA1);
  _Pragma("unroll") for(int r=0;r<16;++r)pA1[r]=__builtin_amdgcn_exp2f(pA1[r]);
  WAIT_BAR(0);
  DMA_K(3,0);DMA_V(1,SLOTB);
  ROT();
  kload8(kf,kp0+sl_cur);
  WAIT_BAR(2);
  s16x4 vlo[8],vhi[8]; u32x4 pw0,pw1,pw2,pw3;
  #define PKW(P,B) cvtpk_s(P[B],P[B+1])
  #define PAF(k) __builtin_bit_cast(bf16x8,pw##k)
  #define VFR(i) (bf16x8){vlo[i][0],vlo[i][1],vlo[i][2],vlo[i][3],vhi[i][0],vhi[i][1],vhi[i][2],vhi[i][3]}
  #define PIN(x) asm volatile("":"+v"(x))
  #define MX3(a,b,c) __builtin_fmaxf(__builtin_fmaxf((a),(b)),(c))
  #define GAPA(MF,A0,A1,A2,A3,W0,W1,PW) do{ MF; sacc+=A0; sacc+=A1; sacc+=A2; sacc+=A3; PIN(sacc); W0; W1; PIN(PW); SBAR(); }while(0)
  #define EX(v) __builtin_amdgcn_exp2f(v)
  #define GAPB(MF,X,B) do{ MF; X[B]=EX(X[B]); X[B+1]=EX(X[B+1]); X[B+2]=EX(X[B+2]); X[B+3]=EX(X[B+3]); PIN(X); SBAR(); }while(0)
  #define VRD(i) do{ vlo[i]=vtr(vp_+(((i)>>2)*4096+((i)&3)*1024)); vhi[i]=vtr(vp_+(((i)>>2)*4096+((i)&3)*1024+512)); }while(0)
  #define KRD(G,j) do{ if(G){ kload2(kf,kp0+sl_next,j); SBAR(); } }while(0)
  #define STEP(C0,C1,P0,P1,t,GK,GV,GL) do{ SBAR(); \
    const lds_cptr vp_=vp0+sl_prev; \
    VRD(0); SBAR(); float sacc=(P0[0]+P0[1]); \
    GAPA(C0=__builtin_amdgcn_mfma_f32_32x32x16_bf16(kf[0],qr[0],negm,0,0,0), P0[2],P0[3],P0[4],P0[5],     pw0[0]=PKW(P0,0), pw0[1]=PKW(P0,2), pw0); \
    VRD(4); SBAR(); GAPA(C1=__builtin_amdgcn_mfma_f32_32x32x16_bf16(kf[1],qr[0],negm,0,0,0), P0[6],P0[7],P0[8],P0[9],     pw0[2]=PKW(P0,4), pw0[3]=PKW(P0,6), pw0); \
    VRD(1); SBAR(); GAPA(C0=__builtin_amdgcn_mfma_f32_32x32x16_bf16(kf[2],qr[1],C0,0,0,0),   P0[10],P0[11],P0[12],P0[13], pw1[0]=PKW(P0,8), pw1[1]=PKW(P0,10), pw1); \
    VRD(5); SBAR(); GAPA(C1=__builtin_amdgcn_mfma_f32_32x32x16_bf16(kf[3],qr[1],C1,0,0,0),   P0[14],P0[15],P1[0],P1[1],   pw1[2]=PKW(P0,12),pw1[3]=PKW(P0,14), pw1); \
    VRD(2); SBAR(); GAPA(C0=__builtin_amdgcn_mfma_f32_32x32x16_bf16(kf[4],qr[2],C0,0,0,0),   P1[2],P1[3],P1[4],P1[5],     pw2[0]=PKW(P1,0), pw2[1]=PKW(P1,2), pw2); \
    VRD(6); SBAR(); GAPA(C1=__builtin_amdgcn_mfma_f32_32x32x16_bf16(kf[5],qr[2],C1,0,0,0),   P1[6],P1[7],P1[8],P1[9],     pw2[2]=PKW(P1,4), pw2[3]=PKW(P1,6), pw2); \
    VRD(3); SBAR(); GAPA(C0=__builtin_amdgcn_mfma_f32_32x32x16_bf16(kf[6],qr[3],C0,0,0,0),   P1[10],P1[11],P1[12],P1[13], pw3[0]=PKW(P1,8), pw3[1]=PKW(P1,10), pw3); \
    VRD(7); SBAR(); GAPA(C1=__builtin_amdgcn_mfma_f32_32x32x16_bf16(kf[7],qr[3],C1,0,0,0),   P1[14],P1[15],0.f,0.f,       pw3[2]=PKW(P1,12),pw3[3]=PKW(P1,14), pw3); \
    l_reg+=sacc; \
    if(GK){DMA_K((t)+3,sl_cur);} if(GV){DMA_V((t)+1,sl_next);} \
    CMASK(C0,C1,t); \
    { float a=MX3(C0[0],C0[1],C1[0]),b=MX3(C0[2],C0[3],C1[1]); a=MX3(a,C1[2],C1[3]); \
      _Pragma("unroll") for(int r=4;r<16;r+=4){a=MX3(a,C0[r],C0[r+1]);b=MX3(b,C0[r+2],C0[r+3]);a=MX3(a,C1[r],C1[r+1]);b=MX3(b,C1[r+2],C1[r+3]);} \
      float rm=__builtin_fmaxf(a,b); { auto rr=__builtin_amdgcn_permlane32_swap(__float_as_uint(rm),__float_as_uint(rm),false,false); rm=__builtin_fmaxf(__uint_as_float(rr[0]),__uint_as_float(rr[1])); } \
      resc=false; \
      if(__builtin_expect(__any(rm>(float)THRL),0)){ const float dl=__builtin_fmaxf(rm,0.f); mhat+=dl; \
        _Pragma("unroll") for(int r=0;r<16;++r){C0[r]-=dl;C1[r]-=dl;} \
        _Pragma("unroll") for(int r=0;r<16;++r)negm[r]=-mhat; asm volatile("":"+v"(negm)); \
        const float f=__builtin_amdgcn_exp2f(-dl); l_reg*=f; if(hi==0)wsf[r32]=f; resc=true; } } \
    SBAR(); \
    GAPB(o[0]=__builtin_amdgcn_mfma_f32_32x32x16_bf16(PAF(0),VFR(0),o[0],0,0,0), C0,0); \
    GAPB(o[1]=__builtin_amdgcn_mfma_f32_32x32x16_bf16(PAF(0),VFR(4),o[1],0,0,0), C0,4); \
    KRD(GL,0); GAPB(o[0]=__builtin_amdgcn_mfma_f32_32x32x16_bf16(PAF(1),VFR(1),o[0],0,0,0), C0,8); \
    KRD(GL,1); GAPB(o[1]=__builtin_amdgcn_mfma_f32_32x32x16_bf16(PAF(1),VFR(5),o[1],0,0,0), C0,12); \
    KRD(GL,2); GAPB(o[0]=__builtin_amdgcn_mfma_f32_32x32x16_bf16(PAF(2),VFR(2),o[0],0,0,0), C1,0); \
    KRD(GL,3); GAPB(o[1]=__builtin_amdgcn_mfma_f32_32x32x16_bf16(PAF(2),VFR(6),o[1],0,0,0), C1,4); \
    GAPB(o[0]=__builtin_amdgcn_mfma_f32_32x32x16_bf16(PAF(3),VFR(3),o[0],0,0,0), C1,8); \
    GAPB(o[1]=__builtin_amdgcn_mfma_f32_32x32x16_bf16(PAF(3),VFR(7),o[1],0,0,0), C1,12); \
    }while(0)
  int t=1;
  #undef CMASK
  #define CMASK(P0,P1,t) do{}while(0)
  for(;t+7<NT;t+=2){
    STEP(pB0,pB1,pA0,pA1,t,true,true,true);     WAIT_BAR(2); RESC(); ROT();
    STEP(pA0,pA1,pB0,pB1,t+1,true,true,true);   WAIT_BAR(2); RESC(); ROT();
  }
  #undef CMASK
  #define CMASK(P0,P1,t) do{int jb_=(t)-(NT-4); if(jb_>=-2)bmask(P0,P1,jb_,qrel,hi,btab);}while(0)
  #define ENDW(tt) do{ if((tt)+3<NT){WAIT_BAR(2);} else if((tt)+2<NT){WAIT_BAR(1);} else {WAIT_BAR(0);} }while(0)
  for(;t+1<NT;t+=2){
    STEP(pB0,pB1,pA0,pA1,t,(t+3<NT),(t+1<NT),(t+1<NT));       ENDW(t);   RESC(); ROT();
    STEP(pA0,pA1,pB0,pB1,t+1,(t+4<NT),(t+2<NT),(t+2<NT));     ENDW(t+1); RESC(); ROT();
  }
  STEP(pB0,pB1,pA0,pA1,NT-1,false,false,false); RESC();
  { float sacc=pB0[0]+pB0[1]; _Pragma("unroll") for(int r=2;r<16;++r)sacc+=pB0[r]; _Pragma("unroll") for(int r=0;r<16;++r)sacc+=pB1[r]; l_reg+=sacc;
    pw0=(u32x4){PKW(pB0,0),PKW(pB0,2),PKW(pB0,4),PKW(pB0,6)};pw1=(u32x4){PKW(pB0,8),PKW(pB0,10),PKW(pB0,12),PKW(pB0,14)};pw2=(u32x4){PKW(pB1,0),PKW(pB1,2),PKW(pB1,4),PKW(pB1,6)};pw3=(u32x4){PKW(pB1,8),PKW(pB1,10),PKW(pB1,12),PKW(pB1,14)};
    SBAR(); pv(o,vb0+sl_cur,PAF(0),PAF(1),PAF(2),PAF(3)); }
  #undef PKW
  #undef PAF
  #undef VFR
  #undef PIN
  #undef MX3
  #undef GAPA
  #undef GAPB
  #undef EX
  #undef VRD
  #undef KRD
  #undef STEP
  #undef ENDW
  {auto rr=__builtin_amdgcn_permlane32_swap(__float_as_uint(l_reg),__float_as_uint(l_reg),false,false);l_reg=__uint_as_float(rr[0])+__uint_as_float(rr[1]);}
  if(hi==0)wsf[32+r32]=l_reg;asm volatile("s_waitcnt lgkmcnt(0)":::"memory");
  float rli[16];
  #pragma unroll
  for(int r=0;r<16;++r)rli[r]=__builtin_amdgcn_rcpf(wsf[32+crow(r,hi)]);
  bf16*Ow=O+(rowbase+q0+wid*QBLK)*OPITCH+OCOL0+hv*D;
  { bf16*stg=(bf16*)(shm+LDS_OST)+wid*2048; bf16*stga=(bf16*)(shm+LDS_OSTA)+wid*2048;
    #pragma unroll
    for(int r=0;r<16;++r){const int orow=crow(r,hi);
      #pragma unroll
      for(int d0=0;d0<2;++d0){const int ix=orow*64+d0*32+r32; const float ov=o[d0][r]*rli[r]; if(pass==0)stga[ix]=__float2bfloat16(ov); else stg[ix]=__float2bfloat16(__bfloat162float(stga[ix])-lam*ov);}}
    asm volatile("s_waitcnt lgkmcnt(0)":::"memory");
    #pragma unroll
    for(int i=0;i<4;++i){const int row=i*8+(lane>>3),ch=lane&7; if(pass!=0){const u32x4 v=*(const u32x4*)(stg+row*64+ch*8); ATTN_STORE16(Ow+(long)row*OPITCH+ch*8,v);}} }
  asm volatile("s_waitcnt lgkmcnt(0)\n\ts_barrier":::"memory");
  #undef DMA_K
  #undef DMA_V
  #undef CMASK
  #undef START
  #undef RESC
  #undef ROT
}
constexpr int ATTN_LDS_BYTES=LDS_BYTES;
struct AttnTensors { const bf16* Q; const bf16* K; const bf16* V; bf16* O; float lam; const float* relb; };
struct AttnUnit { int bh; int qb; };
struct StaticOrder {
  int vcu;
  __device__ __forceinline__ explicit StaticOrder(int grid,int block):vcu((block%8)*(grid/8)+block/8){}
  __device__ __forceinline__ bool next(int i,AttnUnit&u)const{ if(i>=4)return false; const int s=vcu&7; u.bh=vcu>>3; u.qb=(i==0)?s:(i==1)?15-s:(i==2)?16+s:31-s; return true; }
  __device__ __forceinline__ void a_ready(const AttnUnit&)const{}
  __device__ __forceinline__ void done(const AttnUnit&)const{}
};
template<class Sched,int THRL=8> __device__ __forceinline__ void attn_phase(char*lds,const AttnTensors&T,const Sched&S){
  AttnUnit u;
  for(int i=0;S.next(i,u);++i){ S.a_ready(u); const int b_=u.bh/NHEAD,hp_=u.bh%NHEAD; float*bt_=(float*)(lds+LDS_BTAB);
    for(int t_=threadIdx.x;t_<BT_N;t_+=NW*64){ const int rel=t_-256; float v_=0.f;
      if(rel>=0&&rel<113){ int bk=rel; if(rel>=16){ bk=16+(int)(logf((float)rel*(1.0f/16.0f))/logf(8.0f)*16.0f); bk=bk>31?31:bk; } v_=(T.relb[bk*8+(hp_>>1)]-T.relb[31*8+(hp_>>1)])*1.4426950408889634f; }
      bt_[t_]=v_; }
    asm volatile("s_waitcnt lgkmcnt(0)\n\ts_barrier":::"memory");
    for(int pass=0;pass<2;++pass) attn_unit<THRL>(b_,(hp_&~1)+pass,hp_,u.qb,pass,T.lam,bt_,T.Q,T.K,T.V,T.O,lds); S.done(u); }
}
#undef SBAR
#undef WAIT_BAR
}
namespace attn2 {
using attn_body::bf16; using attn_body::bf16x8; using attn_body::s16x4; using attn_body::f32x16; using attn_body::u32x4; using attn_body::lds_cptr;
using attn_body::glds16; using attn_body::vtr; using attn_body::cvtpk_s; using attn_body::crow; using attn_body::BT_N;
constexpr int SEQ=8192,DM=1024,NW=8,QBLK=32,QB=256;
constexpr int KSLOT=8192,VSLOT=8192,NS=4,NSV=5;
constexpr int L_K=0,L_V=NS*KSLOT,L_WS=L_V+NSV*VSLOT,L_OST=0,L_BTAB=L_WS+NW*256,L_TOTAL=L_BTAB+BT_N*4;
static_assert(NW*8192<=L_WS,"O stage inside the ring region");
constexpr int OP=2048,OC0=1024;
#define SBAR() __builtin_amdgcn_sched_barrier(0)
#define WAIT_BAR(N) asm volatile("s_waitcnt vmcnt(" #N ") lgkmcnt(0)\n\ts_barrier":::"memory")
#define A2LAS __attribute__((address_space(3)))
__device__ __forceinline__ void bmask1(f32x16&p,int jb,int qrel,int hi,const float*bt){
  const float NEG=-INFINITY; const int brel=qrel-32*jb-4*hi; const float*bp=bt+(brel+256);
  #pragma unroll
  for(int r=0;r<16;++r){const int c0=(r&3)+8*(r>>2); const float b0=bp[-c0]; p[r]=(brel<c0)?NEG:p[r]+b0; if((r&3)==3)SBAR();}
}
__device__ __forceinline__ float rowmax1(const f32x16&p){
  #define MX3(a,b,c) __builtin_fmaxf(__builtin_fmaxf((a),(b)),(c))
  float a=MX3(p[0],p[1],p[2]),b=MX3(p[3],p[4],p[5]); a=MX3(a,p[6],p[7]); b=MX3(b,p[8],p[9]); a=MX3(a,p[10],p[11]); b=MX3(b,p[12],p[13]); a=MX3(a,p[14],p[15]);
  float m=__builtin_fmaxf(a,b); auto rr=__builtin_amdgcn_permlane32_swap(__float_as_uint(m),__float_as_uint(m),false,false);
  return __builtin_fmaxf(__uint_as_float(rr[0]),__uint_as_float(rr[1]));
  #undef MX3
}
template<int THRL> __device__ __forceinline__ void unit2(int b,int h,int qb,int pass,float lam,float kmax2,float bmax,const float*subg,const float*btab,const bf16*Q,const bf16*__restrict__ K,const bf16*__restrict__ V,bf16*O,char*shm){
  const int tid=threadIdx.x,lane=tid&63,r32=lane&31,hi=lane>>5; const int wid=__builtin_amdgcn_readfirstlane(tid>>6);
  const long rowbase=(long)b*SEQ; const int q0=qb*QB; const int hq=2*h+pass;
  const bf16*Qw=Q+(rowbase+q0+wid*QBLK)*DM+hq*64;
  const bf16*Kh=K+rowbase*DM+hq*64,*Vh=V+rowbase*DM+h*128;
  const unsigned lds0=(unsigned)(uintptr_t)shm;
  float*wsf=(float*)(shm+L_WS)+wid*64;
  const bf16*ksrc=Kh+(long)lane*DM+wid*8;
  const bf16*vsrc=Vh+(long)(16*(wid&1)+(lane>>2))*DM+(wid>>1)*32+(lane&3)*8;
  const unsigned kdst=lds0+L_K+wid*1024, vdst=lds0+L_V+wid*1024;
  #define DMA_K(T,slot) glds16(ksrc+(long)(T)*64*DM,(unsigned)__builtin_amdgcn_readfirstlane(kdst+(slot)))
  #define DMA_V(u,slot) glds16(vsrc+(long)(u)*32*DM,(unsigned)__builtin_amdgcn_readfirstlane(vdst+(slot)))
  const lds_cptr shm3=(lds_cptr)shm; const lds_cptr kp0=shm3+L_K+hi*1024+r32*16;
  const lds_cptr vp0=shm3+L_V+((lane>>4)&1)*32+(lane&3)*8+(4*hi+((lane&15)>>2))*64;
  const int NT2=(q0+QB)/32, NT=NT2/2;
  DMA_K(0,0);DMA_V(0,0);DMA_K(1,KSLOT);
  bf16x8 qr[4];
  #pragma unroll
  for(int d0=0;d0<4;++d0)qr[d0]=*reinterpret_cast<const bf16x8*>(&Qw[(long)r32*DM+d0*16+hi*8]);
  float l_reg=0.f;f32x16 o[4];o[0]=f32x16{};o[1]=f32x16{};o[2]=f32x16{};o[3]=f32x16{};
  f32x16 negm;
  { float q2=0.f;
    #pragma unroll
    for(int d0=0;d0<4;++d0)
      #pragma unroll
      for(int j=0;j<8;++j){ const float qv=__uint_as_float((unsigned)(unsigned short)qr[d0][j]<<16); q2+=qv*qv; }
    auto rr=__builtin_amdgcn_permlane32_swap(__float_as_uint(q2),__float_as_uint(q2),false,false); q2=__uint_as_float(rr[0])+__uint_as_float(rr[1]);
    const float mref=__builtin_sqrtf(q2*kmax2)*1.01f+bmax+0.0078125f;
    #pragma unroll
    for(int r=0;r<16;++r)negm[r]=-mref;
    asm volatile("":"+v"(negm)); }
  const int qrel=wid*QBLK+r32;
  f32x16 pA,pB; bf16x8 kf[4]; s16x4 vlo[8],vhi[8]; u32x4 pw0,pw1;
  int sv_prev=0,sv_cur=VSLOT,sv_n1=2*VSLOT,sv_n2=3*VSLOT,sv_sp=4*VSLOT;
  int sk_cur=0,sk_next=KSLOT,sk_nn=2*KSLOT,sk_sp=3*KSLOT;
  #define ROTV() do{const int t_=sv_prev;sv_prev=sv_cur;sv_cur=sv_n1;sv_n1=sv_n2;sv_n2=sv_sp;sv_sp=t_;}while(0)
  #define ROTK() do{const int t_=sk_cur;sk_cur=sk_next;sk_next=sk_nn;sk_nn=sk_sp;sk_sp=t_;}while(0)
  #define KLD(j,p) kf[j]=*(const A2LAS bf16x8*)((p)+(j)*2048)
  DMA_K(2,2*KSLOT);DMA_V(1,VSLOT);
  WAIT_BAR(4);
  { KLD(0,kp0);KLD(1,kp0);KLD(2,kp0);KLD(3,kp0);
    pA=__builtin_amdgcn_mfma_f32_32x32x16_bf16(kf[0],qr[0],negm,0,0,0); pA=__builtin_amdgcn_mfma_f32_32x32x16_bf16(kf[1],qr[1],pA,0,0,0);
    pA=__builtin_amdgcn_mfma_f32_32x32x16_bf16(kf[2],qr[2],pA,0,0,0); pA=__builtin_amdgcn_mfma_f32_32x32x16_bf16(kf[3],qr[3],pA,0,0,0);
    if(NT2==8)bmask1(pA,0,qrel,hi,btab);
    #pragma unroll
    for(int r=0;r<16;++r)pA[r]=__builtin_amdgcn_exp2f(pA[r]);
    KLD(0,kp0+512);KLD(1,kp0+512);KLD(2,kp0+512);KLD(3,kp0+512); }
  WAIT_BAR(0);
  #define PKW(P,B) cvtpk_s(P[B],P[B+1])
  #define PAF(k) __builtin_bit_cast(bf16x8,pw##k)
  #define VFR(i) (bf16x8){vlo[i][0],vlo[i][1],vlo[i][2],vlo[i][3],vhi[i][0],vhi[i][1],vhi[i][2],vhi[i][3]}
  #define PIN(x) asm volatile("":"+v"(x))
  #define MX3(a,b,c) __builtin_fmaxf(__builtin_fmaxf((a),(b)),(c))
  #define EX(v) __builtin_amdgcn_exp2f(v)
  #define GAPA(MF,A0,A1,A2,A3,W0,W1,PW) do{ MF; sacc+=A0; sacc+=A1; sacc+=A2; sacc+=A3; PIN(sacc); W0; W1; PIN(PW); SBAR(); }while(0)
  #define GAPB(MF,X,B) do{ MF; X[B]=EX(X[B]); X[B+1]=EX(X[B+1]); PIN(X); SBAR(); }while(0)
  #define VRD(i) do{ vlo[i]=vtr(vp_+(((i)>>1)*2048+((i)&1)*1024)); vhi[i]=vtr(vp_+(((i)>>1)*2048+((i)&1)*1024+512)); }while(0)
  #define KRD(G,j) do{ if(G){ KLD(j,kn_); SBAR(); } }while(0)
  #define MF32(a,b,c) __builtin_amdgcn_mfma_f32_32x32x16_bf16(a,b,c,0,0,0)
  #define SUB(C,P,u,ODD,GK,GV,GV2,GL,MASK,MIDW) do{ SBAR(); \
    const lds_cptr vp_=vp0+sv_prev; const lds_cptr kn_=kp0+((ODD)?sk_next:(sk_cur+512)); \
    VRD(0); SBAR(); float sacc=(P[0]+P[1]); \
    GAPA(C=MF32(kf[0],qr[0],negm), P[2],P[3],P[4],P[5],     pw0[0]=PKW(P,0), pw0[1]=PKW(P,2), pw0); \
    VRD(2); SBAR(); GAPA(C=MF32(kf[1],qr[1],C), P[6],P[7],P[8],P[9],     pw0[2]=PKW(P,4), pw0[3]=PKW(P,6), pw0); \
    VRD(1); SBAR(); GAPA(C=MF32(kf[2],qr[2],C), P[10],P[11],P[12],P[13], pw1[0]=PKW(P,8), pw1[1]=PKW(P,10), pw1); \
    VRD(3); SBAR(); GAPA(C=MF32(kf[3],qr[3],C), P[14],P[15],0.f,0.f,     pw1[2]=PKW(P,12),pw1[3]=PKW(P,14), pw1); \
    l_reg+=sacc; \
    if(ODD){ if(GV){DMA_V((u)+1,sv_n1);} if(GV2){DMA_V((u)+2,sv_n2);} if(GK){DMA_K(((u)>>1)+3,sk_sp);} } \
    if(MASK){ const int jb_=(u)-(NT2-8); if(jb_>=-4)bmask1(C,jb_,qrel,hi,btab); } \
    SBAR(); \
    if((MIDW)>=0 && wid>=4){ if((MIDW)==1){WAIT_BAR(1);}else{WAIT_BAR(0);} } \
    SBAR(); \
    VRD(4); SBAR(); GAPB(o[0]=MF32(PAF(0),VFR(0),o[0]), C,0); \
    VRD(6); SBAR(); GAPB(o[1]=MF32(PAF(0),VFR(2),o[1]), C,2); \
    VRD(5); SBAR(); GAPB(o[0]=MF32(PAF(1),VFR(1),o[0]), C,4); \
    VRD(7); SBAR(); GAPB(o[1]=MF32(PAF(1),VFR(3),o[1]), C,6); \
    KRD(GL,0); GAPB(o[2]=MF32(PAF(0),VFR(4),o[2]), C,8); \
    KRD(GL,1); GAPB(o[3]=MF32(PAF(0),VFR(6),o[3]), C,10); \
    KRD(GL,2); GAPB(o[2]=MF32(PAF(1),VFR(5),o[2]), C,12); \
    KRD(GL,3); GAPB(o[3]=MF32(PAF(1),VFR(7),o[3]), C,14); \
    }while(0)
  int u=1;
  for(;u+13<NT2;u+=2){
    SUB(pB,pA,u,true,true,true,true,true,false,-1); ROTV(); ROTK();
    SUB(pA,pB,u+1,false,false,false,false,true,false,1);   if(wid<4){WAIT_BAR(1);} ROTV();
  }
  for(;u+1<NT2;u+=2){
    const bool gk=((u>>1)+3<NT), gv2=(u+2<NT2);
    SUB(pB,pA,u,true,gk,true,gv2,true,true,-1); ROTV(); ROTK();
    { const int mw_=gk?1:0; SUB(pA,pB,u+1,false,false,false,false,gv2,true,mw_); if(wid<4){ if(gk){WAIT_BAR(1);}else{WAIT_BAR(0);} } } ROTV();
  }
  SUB(pB,pA,NT2-1,true,false,false,false,false,true,-1);
  { float sacc=pB[0]+pB[1];
    #pragma unroll
    for(int r=2;r<16;++r)sacc+=pB[r];
    l_reg+=sacc;
    pw0=(u32x4){PKW(pB,0),PKW(pB,2),PKW(pB,4),PKW(pB,6)};pw1=(u32x4){PKW(pB,8),PKW(pB,10),PKW(pB,12),PKW(pB,14)};
    SBAR(); const lds_cptr vp_=vp0+sv_cur;
    #pragma unroll
    for(int db=0;db<4;++db){ VRD(2*db); VRD(2*db+1); o[db]=MF32(PAF(0),VFR(2*db),o[db]); o[db]=MF32(PAF(1),VFR(2*db+1),o[db]); } }
  #undef PKW
  #undef PAF
  #undef VFR
  #undef PIN
  #undef MX3
  #undef EX
  #undef GAPA
  #undef GAPB
  #undef VRD
  #undef KRD
  #undef SUB
  asm volatile("s_waitcnt lgkmcnt(0)\n\ts_barrier":::"memory");
  {auto rr=__builtin_amdgcn_permlane32_swap(__float_as_uint(l_reg),__float_as_uint(l_reg),false,false);l_reg=__uint_as_float(rr[0])+__uint_as_float(rr[1]);}
  if(hi==0)wsf[32+r32]=l_reg;asm volatile("s_waitcnt lgkmcnt(0)":::"memory");
  float rli[16];
  #pragma unroll
  for(int r=0;r<16;++r)rli[r]=__builtin_amdgcn_rcpf(wsf[32+crow(r,hi)]);
  bf16*Ow=O+(rowbase+q0+wid*QBLK)*OP+OC0+h*128;
  { bf16*stg=(bf16*)(shm+L_OST)+wid*4096;
    #pragma unroll
    for(int r=0;r<16;++r){const int orow=crow(r,hi);
      #pragma unroll
      for(int db=0;db<4;++db)stg[orow*128+db*32+r32]=__float2bfloat16(o[db][r]*rli[r]);}
    asm volatile("s_waitcnt lgkmcnt(0)":::"memory");
    float sg[8];
    #pragma unroll
    for(int e=0;e<8;++e)sg[e]=subg[(lane&15)*8+e]*0.8f;
    #pragma unroll
    for(int i=0;i<8;++i){const int row=i*4+(lane>>4),ch=lane&15; u32x4 v=*(const u32x4*)(stg+row*128+ch*8); bf16*gp=Ow+(long)row*OP+ch*8;
      if(pass!=0){ const u32x4 a=*(const u32x4*)gp; u32x4 w; float d[8]; float ss=0.f;
        #pragma unroll
        for(int e=0;e<4;++e){ const float a0=__uint_as_float(a[e]<<16),a1=__uint_as_float(a[e]&0xffff0000u),b0=__uint_as_float(v[e]<<16),b1=__uint_as_float(v[e]&0xffff0000u); d[2*e]=a0-lam*b0; d[2*e+1]=a1-lam*b1; ss+=d[2*e]*d[2*e]+d[2*e+1]*d[2*e+1]; }
        ss+=__shfl_xor(ss,1); ss+=__shfl_xor(ss,2); ss+=__shfl_xor(ss,4); ss+=__shfl_xor(ss,8);
        const float rs=rsqrtf(ss*(1.f/128.f)+1e-6f);
        #pragma unroll
        for(int e=0;e<4;++e) w[e]=cvtpk_s(d[2*e]*rs*sg[2*e],d[2*e+1]*rs*sg[2*e+1]);
        v=w; }
      *(u32x4*)gp=v; } }
  asm volatile("s_waitcnt lgkmcnt(0)\n\ts_barrier":::"memory");
  #undef DMA_K
  #undef DMA_V
  #undef ROTV
  #undef ROTK
  #undef KLD
  #undef MF32
}
struct Tensors { const bf16* Q; const bf16* K; const bf16* V; bf16* O; float lam; const float* relb; const float* subg; const float* kmax; };
template<int THRL=8> __device__ __forceinline__ void phase(char*lds,const Tensors&T,int grid,int block){
  const int vcu=(block%8)*(grid/8)+block/8;
  for(int i=0;i<2;++i){ const int bh=vcu>>4,s=vcu&15,qb=(i==0)?s:31-s,b_=bh>>3,h_=bh&7; float*bt_=(float*)(lds+L_BTAB);
    for(int t_=threadIdx.x;t_<BT_N;t_+=NW*64){ const int rel=t_-256; float v_=0.f;
      if(rel>=0&&rel<113){ int bk=rel; if(rel>=16){ bk=16+(int)(logf((float)rel*(1.0f/16.0f))/logf(8.0f)*16.0f); bk=bk>31?31:bk; } v_=(T.relb[bk*8+h_]-T.relb[31*8+h_])*1.4426950408889634f; }
      bt_[t_]=v_; }
    asm volatile("s_waitcnt lgkmcnt(0)\n\ts_barrier":::"memory");
    float bmax=0.f;
    for(int bk=0;bk<31;++bk)bmax=__builtin_fmaxf(bmax,(T.relb[bk*8+h_]-T.relb[31*8+h_])*1.4426950408889634f);
    for(int pass=0;pass<2;++pass){ const float*kp_=T.kmax+((bh*2+pass)*2); const float kmax2=__hip_atomic_load(kp_,__ATOMIC_RELAXED,__HIP_MEMORY_SCOPE_AGENT)+__hip_atomic_load(kp_+1,__ATOMIC_RELAXED,__HIP_MEMORY_SCOPE_AGENT);
      unit2<THRL>(b_,h_,qb,pass,T.lam,kmax2,bmax,T.subg,bt_,T.Q,T.K,T.V,T.O,lds); } }
}
#undef SBAR
#undef WAIT_BAR
#undef A2LAS
}
constexpr int NWAVES = 8;
constexpr int BATCH = 2, SEQ = 8192, DM = 1024, M = BATCH * SEQ;
constexpr int DFF = 2816, NGU = 2 * DFF;
constexpr int NQKV = 3072;
constexpr int NMIX = 2816;
constexpr int NIN = NQKV + NMIX;
constexpr int IN_WIDTH = 5648;
constexpr int KOUT = 2048;
constexpr int NMOD = 9 * DM;
constexpr int NCHUNK = SEQ / 128, NBC = BATCH * NCHUNK;
constexpr float EPS = 1e-6f;
constexpr float LAM_INIT = 0.2f;
constexpr float LOG2E = 1.4426950408889634f;

constexpr size_t MiB = 1u << 20;
constexpr size_t WS_CTL = 0, CTL_ZERO_BYTES = 64 * 1024;
constexpr size_t WS_MOD = 1 * MiB;
constexpr size_t WS_DTRAW = 2 * MiB;
constexpr size_t WS_DTS = 3 * MiB;
constexpr size_t WS_AC = 4 * MiB;
constexpr size_t WS_CDEC = 5 * MiB;
constexpr size_t WS_WA = 6 * MiB;
constexpr size_t WS_WB = 18 * MiB;
constexpr size_t WS_H = 24 * MiB;
constexpr size_t WS_U = 56 * MiB;
constexpr size_t WS_ACT = WS_U, WS_D = WS_U + 88 * MiB;
constexpr size_t WS_Q = WS_U, WS_K = WS_U + 32 * MiB, WS_V = WS_U + 64 * MiB;
constexpr size_t WS_YCAT = WS_U + 96 * MiB;
constexpr size_t WS_Z = WS_U, WS_XBC = WS_U + 32 * MiB;
constexpr size_t WS_BT = WS_U + 80 * MiB, WS_CM = WS_U + 88 * MiB;
constexpr size_t WS_XT = WS_U + 160 * MiB, WS_BM = WS_U + 192 * MiB;
constexpr size_t WS_ST = WS_H;
constexpr size_t WS_D2 = WS_U;
constexpr size_t WS_X2 = WS_U + 152 * MiB;
constexpr size_t WS_END = 256 * MiB;
static_assert(WS_BM + 8 * MiB <= WS_END && WS_D + 64 * MiB <= WS_END && WS_YCAT + 64 * MiB <= WS_XT && WS_CM + 8 * MiB <= WS_YCAT && WS_XBC + 48 * MiB <= WS_BT, "d_ws map");

constexpr int RING_OFF = 0, RING_BYTES = 131072;
constexpr int LDSCTL_OFF = RING_BYTES, MISC_OFF = LDSCTL_OFF + 320;
constexpr int LDS_BYTES = 147456;
static_assert(attn_body::LDS_TOTAL <= RING_BYTES && attn2::L_TOTAL <= RING_BYTES, "attention scratch inside the ring region");

#define GAS __attribute__((address_space(1)))
#define LAS __attribute__((address_space(3)))
typedef unsigned short bf16;
typedef unsigned v4u __attribute__((ext_vector_type(4)));
typedef unsigned v2u __attribute__((ext_vector_type(2)));
typedef float f32x4 __attribute__((ext_vector_type(4)));
typedef float f32x16 __attribute__((ext_vector_type(16)));
typedef short bf16x8 __attribute__((ext_vector_type(8)));
typedef GAS unsigned gu32;
#define RLX_AGENT __ATOMIC_RELAXED, __HIP_MEMORY_SCOPE_AGENT
#define LDS_WAIT() asm volatile("s_waitcnt lgkmcnt(0)" ::: "memory")
#define VM_WAIT() asm volatile("s_waitcnt vmcnt(0)" ::: "memory")
__device__ __forceinline__ unsigned f2bf(float f) { unsigned u = __builtin_bit_cast(unsigned, f); return (u + 0x7fffu + ((u >> 16) & 1u)) >> 16; }
typedef float f32x2_p __attribute__((ext_vector_type(2))); typedef __bf16 bf16x2_p __attribute__((ext_vector_type(2)));
__device__ __forceinline__ unsigned pk2(float lo, float hi) { f32x2_p v = {lo, hi}; return __builtin_bit_cast(unsigned, __builtin_convertvector(v, bf16x2_p)); }
__device__ __forceinline__ float bf2f(unsigned short h) { return __builtin_bit_cast(float, (unsigned)h << 16); }
__device__ __forceinline__ float bflo(unsigned w) { return __builtin_bit_cast(float, w << 16); }
__device__ __forceinline__ float bfhi(unsigned w) { return __builtin_bit_cast(float, w & 0xffff0000u); }
__device__ __forceinline__ float silu(float v) { return v * __builtin_amdgcn_rcpf(1.0f + __expf(-v)); }
__device__ __forceinline__ int crow(int r, int hi) { return (r & 3) + 8 * (r >> 2) + 4 * hi; }
#define MFMA32(a, b, c) __builtin_amdgcn_mfma_f32_32x32x16_bf16(a, b, c, 0, 0, 0)

#define XB_TMO      128
#define XB_XCNT(j)  (256  + 64 * (j))
#define XB_XSUB(j)  (1280 + 64 * (j))
#define XB_XGEN(j)  (2304 + 64 * (j))
#define XB_TOP      3328
#define XB_TOPGEN   3392
#define XCD_BAR_WORDS 3456
#define XB_SPIN_CAP (1u << 18)
constexpr int CW_KMAX = 12288;
constexpr int CW_BAR = 4096;
static_assert((CW_BAR + XCD_BAR_WORDS) <= CW_KMAX && (CW_KMAX + 64) * 4 <= (int)CTL_ZERO_BYTES, "control words inside the memset region");
__device__ __forceinline__ unsigned xb_ld(unsigned* p)              { return __hip_atomic_load(p, __ATOMIC_RELAXED, __HIP_MEMORY_SCOPE_AGENT); }
__device__ __forceinline__ unsigned xb_add(unsigned* p, unsigned v) { return __hip_atomic_fetch_add(p, v, __ATOMIC_RELAXED, __HIP_MEMORY_SCOPE_AGENT); }
__device__ __forceinline__ unsigned xb_xcc_id() { return (unsigned)__builtin_amdgcn_s_getreg((3 << 11) | 20) & 0xFu; }
#define XB_SPIN(cond, bar) do { unsigned _sp = 0; while (cond) { __builtin_amdgcn_s_sleep(1); \
    if ((++_sp & 255u) == 0u) { if (xb_ld(&(bar)[XB_TMO])) break; if (_sp > XB_SPIN_CAP) { atomicAdd(&(bar)[XB_TMO], 1u); break; } } } } while (0)
struct XcdBarrier { unsigned* bar; unsigned x; volatile LAS unsigned* st; };
__device__ __forceinline__ XcdBarrier xcd_barrier_post(unsigned* bar, volatile LAS unsigned* st) {
    XcdBarrier b; b.bar = bar; b.x = xb_xcc_id(); b.st = st;
    if (threadIdx.x == 0) (void)xb_add(&bar[XB_XCNT(b.x)], 1u);
    return b;
}
__device__ __forceinline__ void xcd_barrier_complete(unsigned* bar, unsigned x, unsigned& nloc, unsigned& nx) {
    const unsigned G = gridDim.x * gridDim.y * gridDim.z;
    unsigned sum, cnt, mine, sp = 0u;
    for (;;) {
        sum = 0u; cnt = 0u; mine = 0u;
#pragma unroll
        for (unsigned j = 0; j < 16; ++j) { const unsigned c = xb_ld(&bar[XB_XCNT(j)]); sum += c; cnt += (c > 0u) ? 1u : 0u; mine = (j == x) ? c : mine; }
        if (sum == G) break;
        __builtin_amdgcn_s_sleep(1);
        if ((++sp & 255u) == 0u) { if (xb_ld(&bar[XB_TMO])) break; if (sp > XB_SPIN_CAP) { atomicAdd(&bar[XB_TMO], 1u); break; } }
    }
    nloc = mine > 0u ? mine : 1u; nx = cnt > 0u ? cnt : 1u;
}
__device__ __forceinline__ void xcd_barrier(const XcdBarrier& b) {
    asm volatile("s_waitcnt vmcnt(0)" ::: "memory");
    __syncthreads();
    if (threadIdx.x == 0) {
        unsigned* bar = b.bar;
        __builtin_amdgcn_s_waitcnt(0);
        unsigned nloc = b.st[0], nx = b.st[1];
        if (nloc == 0u) { xcd_barrier_complete(bar, b.x, nloc, nx); b.st[0] = nloc; b.st[1] = nx; }
        const unsigned old = xb_add(&bar[XB_XSUB(b.x)], 1u);
        const unsigned gen = old / nloc;
        if (old + 1u == (gen + 1u) * nloc) {
            __builtin_amdgcn_fence(__ATOMIC_RELEASE, "agent");
            asm volatile("s_waitcnt vmcnt(0)" ::: "memory");
            const unsigned og = xb_add(&bar[XB_TOP], 1u);
            const unsigned tg = og / nx;
            if (og + 1u == (tg + 1u) * nx) xb_add(&bar[XB_TOPGEN], 1u);
            else XB_SPIN(xb_ld(&bar[XB_TOPGEN]) == tg, bar);
            __builtin_amdgcn_fence(__ATOMIC_ACQUIRE, "agent");
            xb_add(&bar[XB_XGEN(b.x)], 1u);
            asm volatile("s_waitcnt vmcnt(0)" ::: "memory");
        } else {
            XB_SPIN(xb_ld(&bar[XB_XGEN(b.x)]) == gen, bar);
            __builtin_amdgcn_fence(__ATOMIC_ACQUIRE, "agent");
            asm volatile("s_waitcnt vmcnt(0)" ::: "memory");
        }
    }
    __syncthreads();
}

struct Frame {
    LAS unsigned char* lds;
    int tid, lane, wave;
    int vcu, G;
    int gw, NGW;
};
__device__ __forceinline__ float wave_sum(float v) {
#pragma unroll
    for (int o = 1; o < 64; o <<= 1) v += __shfl_xor(v, o);
    return v;
}
__device__ __forceinline__ void tr_item(const float* W, int N, int n0, int k0, bf16* WT, int K, int drow0, int nvalid, LAS float* scr, int lane) {
#pragma unroll 8
    for (int i = 0; i < 32; ++i) { const int kk = 2 * i + (lane >> 5); scr[kk * 33 + (lane & 31)] = __builtin_nontemporal_load(W + (size_t)(k0 + kk) * N + n0 + (lane & 31)); }
    LDS_WAIT(); asm volatile("" ::: "memory");
    const int c = lane & 7;
#pragma unroll
    for (int j = 0; j < 4; ++j) { const int n = (lane >> 3) + 8 * j; const LAS float* s = scr + (8 * c) * 33 + n;
        v4u o; o.x = pk2(s[0 * 33], s[1 * 33]); o.y = pk2(s[2 * 33], s[3 * 33]); o.z = pk2(s[4 * 33], s[5 * 33]); o.w = pk2(s[6 * 33], s[7 * 33]);
        if (n >= nvalid) o = (v4u){0u, 0u, 0u, 0u};
        *(GAS v4u*)(WT + (size_t)(drow0 + n) * K + k0 + 8 * c) = o; }
    LDS_WAIT(); asm volatile("" ::: "memory");
}
__device__ __forceinline__ void convert_gu_half(Frame& F, int w, int nw, const float* Wx, int up, bf16* WA) {
    LAS float* scr = (LAS float*)(F.lds + RING_OFF + F.wave * 16384);
    constexpr int NB = DFF / 32, I_G = (DM / 64) * NB;
    for (int r = w; r < I_G; r += nw) { const int kb = r / NB, nb = r % NB, n0 = 32 * nb;
        tr_item(Wx, DFF, n0, 64 * kb, WA, DM, (n0 >> 7) * 256 + (n0 & 127) + (up ? 128 : 0), 32, scr, F.lane); }
}
__device__ __forceinline__ void convert_down(Frame& F, int w, int nw, const float* Wd, bf16* WB) {
    LAS float* scr = (LAS float*)(F.lds + RING_OFF + F.wave * 16384);
    constexpr int I_D = (DFF / 64) * (DM / 32);
    for (int r = w; r < I_D; r += nw) { const int kb = r / (DM / 32), nb = r % (DM / 32); tr_item(Wd, DM, 32 * nb, 64 * kb, WB, DFF, 32 * nb, 32, scr, F.lane); }
}
__device__ __forceinline__ void convert_ffn(Frame& F, const float* Wg, const float* Wu, const float* Wd, bf16* WA, bf16* WB) {
    LAS float* scr = (LAS float*)(F.lds + RING_OFF + F.wave * 16384);
    constexpr int NB = DFF / 32, I_G = (DM / 64) * NB, I_D = (DFF / 64) * (DM / 32);
    for (int it = F.gw; it < 2 * I_G + I_D; it += F.NGW) {
        int r = it;
        if (r < 2 * I_G) { const int up = r >= I_G; if (up) r -= I_G; const int kb = r / NB, nb = r % NB, n0 = 32 * nb;
            tr_item(up ? Wu : Wg, DFF, n0, 64 * kb, WA, DM, (n0 >> 7) * 256 + (n0 & 127) + (up ? 128 : 0), 32, scr, F.lane); continue; }
        r -= 2 * I_G; { const int kb = r / (DM / 32), nb = r % (DM / 32); tr_item(Wd, DM, 32 * nb, 64 * kb, WB, DFF, 32 * nb, 32, scr, F.lane); }
    }
}
__device__ __forceinline__ void convert_mix(Frame& F, int w, int nw, const float* Win, const float* Wout, bf16* WA, bf16* WB) {
    LAS float* scr = (LAS float*)(F.lds + RING_OFF + F.wave * 16384);
    constexpr int NB_IN = 177, I_IN = (DM / 64) * NB_IN, I_OUT = (KOUT / 64) * (DM / 32);
    for (int it = w; it < I_IN + I_OUT; it += nw) {
        int r = it;
        if (r < I_IN) { const int kb = r / NB_IN; int nb = r % NB_IN; int src, dst, nv = 32;
            if (nb < 32) { src = 0 + 32 * nb; dst = 3072 + 32 * nb; }
            else if (nb < 80) { nb -= 32; src = 1024 + 32 * nb; dst = 4096 + 32 * nb; }
            else if (nb < 81) { src = 2560; dst = 5632; nv = 16; }
            else if (nb < 113) { nb -= 81; src = 2576 + 32 * nb; dst = 0 + 32 * nb; }
            else if (nb < 145) { nb -= 113; src = 3600 + 32 * nb; dst = 1024 + 32 * nb; }
            else { nb -= 145; src = 4624 + 32 * nb; dst = 2048 + 32 * nb; }
            tr_item(Win, IN_WIDTH, src, 64 * kb, WA, DM, dst, nv, scr, F.lane); continue; }
        r -= I_IN; { const int kb = r / (DM / 32), nb = r % (DM / 32); tr_item(Wout, DM, 32 * nb, 64 * kb, WB, KOUT, 32 * nb, 32, scr, F.lane); }
    }
    { GAS v4u* z = (GAS v4u*)(WA + (size_t)5664 * DM); const int n16 = 224 * DM * 2 / 16;
      for (int i = w * 64 + F.lane; i < n16; i += nw * 64) z[i] = (v4u){0u, 0u, 0u, 0u}; }
}
__device__ __forceinline__ void mod_gemv(Frame& F, const float* c, const float* w_ada, const float* b_ada, float* mod) {
    LAS float* cs = (LAS float*)(F.lds + RING_OFF);
    LAS float* red = cs + 2048;
    __syncthreads();
    for (int i = F.tid; i < 2 * DM; i += NWAVES * 64) cs[i] = silu(c[i]);
    __syncthreads();
    for (int u = blockIdx.x; u < NMOD / 64; u += F.G) {
        const int col = 64 * u + F.lane; float a0 = 0.f, a1 = 0.f;
        const float* wp = w_ada + (size_t)(128 * F.wave) * NMOD + col;
#pragma unroll 16
        for (int k = 0; k < 128; ++k) { const float w = __builtin_nontemporal_load(wp + (size_t)k * NMOD); a0 += cs[128 * F.wave + k] * w; a1 += cs[DM + 128 * F.wave + k] * w; }
        red[(F.wave * 2 + 0) * 64 + F.lane] = a0; red[(F.wave * 2 + 1) * 64 + F.lane] = a1;
        __syncthreads();
        if (F.tid < 128) { const int b = F.tid >> 6, l = F.tid & 63; float s = b_ada[64 * u + l];
#pragma unroll
            for (int w = 0; w < 8; ++w) s += red[(w * 2 + b) * 64 + l];
            mod[b * NMOD + 64 * u + l] = s; }
        __syncthreads();
    }
}

struct Row16 { f32x4 v[4]; };
__device__ __forceinline__ Row16 ld_row(const float* p, int lane) { Row16 r; const GAS f32x4* q = (const GAS f32x4*)p + lane;
#pragma unroll
    for (int j = 0; j < 4; ++j) r.v[j] = q[64 * j];
    return r; }
__device__ __forceinline__ Row16 ld_row_bf(const bf16* p, int lane) { Row16 r; const GAS v2u* q = (const GAS v2u*)p + lane;
#pragma unroll
    for (int j = 0; j < 4; ++j) { const v2u w = q[64 * j]; r.v[j] = (f32x4){bflo(w.x), bfhi(w.x), bflo(w.y), bfhi(w.y)}; }
    return r; }
__device__ __forceinline__ float row_ssq_part(const Row16& r) { float s = 0.f;
#pragma unroll
    for (int j = 0; j < 4; ++j) s += (r.v[j].x * r.v[j].x + r.v[j].y * r.v[j].y) + (r.v[j].z * r.v[j].z + r.v[j].w * r.v[j].w);
    return s; }
__device__ __forceinline__ void st_row_bf(bf16* out, const Row16& h, int lane) { GAS unsigned long long* o8 = (GAS unsigned long long*)out + lane;
#pragma unroll
    for (int j = 0; j < 4; ++j) o8[64 * j] = (unsigned long long)pk2(h.v[j].x, h.v[j].y) | ((unsigned long long)pk2(h.v[j].z, h.v[j].w) << 32); }
constexpr int RW = 4;
__device__ __forceinline__ void rows_first(Frame& F, const float* x, const float* pre_g, const float* mod, int sidx, bf16* H) {
#pragma unroll 1
    for (int b = 0; b < BATCH; ++b) { const float* mb = mod + b * NMOD;
        Row16 A = ld_row(pre_g, F.lane); const Row16 SC = ld_row(mb + (sidx + 1) * DM, F.lane), S = ld_row(mb + sidx * DM, F.lane);
#pragma unroll
        for (int j = 0; j < 4; ++j) A.v[j] = A.v[j] * (SC.v[j] + 1.0f);
#pragma unroll 1
        for (int r = F.gw; r < SEQ; r += RW * F.NGW) { Row16 xr[RW]; size_t m[RW]; bool ok[RW];
#pragma unroll
            for (int q = 0; q < RW; ++q) { ok[q] = r + q * F.NGW < SEQ; m[q] = (size_t)b * SEQ + (ok[q] ? r + q * F.NGW : r); xr[q] = ld_row(x + m[q] * DM, F.lane); }
#pragma unroll
            for (int q = 0; q < RW; ++q) { const float rs = rsqrtf(wave_sum(row_ssq_part(xr[q])) * (1.f / DM) + EPS);
#pragma unroll
                for (int j = 0; j < 4; ++j) xr[q].v[j] = xr[q].v[j] * rs * A.v[j] + S.v[j];
                if (ok[q]) st_row_bf(H + m[q] * DM, xr[q], F.lane); } } }
}
template <bool NEXT, bool XIB, bool XOB> __device__ __forceinline__ void rows_res(Frame& F, const void* xin, const bf16* Dm, const float* post_g, const float* mod, int gidx, float gscale, void* xo,
                                                                                  const float* pre_g, int sidx, bf16* H) {
#pragma unroll 1
    for (int b = 0; b < BATCH; ++b) { const float* mb = mod + b * NMOD;
        Row16 PGT = ld_row(post_g, F.lane); { const Row16 GT = ld_row(mb + gidx * DM, F.lane);
#pragma unroll
            for (int j = 0; j < 4; ++j) PGT.v[j] = PGT.v[j] * GT.v[j] * gscale; }
        Row16 A, S;
        if (NEXT) { A = ld_row(pre_g, F.lane); const Row16 SC = ld_row(mb + (sidx + 1) * DM, F.lane); S = ld_row(mb + sidx * DM, F.lane);
#pragma unroll
            for (int j = 0; j < 4; ++j) A.v[j] = A.v[j] * (SC.v[j] + 1.0f); }
#pragma unroll 1
        for (int r = F.gw; r < SEQ; r += RW * F.NGW) { Row16 xr[RW], dr[RW]; size_t m[RW]; bool ok[RW];
#pragma unroll
            for (int q = 0; q < RW; ++q) { ok[q] = r + q * F.NGW < SEQ; m[q] = (size_t)b * SEQ + (ok[q] ? r + q * F.NGW : r);
                xr[q] = XIB ? ld_row_bf((const bf16*)xin + m[q] * DM, F.lane) : ld_row((const float*)xin + m[q] * DM, F.lane); dr[q] = ld_row_bf(Dm + m[q] * DM, F.lane); }
#pragma unroll
            for (int q = 0; q < RW; ++q) { const float qs = rsqrtf(wave_sum(row_ssq_part(dr[q])) * (1.f / DM) + EPS);
#pragma unroll
                for (int j = 0; j < 4; ++j) xr[q].v[j] = xr[q].v[j] + PGT.v[j] * (dr[q].v[j] * qs);
                if (ok[q]) { if (XOB) st_row_bf((bf16*)xo + m[q] * DM, xr[q], F.lane);
                    else { GAS f32x4* o = (GAS f32x4*)((float*)xo + m[q] * DM) + F.lane;
#pragma unroll
                        for (int j = 0; j < 4; ++j) o[64 * j] = xr[q].v[j]; } }
                if (NEXT) { const float rs = rsqrtf(wave_sum(row_ssq_part(xr[q])) * (1.f / DM) + EPS);
#pragma unroll
                    for (int j = 0; j < 4; ++j) xr[q].v[j] = xr[q].v[j] * rs * A.v[j] + S.v[j];
                    if (ok[q]) st_row_bf(H + m[q] * DM, xr[q], F.lane); } } } }
}
__device__ __forceinline__ float bf_elem(const v4u& w, int e) { const unsigned u = (e >> 1) == 0 ? w.x : (e >> 1) == 1 ? w.y : (e >> 1) == 2 ? w.z : w.w; return (e & 1) ? bfhi(u) : bflo(u); }
__device__ __forceinline__ void conv_item(int lane, int bc, int cg, const bf16* XBC, const float* conv_w, const float* conv_b, bf16* XT, bf16* Bm, bf16* BTm, bf16* Cm) {
    const int o = lane >> 2, q = lane & 3, c = bc % NCHUNK; const size_t t0 = (size_t)bc * 128;
    const int ch0 = cg * 32 + q * 8;
    v4u raw[11];
#pragma unroll
    for (int k = 0; k < 11; ++k) { const int row = 8 * o + k - 3; raw[k] = (v4u){0u, 0u, 0u, 0u};
        if (row >= 0 || c > 0) raw[k] = *(const GAS v4u*)(XBC + (size_t)((long)t0 + row) * 1536 + ch0); }
    float wk[4][8], cb[8];
#pragma unroll
    for (int k = 0; k < 4; ++k) { const f32x4 a = *(const GAS f32x4*)(conv_w + k * 1536 + ch0), b = *(const GAS f32x4*)(conv_w + k * 1536 + ch0 + 4);
#pragma unroll
        for (int e = 0; e < 4; ++e) { wk[k][e] = a[e]; wk[k][4 + e] = b[e]; } }
    { const f32x4 a = *(const GAS f32x4*)(conv_b + ch0), b = *(const GAS f32x4*)(conv_b + ch0 + 4);
#pragma unroll
      for (int e = 0; e < 4; ++e) { cb[e] = a[e]; cb[4 + e] = b[e]; } }
    float outv[8][8];
#pragma unroll
    for (int e = 0; e < 8; ++e) { float x[11];
#pragma unroll
        for (int k = 0; k < 11; ++k) x[k] = bf_elem(raw[k], e);
#pragma unroll
        for (int jj = 0; jj < 8; ++jj) outv[jj][e] = silu(cb[e] + wk[0][e] * x[jj] + wk[1][e] * x[jj + 1] + wk[2][e] * x[jj + 2] + wk[3][e] * x[jj + 3]); }
    if (cg < 40) {
        bf16* dst;
        if (cg < 32) dst = XT + (((size_t)bc * 16 + (cg >> 1)) * 64 + (cg & 1) * 32 + q * 8) * 128 + 8 * o;
        else { const int bb = cg - 32; dst = BTm + (((size_t)bc * 2 + (bb >> 2)) * 128 + (bb & 3) * 32 + q * 8) * 128 + 8 * o; }
#pragma unroll
        for (int e = 0; e < 8; ++e) { v4u w; w.x = pk2(outv[0][e], outv[1][e]); w.y = pk2(outv[2][e], outv[3][e]); w.z = pk2(outv[4][e], outv[5][e]); w.w = pk2(outv[6][e], outv[7][e]);
            *(GAS v4u*)(dst + (size_t)e * 128) = w; }
    }
    if (cg >= 32) {
        const int bb = (cg - 32) & 7; bf16* dst = (cg < 40 ? Bm : Cm) + (((size_t)bc * 2 + ((bb & 7) >> 2)) * 128 + 8 * o) * 128 + (bb & 3) * 32 + q * 8;
#pragma unroll
        for (int jj = 0; jj < 8; ++jj) { v4u w; w.x = pk2(outv[jj][0], outv[jj][1]); w.y = pk2(outv[jj][2], outv[jj][3]); w.z = pk2(outv[jj][4], outv[jj][5]); w.w = pk2(outv[jj][6], outv[jj][7]);
            *(GAS v4u*)(dst + (size_t)jj * 128) = w; }
    }
}
__device__ __forceinline__ void dt_item(int lane, int it, const float* dtraw, const float* dt_bias, const float* a_log, float* DTS, float* AC, float* CDEC) {
    const int bc = it >> 4, h = it & 15; const size_t t0 = (size_t)bc * 128;
    const float bias = dt_bias[h], a = -__expf(a_log[h]);
    const float x0 = dtraw[(t0 + 2 * lane) * 16 + h] + bias, x1 = dtraw[(t0 + 2 * lane + 1) * 16 + h] + bias;
    const float d0 = x0 > 20.f ? x0 : log1pf(__expf(x0)), d1 = x1 > 20.f ? x1 : log1pf(__expf(x1));
    float* dp = DTS + (size_t)it * 128 + 2 * lane; dp[0] = d0; dp[1] = d1;
    const float v0 = d0 * a, v1 = d1 * a, s = v0 + v1; float inc = s;
#pragma unroll
    for (int sh = 1; sh < 64; sh <<= 1) { const float t = __shfl_up(inc, sh); if (lane >= sh) inc += t; }
    const float ex = inc - s; float* acp = AC + (size_t)it * 128 + 2 * lane; acp[0] = ex + v0; acp[1] = ex + v0 + v1;
    if (lane == 63) CDEC[it] = __expf(inc);
}
__device__ __forceinline__ bf16x8 scale8(v4u w, const float* s) {
    v4u o; o.x = pk2(bflo(w.x) * s[0], bfhi(w.x) * s[1]); o.y = pk2(bflo(w.y) * s[2], bfhi(w.y) * s[3]); o.z = pk2(bflo(w.z) * s[4], bfhi(w.z) * s[5]); o.w = pk2(bflo(w.w) * s[6], bfhi(w.w) * s[7]);
    return __builtin_bit_cast(bf16x8, o); }
__device__ __forceinline__ void states_item(Frame& F, int it2, const bf16* XT, const bf16* BTm, const float* DTS, const float* AC, bf16* ST) {
    LAS float* wl = (LAS float*)(F.lds + RING_OFF + F.wave * 1024);
    { const int it = it2 >> 1, nh = it2 & 1, bc = it >> 4, h = it & 15, g = h >> 3;
        int lane_ = F.lane; asm volatile("" : "+v"(lane_));
        const int r32 = lane_ & 31, hi = lane_ >> 5;
        const bf16* xt = XT + (size_t)it * 64 * 128 + (size_t)r32 * 128 + 8 * hi; const bf16* bt = BTm + ((size_t)bc * 2 + g) * 128 * 128 + (size_t)(64 * nh + r32) * 128 + 8 * hi;
        { const float acl = AC[(size_t)it * 128 + 127]; const float2 d2 = *(const float2*)(DTS + (size_t)it * 128 + 2 * lane_), a2 = *(const float2*)(AC + (size_t)it * 128 + 2 * lane_);
          wl[2 * lane_] = d2.x * __expf(acl - a2.x); wl[2 * lane_ + 1] = d2.y * __expf(acl - a2.y); }
        f32x16 acc[2][2];
#pragma unroll
        for (int a = 0; a < 2; ++a) { acc[a][0] = f32x16{}; acc[a][1] = f32x16{}; }
#pragma unroll 1
        for (int kh = 0; kh < 2; ++kh) { v4u xa[4][2], ba[4][2];
#pragma unroll
            for (int ks = 0; ks < 4; ++ks)
#pragma unroll
                for (int b2 = 0; b2 < 2; ++b2) { xa[ks][b2] = *(const GAS v4u*)(xt + (size_t)(32 * b2) * 128 + 16 * (4 * kh + ks)); ba[ks][b2] = *(const GAS v4u*)(bt + (size_t)(32 * b2) * 128 + 16 * (4 * kh + ks)); }
#pragma unroll
            for (int ks = 0; ks < 4; ++ks) { float wv[8];
                { const f32x4 w0 = *(const LAS f32x4*)(wl + 16 * (4 * kh + ks) + 8 * hi), w1 = *(const LAS f32x4*)(wl + 16 * (4 * kh + ks) + 8 * hi + 4);
#pragma unroll
                  for (int e = 0; e < 4; ++e) { wv[e] = w0[e]; wv[4 + e] = w1[e]; } }
                bf16x8 xf[2];
#pragma unroll
                for (int pb = 0; pb < 2; ++pb) xf[pb] = scale8(xa[ks][pb], wv);
#pragma unroll
                for (int nb = 0; nb < 2; ++nb) { const bf16x8 bfv = __builtin_bit_cast(bf16x8, ba[ks][nb]);
#pragma unroll
                    for (int pb = 0; pb < 2; ++pb) acc[nb][pb] = MFMA32(bfv, xf[pb], acc[nb][pb]); } } }
        bf16* st = ST + (size_t)it * 64 * 128 + 64 * nh;
#pragma unroll
        for (int nb = 0; nb < 2; ++nb)
#pragma unroll
            for (int pb = 0; pb < 2; ++pb)
#pragma unroll
                for (int g4 = 0; g4 < 4; ++g4) { v2u w; w.x = pk2(acc[nb][pb][4 * g4], acc[nb][pb][4 * g4 + 1]); w.y = pk2(acc[nb][pb][4 * g4 + 2], acc[nb][pb][4 * g4 + 3]);
                    *(GAS v2u*)(st + (size_t)(32 * pb + r32) * 128 + 32 * nb + 8 * g4 + 4 * hi) = w; }
    }
}
__device__ __forceinline__ void ssd_conv_states(Frame& F, const bf16* XBC, const float* dtraw, const float* conv_w, const float* conv_b, const float* dt_bias, const float* a_log,
                                                bf16* XT, bf16* Bm, bf16* BTm, bf16* Cm, float* DTS, float* AC, float* CDEC, bf16* ST) {
    for (int pr = blockIdx.x; pr < NBC * 2; pr += F.G) { const int bc = pr >> 1, hh = pr & 1;
#pragma unroll 1
        for (int k = F.wave; k < 32; k += NWAVES) {
            if (k < 16) conv_item(F.lane, bc, 16 * hh + k, XBC, conv_w, conv_b, XT, Bm, BTm, Cm);
            else if (k < 20) conv_item(F.lane, bc, 32 + 4 * hh + (k - 16), XBC, conv_w, conv_b, XT, Bm, BTm, Cm);
            else if (k < 24) conv_item(F.lane, bc, 40 + 4 * hh + (k - 20), XBC, conv_w, conv_b, XT, Bm, BTm, Cm);
            else dt_item(F.lane, bc * 16 + 8 * hh + (k - 24), dtraw, dt_bias, a_log, DTS, AC, CDEC); }
        asm volatile("s_waitcnt vmcnt(0)" ::: "memory");
        if (F.tid == 0) { __builtin_amdgcn_fence(__ATOMIC_ACQUIRE, "agent"); asm volatile("s_waitcnt vmcnt(0)" ::: "memory"); }
        __syncthreads();
#pragma unroll 1
        for (int k = F.wave; k < 16; k += NWAVES) states_item(F, ((bc * 16 + 8 * hh + (k >> 1)) << 1) | (k & 1), XT, BTm, DTS, AC, ST);
        __syncthreads();
    }
}
__device__ __forceinline__ void ssd_scan(Frame& F, bf16* ST, const float* CDEC) {
    constexpr int PER_B = 16 * 64 * 128 / 2;
    for (int T = blockIdx.x * (NWAVES * 64) + F.tid; T < BATCH * PER_B; T += F.G * NWAVES * 64) { const int b = T / PER_B, e = T % PER_B, h = e / (64 * 128 / 2);
        GAS unsigned* p = (GAS unsigned*)ST + (size_t)b * NCHUNK * PER_B + e; unsigned v[NCHUNK];
#pragma unroll
        for (int c = 0; c < NCHUNK; ++c) v[c] = p[(size_t)c * PER_B];
        float r0 = 0.f, r1 = 0.f;
#pragma unroll
        for (int c = 0; c < NCHUNK; ++c) { const float dec = CDEC[(b * NCHUNK + c) * 16 + h]; p[(size_t)c * PER_B] = pk2(r0, r1); r0 = r0 * dec + bflo(v[c]); r1 = r1 * dec + bfhi(v[c]); }
    }
}
template <int PM  > __device__ __forceinline__ void ssd_out(Frame& F, const bf16* XT, const bf16* Bm, const bf16* Cm, const bf16* ST, const float* DTS, const float* AC, const bf16* Z,
                                        const float* d_skip, const float* norm_g, bf16* YCAT) {
    constexpr int CP = 136;
    LAS bf16* CmS = (LAS bf16*)(F.lds + RING_OFF);
    LAS bf16* BmS = CmS + 128 * CP;
    LAS float* CBs = (LAS float*)(BmS);
    LAS float* acl = (LAS float*)(F.lds + RING_OFF + 34816 + 67584);
    LAS float* dtl = acl + 8 * 128;
    LAS float* red = dtl + 8 * 128;
    LAS float* rsd = red + 8 * 128;
    for (int it = blockIdx.x; it < NBC * 2; it += F.G) {
        int lane_ = F.lane; asm volatile("" : "+v"(lane_));
        const int r32 = lane_ & 31, hi = lane_ >> 5, w = F.wave;
        const int bc = it >> 1, g = it & 1, h = 8 * g + w; const size_t t0 = (size_t)bc * 128;
        __syncthreads();
        { const GAS v4u* cg_ = (const GAS v4u*)(Cm + (size_t)it * 128 * 128); const GAS v4u* bg_ = (const GAS v4u*)(Bm + (size_t)it * 128 * 128);
#pragma unroll
          for (int q = 0; q < 4; ++q) { const int idx = F.tid + 512 * q, row = idx >> 4, c16 = idx & 15;
              const v4u cv = cg_[idx], bv = bg_[idx];
              *(LAS v4u*)(CmS + row * CP + c16 * 8) = cv; *(LAS v4u*)(BmS + row * CP + c16 * 8) = bv; }
          for (int i = F.tid; i < 1024; i += NWAVES * 64) { acl[i] = AC[((size_t)bc * 16 + 8 * g) * 128 + i] * LOG2E; dtl[i] = DTS[((size_t)bc * 16 + 8 * g) * 128 + i]; } }
        __syncthreads();
        { f32x16 cbt[2];
#pragma unroll
          for (int tt = 0; tt < 2; ++tt) { const int ib = (2 * w + tt) >> 2, jb = (2 * w + tt) & 3; cbt[tt] = f32x16{};
            if (jb <= ib) {
#pragma unroll
                for (int ks = 0; ks < 8; ++ks) { const int n0 = 16 * ks + 8 * hi;
                    const bf16x8 a = *(const LAS bf16x8*)(CmS + (32 * ib + r32) * CP + n0), b = *(const LAS bf16x8*)(BmS + (32 * jb + r32) * CP + n0);
                    cbt[tt] = MFMA32(a, b, cbt[tt]); } } }
          __syncthreads();
#pragma unroll
          for (int tt = 0; tt < 2; ++tt) { const int ib = (2 * w + tt) >> 2, jb = (2 * w + tt) & 3;
            if (jb <= ib) {
#pragma unroll
                for (int r = 0; r < 16; ++r) CBs[(32 * ib + crow(r, hi)) * 132 + 32 * jb + r32] = cbt[tt][r]; } } }
        __syncthreads();
        const LAS float* ach = acl + w * 128; const LAS float* dth = dtl + w * 128;
        const float dsk = d_skip[h];
        if (PM == 1) continue;
        const int prm = (r32 & 3) + 4 * ((r32 >> 3) & 1) + 8 * ((r32 >> 2) & 1) + 16 * (r32 >> 4);
        const bf16* xt = XT + ((size_t)bc * 16 + h) * 64 * 128 + (size_t)prm * 128 + 8 * hi; const bf16* hin = ST + ((size_t)bc * 16 + h) * 64 * 128 + (size_t)prm * 128 + 8 * hi;
        v4u hf[8][2], xf[8][2];
#pragma unroll
        for (int ks = 0; ks < 8; ++ks)
#pragma unroll
            for (int pb = 0; pb < 2; ++pb) { hf[ks][pb] = *(const GAS v4u*)(hin + (size_t)(32 * pb) * 128 + 16 * ks); xf[ks][pb] = *(const GAS v4u*)(xt + (size_t)(32 * pb) * 128 + 16 * ks); }
#pragma unroll 1
        for (int ib = 0; ib < 4; ++ib) { const int i = 32 * ib + r32; const float aci = ach[i];
            int hj = 8 * hi; asm volatile("" : "+v"(hj));
            const bf16* zp = Z + (t0 + i) * 1024 + h * 64 + 8 * hi; v4u zq[2][2];
#pragma unroll
            for (int pb = 0; pb < 2; ++pb)
#pragma unroll
                for (int g2 = 0; g2 < 2; ++g2) zq[pb][g2] = *(const GAS v4u*)(zp + 32 * pb + 16 * g2);
            f32x16 acc0 = f32x16{}, acc1 = f32x16{};
            { const float ei = __builtin_amdgcn_exp2f(aci); float es[8];
#pragma unroll
              for (int e = 0; e < 8; ++e) es[e] = ei;
#pragma unroll
              for (int ks = 0; ks < 8; ++ks) { const bf16x8 bfv = scale8(*(const LAS v4u*)(CmS + i * CP + 16 * ks + hj), es);
                acc0 = MFMA32(__builtin_bit_cast(bf16x8, hf[ks][0]), bfv, acc0); acc1 = MFMA32(__builtin_bit_cast(bf16x8, hf[ks][1]), bfv, acc1); } }
#pragma unroll
            for (int ks = 0; ks < 8; ++ks) if (ks < 2 * ib + 2) { const int j0 = 16 * ks + hj; float m[8];
                { const f32x4 c0 = *(const LAS f32x4*)(CBs + i * 132 + j0), c1 = *(const LAS f32x4*)(CBs + i * 132 + j0 + 4);
                  const f32x4 a0 = *(const LAS f32x4*)(ach + j0), a1 = *(const LAS f32x4*)(ach + j0 + 4), d0 = *(const LAS f32x4*)(dth + j0), d1 = *(const LAS f32x4*)(dth + j0 + 4);
#pragma unroll
                  for (int e = 0; e < 4; ++e) { m[e] = c0[e] * __builtin_amdgcn_exp2f(aci - a0[e]) * d0[e]; m[4 + e] = c1[e] * __builtin_amdgcn_exp2f(aci - a1[e]) * d1[e]; }
                  if (ks >= 2 * ib) {
#pragma unroll
                      for (int e = 0; e < 8; ++e) { m[e] = (j0 + e <= i) ? m[e] : 0.f; if (j0 + e == i) m[e] += dsk; } } }
                v4u pw; pw.x = pk2(m[0], m[1]); pw.y = pk2(m[2], m[3]); pw.z = pk2(m[4], m[5]); pw.w = pk2(m[6], m[7]);
                const bf16x8 mf = __builtin_bit_cast(bf16x8, pw);
                acc0 = MFMA32(__builtin_bit_cast(bf16x8, xf[ks][0]), mf, acc0); acc1 = MFMA32(__builtin_bit_cast(bf16x8, xf[ks][1]), mf, acc1); }
            float ss = 0.f;
#pragma unroll
            for (int pb = 0; pb < 2; ++pb)
#pragma unroll
                for (int g2 = 0; g2 < 2; ++g2) { const v4u z = zq[pb][g2]; const float zv[8] = {bflo(z.x), bfhi(z.x), bflo(z.y), bfhi(z.y), bflo(z.z), bfhi(z.z), bflo(z.w), bfhi(z.w)};
#pragma unroll
                    for (int e = 0; e < 8; ++e) { const float y = (pb ? acc1[8 * g2 + e] : acc0[8 * g2 + e]) * silu(zv[e]); ss += y * y; if (pb) acc1[8 * g2 + e] = y; else acc0[8 * g2 + e] = y; } }
            ss += __shfl_xor(ss, 32);
            if (PM == 2) { asm volatile("" :: "v"(ss)); continue; }
            if (hi == 0) red[w * 32 + r32] = ss;
            __syncthreads();
            if (F.tid < 32) { float s = 0.f;
#pragma unroll
                for (int ww = 0; ww < 8; ++ww) s += red[ww * 32 + F.tid];
                rsd[F.tid] = rsqrtf(s * (1.f / 512.f) + EPS); }
            __syncthreads();
            const float rs = rsd[r32]; const float* gp = norm_g + h * 64 + 8 * hi; bf16* yp = YCAT + (t0 + i) * 2048 + h * 64 + 8 * hi;
#pragma unroll
            for (int pb = 0; pb < 2; ++pb)
#pragma unroll
                for (int g2 = 0; g2 < 2; ++g2) { const f32x4 g0 = *(const GAS f32x4*)(gp + 32 * pb + 16 * g2), g1 = *(const GAS f32x4*)(gp + 32 * pb + 16 * g2 + 4); float y[8];
#pragma unroll
                    for (int e = 0; e < 8; ++e) y[e] = (pb ? acc1[8 * g2 + e] : acc0[8 * g2 + e]) * rs;
                    v4u o; o.x = pk2(y[0] * g0[0], y[1] * g0[1]); o.y = pk2(y[2] * g0[2], y[3] * g0[3]); o.z = pk2(y[4] * g1[0], y[5] * g1[1]); o.w = pk2(y[6] * g1[2], y[7] * g1[3]);
                    *(GAS v4u*)(yp + 32 * pb + 16 * g2) = o; }
        }
    }
}
__device__ __forceinline__ void subln_row(const v4u a, const v4u b, const float* gq, GAS v4u* p) {
    float v[16] = {bflo(a.x), bfhi(a.x), bflo(a.y), bfhi(a.y), bflo(a.z), bfhi(a.z), bflo(a.w), bfhi(a.w), bflo(b.x), bfhi(b.x), bflo(b.y), bfhi(b.y), bflo(b.z), bfhi(b.z), bflo(b.w), bfhi(b.w)};
    float s = 0.f;
#pragma unroll
    for (int e = 0; e < 16; ++e) s += v[e] * v[e];
    s += __shfl_xor(s, 1); s += __shfl_xor(s, 2); s += __shfl_xor(s, 4);
    const float rs = rsqrtf(s * (1.f / 128.f) + EPS);
#pragma unroll
    for (int e = 0; e < 16; ++e) v[e] *= rs * gq[e];
    v4u oa, ob; oa.x = pk2(v[0], v[1]); oa.y = pk2(v[2], v[3]); oa.z = pk2(v[4], v[5]); oa.w = pk2(v[6], v[7]); ob.x = pk2(v[8], v[9]); ob.y = pk2(v[10], v[11]); ob.z = pk2(v[12], v[13]); ob.w = pk2(v[14], v[15]);
    p[0] = oa; p[1] = ob; }
__device__ __forceinline__ void attn_subln(Frame& F, bf16* YCAT, const float* subln_g) {
    const int d0 = (F.lane & 7) * 16; float gq[16];
#pragma unroll
    for (int e = 0; e < 16; ++e) gq[e] = subln_g[d0 + e] * (1.0f - LAM_INIT);
#pragma unroll 1
    for (int m = F.gw; m < M; m += 2 * F.NGW) { const bool two = m + F.NGW < M; const int m1 = two ? m + F.NGW : m;
        GAS v4u* p0 = (GAS v4u*)(YCAT + (size_t)m * 2048 + 1024 + F.lane * 16); GAS v4u* p1 = (GAS v4u*)(YCAT + (size_t)m1 * 2048 + 1024 + F.lane * 16);
        const v4u a0 = p0[0], b0 = p0[1], a1 = p1[0], b1 = p1[1];
        subln_row(a0, b0, gq, p0); if (two) subln_row(a1, b1, gq, p1); }
}
#ifndef MK_PER_PHASE
#define MK_PER_PHASE 0
#endif
#ifndef MK_CG_SYNC
#define MK_CG_SYNC 0
#endif
constexpr int N_PHASES = 17;
#ifndef ATTN_FORM
#define ATTN_FORM 2
#endif
#ifndef PROBE_SSD_MODE
#define PROBE_SSD_MODE 0
#endif
#ifndef PROBE_EXTRA_BARS
#define PROBE_EXTRA_BARS 0
#endif
#ifndef PROBE_DUP
#define PROBE_DUP 0
#endif
struct Args { const float* in[30]; float* out; unsigned char* ws; int ph_lo, ph_hi; };
enum InIdx { I_X = 0, I_C, I_WADA, I_BADA, I_F1PRE, I_F1POST, I_F1WG, I_F1WU, I_F1WD, I_MPRE, I_MPOST, I_WIN, I_CONVW, I_CONVB, I_DTB, I_ALOG, I_DSKIP, I_SSDG,
             I_LQ1, I_LK1, I_LQ2, I_LK2, I_SUBLN, I_WOUT, I_F2PRE, I_F2POST, I_F2WG, I_F2WU, I_F2WD, I_RELB };

__global__ void __launch_bounds__(NWAVES * 64, 2) layer_fwd(Args args) {
    extern __shared__ __attribute__((aligned(16))) unsigned char lds[];
    Frame F;
    F.lds = (LAS unsigned char*)lds;
    F.tid = threadIdx.x; F.lane = F.tid & 63; F.wave = __builtin_amdgcn_readfirstlane(F.tid >> 6);
    F.G = gridDim.x; { const int bx = blockIdx.x; F.vcu = (F.G % 8 == 0) ? (bx % 8) * (F.G / 8) + bx / 8 : bx; }
    F.gw = F.vcu * NWAVES + F.wave; F.NGW = F.G * NWAVES;
    unsigned char* ws = args.ws;
#define MOD ((float*)(ws + WS_MOD))
#define DTRAW ((float*)(ws + WS_DTRAW))
#define DTS ((float*)(ws + WS_DTS))
#define ACm ((float*)(ws + WS_AC))
#define CDEC ((float*)(ws + WS_CDEC))
#define WA ((bf16*)(ws + WS_WA))
#define WB ((bf16*)(ws + WS_WB))
#define H ((bf16*)(ws + WS_H))
#define ACT ((bf16*)(ws + WS_ACT))
#define Dm ((bf16*)(ws + WS_D))
#define Qb ((bf16*)(ws + WS_Q))
#define Kb ((bf16*)(ws + WS_K))
#define Vb ((bf16*)(ws + WS_V))
#define YCAT ((bf16*)(ws + WS_YCAT))
#define Zb ((bf16*)(ws + WS_Z))
#define XBC ((bf16*)(ws + WS_XBC))
#define XT ((bf16*)(ws + WS_XT))
#define Bm ((bf16*)(ws + WS_BM))
#define BTm ((bf16*)(ws + WS_BT))
#define Cm ((bf16*)(ws + WS_CM))
#define ST ((bf16*)(ws + WS_ST))
#define D2 ((bf16*)(ws + WS_D2))
#define WC_IN ((bf16*)((unsigned char*)out + 32 * MiB))
#define WC_OUT ((bf16*)((unsigned char*)out + 32 * MiB) + (size_t)NIN * DM)
#define WC_GU2 (WC_OUT + (size_t)DM * KOUT)
#define WC_D2 (WC_GU2 + (size_t)NGU * DM)
#define X1B ((bf16*)out)
#define X2B ((bf16*)(ws + WS_X2))
    float* out = args.out;
#if MK_CG_SYNC
    cg::grid_group grid = cg::this_grid();
#define GRID_BAR() grid.sync()
#else
    for (int u = F.tid; u < (LDS_BYTES - LDSCTL_OFF) / 4; u += NWAVES * 64) ((LAS unsigned*)(F.lds + LDSCTL_OFF))[u] = 0u;
    __syncthreads();
    XcdBarrier bar = xcd_barrier_post((unsigned*)(ws + WS_CTL) + CW_BAR, (volatile LAS unsigned*)(F.lds + MISC_OFF) + 8);
#define GRID_BAR() xcd_barrier(bar)
#endif
    const int lo = args.ph_lo, hi = args.ph_hi;
#ifndef PH_MASK
#define PH_MASK 0x1FFFF
#endif
#define IN(k) (((PH_MASK >> (k)) & 1) && lo <= (k) && (k) < hi)
#define SEAM(k) do { if (IN(k) && IN((k) + 1)) GRID_BAR(); } while (0)
#define PHASE(k, ...) if (IN(k)) { const bool second_ = false; (void)second_; __VA_ARGS__ } if (((PROBE_DUP >> (k)) & 1) && IN(k)) { const bool second_ = true; (void)second_; GRID_BAR(); __VA_ARGS__ }

    PHASE(0,
        { convert_ffn(F, args.in[I_F1WG], args.in[I_F1WU], args.in[I_F1WD], WA, WB); mod_gemv(F, args.in[I_C], args.in[I_WADA], args.in[I_BADA], MOD); }
    )
    SEAM(0);
    PHASE(1,
        rows_first(F, args.in[I_X], args.in[I_F1PRE], MOD, 0, H);
    )
    SEAM(1);
    PHASE(2,
        { pg8::Gemm g{H, WA, M, NGU, DM}; pg8::StaticOrder S; S.init(M, NGU, F.G, (int)blockIdx.x); pg8::EpiSwiglu E{ACT, DFF};
        pg8::gemm_phase<pg8::EpiSwiglu, pg8::StaticOrder, true, true>(F.lds + RING_OFF, g, S, E);
        }
    )
    SEAM(2);
    PHASE(3,
        { pg8::Gemm g{ACT, WB, M, DM, DFF}; pg8::StaticOrder S; S.init(M, DM, F.G, (int)blockIdx.x); pg8::EpiBf16<0> E{Dm, DM, nullptr, 0, 0, 1.f};
        pg8::gemm_phase<pg8::EpiBf16<0>, pg8::StaticOrder, true, true>(F.lds + RING_OFF, g, S, E); }
    )
    SEAM(3);
    PHASE(4,
        { rows_res<true, false, true>(F, args.in[I_X], Dm, args.in[I_F1POST], MOD, 2, 0.5f, X1B, args.in[I_MPRE], 3, H); convert_mix(F, F.gw, F.NGW, args.in[I_WIN], args.in[I_WOUT], WC_IN, WC_OUT); }
    )
    SEAM(4);
    PHASE(5,
        { pg8::Gemm g{H, WC_IN, M, NQKV, DM}; pg8::StaticOrder S; S.init(M, NQKV, F.G, (int)blockIdx.x);
        pg8::EpiQKV E{Qb, DM, (size_t)(WS_K - WS_Q) / 2, attn_body::C2, (unsigned*)(ws + WS_CTL) + CW_KMAX};
        pg8::gemm_phase<pg8::EpiQKV, pg8::StaticOrder, true, true>(F.lds + RING_OFF, g, S, E); }
    )
    SEAM(5);
    PHASE(6,
        float lam;
        { const float q1 = args.in[I_LQ1][F.lane] * args.in[I_LK1][F.lane], q2 = args.in[I_LQ2][F.lane] * args.in[I_LK2][F.lane];
          lam = __expf(wave_sum(q1)) - __expf(wave_sum(q2)) + LAM_INIT; lam = __builtin_bit_cast(float, __builtin_amdgcn_readfirstlane(__builtin_bit_cast(int, lam))); }
#if ATTN_FORM == 2
        const attn2::Tensors AT{(const attn_body::bf16*)Qb, (const attn_body::bf16*)Kb, (const attn_body::bf16*)Vb, (attn_body::bf16*)YCAT, lam, args.in[I_RELB], args.in[I_SUBLN], (const float*)((const unsigned*)(ws + WS_CTL) + CW_KMAX)};
        attn2::phase<8>((char*)lds + RING_OFF, AT, (int)F.G, (int)blockIdx.x);
#else
        const attn_body::AttnTensors AT{(const attn_body::bf16*)Qb, (const attn_body::bf16*)Kb, (const attn_body::bf16*)Vb, (attn_body::bf16*)YCAT, lam, args.in[I_RELB]};
        const attn_body::StaticOrder S((int)F.G, (int)blockIdx.x);
        attn_body::attn_phase<attn_body::StaticOrder>((char*)lds + RING_OFF, AT, S);
#endif
    )
    SEAM(6);
    PHASE(7,
        { pg8::Gemm g{H, WC_IN + (size_t)NQKV * DM, M, NMIX, DM}; pg8::StaticOrder S; S.init(M, NMIX, F.G, (int)blockIdx.x); pg8::EpiMix E{Zb, XBC, DTRAW};
        pg8::gemm_phase<pg8::EpiMix, pg8::StaticOrder, true, true>(F.lds + RING_OFF, g, S, E);
        if (!second_ && F.G == 256 && blockIdx.x >= 192) convert_gu_half(F, ((int)blockIdx.x - 192) * NWAVES + F.wave, 64 * NWAVES, args.in[I_F2WG], 0, WC_GU2); }
    )
    SEAM(7);
    PHASE(8,
        ssd_conv_states(F, XBC, DTRAW, args.in[I_CONVW], args.in[I_CONVB], args.in[I_DTB], args.in[I_ALOG], XT, Bm, BTm, Cm, DTS, ACm, CDEC, ST);
    )
    SEAM(9);
    PHASE(10,
        ssd_scan(F, ST, CDEC);
    )
    SEAM(10);
    PHASE(11,
        { if (!second_) { ssd_out<0>(F, XT, Bm, Cm, ST, DTS, ACm, Zb, args.in[I_DSKIP], args.in[I_SSDG], YCAT); if (ATTN_FORM != 2) attn_subln(F, YCAT, args.in[I_SUBLN]); }
          else ssd_out<PROBE_SSD_MODE>(F, XT, Bm, Cm, ST, DTS, ACm, Zb, args.in[I_DSKIP], args.in[I_SSDG], YCAT); }
    )
    SEAM(11);
    PHASE(12,
        { pg8::Gemm g{YCAT, WC_OUT, M, DM, KOUT}; pg8::StaticOrder S; S.init(M, DM, F.G, (int)blockIdx.x); pg8::EpiBf16<0> E{D2, DM, nullptr, 0, 0, 1.f};
        pg8::gemm_phase<pg8::EpiBf16<0>, pg8::StaticOrder, true, true>(F.lds + RING_OFF, g, S, E); }
    )
    SEAM(12);
    PHASE(13,
        { rows_res<true, true, true>(F, X1B, D2, args.in[I_MPOST], MOD, 5, 1.0f, X2B, args.in[I_F2PRE], 6, H); convert_gu_half(F, F.gw, F.NGW, args.in[I_F2WU], 1, WC_GU2);
          if (F.G != 256) { convert_gu_half(F, F.gw, F.NGW, args.in[I_F2WG], 0, WC_GU2); convert_down(F, F.gw, F.NGW, args.in[I_F2WD], WC_D2); } }
    )
    SEAM(13);
    PHASE(14,
        { pg8::Gemm g{H, WC_GU2, M, NGU, DM}; pg8::StaticOrder S; S.init(M, NGU, F.G, (int)blockIdx.x); pg8::EpiSwiglu E{ACT, DFF};
        pg8::gemm_phase<pg8::EpiSwiglu, pg8::StaticOrder, true, true>(F.lds + RING_OFF, g, S, E);
        if (!second_ && F.G == 256 && blockIdx.x >= 128) convert_down(F, ((int)blockIdx.x - 128) * NWAVES + F.wave, 128 * NWAVES, args.in[I_F2WD], WC_D2); }
    )
    SEAM(14);
    PHASE(15,
        { pg8::Gemm g{ACT, WC_D2, M, DM, DFF}; pg8::StaticOrder S; S.init(M, DM, F.G, (int)blockIdx.x); pg8::EpiBf16<0> E{Dm, DM, nullptr, 0, 0, 1.f};
        pg8::gemm_phase<pg8::EpiBf16<0>, pg8::StaticOrder, true, true>(F.lds + RING_OFF, g, S, E); }
    )
    SEAM(15);
    PHASE(16,
        rows_res<false, true, false>(F, X2B, Dm, args.in[I_F2POST], MOD, 8, 0.5f, out, nullptr, 0, nullptr);
    )
#if PROBE_EXTRA_BARS
    for (int q_ = 0; q_ < PROBE_EXTRA_BARS; ++q_) GRID_BAR();
#endif
#undef IN
#undef SEAM
}

extern "C" void kernel_launch(void* const* d_in, const int* in_sizes, int n_in, void* d_out, int out_size, void* d_ws, size_t ws_size, hipStream_t stream) {
    static int grid = 0;
    if (grid == 0) {
        if (n_in != 30 || in_sizes[0] != M * DM || out_size != M * DM || ws_size < WS_END) { fprintf(stderr, "kernel_launch: unexpected shapes (n_in %d, in0 %d, out %d, ws %zu); nothing launched\n", n_in, n_in > 0 ? in_sizes[0] : -1, out_size, ws_size); grid = -1; return; }
        int dev = 0, cus = 0, per_cu = 0;
        if (hipGetDevice(&dev) != hipSuccess || hipDeviceGetAttribute(&cus, hipDeviceAttributeMultiprocessorCount, dev) != hipSuccess) { grid = -1; return; }
        if (hipFuncSetAttribute((const void*)layer_fwd, hipFuncAttributeMaxDynamicSharedMemorySize, LDS_BYTES) != hipSuccess) { fprintf(stderr, "kernel_launch: hipFuncSetAttribute failed\n"); grid = -1; return; }
        if (hipOccupancyMaxActiveBlocksPerMultiprocessor(&per_cu, (const void*)layer_fwd, NWAVES * 64, LDS_BYTES) != hipSuccess || per_cu < 1) { fprintf(stderr, "kernel_launch: occupancy query says %d blocks per CU\n", per_cu); per_cu = 1; }
        (void)hipGetLastError();
        grid = cus;
        if (grid % 8 != 0 || grid > 256) fprintf(stderr, "kernel_launch: note: %d CUs\n", grid);
    }
    if (grid < 0) return;
    (void)hipMemsetAsync((char*)d_ws + WS_CTL, 0, CTL_ZERO_BYTES, stream);
    Args a{};
    for (int i = 0; i < 30; ++i) a.in[i] = (const float*)d_in[i];
    a.out = (float*)d_out; a.ws = (unsigned char*)d_ws;
#if MK_PER_PHASE
    for (int p = 0; p < N_PHASES; ++p) { a.ph_lo = p; a.ph_hi = p + 1; void* kargs[] = {&a};
        hipError_t e = hipLaunchCooperativeKernel((const void*)layer_fwd, dim3(grid), dim3(NWAVES * 64), kargs, LDS_BYTES, stream);
        if (e != hipSuccess) { fprintf(stderr, "kernel_launch: phase %d launch failed: %s\n", p, hipGetErrorString(e)); break; } }
#else
    a.ph_lo = 0; a.ph_hi = N_PHASES; void* kargs[] = {&a};
    hipError_t e = hipLaunchCooperativeKernel((const void*)layer_fwd, dim3(grid), dim3(NWAVES * 64), kargs, LDS_BYTES, stream);
    if (e != hipSuccess) fprintf(stderr, "kernel_launch: cooperative launch failed: %s (grid %d)\n", hipGetErrorString(e), grid);
#endif
}
```

```cpp
#include <hip/hip_runtime.h>
#include <hip/hip_cooperative_groups.h>
#include <hip/hip_bf16.h>
#include <cstdio>
#include <cstdint>
#include <cmath>
namespace cg = cooperative_groups;
namespace pg8 {
#define PG8_LAS __attribute__((address_space(3)))
typedef unsigned short bf16_t;
typedef short bf16x8 __attribute__((ext_vector_type(8)));
typedef float f32x4 __attribute__((ext_vector_type(4)));
typedef unsigned u32x4 __attribute__((ext_vector_type(4)));
constexpr int BM = 256, BK = 64, HALF = 128, HTB = HALF * BK * 2  , STAGE_BYTES = 8 * HTB, NXCD = 8, WGM = 8;

__host__ __device__ __forceinline__ int lds_byte(int r, int c) { const int st = (r >> 4) * 2 + (c >> 5), rr = r & 15, cc = c & 31, ob = rr * 64 + cc * 2; return st * 1024 + (ob ^ (((ob >> 9) & 1) << 5)); }
__host__ __device__ __forceinline__ void stage_rc(int b, int& R, int& C) { const int st = b / 1024, sb = b % 1024, swz = sb ^ (((sb >> 9) & 1) << 5); R = (st >> 1) * 16 + swz / 64; C = (st & 1) * 32 + (swz % 64) / 2; }
__host__ __device__ __forceinline__ int perm32(int rho) { const int n = rho >> 4, i = rho & 15; return 8 * (i >> 2) + 4 * n + (i & 3); }

struct Unit { int pm, pn; };
struct Gemm { const bf16_t* A; const bf16_t* Bt; int M, N, K; };

struct StaticOrder {
    int nM, nN, nwg, G, c;
    __host__ __device__ void init(int M, int N, int G_, int c_) { nM = M / BM; nN = N / BM; nwg = nM * nN; G = G_; c = c_; }
    __host__ __device__ bool next(int i, Unit& u) const {
        const long L = (long)i * G + c; if (L >= nwg) return false;
        int wgid = (int)L; { const int q = nwg / NXCD, r = nwg % NXCD, xcd = wgid % NXCD, off = wgid / NXCD; wgid = (xcd < r ? xcd * (q + 1) : r * (q + 1) + (xcd - r) * q) + off; }
        const int nig = WGM * nN, gid = wgid / nig, fm = gid * WGM, gsz = (nM - fm) < WGM ? (nM - fm) : WGM;
        u.pm = fm + ((wgid % nig) % gsz); u.pn = (wgid % nig) / gsz; return true;
    }
    __device__ __forceinline__ void a_ready(const Unit&) const {}
    __device__ __forceinline__ void done(const Unit&) const {}
};

__device__ __forceinline__ unsigned cvt_pk_bf16(float lo, float hi) { unsigned r; asm volatile("v_cvt_pk_bf16_f32 %0, %1, %2" : "=v"(r) : "v"(lo), "v"(hi)); return r; }
__device__ __forceinline__ void st16_wt(void* ptr, u32x4 v) { asm volatile("global_store_dwordx4 %0, %1, off sc1\n\ts_nop 1" :: "v"(ptr), "v"(v) : "memory"); }
typedef float f32x2 __attribute__((ext_vector_type(2)));
__device__ __forceinline__ f32x2 gelu_pk(f32x2 v) {
    const f32x2 av = __builtin_elementwise_abs(v), d = av * 0.2316418882f + 1.0f;
    f32x2 t; t.x = __builtin_amdgcn_rcpf(d.x); t.y = __builtin_amdgcn_rcpf(d.y);
    f32x2 q = t * 0.5307027145f + (-0.7265760135f); q = q * t + 0.7107068705f; q = q * t + (-0.142248368f); q = q * t + 0.127414796f; q = q * t;
    const f32x2 s = (v * v) * (-0.72134752044f);
    f32x2 e; e.x = __builtin_amdgcn_exp2f(s.x); e.y = __builtin_amdgcn_exp2f(s.y);
    const f32x2 m = v * (q * e), r = v - m;
    f32x2 o; o.x = v.x < 0.f ? m.x : r.x; o.y = v.y < 0.f ? m.y : r.y; return o;
}

template <int ACT  > struct EpiBf16 {
    static constexpr bool PERM = true, AFTER_DRAIN = false; static_assert(ACT == 0 || ACT == 1, "EpiBf16: ACT is 0 (none) or 1 (gelu_pk)");
    bf16_t* O; int ldc; const float* bias; int split_cols; size_t split_stride; float scale0;
    __device__ __forceinline__ void operator()(const f32x4 (&acc)[2][2][4][2], const Unit& u, int wr, int wc, int fr, int fq) const {
        const int row0 = u.pm * BM + wr * 64 + fr; int colt = u.pn * BM; bf16_t* base = O;
        float sc = 1.f; if (split_cols) { const int t = colt / split_cols; base += (size_t)t * split_stride; colt -= t * split_cols; if (t == 0) sc = scale0; }
        const int col0 = colt + wc * 32 + 8 * fq, bcol0 = u.pn * BM + wc * 32 + 8 * fq;
        f32x4 bv[2][2];
#pragma unroll
        for (int bj = 0; bj < 2; ++bj)
#pragma unroll
            for (int n = 0; n < 2; ++n) bv[bj][n] = bias ? *(const f32x4*)(bias + bcol0 + bj * HALF + 4 * n) : (f32x4){0.f, 0.f, 0.f, 0.f};
#pragma unroll
        for (int ai = 0; ai < 2; ++ai)
#pragma unroll
            for (int m = 0; m < 4; ++m) { bf16_t* rowp = base + (size_t)(row0 + ai * HALF + m * 16) * ldc + col0;
#pragma unroll
                for (int bj = 0; bj < 2; ++bj) { f32x4 v0 = acc[ai][bj][m][0] + bv[bj][0], v1 = acc[ai][bj][m][1] + bv[bj][1];
                    if (ACT == 1) { f32x2 a = gelu_pk((f32x2){v0[0], v0[1]}), b = gelu_pk((f32x2){v0[2], v0[3]}), c = gelu_pk((f32x2){v1[0], v1[1]}), d = gelu_pk((f32x2){v1[2], v1[3]});
                        v0 = (f32x4){a.x, a.y, b.x, b.y}; v1 = (f32x4){c.x, c.y, d.x, d.y}; }
                    v0 = v0 * sc; v1 = v1 * sc; u32x4 w; w.x = cvt_pk_bf16(v0[0], v0[1]); w.y = cvt_pk_bf16(v0[2], v0[3]); w.z = cvt_pk_bf16(v1[0], v1[1]); w.w = cvt_pk_bf16(v1[2], v1[3]);
                    st16_wt(rowp + bj * HALF, w); } }
    }
};

struct PanelStats {
    unsigned* xbuf;
    unsigned* cnt;
    unsigned* tmo;
    int ntn; float eps;
    unsigned code;
    __device__ __forceinline__ bool run(const f32x4 (&v)[2][2][4][2], const Unit& u, int wr, int wc, int fr, int fq, PG8_LAS unsigned char* lds, int wid, int lane) const {
        typedef float f32x2v __attribute__((ext_vector_type(2)));
        PG8_LAS f32x2v* P = (PG8_LAS f32x2v*)lds;
        PG8_LAS f32x2v* S = (PG8_LAS f32x2v*)(lds + 8192);
        PG8_LAS unsigned* flag = (PG8_LAS unsigned*)(lds + 8192 + 2048);
#pragma unroll
        for (int ai = 0; ai < 2; ++ai)
#pragma unroll
            for (int m = 0; m < 4; ++m) {
                float s = 0.f;
#pragma unroll
                for (int bj = 0; bj < 2; ++bj)
#pragma unroll
                    for (int n = 0; n < 2; ++n) { const f32x4 x = v[ai][bj][m][n]; s += (x[0] + x[1]) + (x[2] + x[3]); }
                s += __shfl_xor(s, 16); s += __shfl_xor(s, 32);
                const float mw = s * (1.0f / 64.0f); float q = 0.f;
#pragma unroll
                for (int bj = 0; bj < 2; ++bj)
#pragma unroll
                    for (int n = 0; n < 2; ++n) { const f32x4 d = v[ai][bj][m][n] - mw; q += (d[0] * d[0] + d[1] * d[1]) + (d[2] * d[2] + d[3] * d[3]); }
                q += __shfl_xor(q, 16); q += __shfl_xor(q, 32);
                if (fq == 0) P[(ai * HALF + wr * 64 + m * 16 + fr) * 4 + wc] = (f32x2v){mw, q};
            }
        asm volatile("s_waitcnt lgkmcnt(0)" ::: "memory"); __builtin_amdgcn_s_barrier(); asm volatile("" ::: "memory");
#if defined(BROKEN_EXCHANGE_NO_WAIT)
#warning BROKEN CONTROL BUILD: the row-statistics exchange does not wait; results are wrong by design
        if (blockIdx.x >= 64) { const long long t0_ = clock64(); while (clock64() - t0_ < 60000) __builtin_amdgcn_s_sleep(8); }
#endif
        const int row = wid * 32 + (lane & 31);
        if (lane < 32) {
            const f32x2v a = P[row * 4 + 0], b = P[row * 4 + 1], c = P[row * 4 + 2], d = P[row * 4 + 3];
            const float mt = (a.x + b.x + c.x + d.x) * 0.25f;
            const float da = a.x - mt, db = b.x - mt, dc = c.x - mt, dd = d.x - mt;
            const float m2 = (a.y + b.y) + (c.y + d.y) + 64.0f * ((da * da + db * db) + (dc * dc + dd * dd));
            unsigned long long* slot = (unsigned long long*)xbuf + ((size_t)(u.pm * BM + row) * 4 + u.pn);
            __hip_atomic_store(slot, ((unsigned long long)__float_as_uint(m2) << 32) | __float_as_uint(mt), __ATOMIC_RELAXED, __HIP_MEMORY_SCOPE_AGENT);
        }
        asm volatile("s_waitcnt vmcnt(0)" ::: "memory");
        if (lane == 0) __hip_atomic_fetch_add(cnt + 64 * u.pm, 1u, __ATOMIC_RELAXED, __HIP_MEMORY_SCOPE_AGENT);
        if (wid == 0) {
            bool dead = false; const unsigned long long t0 = __builtin_amdgcn_s_memrealtime(); const unsigned want = 8u * (unsigned)ntn;
            for (;;) {
#if defined(BROKEN_EXCHANGE_NO_WAIT)
                break;
#endif
                if ((unsigned)__builtin_amdgcn_readfirstlane(__hip_atomic_load(cnt + 64 * u.pm, __ATOMIC_RELAXED, __HIP_MEMORY_SCOPE_AGENT)) >= want) break;
                if (__builtin_amdgcn_s_memrealtime() - t0 > 2000000ull) {
                    if (lane == 0) { unsigned expect = 0u; __hip_atomic_compare_exchange_strong(tmo + 1, &expect, code | (unsigned)(u.pm & 0xff), __ATOMIC_RELAXED, __ATOMIC_RELAXED, __HIP_MEMORY_SCOPE_AGENT);
                                     __hip_atomic_store(tmo, 1u, __ATOMIC_RELAXED, __HIP_MEMORY_SCOPE_AGENT); }
                    dead = true; break; }
                __builtin_amdgcn_s_sleep(2);
            }
            __builtin_amdgcn_fence(__ATOMIC_ACQUIRE, "agent");
            if (lane == 0) flag[0] = dead ? 1u : 0u;
        }
        asm volatile("s_waitcnt vmcnt(0) lgkmcnt(0)" ::: "memory"); __builtin_amdgcn_s_barrier(); asm volatile("" ::: "memory");
        const bool bad = flag[0] != 0u;
        if (lane < 32) {
            const unsigned long long* slot = (const unsigned long long*)xbuf + (size_t)(u.pm * BM + row) * 4; float mt[4], m2[4]; float ms = 0.f;
#pragma unroll
            for (int t = 0; t < 4; ++t) { if (t < ntn) { const unsigned long long w = __hip_atomic_load(slot + t, __ATOMIC_RELAXED, __HIP_MEMORY_SCOPE_AGENT); mt[t] = __uint_as_float((unsigned)w); m2[t] = __uint_as_float((unsigned)(w >> 32)); } else { mt[t] = 0.f; m2[t] = 0.f; } ms += mt[t]; }
            const float mean = ms / (float)ntn; float q = 0.f;
#pragma unroll
            for (int t = 0; t < 4; ++t) if (t < ntn) { const float dm = mt[t] - mean; q += m2[t] + 256.0f * dm * dm; }
            S[row] = (f32x2v){mean, 1.0f / sqrtf(q / (256.0f * (float)ntn) + eps)};
        }
        asm volatile("s_waitcnt lgkmcnt(0)" ::: "memory"); __builtin_amdgcn_s_barrier(); asm volatile("" ::: "memory");
        return bad;
    }
};
struct EpiLnRes {
    static constexpr bool PERM = false, AFTER_DRAIN = true;
    const float* base; float* out; int ldc; const float* bias; PanelStats st; unsigned poison;
    __device__ __forceinline__ void fused(f32x4 (&acc)[2][2][4][2], const Unit& u, int wr, int wc, int fr, int fq, PG8_LAS unsigned char* lds, int wid, int lane) const {
        typedef float f32x2v __attribute__((ext_vector_type(2)));
        const PG8_LAS f32x2v* S = (const PG8_LAS f32x2v*)(lds + 8192);
        const int col0 = u.pn * BM + wc * 32 + 4 * fq;
#pragma unroll
        for (int bj = 0; bj < 2; ++bj)
#pragma unroll
            for (int n = 0; n < 2; ++n) { const f32x4 bv = bias ? *(const f32x4*)(bias + col0 + bj * HALF + n * 16) : (f32x4){0.f, 0.f, 0.f, 0.f};
#pragma unroll
                for (int ai = 0; ai < 2; ++ai)
#pragma unroll
                    for (int m = 0; m < 4; ++m) acc[ai][bj][m][n] += bv; }
        f32x4 pre[4][2][2];
#pragma unroll
        for (int m = 0; m < 4; ++m) { const size_t off = (size_t)(u.pm * BM + wr * 64 + m * 16 + fr) * ldc + col0;
#pragma unroll
            for (int bj = 0; bj < 2; ++bj)
#pragma unroll
                for (int n = 0; n < 2; ++n) pre[m][bj][n] = *(const f32x4*)(base + off + bj * HALF + n * 16); }
        const bool bad = st.run(acc, u, wr, wc, fr, fq, lds, wid, lane) || poison != 0u;
        const float qnan = __builtin_nanf("");
#pragma unroll
        for (int ai = 0; ai < 2; ++ai)
#pragma unroll
            for (int m = 0; m < 4; ++m) { const int r = ai * HALF + wr * 64 + m * 16 + fr; const f32x2v sr = S[r]; const size_t off = (size_t)(u.pm * BM + r) * ldc + col0;
#pragma unroll
                for (int bj = 0; bj < 2; ++bj)
#pragma unroll
                    for (int n = 0; n < 2; ++n) { const f32x4 bs = ai == 0 ? pre[m][bj][n] : *(const f32x4*)(base + off + bj * HALF + n * 16); f32x4 o = bs + (acc[ai][bj][m][n] - sr.x) * sr.y;
                        if (bad) o = (f32x4){qnan, qnan, qnan, qnan}; *(f32x4*)(out + off + bj * HALF + n * 16) = o; }
                if (m & 1) asm volatile("" ::: "memory"); }
    }
};
struct EpiLnResLn {
    static constexpr bool PERM = false, AFTER_DRAIN = true;
    const float* base; float* out; bf16_t* xn; int ldc; const float* bias; PanelStats st1, st2; unsigned poison;
    __device__ __forceinline__ void fused(f32x4 (&acc)[2][2][4][2], const Unit& u, int wr, int wc, int fr, int fq, PG8_LAS unsigned char* lds, int wid, int lane) const {
        typedef float f32x2v __attribute__((ext_vector_type(2))); typedef unsigned u32x2v __attribute__((ext_vector_type(2)));
        const PG8_LAS f32x2v* S = (const PG8_LAS f32x2v*)(lds + 8192);
        const int col0 = u.pn * BM + wc * 32 + 4 * fq;
#pragma unroll
        for (int bj = 0; bj < 2; ++bj)
#pragma unroll
            for (int n = 0; n < 2; ++n) { const f32x4 bv = bias ? *(const f32x4*)(bias + col0 + bj * HALF + n * 16) : (f32x4){0.f, 0.f, 0.f, 0.f};
#pragma unroll
                for (int ai = 0; ai < 2; ++ai)
#pragma unroll
                    for (int m = 0; m < 4; ++m) acc[ai][bj][m][n] += bv; }
        bool bad = st1.run(acc, u, wr, wc, fr, fq, lds, wid, lane) || poison != 0u;
        const float qnan = __builtin_nanf("");
#pragma unroll
        for (int ai = 0; ai < 2; ++ai)
#pragma unroll
            for (int m = 0; m < 4; ++m) { const int r = ai * HALF + wr * 64 + m * 16 + fr; const f32x2v sr = S[r]; const size_t off = (size_t)(u.pm * BM + r) * ldc + col0;
#pragma unroll
                for (int bj = 0; bj < 2; ++bj)
#pragma unroll
                    for (int n = 0; n < 2; ++n) { const f32x4 bs = *(const f32x4*)(base + off + bj * HALF + n * 16); acc[ai][bj][m][n] = bs + (acc[ai][bj][m][n] - sr.x) * sr.y; }
                asm volatile("" : "+v"(acc[ai][0][m][0]), "+v"(acc[ai][0][m][1]), "+v"(acc[ai][1][m][0]), "+v"(acc[ai][1][m][1]));
                if (m & 1) asm volatile("" ::: "memory"); }
        const bool bad1 = bad;
        bad = st2.run(acc, u, wr, wc, fr, fq, lds, wid, lane) || bad;
#pragma unroll
        for (int ai = 0; ai < 2; ++ai)
#pragma unroll
            for (int m = 0; m < 4; ++m) { const int r = ai * HALF + wr * 64 + m * 16 + fr; const f32x2v sr = S[r]; const size_t off = (size_t)(u.pm * BM + r) * ldc + col0;
#pragma unroll
                for (int bj = 0; bj < 2; ++bj)
#pragma unroll
                    for (int n = 0; n < 2; ++n) { const f32x4 x1 = acc[ai][bj][m][n]; *(f32x4*)(out + off + bj * HALF + n * 16) = bad1 ? (f32x4){qnan, qnan, qnan, qnan} : x1;
                        const f32x4 o = (x1 - sr.x) * sr.y; u32x2v w; w.x = cvt_pk_bf16(o[0], o[1]); w.y = cvt_pk_bf16(o[2], o[3]);
                        if (bad) { w.x = 0x7fc07fc0u; w.y = 0x7fc07fc0u; } *(u32x2v*)(xn + off + bj * HALF + n * 16) = w; }
                asm volatile("" ::: "memory"); }
    }
};

template <class Epi, class Sched, bool ALIGN_EPI = false, bool SP2 = false>
__device__ __forceinline__ void gemm_phase(PG8_LAS unsigned char* lds, const Gemm g, const Sched& S, const Epi& E) {
    const int tid = threadIdx.x, wid = __builtin_amdgcn_readfirstlane(tid >> 6), lane = tid & 63, wr = wid >> 2, wc = wid & 3, fr = lane & 15, fq = lane >> 4;
    const int K = g.K, nt = K / BK;
    unsigned voffA[2], voffB[2];
#pragma unroll
    for (int i = 0; i < 2; ++i) { int R, C; stage_rc(tid * 16 + i * 8192, R, C); const int Rb = Epi::PERM ? ((R & ~31) + perm32(R & 31)) : R;
        voffA[i] = (unsigned)(R * K + C) * 2u; voffB[i] = (unsigned)(Rb * K + C) * 2u; }
    const size_t kstep = (size_t)(BK * 2);
    const size_t hstep = (size_t)HALF * K * 2;
    const size_t tstep = 2 * hstep;
    const unsigned ldsw = (unsigned)wid * 1024u;
    const int aoff = lds_byte(wr * 64 + fr, fq * 8), boff = lds_byte(wc * 32 + fr, fq * 8);
#define PG8_SA(b, h) (((b) * 2 + (h)) * HTB)
#define PG8_SB(b, h) ((4 + (b) * 2 + (h)) * HTB)
#define PG8_STAGE(bufoff, gbase, voff) do { _Pragma("unroll") for (int _i = 0; _i < 2; ++_i) \
        __builtin_amdgcn_global_load_lds((const unsigned*)((const char*)(gbase) + (voff)[_i]), (PG8_LAS unsigned*)(lds + (bufoff) + ldsw + _i * 8192), 16, 0, 0); } while (0)
#define PG8_LDA(dst, b, h) do { _Pragma("unroll") for (int m = 0; m < 4; ++m) _Pragma("unroll") for (int k = 0; k < 2; ++k) dst[m][k] = *(const PG8_LAS bf16x8*)(lds + PG8_SA(b, h) + aoff + m * 2048 + k * 1024); } while (0)
#define PG8_LDB(dst, b, h) do { _Pragma("unroll") for (int n = 0; n < 2; ++n) _Pragma("unroll") for (int k = 0; k < 2; ++k) dst[n][k] = *(const PG8_LAS bf16x8*)(lds + PG8_SB(b, h) + boff + n * 2048 + k * 1024); } while (0)
#define PG8_MMA(ai, bj, At, Bt) do { __builtin_amdgcn_s_setprio(1); _Pragma("unroll") for (int m = 0; m < 4; ++m) _Pragma("unroll") for (int n = 0; n < 2; ++n) _Pragma("unroll") for (int k = 0; k < 2; ++k) \
        acc[ai][bj][m][n] = __builtin_amdgcn_mfma_f32_16x16x32_bf16(Bt[n][k], At[m][k], acc[ai][bj][m][n], 0, 0, 0); __builtin_amdgcn_s_setprio(0); } while (0)
#define PG8_WAIT_V(n) asm volatile("s_waitcnt vmcnt(" #n ")" ::: "memory")
#define PG8_WAIT_L(n) asm volatile("s_waitcnt lgkmcnt(" #n ")" ::: "memory")
#define PG8_BAR __builtin_amdgcn_s_barrier()
#define PG8_SCHED __builtin_amdgcn_sched_barrier(0)
    Unit cur, nxt; int ui = 0;
    if (!S.next(0, cur)) return;
    f32x4 acc[2][2][4][2];
#pragma unroll
    for (int a = 0; a < 2; ++a)
#pragma unroll
        for (int b = 0; b < 2; ++b)
#pragma unroll
            for (int m = 0; m < 4; ++m)
#pragma unroll
                for (int n = 0; n < 2; ++n) acc[a][b][m][n] = (f32x4){0.f, 0.f, 0.f, 0.f};
    bf16x8 At[4][2], B0[2][2], B1[2][2];
    const char* cA = (const char*)g.A + (size_t)cur.pm * tstep; const char* cB = (const char*)g.Bt + (size_t)cur.pn * tstep;
    S.a_ready(cur);
    if constexpr (SP2) {
        PG8_STAGE(PG8_SB(0, 0), cB, voffB); PG8_STAGE(PG8_SB(0, 1), cB + hstep, voffB); PG8_STAGE(PG8_SA(0, 0), cA, voffA); PG8_STAGE(PG8_SA(0, 1), cA + hstep, voffA);
        if (wr == 1) PG8_BAR;
        PG8_WAIT_V(2); PG8_BAR;
        PG8_STAGE(PG8_SB(1, 0), cB + kstep, voffB); PG8_STAGE(PG8_SA(1, 0), cA + kstep, voffA); PG8_STAGE(PG8_SB(1, 1), cB + hstep + kstep, voffB);
        PG8_WAIT_V(6); PG8_BAR;
    } else {
        PG8_STAGE(PG8_SB(0, 0), cB, voffB); PG8_STAGE(PG8_SA(0, 0), cA, voffA); PG8_STAGE(PG8_SB(0, 1), cB + hstep, voffB); PG8_STAGE(PG8_SA(0, 1), cA + hstep, voffA);
        if (wr == 1) PG8_BAR;
        PG8_WAIT_V(4); PG8_BAR;
        PG8_STAGE(PG8_SB(1, 0), cB + kstep, voffB); PG8_STAGE(PG8_SA(1, 0), cA + kstep, voffA); PG8_STAGE(PG8_SB(1, 1), cB + hstep + kstep, voffB);
        PG8_WAIT_V(6); PG8_BAR;
    }
    for (;;) {
        const bool has_next = S.next(ui + 1, nxt);
        const char* nA = has_next ? (const char*)g.A + (size_t)nxt.pm * tstep : cA; const char* nB = has_next ? (const char*)g.Bt + (size_t)nxt.pn * tstep : cB;
        for (int t = 0; t < nt; t += 2) {
            const bool last = (t == nt - 2);
            const char* a1 = cA + (size_t)(t + 1) * kstep;
            const char* a2 = last ? nA : cA + (size_t)(t + 2) * kstep; const char* b2 = last ? nB : cB + (size_t)(t + 2) * kstep;
            const char* a3 = a2 + kstep; const char* b3 = b2 + kstep;
            if (last && has_next) S.a_ready(nxt);
            if constexpr (SP2) {
            PG8_LDB(B0, 0, 0); PG8_LDB(B1, 0, 1); PG8_SCHED; PG8_LDA(At, 0, 0); PG8_STAGE(PG8_SA(1, 1), a1 + hstep, voffA);
            PG8_WAIT_V(8); PG8_WAIT_L(0); PG8_BAR; PG8_MMA(0, 0, At, B0); PG8_MMA(0, 1, At, B1); PG8_BAR; PG8_SCHED;
            PG8_LDA(At, 0, 1); PG8_STAGE(PG8_SB(0, 0), b2, voffB); PG8_STAGE(PG8_SB(0, 1), b2 + hstep, voffB); PG8_STAGE(PG8_SA(0, 0), a2, voffA);
            PG8_WAIT_V(8); PG8_WAIT_L(0); PG8_BAR; PG8_MMA(1, 0, At, B0); PG8_MMA(1, 1, At, B1); PG8_BAR; PG8_SCHED;
            PG8_LDB(B0, 1, 0); PG8_LDB(B1, 1, 1); PG8_SCHED; PG8_LDA(At, 1, 0); PG8_STAGE(PG8_SA(0, 1), a2 + hstep, voffA);
            PG8_WAIT_V(8); PG8_WAIT_L(0); PG8_BAR; PG8_MMA(0, 0, At, B0); PG8_MMA(0, 1, At, B1); PG8_BAR; PG8_SCHED;
            PG8_LDA(At, 1, 1); PG8_STAGE(PG8_SB(1, 0), b3, voffB); PG8_STAGE(PG8_SB(1, 1), b3 + hstep, voffB); PG8_STAGE(PG8_SA(1, 0), a3, voffA);
            PG8_WAIT_V(8); PG8_WAIT_L(0); PG8_BAR; PG8_MMA(1, 0, At, B0); PG8_MMA(1, 1, At, B1); PG8_BAR; PG8_SCHED;
            } else {
            PG8_LDB(B0, 0, 0); PG8_SCHED; PG8_LDA(At, 0, 0); PG8_STAGE(PG8_SA(1, 1), a1 + hstep, voffA);
            PG8_WAIT_L(8); PG8_BAR; PG8_WAIT_L(0); PG8_MMA(0, 0, At, B0); PG8_BAR; PG8_SCHED;
            PG8_LDB(B1, 0, 1); PG8_STAGE(PG8_SB(0, 0), b2, voffB);
            PG8_BAR; PG8_WAIT_L(0); PG8_MMA(0, 1, At, B1); PG8_BAR;
            PG8_LDA(At, 0, 1); PG8_STAGE(PG8_SA(0, 0), a2, voffA);
            PG8_BAR; PG8_WAIT_L(0); PG8_MMA(1, 0, At, B0); PG8_BAR; PG8_SCHED;
            PG8_STAGE(PG8_SB(0, 1), b2 + hstep, voffB);
            PG8_WAIT_V(6); PG8_BAR; PG8_MMA(1, 1, At, B1); PG8_BAR;
            PG8_LDB(B0, 1, 0); PG8_SCHED; PG8_LDA(At, 1, 0); PG8_STAGE(PG8_SA(0, 1), a2 + hstep, voffA);
            PG8_WAIT_L(8); PG8_BAR; PG8_WAIT_L(0); PG8_MMA(0, 0, At, B0); PG8_BAR; PG8_SCHED;
            PG8_LDB(B1, 1, 1); PG8_STAGE(PG8_SB(1, 0), b3, voffB);
            PG8_BAR; PG8_WAIT_L(0); PG8_MMA(0, 1, At, B1); PG8_BAR;
            PG8_LDA(At, 1, 1); PG8_STAGE(PG8_SA(1, 0), a3, voffA);
            PG8_BAR; PG8_WAIT_L(0); PG8_MMA(1, 0, At, B0); PG8_BAR; PG8_SCHED;
            PG8_STAGE(PG8_SB(1, 1), b3 + hstep, voffB);
            PG8_WAIT_V(6); PG8_BAR; PG8_MMA(1, 1, At, B1); PG8_BAR;
            }
        }
        if constexpr (ALIGN_EPI) { if (wr == 0) PG8_BAR; }
        if constexpr (!Epi::AFTER_DRAIN) { E(acc, cur, wr, wc, fr, fq); S.done(cur); }
        if (!has_next) break;
#pragma unroll
        for (int a = 0; a < 2; ++a)
#pragma unroll
            for (int b = 0; b < 2; ++b)
#pragma unroll
                for (int m = 0; m < 4; ++m)
#pragma unroll
                    for (int n = 0; n < 2; ++n) acc[a][b][m][n] = (f32x4){0.f, 0.f, 0.f, 0.f};
        cur = nxt; cA = nA; cB = nB; ++ui;
        if constexpr (ALIGN_EPI) { if (wr == 1) PG8_BAR; }
    }
    PG8_WAIT_V(0);
    if constexpr (!ALIGN_EPI) { if (wr == 0) PG8_BAR; }
    PG8_BAR;
    if constexpr (Epi::AFTER_DRAIN) { E.fused(acc, cur, wr, wc, fr, fq, lds, wid, lane); S.done(cur); }
#undef PG8_SA
#undef PG8_SB
#undef PG8_STAGE
#undef PG8_LDA
#undef PG8_LDB
#undef PG8_MMA
#undef PG8_WAIT_V
#undef PG8_WAIT_L
#undef PG8_BAR
#undef PG8_SCHED
}
}
namespace pg8 {
__device__ __forceinline__ float silu_f(float v) { return v * __builtin_amdgcn_rcpf(1.0f + __expf(-v)); }
struct EpiF32 {
    static constexpr bool PERM = false, AFTER_DRAIN = false;
    float* C; int ldc;
    __device__ __forceinline__ void operator()(const f32x4 (&acc)[2][2][4][2], const Unit& u, int wr, int wc, int fr, int fq) const {
        const int row0 = u.pm * BM + wr * 64 + fr, col0 = u.pn * BM + wc * 32 + 4 * fq;
#pragma unroll
        for (int ai = 0; ai < 2; ++ai)
#pragma unroll
            for (int m = 0; m < 4; ++m) { float* rowp = C + (size_t)(row0 + ai * HALF + m * 16) * ldc + col0;
#pragma unroll
                for (int bj = 0; bj < 2; ++bj)
#pragma unroll
                    for (int n = 0; n < 2; ++n) *(f32x4*)(rowp + bj * HALF + n * 16) = acc[ai][bj][m][n]; }
    }
};
struct EpiSwiglu {
    static constexpr bool PERM = true, AFTER_DRAIN = false;
    bf16_t* O; int ldc;
    __device__ __forceinline__ void operator()(const f32x4 (&acc)[2][2][4][2], const Unit& u, int wr, int wc, int fr, int fq) const {
        const int row0 = u.pm * BM + wr * 64 + fr, col0 = u.pn * HALF + wc * 32 + 8 * fq;
#pragma unroll
        for (int ai = 0; ai < 2; ++ai)
#pragma unroll
            for (int m = 0; m < 4; ++m) { bf16_t* rowp = O + (size_t)(row0 + ai * HALF + m * 16) * ldc + col0;
                const f32x4 g0 = acc[ai][0][m][0], g1 = acc[ai][0][m][1], u0 = acc[ai][1][m][0], u1 = acc[ai][1][m][1];
                u32x4 w;
                w.x = cvt_pk_bf16(silu_f(g0[0]) * u0[0], silu_f(g0[1]) * u0[1]); w.y = cvt_pk_bf16(silu_f(g0[2]) * u0[2], silu_f(g0[3]) * u0[3]);
                w.z = cvt_pk_bf16(silu_f(g1[0]) * u1[0], silu_f(g1[1]) * u1[1]); w.w = cvt_pk_bf16(silu_f(g1[2]) * u1[2], silu_f(g1[3]) * u1[3]);
                st16_wt(rowp, w); }
    }
};
struct EpiMix {
    static constexpr bool PERM = true, AFTER_DRAIN = false;
    bf16_t* Z; bf16_t* XBC; float* DT;
    __device__ __forceinline__ void operator()(const f32x4 (&acc)[2][2][4][2], const Unit& u, int wr, int wc, int fr, int fq) const {
        const int row0 = u.pm * BM + wr * 64 + fr;
        if (u.pn < 10) {
            bf16_t* base; int ldc, colt;
            if (u.pn < 4) { base = Z; ldc = 1024; colt = u.pn * BM; } else { base = XBC; ldc = 1536; colt = (u.pn - 4) * BM; }
            const int col0 = colt + wc * 32 + 8 * fq;
#pragma unroll
            for (int ai = 0; ai < 2; ++ai)
#pragma unroll
                for (int m = 0; m < 4; ++m) { bf16_t* rowp = base + (size_t)(row0 + ai * HALF + m * 16) * ldc + col0;
#pragma unroll
                    for (int bj = 0; bj < 2; ++bj) { const f32x4 v0 = acc[ai][bj][m][0], v1 = acc[ai][bj][m][1];
                        u32x4 w; w.x = cvt_pk_bf16(v0[0], v0[1]); w.y = cvt_pk_bf16(v0[2], v0[3]); w.z = cvt_pk_bf16(v1[0], v1[1]); w.w = cvt_pk_bf16(v1[2], v1[3]);
                        st16_wt(rowp + bj * HALF, w); } }
        } else if (wc == 0 && fq < 2) {
#pragma unroll
            for (int ai = 0; ai < 2; ++ai)
#pragma unroll
                for (int m = 0; m < 4; ++m) { float* rowp = DT + (size_t)(row0 + ai * HALF + m * 16) * 16 + 8 * fq;
                    *(f32x4*)rowp = acc[ai][0][m][0]; *(f32x4*)(rowp + 4) = acc[ai][0][m][1]; }
        }
    }
};
struct EpiQKV {
    static constexpr bool PERM = true, AFTER_DRAIN = false;
    bf16_t* O; int ldc; size_t split_stride; float scale0; unsigned* kmax;
    __device__ __forceinline__ void operator()(const f32x4 (&acc)[2][2][4][2], const Unit& u, int wr, int wc, int fr, int fq) const {
        const int row0 = u.pm * BM + wr * 64 + fr; int colt = u.pn * BM; const int t = colt / 1024; bf16_t* base = O + (size_t)t * split_stride; colt -= t * 1024;
        const float sc = (t == 0) ? scale0 : 1.f; const int col0 = colt + wc * 32 + 8 * fq;
        float km[2] = {0.f, 0.f};
#pragma unroll
        for (int ai = 0; ai < 2; ++ai)
#pragma unroll
            for (int m = 0; m < 4; ++m) { bf16_t* rowp = base + (size_t)(row0 + ai * HALF + m * 16) * ldc + col0;
#pragma unroll
                for (int bj = 0; bj < 2; ++bj) { const f32x4 v0 = acc[ai][bj][m][0] * sc, v1 = acc[ai][bj][m][1] * sc;
                    u32x4 w; w.x = cvt_pk_bf16(v0[0], v0[1]); w.y = cvt_pk_bf16(v0[2], v0[3]); w.z = cvt_pk_bf16(v1[0], v1[1]); w.w = cvt_pk_bf16(v1[2], v1[3]);
                    st16_wt(rowp + bj * HALF, w);
                    if (t == 1) { float s = 0.f;
#pragma unroll
                        for (int e = 0; e < 4; ++e) { const float lo = __builtin_bit_cast(float, w[e] << 16), hi = __builtin_bit_cast(float, w[e] & 0xffff0000u); s += lo * lo + hi * hi; }
                        s += __shfl_xor(s, 16); s += __shfl_xor(s, 32); km[bj] = __builtin_fmaxf(km[bj], s); } } }
        if (t == 1) {
#pragma unroll
            for (int bj = 0; bj < 2; ++bj) { float v = km[bj];
                v = __builtin_fmaxf(v, __shfl_xor(v, 1)); v = __builtin_fmaxf(v, __shfl_xor(v, 2)); v = __builtin_fmaxf(v, __shfl_xor(v, 4)); v = __builtin_fmaxf(v, __shfl_xor(v, 8));
                if ((fr | fq) == 0) { const int b = u.pm >> 5, head = (colt >> 7) + bj; atomicMax(kmax + (((b * 8 + head) * 2 + (wc >> 1)) * 2 + (wc & 1)), __builtin_bit_cast(unsigned, v)); } } }
    }
};
}
#include <hip/hip_bf16.h>
#include <cmath>
namespace attn_body {
using bf16=__hip_bfloat16;
using bf16x8=__attribute__((ext_vector_type(8)))short;
using s16x4=__attribute__((ext_vector_type(4)))short;
using f32x16=__attribute__((ext_vector_type(16)))float;
using u32x4=__attribute__((ext_vector_type(4)))unsigned;
constexpr int BATCH=2,NHEAD=16,SEQ=8192,D=64,DM=NHEAD*D;
constexpr int NW=8,QBLK=32,QB=QBLK*NW,KVBLK=64,NQB=SEQ/QB;
constexpr int ATTN_PITCH=DM, ATTN_UNIT_ROWS=QB, OPITCH=2048, OCOL0=1024;
__device__ __forceinline__ int crow(int r,int hi){return (r&3)+8*(r>>2)+4*hi;}
#define SBAR() __builtin_amdgcn_sched_barrier(0)
__device__ __forceinline__ void cmask(f32x16&p0,f32x16&p1,int jb,int qrel,int hi){
  const float NEG=-INFINITY; int kb=64*jb+4*hi;
  #pragma unroll
  for(int r=0;r<16;++r){int kv=kb+(r&3)+8*(r>>2); if(kv>qrel)p0[r]=NEG; if(kv+32>qrel)p1[r]=NEG;}
}

constexpr int BT_N=704;
__device__ __forceinline__ void bmask(f32x16&p0,f32x16&p1,int jb,int qrel,int hi,const float*bt){
  const float NEG=-INFINITY; const int brel=qrel-64*jb-4*hi; const float*bp=bt+(brel+256);
  #pragma unroll
  for(int r=0;r<16;++r){const int c0=(r&3)+8*(r>>2);
    const float b0=bp[-c0], b1=bp[-c0-32];
    p0[r]=(brel<c0)?NEG:p0[r]+b0; p1[r]=(brel<c0+32)?NEG:p1[r]+b1;
    if((r&3)==3)SBAR();}
}
constexpr int NSLOT=3, SLOTB=8192;
constexpr int LDS_K=0, LDS_V=NSLOT*SLOTB, LDS_WS=2*NSLOT*SLOTB, LDS_OST=LDS_WS+NW*64*4, LDS_BYTES=LDS_OST+NW*4096, LDS_OSTA=86016, LDS_BTAB=LDS_OSTA+NW*4096, LDS_TOTAL=LDS_BTAB+704*4;
constexpr float C2=0.125f*1.4426950408889634f;
__device__ __forceinline__ void glds16(const void*gsrc,unsigned lds_dst){unsigned keep;
  asm volatile("s_mov_b32 %0, m0\n\ts_mov_b32 m0, %2\n\ts_nop 0\n\tglobal_load_lds_dwordx4 %1, off\n\ts_mov_b32 m0, %0":"=&s"(keep):"v"(gsrc),"s"(lds_dst):"memory");}
__device__ __forceinline__ float max3f(float a,float b,float c){float r;asm("v_max3_f32 %0, %1, %2, %3":"=v"(r):"v"(a),"v"(b),"v"(c));return r;}
__device__ __forceinline__ float max2f(float a,float b){float r;asm("v_max_f32_e32 %0, %1, %2":"=v"(r):"v"(a),"v"(b));return r;}
__device__ __forceinline__ float fadd_s(float a,float b){float r;asm("v_add_f32_e32 %0, %1, %2":"=v"(r):"v"(a),"v"(b));return r;}
__device__ __forceinline__ float fsub_s(float a,float b){float r;asm("v_sub_f32_e32 %0, %1, %2":"=v"(r):"v"(a),"v"(b));return r;}
typedef float f32x2_t __attribute__((ext_vector_type(2))); typedef __bf16 bf16x2_t __attribute__((ext_vector_type(2)));
__device__ __forceinline__ unsigned cvtpk_s(float lo,float hi){f32x2_t v={lo,hi};bf16x2_t b=__builtin_convertvector(v,bf16x2_t);return __builtin_bit_cast(unsigned,b);}
#define WAIT_BAR(N) asm volatile("s_waitcnt vmcnt(" #N ") lgkmcnt(0)\n\ts_barrier":::"memory")

__device__ __forceinline__ void qkt(f32x16&p0,f32x16&p1,const char*Kslot,const bf16x8*qr,const f32x16&negm,int r32,int hi){
  const char*kb=Kslot+hi*1024+r32*16;
  #pragma unroll
  for(int d0=0;d0<4;++d0){
    const bf16x8 b0=*reinterpret_cast<const bf16x8*>(kb+d0*2048);
    const bf16x8 b1=*reinterpret_cast<const bf16x8*>(kb+d0*2048+512);
    if(d0==0){p0=__builtin_amdgcn_mfma_f32_32x32x16_bf16(b0,qr[0],negm,0,0,0);p1=__builtin_amdgcn_mfma_f32_32x32x16_bf16(b1,qr[0],negm,0,0,0);}
    else{p0=__builtin_amdgcn_mfma_f32_32x32x16_bf16(b0,qr[d0],p0,0,0,0);p1=__builtin_amdgcn_mfma_f32_32x32x16_bf16(b1,qr[d0],p1,0,0,0);}}
}
typedef __attribute__((address_space(3))) const char* lds_cptr;
typedef short v4i16_t __attribute__((ext_vector_type(4)));
__device__ __forceinline__ void kload8(bf16x8*kf,lds_cptr kp){
  kf[0]=*(const __attribute__((address_space(3))) bf16x8*)(kp);      kf[1]=*(const __attribute__((address_space(3))) bf16x8*)(kp+512);
  kf[2]=*(const __attribute__((address_space(3))) bf16x8*)(kp+2048); kf[3]=*(const __attribute__((address_space(3))) bf16x8*)(kp+2560);
  kf[4]=*(const __attribute__((address_space(3))) bf16x8*)(kp+4096); kf[5]=*(const __attribute__((address_space(3))) bf16x8*)(kp+4608);
  kf[6]=*(const __attribute__((address_space(3))) bf16x8*)(kp+6144); kf[7]=*(const __attribute__((address_space(3))) bf16x8*)(kp+6656);
}
__device__ __forceinline__ void kload2(bf16x8*kf,lds_cptr kp,int j){ kf[2*j]=*(const __attribute__((address_space(3))) bf16x8*)(kp+j*2048); kf[2*j+1]=*(const __attribute__((address_space(3))) bf16x8*)(kp+j*2048+512); }
__device__ __forceinline__ s16x4 vtr(lds_cptr p){ return __builtin_bit_cast(s16x4,__builtin_amdgcn_ds_read_tr16_b64_v4i16((__attribute__((address_space(3))) v4i16_t*)p)); }
__device__ __forceinline__ float rowmax(const f32x16&p0,const f32x16&p1){
  float a=max3f(p0[0],p0[1],p1[0]),b=max3f(p0[2],p0[3],p1[1]);a=max3f(a,p1[2],p1[3]);
  #pragma unroll
  for(int r=4;r<16;r+=4){a=max3f(a,p0[r],p0[r+1]);b=max3f(b,p0[r+2],p0[r+3]);a=max3f(a,p1[r],p1[r+1]);b=max3f(b,p1[r+2],p1[r+3]);}
  const float m=max2f(a,b);
  auto rr=__builtin_amdgcn_permlane32_swap(__float_as_uint(m),__float_as_uint(m),false,false);
  return max2f(__uint_as_float(rr[0]),__uint_as_float(rr[1]));
}
__device__ __forceinline__ void pv(f32x16*o,int vb,bf16x8 pa0,bf16x8 pa1,bf16x8 pa2,bf16x8 pa3){
  #pragma unroll
  for(int d0=0;d0<2;++d0){s16x4 lo[4],hi[4];
    #pragma unroll
    for(int ks=0;ks<4;++ks){
      asm volatile("ds_read_b64_tr_b16 %0,%1 offset:%c2":"=&v"(lo[ks]):"v"(vb),"i"(d0*4096+ks*1024):"memory");
      asm volatile("ds_read_b64_tr_b16 %0,%1 offset:%c2":"=&v"(hi[ks]):"v"(vb),"i"(d0*4096+ks*1024+512):"memory");}
    asm volatile("s_waitcnt lgkmcnt(0)":::"memory");SBAR();
    #define PK(k) (bf16x8){lo[k][0],lo[k][1],lo[k][2],lo[k][3],hi[k][0],hi[k][1],hi[k][2],hi[k][3]}
    o[d0]=__builtin_amdgcn_mfma_f32_32x32x16_bf16(pa0,PK(0),o[d0],0,0,0);
    o[d0]=__builtin_amdgcn_mfma_f32_32x32x16_bf16(pa1,PK(1),o[d0],0,0,0);
    o[d0]=__builtin_amdgcn_mfma_f32_32x32x16_bf16(pa2,PK(2),o[d0],0,0,0);
    o[d0]=__builtin_amdgcn_mfma_f32_32x32x16_bf16(pa3,PK(3),o[d0],0,0,0);
    #undef PK
  }
}

#ifndef ATTN_STORE16
#define ATTN_STORE16(p,v) (*(u32x4*)(p)=(v))
#endif
template<int THRL> __device__ __forceinline__ void attn_unit(int b,int hq,int hv,int qb,int pass,float lam,const float*btab,const bf16*Q,const bf16*__restrict__ K,const bf16*__restrict__ V,bf16*O,char*shm){
  const int tid=threadIdx.x,lane=tid&63,r32=lane&31,hi=lane>>5; const int wid=__builtin_amdgcn_readfirstlane(tid>>6);
  const long rowbase=(long)b*SEQ; const int q0=qb*QB;
  const bf16*Qw=Q+(rowbase+q0+wid*QBLK)*DM+hq*D;
  const bf16*Kh=K+rowbase*DM+hq*D,*Vh=V+rowbase*DM+hv*D;
  const unsigned lds0=(unsigned)(uintptr_t)shm;
  float*wsf=(float*)(shm+LDS_WS)+wid*64;
  const bf16*ksrc=Kh+(long)lane*DM+wid*8;
  const bf16*vsrc=Vh+(long)(16*(wid&3)+(lane>>2))*DM+(wid>>2)*32+(lane&3)*8;
  const unsigned kdst=lds0+LDS_K+wid*1024, vdst=lds0+LDS_V+wid*1024;
  #define DMA_K(t,slot) glds16(ksrc+(long)(t)*KVBLK*DM,(unsigned)__builtin_amdgcn_readfirstlane(kdst+(slot)))
  #define DMA_V(t,slot) glds16(vsrc+(long)(t)*KVBLK*DM,(unsigned)__builtin_amdgcn_readfirstlane(vdst+(slot)))
  const int vb0=(int)(lds0+LDS_V)+((lane>>4)&1)*32+(lane&3)*8+(4*hi+((lane&15)>>2))*64;
  const char*Kbase=shm+LDS_K; bf16x8 kf[8];
  const lds_cptr shm3=(lds_cptr)shm; const lds_cptr kp0=shm3+LDS_K+hi*1024+r32*16; const lds_cptr vp0=shm3+LDS_V+((lane>>4)&1)*32+(lane&3)*8+(4*hi+((lane&15)>>2))*64;
  const int NT=(q0+QB)/KVBLK;
  DMA_K(0,0);DMA_V(0,0);DMA_K(1,SLOTB);
  bf16x8 qr[4];
  #pragma unroll
  for(int d0=0;d0<4;++d0)qr[d0]=*reinterpret_cast<const bf16x8*>(&Qw[(long)r32*DM+d0*16+hi*8]);
  float mhat=0.f,l_reg=0.f;f32x16 o[2];o[0]=f32x16{};o[1]=f32x16{};f32x16 negm=f32x16{};asm volatile("":"+v"(negm));
  const int qrel=wid*QBLK+r32;
  #define CMASK(P0,P1,t) do{int jb_=(t)-(NT-4); if(jb_>=-2)bmask(P0,P1,jb_,qrel,hi,btab);}while(0)
  bool resc=false;
  #define START(P0,P1) do{ const float rm=rowmax(P0,P1); resc=false; \
    { const float dl=rm; mhat=fadd_s(mhat,dl); \
      _Pragma("unroll") for(int r=0;r<16;++r){P0[r]=fsub_s(P0[r],dl);P1[r]=fsub_s(P1[r],dl);} \
      _Pragma("unroll") for(int r=0;r<16;++r)negm[r]=-mhat; asm volatile("":"+v"(negm)); } \
    _Pragma("unroll") for(int r=0;r<16;++r)P0[r]=__builtin_amdgcn_exp2f(P0[r]); }while(0)
  #define RESC() do{ if(resc){ asm volatile("s_waitcnt lgkmcnt(0)":::"memory"); \
      _Pragma("unroll") for(int d_=0;d_<2;++d_) _Pragma("unroll") for(int r=0;r<16;++r)o[d_][r]*=wsf[crow(r,hi)]; } }while(0)
  f32x16 pA0,pA1,pB0,pB1;
  int sl_prev=0,sl_cur=0,sl_next=SLOTB;
  #define ROT() do{sl_prev=sl_cur;sl_cur=sl_next;sl_next=(sl_next==(NSLOT-1)*SLOTB)?0:sl_next+SLOTB;}while(0)
  DMA_K(2,2*SLOTB);
  WAIT_BAR(3);
  qkt(pA0,pA1,Kbase,qr,negm,r32,hi);asm volatile("s_nop 15\n\ts_nop 7":"+v"(pA0),"+v"(pA1));CMASK(pA0,pA1,0);
  START(pA0,pA1);
  _Pragma("unroll") for(int r=0;r<16;++r)pA1[r]=__builtin_amdgcn_exp2f(pA1[r]);
  WAIT_BAR(0);
  DMA_K(3,0);DMA_V(1,SLOTB);
  ROT();
  kload8(kf,kp0+sl_cur);
  WAIT_BAR(2);
  s16x4 vlo[8],vhi[8]; u32x4 pw0,pw1,pw2,pw3;
  #define PKW(P,B) cvtpk_s(P[B],P[B+1])
  #define PAF(k) __builtin_bit_cast(bf16x8,pw##k)
  #define VFR(i) (bf16x8){vlo[i][0],vlo[i][1],vlo[i][2],vlo[i][3],vhi[i][0],vhi[i][1],vhi[i][2],vhi[i][3]}
  #define PIN(x) asm volatile("":"+v"(x))
  #define MX3(a,b,c) __builtin_fmaxf(__builtin_fmaxf((a),(b)),(c))
  #define GAPA(MF,A0,A1,A2,A3,W0,W1,PW) do{ MF; sacc+=A0; sacc+=A1; sacc+=A2; sacc+=A3; PIN(sacc); W0; W1; PIN(PW); SBAR(); }while(0)
  #define EX(v) __builtin_amdgcn_exp2f(v)
  #define GAPB(MF,X,B) do{ MF; X[B]=EX(X[B]); X[B+1]=EX(X[B+1]); X[B+2]=EX(X[B+2]); X[B+3]=EX(X[B+3]); PIN(X); SBAR(); }while(0)
  #define VRD(i) do{ vlo[i]=vtr(vp_+(((i)>>2)*4096+((i)&3)*1024)); vhi[i]=vtr(vp_+(((i)>>2)*4096+((i)&3)*1024+512)); }while(0)
  #define KRD(G,j) do{ if(G){ kload2(kf,kp0+sl_next,j); SBAR(); } }while(0)
  #define STEP(C0,C1,P0,P1,t,GK,GV,GL) do{ SBAR(); \
    const lds_cptr vp_=vp0+sl_prev; \
    VRD(0); SBAR(); float sacc=(P0[0]+P0[1]); \
    GAPA(C0=__builtin_amdgcn_mfma_f32_32x32x16_bf16(kf[0],qr[0],negm,0,0,0), P0[2],P0[3],P0[4],P0[5],     pw0[0]=PKW(P0,0), pw0[1]=PKW(P0,2), pw0); \
    VRD(4); SBAR(); GAPA(C1=__builtin_amdgcn_mfma_f32_32x32x16_bf16(kf[1],qr[0],negm,0,0,0), P0[6],P0[7],P0[8],P0[9],     pw0[2]=PKW(P0,4), pw0[3]=PKW(P0,6), pw0); \
    VRD(1); SBAR(); GAPA(C0=__builtin_amdgcn_mfma_f32_32x32x16_bf16(kf[2],qr[1],C0,0,0,0),   P0[10],P0[11],P0[12],P0[13], pw1[0]=PKW(P0,8), pw1[1]=PKW(P0,10), pw1); \
    VRD(5); SBAR(); GAPA(C1=__builtin_amdgcn_mfma_f32_32x32x16_bf16(kf[3],qr[1],C1,0,0,0),   P0[14],P0[15],P1[0],P1[1],   pw1[2]=PKW(P0,12),pw1[3]=PKW(P0,14), pw1); \
    VRD(2); SBAR(); GAPA(C0=__builtin_amdgcn_mfma_f32_32x32x16_bf16(kf[4],qr[2],C0,0,0,0),   P1[2],P1[3],P1[4],P1[5],     pw2[0]=PKW(P1,0), pw2[1]=PKW(P1,2), pw2); \
    VRD(6); SBAR(); GAPA(C1=__builtin_amdgcn_mfma_f32_32x32x16_bf16(kf[5],qr[2],C1,0,0,0),   P1[6],P1[7],P1[8],P1[9],     pw2[2]=PKW(P1,4), pw2[3]=PKW(P1,6), pw2); \
    VRD(3); SBAR(); GAPA(C0=__builtin_amdgcn_mfma_f32_32x32x16_bf16(kf[6],qr[3],C0,0,0,0),   P1[10],P1[11],P1[12],P1[13], pw3[0]=PKW(P1,8), pw3[1]=PKW(P1,10), pw3); \
    VRD(7); SBAR(); GAPA(C1=__builtin_amdgcn_mfma_f32_32x32x16_bf16(kf[7],qr[3],C1,0,0,0),   P1[14],P1[15],0.f,0.f,       pw3[2]=PKW(P1,12),pw3[3]=PKW(P1,14), pw3); \
    l_reg+=sacc; \
    if(GK){DMA_K((t)+3,sl_cur);} if(GV){DMA_V((t)+1,sl_next);} \
    CMASK(C0,C1,t); \
    { float a=MX3(C0[0],C0[1],C1[0]),b=MX3(C0[2],C0[3],C1[1]); a=MX3(a,C1[2],C1[3]); \
      _Pragma("unroll") for(int r=4;r<16;r+=4){a=MX3(a,C0[r],C0[r+1]);b=MX3(b,C0[r+2],C0[r+3]);a=MX3(a,C1[r],C1[r+1]);b=MX3(b,C1[r+2],C1[r+3]);} \
      float rm=__builtin_fmaxf(a,b); { auto rr=__builtin_amdgcn_permlane32_swap(__float_as_uint(rm),__float_as_uint(rm),false,false); rm=__builtin_fmaxf(__uint_as_float(rr[0]),__uint_as_float(rr[1])); } \
      resc=false; \
      if(__builtin_expect(__any(rm>(float)THRL),0)){ const float dl=__builtin_fmaxf(rm,0.f); mhat+=dl; \
        _Pragma("unroll") for(int r=0;r<16;++r){C0[r]-=dl;C1[r]-=dl;} \
        _Pragma("unroll") for(int r=0;r<16;++r)negm[r]=-mhat; asm volatile("":"+v"(negm)); \
        const float f=__builtin_amdgcn_exp2f(-dl); l_reg*=f; if(hi==0)wsf[r32]=f; resc=true; } } \
    SBAR(); \
    GAPB(o[0]=__builtin_amdgcn_mfma_f32_32x32x16_bf16(PAF(0),VFR(0),o[0],0,0,0), C0,0); \
    GAPB(o[1]=__builtin_amdgcn_mfma_f32_32x32x16_bf16(PAF(0),VFR(4),o[1],0,0,0), C0,4); \
    KRD(GL,0); GAPB(o[0]=__builtin_amdgcn_mfma_f32_32x32x16_bf16(PAF(1),VFR(1),o[0],0,0,0), C0,8); \
    KRD(GL,1); GAPB(o[1]=__builtin_amdgcn_mfma_f32_32x32x16_bf16(PAF(1),VFR(5),o[1],0,0,0), C0,12); \
    KRD(GL,2); GAPB(o[0]=__builtin_amdgcn_mfma_f32_32x32x16_bf16(PAF(2),VFR(2),o[0],0,0,0), C1,0); \
    KRD(GL,3); GAPB(o[1]=__builtin_amdgcn_mfma_f32_32x32x16_bf16(PAF(2),VFR(6),o[1],0,0,0), C1,4); \
    GAPB(o[0]=__builtin_amdgcn_mfma_f32_32x32x16_bf16(PAF(3),VFR(3),o[0],0,0,0), C1,8); \
    GAPB(o[1]=__builtin_amdgcn_mfma_f32_32x32x16_bf16(PAF(3),VFR(7),o[1],0,0,0), C1,12); \
    }while(0)
  int t=1;
  #undef CMASK
  #define CMASK(P0,P1,t) do{}while(0)
  for(;t+7<NT;t+=2){
    STEP(pB0,pB1,pA0,pA1,t,true,true,true);     WAIT_BAR(2); RESC(); ROT();
    STEP(pA0,pA1,pB0,pB1,t+1,true,true,true);   WAIT_BAR(2); RESC(); ROT();
  }
  #undef CMASK
  #define CMASK(P0,P1,t) do{int jb_=(t)-(NT-4); if(jb_>=-2)bmask(P0,P1,jb_,qrel,hi,btab);}while(0)
  #define ENDW(tt) do{ if((tt)+3<NT){WAIT_BAR(2);} else if((tt)+2<NT){WAIT_BAR(1);} else {WAIT_BAR(0);} }while(0)
  for(;t+1<NT;t+=2){
    STEP(pB0,pB1,pA0,pA1,t,(t+3<NT),(t+1<NT),(t+1<NT));       ENDW(t);   RESC(); ROT();
    STEP(pA0,pA1,pB0,pB1,t+1,(t+4<NT),(t+2<NT),(t+2<NT));     ENDW(t+1); RESC(); ROT();
  }
  STEP(pB0,pB1,pA0,pA1,NT-1,false,false,false); RESC();
  { float sacc=pB0[0]+pB0[1]; _Pragma("unroll") for(int r=2;r<16;++r)sacc+=pB0[r]; _Pragma("unroll") for(int r=0;r<16;++r)sacc+=pB1[r]; l_reg+=sacc;
    pw0=(u32x4){PKW(pB0,0),PKW(pB0,2),PKW(pB0,4),PKW(pB0,6)};pw1=(u32x4){PKW(pB0,8),PKW(pB0,10),PKW(pB0,12),PKW(pB0,14)};pw2=(u32x4){PKW(pB1,0),PKW(pB1,2),PKW(pB1,4),PKW(pB1,6)};pw3=(u32x4){PKW(pB1,8),PKW(pB1,10),PKW(pB1,12),PKW(pB1,14)};
    SBAR(); pv(o,vb0+sl_cur,PAF(0),PAF(1),PAF(2),PAF(3)); }
  #undef PKW
  #undef PAF
  #undef VFR
  #undef PIN
  #undef MX3
  #undef GAPA
  #undef GAPB
  #undef EX
  #undef VRD
  #undef KRD
  #undef STEP
  #undef ENDW
  {auto rr=__builtin_amdgcn_permlane32_swap(__float_as_uint(l_reg),__float_as_uint(l_reg),false,false);l_reg=__uint_as_float(rr[0])+__uint_as_float(rr[1]);}
  if(hi==0)wsf[32+r32]=l_reg;asm volatile("s_waitcnt lgkmcnt(0)":::"memory");
  float rli[16];
  #pragma unroll
  for(int r=0;r<16;++r)rli[r]=__builtin_amdgcn_rcpf(wsf[32+crow(r,hi)]);
  bf16*Ow=O+(rowbase+q0+wid*QBLK)*OPITCH+OCOL0+hv*D;
  { bf16*stg=(bf16*)(shm+LDS_OST)+wid*2048; bf16*stga=(bf16*)(shm+LDS_OSTA)+wid*2048;
    #pragma unroll
    for(int r=0;r<16;++r){const int orow=crow(r,hi);
      #pragma unroll
      for(int d0=0;d0<2;++d0){const int ix=orow*64+d0*32+r32; const float ov=o[d0][r]*rli[r]; if(pass==0)stga[ix]=__float2bfloat16(ov); else stg[ix]=__float2bfloat16(__bfloat162float(stga[ix])-lam*ov);}}
    asm volatile("s_waitcnt lgkmcnt(0)":::"memory");
    #pragma unroll
    for(int i=0;i<4;++i){const int row=i*8+(lane>>3),ch=lane&7; if(pass!=0){const u32x4 v=*(const u32x4*)(stg+row*64+ch*8); ATTN_STORE16(Ow+(long)row*OPITCH+ch*8,v);}} }
  asm volatile("s_waitcnt lgkmcnt(0)\n\ts_barrier":::"memory");
  #undef DMA_K
  #undef DMA_V
  #undef CMASK
  #undef START
  #undef RESC
  #undef ROT
}
constexpr int ATTN_LDS_BYTES=LDS_BYTES;
struct AttnTensors { const bf16* Q; const bf16* K; const bf16* V; bf16* O; float lam; const float* relb; };
struct AttnUnit { int bh; int qb; };
struct StaticOrder {
  int vcu;
  __device__ __forceinline__ explicit StaticOrder(int grid,int block):vcu((block%8)*(grid/8)+block/8){}
  __device__ __forceinline__ bool next(int i,AttnUnit&u)const{ if(i>=4)return false; const int s=vcu&7; u.bh=vcu>>3; u.qb=(i==0)?s:(i==1)?15-s:(i==2)?16+s:31-s; return true; }
  __device__ __forceinline__ void a_ready(const AttnUnit&)const{}
  __device__ __forceinline__ void done(const AttnUnit&)const{}
};
template<class Sched,int THRL=8> __device__ __forceinline__ void attn_phase(char*lds,const AttnTensors&T,const Sched&S){
  AttnUnit u;
  for(int i=0;S.next(i,u);++i){ S.a_ready(u); const int b_=u.bh/NHEAD,hp_=u.bh%NHEAD; float*bt_=(float*)(lds+LDS_BTAB);
    for(int t_=threadIdx.x;t_<BT_N;t_+=NW*64){ const int rel=t_-256; float v_=0.f;
      if(rel>=0&&rel<113){ int bk=rel; if(rel>=16){ bk=16+(int)(logf((float)rel*(1.0f/16.0f))/logf(8.0f)*16.0f); bk=bk>31?31:bk; } v_=(T.relb[bk*8+(hp_>>1)]-T.relb[31*8+(hp_>>1)])*1.4426950408889634f; }
      bt_[t_]=v_; }
    asm volatile("s_waitcnt lgkmcnt(0)\n\ts_barrier":::"memory");
    for(int pass=0;pass<2;++pass) attn_unit<THRL>(b_,(hp_&~1)+pass,hp_,u.qb,pass,T.lam,bt_,T.Q,T.K,T.V,T.O,lds); S.done(u); }
}
#undef SBAR
#undef WAIT_BAR
}
namespace attn2 {
using attn_body::bf16; using attn_body::bf16x8; using attn_body::s16x4; using attn_body::f32x16; using attn_body::u32x4; using attn_body::lds_cptr;
using attn_body::glds16; using attn_body::vtr; using attn_body::cvtpk_s; using attn_body::crow; using attn_body::BT_N;
constexpr int SEQ=8192,DM=1024,NW=8,QBLK=32,QB=256;
constexpr int KSLOT=8192,VSLOT=8192,NS=4,NSV=5;
constexpr int L_K=0,L_V=NS*KSLOT,L_WS=L_V+NSV*VSLOT,L_OST=0,L_BTAB=L_WS+NW*256,L_TOTAL=L_BTAB+BT_N*4;
static_assert(NW*8192<=L_WS,"O stage inside the ring region");
constexpr int OP=2048,OC0=1024;
#define SBAR() __builtin_amdgcn_sched_barrier(0)
#define WAIT_BAR(N) asm volatile("s_waitcnt vmcnt(" #N ") lgkmcnt(0)\n\ts_barrier":::"memory")
#define A2LAS __attribute__((address_space(3)))
__device__ __forceinline__ void bmask1(f32x16&p,int jb,int qrel,int hi,const float*bt){
  const float NEG=-INFINITY; const int brel=qrel-32*jb-4*hi; const float*bp=bt+(brel+256);
  #pragma unroll
  for(int r=0;r<16;++r){const int c0=(r&3)+8*(r>>2); const float b0=bp[-c0]; p[r]=(brel<c0)?NEG:p[r]+b0; if((r&3)==3)SBAR();}
}
__device__ __forceinline__ float rowmax1(const f32x16&p){
  #define MX3(a,b,c) __builtin_fmaxf(__builtin_fmaxf((a),(b)),(c))
  float a=MX3(p[0],p[1],p[2]),b=MX3(p[3],p[4],p[5]); a=MX3(a,p[6],p[7]); b=MX3(b,p[8],p[9]); a=MX3(a,p[10],p[11]); b=MX3(b,p[12],p[13]); a=MX3(a,p[14],p[15]);
  float m=__builtin_fmaxf(a,b); auto rr=__builtin_amdgcn_permlane32_swap(__float_as_uint(m),__float_as_uint(m),false,false);
  return __builtin_fmaxf(__uint_as_float(rr[0]),__uint_as_float(rr[1]));
  #undef MX3
}
template<int THRL> __device__ __forceinline__ void unit2(int b,int h,int qb,int pass,float lam,float kmax2,float bmax,const float*subg,const float*btab,const bf16*Q,const bf16*__restrict__ K,const bf16*__restrict__ V,bf16*O,char*shm){
  const int tid=threadIdx.x,lane=tid&63,r32=lane&31,hi=lane>>5; const int wid=__builtin_amdgcn_readfirstlane(tid>>6);
  const long rowbase=(long)b*SEQ; const int q0=qb*QB; const int hq=2*h+pass;
  const bf16*Qw=Q+(rowbase+q0+wid*QBLK)*DM+hq*64;
  const bf16*Kh=K+rowbase*DM+hq*64,*Vh=V+rowbase*DM+h*128;
  const unsigned lds0=(unsigned)(uintptr_t)shm;
  float*wsf=(float*)(shm+L_WS)+wid*64;
  const bf16*ksrc=Kh+(long)lane*DM+wid*8;
  const bf16*vsrc=Vh+(long)(16*(wid&1)+(lane>>2))*DM+(wid>>1)*32+(lane&3)*8;
  const unsigned kdst=lds0+L_K+wid*1024, vdst=lds0+L_V+wid*1024;
  #define DMA_K(T,slot) glds16(ksrc+(long)(T)*64*DM,(unsigned)__builtin_amdgcn_readfirstlane(kdst+(slot)))
  #define DMA_V(u,slot) glds16(vsrc+(long)(u)*32*DM,(unsigned)__builtin_amdgcn_readfirstlane(vdst+(slot)))
  const lds_cptr shm3=(lds_cptr)shm; const lds_cptr kp0=shm3+L_K+hi*1024+r32*16;
  const lds_cptr vp0=shm3+L_V+((lane>>4)&1)*32+(lane&3)*8+(4*hi+((lane&15)>>2))*64;
  const int NT2=(q0+QB)/32, NT=NT2/2;
  DMA_K(0,0);DMA_V(0,0);DMA_K(1,KSLOT);
  bf16x8 qr[4];
  #pragma unroll
  for(int d0=0;d0<4;++d0)qr[d0]=*reinterpret_cast<const bf16x8*>(&Qw[(long)r32*DM+d0*16+hi*8]);
  float l_reg=0.f;f32x16 o[4];o[0]=f32x16{};o[1]=f32x16{};o[2]=f32x16{};o[3]=f32x16{};
  f32x16 negm;
  { float q2=0.f;
    #pragma unroll
    for(int d0=0;d0<4;++d0)
      #pragma unroll
      for(int j=0;j<8;++j){ const float qv=__uint_as_float((unsigned)(unsigned short)qr[d0][j]<<16); q2+=qv*qv; }
    auto rr=__builtin_amdgcn_permlane32_swap(__float_as_uint(q2),__float_as_uint(q2),false,false); q2=__uint_as_float(rr[0])+__uint_as_float(rr[1]);
    const float mref=__builtin_sqrtf(q2*kmax2)*1.01f+bmax+0.0078125f;
    #pragma unroll
    for(int r=0;r<16;++r)negm[r]=-mref;
    asm volatile("":"+v"(negm)); }
  const int qrel=wid*QBLK+r32;
  f32x16 pA,pB; bf16x8 kf[4]; s16x4 vlo[8],vhi[8]; u32x4 pw0,pw1;
  int sv_prev=0,sv_cur=VSLOT,sv_n1=2*VSLOT,sv_n2=3*VSLOT,sv_sp=4*VSLOT;
  int sk_cur=0,sk_next=KSLOT,sk_nn=2*KSLOT,sk_sp=3*KSLOT;
  #define ROTV() do{const int t_=sv_prev;sv_prev=sv_cur;sv_cur=sv_n1;sv_n1=sv_n2;sv_n2=sv_sp;sv_sp=t_;}while(0)
  #define ROTK() do{const int t_=sk_cur;sk_cur=sk_next;sk_next=sk_nn;sk_nn=sk_sp;sk_sp=t_;}while(0)
  #define KLD(j,p) kf[j]=*(const A2LAS bf16x8*)((p)+(j)*2048)
  DMA_K(2,2*KSLOT);DMA_V(1,VSLOT);
  WAIT_BAR(4);
  { KLD(0,kp0);KLD(1,kp0);KLD(2,kp0);KLD(3,kp0);
    pA=__builtin_amdgcn_mfma_f32_32x32x16_bf16(kf[0],qr[0],negm,0,0,0); pA=__builtin_amdgcn_mfma_f32_32x32x16_bf16(kf[1],qr[1],pA,0,0,0);
    pA=__builtin_amdgcn_mfma_f32_32x32x16_bf16(kf[2],qr[2],pA,0,0,0); pA=__builtin_amdgcn_mfma_f32_32x32x16_bf16(kf[3],qr[3],pA,0,0,0);
    if(NT2==8)bmask1(pA,0,qrel,hi,btab);
    #pragma unroll
    for(int r=0;r<16;++r)pA[r]=__builtin_amdgcn_exp2f(pA[r]);
    KLD(0,kp0+512);KLD(1,kp0+512);KLD(2,kp0+512);KLD(3,kp0+512); }
  WAIT_BAR(0);
  #define PKW(P,B) cvtpk_s(P[B],P[B+1])
  #define PAF(k) __builtin_bit_cast(bf16x8,pw##k)
  #define VFR(i) (bf16x8){vlo[i][0],vlo[i][1],vlo[i][2],vlo[i][3],vhi[i][0],vhi[i][1],vhi[i][2],vhi[i][3]}
  #define PIN(x) asm volatile("":"+v"(x))
  #define MX3(a,b,c) __builtin_fmaxf(__builtin_fmaxf((a),(b)),(c))
  #define EX(v) __builtin_amdgcn_exp2f(v)
  #define GAPA(MF,A0,A1,A2,A3,W0,W1,PW) do{ MF; sacc+=A0; sacc+=A1; sacc+=A2; sacc+=A3; PIN(sacc); W0; W1; PIN(PW); SBAR(); }while(0)
  #define GAPB(MF,X,B) do{ MF; X[B]=EX(X[B]); X[B+1]=EX(X[B+1]); PIN(X); SBAR(); }while(0)
  #define VRD(i) do{ vlo[i]=vtr(vp_+(((i)>>1)*2048+((i)&1)*1024)); vhi[i]=vtr(vp_+(((i)>>1)*2048+((i)&1)*1024+512)); }while(0)
  #define KRD(G,j) do{ if(G){ KLD(j,kn_); SBAR(); } }while(0)
  #define MF32(a,b,c) __builtin_amdgcn_mfma_f32_32x32x16_bf16(a,b,c,0,0,0)
  #define SUB(C,P,u,ODD,GK,GV,GV2,GL,MASK,MIDW) do{ SBAR(); \
    const lds_cptr vp_=vp0+sv_prev; const lds_cptr kn_=kp0+((ODD)?sk_next:(sk_cur+512)); \
    VRD(0); SBAR(); float sacc=(P[0]+P[1]); \
    GAPA(C=MF32(kf[0],qr[0],negm), P[2],P[3],P[4],P[5],     pw0[0]=PKW(P,0), pw0[1]=PKW(P,2), pw0); \
    VRD(2); SBAR(); GAPA(C=MF32(kf[1],qr[1],C), P[6],P[7],P[8],P[9],     pw0[2]=PKW(P,4), pw0[3]=PKW(P,6), pw0); \
    VRD(1); SBAR(); GAPA(C=MF32(kf[2],qr[2],C), P[10],P[11],P[12],P[13], pw1[0]=PKW(P,8), pw1[1]=PKW(P,10), pw1); \
    VRD(3); SBAR(); GAPA(C=MF32(kf[3],qr[3],C), P[14],P[15],0.f,0.f,     pw1[2]=PKW(P,12),pw1[3]=PKW(P,14), pw1); \
    l_reg+=sacc; \
    if(ODD){ if(GV){DMA_V((u)+1,sv_n1);} if(GV2){DMA_V((u)+2,sv_n2);} if(GK){DMA_K(((u)>>1)+3,sk_sp);} } \
    if(MASK){ const int jb_=(u)-(NT2-8); if(jb_>=-4)bmask1(C,jb_,qrel,hi,btab); } \
    SBAR(); \
    if((MIDW)>=0 && wid>=4){ if((MIDW)==1){WAIT_BAR(1);}else{WAIT_BAR(0);} } \
    SBAR(); \
    VRD(4); SBAR(); GAPB(o[0]=MF32(PAF(0),VFR(0),o[0]), C,0); \
    VRD(6); SBAR(); GAPB(o[1]=MF32(PAF(0),VFR(2),o[1]), C,2); \
    VRD(5); SBAR(); GAPB(o[0]=MF32(PAF(1),VFR(1),o[0]), C,4); \
    VRD(7); SBAR(); GAPB(o[1]=MF32(PAF(1),VFR(3),o[1]), C,6); \
    KRD(GL,0); GAPB(o[2]=MF32(PAF(0),VFR(4),o[2]), C,8); \
    KRD(GL,1); GAPB(o[3]=MF32(PAF(0),VFR(6),o[3]), C,10); \
    KRD(GL,2); GAPB(o[2]=MF32(PAF(1),VFR(5),o[2]), C,12); \
    KRD(GL,3); GAPB(o[3]=MF32(PAF(1),VFR(7),o[3]), C,14); \
    }while(0)
  int u=1;
  for(;u+13<NT2;u+=2){
    SUB(pB,pA,u,true,true,true,true,true,false,-1); ROTV(); ROTK();
    SUB(pA,pB,u+1,false,false,false,false,true,false,1);   if(wid<4){WAIT_BAR(1);} ROTV();
  }
  for(;u+1<NT2;u+=2){
    const bool gk=((u>>1)+3<NT), gv2=(u+2<NT2);
    SUB(pB,pA,u,true,gk,true,gv2,true,true,-1); ROTV(); ROTK();
    { const int mw_=gk?1:0; SUB(pA,pB,u+1,false,false,false,false,gv2,true,mw_); if(wid<4){ if(gk){WAIT_BAR(1);}else{WAIT_BAR(0);} } } ROTV();
  }
  SUB(pB,pA,NT2-1,true,false,false,false,false,true,-1);
  { float sacc=pB[0]+pB[1];
    #pragma unroll
    for(int r=2;r<16;++r)sacc+=pB[r];
    l_reg+=sacc;
    pw0=(u32x4){PKW(pB,0),PKW(pB,2),PKW(pB,4),PKW(pB,6)};pw1=(u32x4){PKW(pB,8),PKW(pB,10),PKW(pB,12),PKW(pB,14)};
    SBAR(); const lds_cptr vp_=vp0+sv_cur;
    #pragma unroll
    for(int db=0;db<4;++db){ VRD(2*db); VRD(2*db+1); o[db]=MF32(PAF(0),VFR(2*db),o[db]); o[db]=MF32(PAF(1),VFR(2*db+1),o[db]); } }
  #undef PKW
  #undef PAF
  #undef VFR
  #undef PIN
  #undef MX3
  #undef EX
  #undef GAPA
  #undef GAPB
  #undef VRD
  #undef KRD
  #undef SUB
  asm volatile("s_waitcnt lgkmcnt(0)\n\ts_barrier":::"memory");
  {auto rr=__builtin_amdgcn_permlane32_swap(__float_as_uint(l_reg),__float_as_uint(l_reg),false,false);l_reg=__uint_as_float(rr[0])+__uint_as_float(rr[1]);}
  if(hi==0)wsf[32+r32]=l_reg;asm volatile("s_waitcnt lgkmcnt(0)":::"memory");
  float rli[16];
  #pragma unroll
  for(int r=0;r<16;++r)rli[r]=__builtin_amdgcn_rcpf(wsf[32+crow(r,hi)]);
  bf16*Ow=O+(rowbase+q0+wid*QBLK)*OP+OC0+h*128;
  { bf16*stg=(bf16*)(shm+L_OST)+wid*4096;
    #pragma unroll
    for(int r=0;r<16;++r){const int orow=crow(r,hi);
      #pragma unroll
      for(int db=0;db<4;++db)stg[orow*128+db*32+r32]=__float2bfloat16(o[db][r]*rli[r]);}
    asm volatile("s_waitcnt lgkmcnt(0)":::"memory");
    float sg[8];
    #pragma unroll
    for(int e=0;e<8;++e)sg[e]=subg[(lane&15)*8+e]*0.8f;
    #pragma unroll
    for(int i=0;i<8;++i){const int row=i*4+(lane>>4),ch=lane&15; u32x4 v=*(const u32x4*)(stg+row*128+ch*8); bf16*gp=Ow+(long)row*OP+ch*8;
      if(pass!=0){ const u32x4 a=*(const u32x4*)gp; u32x4 w; float d[8]; float ss=0.f;
        #pragma unroll
        for(int e=0;e<4;++e){ const float a0=__uint_as_float(a[e]<<16),a1=__uint_as_float(a[e]&0xffff0000u),b0=__uint_as_float(v[e]<<16),b1=__uint_as_float(v[e]&0xffff0000u); d[2*e]=a0-lam*b0; d[2*e+1]=a1-lam*b1; ss+=d[2*e]*d[2*e]+d[2*e+1]*d[2*e+1]; }
        ss+=__shfl_xor(ss,1); ss+=__shfl_xor(ss,2); ss+=__shfl_xor(ss,4); ss+=__shfl_xor(ss,8);
        const float rs=rsqrtf(ss*(1.f/128.f)+1e-6f);
        #pragma unroll
        for(int e=0;e<4;++e) w[e]=cvtpk_s(d[2*e]*rs*sg[2*e],d[2*e+1]*rs*sg[2*e+1]);
        v=w; }
      *(u32x4*)gp=v; } }
  asm volatile("s_waitcnt lgkmcnt(0)\n\ts_barrier":::"memory");
  #undef DMA_K
  #undef DMA_V
  #undef ROTV
  #undef ROTK
  #undef KLD
  #undef MF32
}
struct Tensors { const bf16* Q; const bf16* K; const bf16* V; bf16* O; float lam; const float* relb; const float* subg; const float* kmax; };
template<int THRL=8> __device__ __forceinline__ void phase(char*lds,const Tensors&T,int grid,int block){
  const int vcu=(block%8)*(grid/8)+block/8;
  for(int i=0;i<2;++i){ const int bh=vcu>>4,s=vcu&15,qb=(i==0)?s:31-s,b_=bh>>3,h_=bh&7; float*bt_=(float*)(lds+L_BTAB);
    for(int t_=threadIdx.x;t_<BT_N;t_+=NW*64){ const int rel=t_-256; float v_=0.f;
      if(rel>=0&&rel<113){ int bk=rel; if(rel>=16){ bk=16+(int)(logf((float)rel*(1.0f/16.0f))/logf(8.0f)*16.0f); bk=bk>31?31:bk; } v_=(T.relb[bk*8+h_]-T.relb[31*8+h_])*1.4426950408889634f; }
      bt_[t_]=v_; }
    asm volatile("s_waitcnt lgkmcnt(0)\n\ts_barrier":::"memory");
    float bmax=0.f;
    for(int bk=0;bk<31;++bk)bmax=__builtin_fmaxf(bmax,(T.relb[bk*8+h_]-T.relb[31*8+h_])*1.4426950408889634f);
    for(int pass=0;pass<2;++pass){ const float*kp_=T.kmax+((bh*2+pass)*2); const float kmax2=__hip_atomic_load(kp_,__ATOMIC_RELAXED,__HIP_MEMORY_SCOPE_AGENT)+__hip_atomic_load(kp_+1,__ATOMIC_RELAXED,__HIP_MEMORY_SCOPE_AGENT);
      unit2<THRL>(b_,h_,qb,pass,T.lam,kmax2,bmax,T.subg,bt_,T.Q,T.K,T.V,T.O,lds); } }
}
#undef SBAR
#undef WAIT_BAR
#undef A2LAS
}
constexpr int NWAVES = 8;
constexpr int BATCH = 2, SEQ = 8192, DM = 1024, M = BATCH * SEQ;
constexpr int DFF = 2816, NGU = 2 * DFF;
constexpr int NQKV = 3072;
constexpr int NMIX = 2816;
constexpr int NIN = NQKV + NMIX;
constexpr int IN_WIDTH = 5648;
constexpr int KOUT = 2048;
constexpr int NMOD = 9 * DM;
constexpr int NCHUNK = SEQ / 128, NBC = BATCH * NCHUNK;
constexpr float EPS = 1e-6f;
constexpr float LAM_INIT = 0.2f;
constexpr float LOG2E = 1.4426950408889634f;

constexpr size_t MiB = 1u << 20;
constexpr size_t WS_CTL = 0, CTL_ZERO_BYTES = 64 * 1024;
constexpr size_t WS_MOD = 1 * MiB;
constexpr size_t WS_DTRAW = 2 * MiB;
constexpr size_t WS_DTS = 3 * MiB;
constexpr size_t WS_AC = 4 * MiB;
constexpr size_t WS_CDEC = 5 * MiB;
constexpr size_t WS_WA = 6 * MiB;
constexpr size_t WS_WB = 18 * MiB;
constexpr size_t WS_H = 24 * MiB;
constexpr size_t WS_U = 56 * MiB;
constexpr size_t WS_ACT = WS_U, WS_D = WS_U + 88 * MiB;
constexpr size_t WS_Q = WS_U, WS_K = WS_U + 32 * MiB, WS_V = WS_U + 64 * MiB;
constexpr size_t WS_YCAT = WS_U + 96 * MiB;
constexpr size_t WS_Z = WS_U, WS_XBC = WS_U + 32 * MiB;
constexpr size_t WS_BT = WS_U + 80 * MiB, WS_CM = WS_U + 88 * MiB;
constexpr size_t WS_XT = WS_U + 160 * MiB, WS_BM = WS_U + 192 * MiB;
constexpr size_t WS_ST = WS_H;
constexpr size_t WS_D2 = WS_U;
constexpr size_t WS_X2 = WS_U + 152 * MiB;
constexpr size_t WS_END = 256 * MiB;
static_assert(WS_BM + 8 * MiB <= WS_END && WS_D + 64 * MiB <= WS_END && WS_YCAT + 64 * MiB <= WS_XT && WS_CM + 8 * MiB <= WS_YCAT && WS_XBC + 48 * MiB <= WS_BT, "d_ws map");

constexpr int RING_OFF = 0, RING_BYTES = 131072;
constexpr int LDSCTL_OFF = RING_BYTES, MISC_OFF = LDSCTL_OFF + 320;
constexpr int LDS_BYTES = 147456;
static_assert(attn_body::LDS_TOTAL <= RING_BYTES && attn2::L_TOTAL <= RING_BYTES, "attention scratch inside the ring region");

#define GAS __attribute__((address_space(1)))
#define LAS __attribute__((address_space(3)))
typedef unsigned short bf16;
typedef unsigned v4u __attribute__((ext_vector_type(4)));
typedef unsigned v2u __attribute__((ext_vector_type(2)));
typedef float f32x4 __attribute__((ext_vector_type(4)));
typedef float f32x16 __attribute__((ext_vector_type(16)));
typedef short bf16x8 __attribute__((ext_vector_type(8)));
typedef GAS unsigned gu32;
#define RLX_AGENT __ATOMIC_RELAXED, __HIP_MEMORY_SCOPE_AGENT
#define LDS_WAIT() asm volatile("s_waitcnt lgkmcnt(0)" ::: "memory")
#define VM_WAIT() asm volatile("s_waitcnt vmcnt(0)" ::: "memory")
__device__ __forceinline__ unsigned f2bf(float f) { unsigned u = __builtin_bit_cast(unsigned, f); return (u + 0x7fffu + ((u >> 16) & 1u)) >> 16; }
typedef float f32x2_p __attribute__((ext_vector_type(2))); typedef __bf16 bf16x2_p __attribute__((ext_vector_type(2)));
__device__ __forceinline__ unsigned pk2(float lo, float hi) { f32x2_p v = {lo, hi}; return __builtin_bit_cast(unsigned, __builtin_convertvector(v, bf16x2_p)); }
__device__ __forceinline__ float bf2f(unsigned short h) { return __builtin_bit_cast(float, (unsigned)h << 16); }
__device__ __forceinline__ float bflo(unsigned w) { return __builtin_bit_cast(float, w << 16); }
__device__ __forceinline__ float bfhi(unsigned w) { return __builtin_bit_cast(float, w & 0xffff0000u); }
__device__ __forceinline__ float silu(float v) { return v * __builtin_amdgcn_rcpf(1.0f + __expf(-v)); }
__device__ __forceinline__ int crow(int r, int hi) { return (r & 3) + 8 * (r >> 2) + 4 * hi; }
#define MFMA32(a, b, c) __builtin_amdgcn_mfma_f32_32x32x16_bf16(a, b, c, 0, 0, 0)

#define XB_TMO      128
#define XB_XCNT(j)  (256  + 64 * (j))
#define XB_XSUB(j)  (1280 + 64 * (j))
#define XB_XGEN(j)  (2304 + 64 * (j))
#define XB_TOP      3328
#define XB_TOPGEN   3392
#define XCD_BAR_WORDS 3456
#define XB_SPIN_CAP (1u << 18)
constexpr int CW_KMAX = 12288;
constexpr int CW_BAR = 4096;
static_assert((CW_BAR + XCD_BAR_WORDS) <= CW_KMAX && (CW_KMAX + 64) * 4 <= (int)CTL_ZERO_BYTES, "control words inside the memset region");
__device__ __forceinline__ unsigned xb_ld(unsigned* p)              { return __hip_atomic_load(p, __ATOMIC_RELAXED, __HIP_MEMORY_SCOPE_AGENT); }
__device__ __forceinline__ unsigned xb_add(unsigned* p, unsigned v) { return __hip_atomic_fetch_add(p, v, __ATOMIC_RELAXED, __HIP_MEMORY_SCOPE_AGENT); }
__device__ __forceinline__ unsigned xb_xcc_id() { return (unsigned)__builtin_amdgcn_s_getreg((3 << 11) | 20) & 0xFu; }
#define XB_SPIN(cond, bar) do { unsigned _sp = 0; while (cond) { __builtin_amdgcn_s_sleep(1); \
    if ((++_sp & 255u) == 0u) { if (xb_ld(&(bar)[XB_TMO])) break; if (_sp > XB_SPIN_CAP) { atomicAdd(&(bar)[XB_TMO], 1u); break; } } } } while (0)
struct XcdBarrier { unsigned* bar; unsigned x; volatile LAS unsigned* st; };
__device__ __forceinline__ XcdBarrier xcd_barrier_post(unsigned* bar, volatile LAS unsigned* st) {
    XcdBarrier b; b.bar = bar; b.x = xb_xcc_id(); b.st = st;
    if (threadIdx.x == 0) (void)xb_add(&bar[XB_XCNT(b.x)], 1u);
    return b;
}
__device__ __forceinline__ void xcd_barrier_complete(unsigned* bar, unsigned x, unsigned& nloc, unsigned& nx) {
    const unsigned G = gridDim.x * gridDim.y * gridDim.z;
    unsigned sum, cnt, mine, sp = 0u;
    for (;;) {
        sum = 0u; cnt = 0u; mine = 0u;
#pragma unroll
        for (unsigned j = 0; j < 16; ++j) { const unsigned c = xb_ld(&bar[XB_XCNT(j)]); sum += c; cnt += (c > 0u) ? 1u : 0u; mine = (j == x) ? c : mine; }
        if (sum == G) break;
        __builtin_amdgcn_s_sleep(1);
        if ((++sp & 255u) == 0u) { if (xb_ld(&bar[XB_TMO])) break; if (sp > XB_SPIN_CAP) { atomicAdd(&bar[XB_TMO], 1u); break; } }
    }
    nloc = mine > 0u ? mine : 1u; nx = cnt > 0u ? cnt : 1u;
}
__device__ __forceinline__ void xcd_barrier(const XcdBarrier& b) {
    asm volatile("s_waitcnt vmcnt(0)" ::: "memory");
    __syncthreads();
    if (threadIdx.x == 0) {
        unsigned* bar = b.bar;
        __builtin_amdgcn_s_waitcnt(0);
        unsigned nloc = b.st[0], nx = b.st[1];
        if (nloc == 0u) { xcd_barrier_complete(bar, b.x, nloc, nx); b.st[0] = nloc; b.st[1] = nx; }
        const unsigned old = xb_add(&bar[XB_XSUB(b.x)], 1u);
        const unsigned gen = old / nloc;
        if (old + 1u == (gen + 1u) * nloc) {
            __builtin_amdgcn_fence(__ATOMIC_RELEASE, "agent");
            asm volatile("s_waitcnt vmcnt(0)" ::: "memory");
            const unsigned og = xb_add(&bar[XB_TOP], 1u);
            const unsigned tg = og / nx;
            if (og + 1u == (tg + 1u) * nx) xb_add(&bar[XB_TOPGEN], 1u);
            else XB_SPIN(xb_ld(&bar[XB_TOPGEN]) == tg, bar);
            __builtin_amdgcn_fence(__ATOMIC_ACQUIRE, "agent");
            xb_add(&bar[XB_XGEN(b.x)], 1u);
            asm volatile("s_waitcnt vmcnt(0)" ::: "memory");
        } else {
            XB_SPIN(xb_ld(&bar[XB_XGEN(b.x)]) == gen, bar);
            __builtin_amdgcn_fence(__ATOMIC_ACQUIRE, "agent");
            asm volatile("s_waitcnt vmcnt(0)" ::: "memory");
        }
    }
    __syncthreads();
}

struct Frame {
    LAS unsigned char* lds;
    int tid, lane, wave;
    int vcu, G;
    int gw, NGW;
};
__device__ __forceinline__ float wave_sum(float v) {
#pragma unroll
    for (int o = 1; o < 64; o <<= 1) v += __shfl_xor(v, o);
    return v;
}
__device__ __forceinline__ void tr_item(const float* W, int N, int n0, int k0, bf16* WT, int K, int drow0, int nvalid, LAS float* scr, int lane) {
#pragma unroll 8
    for (int i = 0; i < 32; ++i) { const int kk = 2 * i + (lane >> 5); scr[kk * 33 + (lane & 31)] = __builtin_nontemporal_load(W + (size_t)(k0 + kk) * N + n0 + (lane & 31)); }
    LDS_WAIT(); asm volatile("" ::: "memory");
    const int c = lane & 7;
#pragma unroll
    for (int j = 0; j < 4; ++j) { const int n = (lane >> 3) + 8 * j; const LAS float* s = scr + (8 * c) * 33 + n;
        v4u o; o.x = pk2(s[0 * 33], s[1 * 33]); o.y = pk2(s[2 * 33], s[3 * 33]); o.z = pk2(s[4 * 33], s[5 * 33]); o.w = pk2(s[6 * 33], s[7 * 33]);
        if (n >= nvalid) o = (v4u){0u, 0u, 0u, 0u};
        *(GAS v4u*)(WT + (size_t)(drow0 + n) * K + k0 + 8 * c) = o; }
    LDS_WAIT(); asm volatile("" ::: "memory");
}
__device__ __forceinline__ void convert_gu_half(Frame& F, int w, int nw, const float* Wx, int up, bf16* WA) {
    LAS float* scr = (LAS float*)(F.lds + RING_OFF + F.wave * 16384);
    constexpr int NB = DFF / 32, I_G = (DM / 64) * NB;
    for (int r = w; r < I_G; r += nw) { const int kb = r / NB, nb = r % NB, n0 = 32 * nb;
        tr_item(Wx, DFF, n0, 64 * kb, WA, DM, (n0 >> 7) * 256 + (n0 & 127) + (up ? 128 : 0), 32, scr, F.lane); }
}
__device__ __forceinline__ void convert_down(Frame& F, int w, int nw, const float* Wd, bf16* WB) {
    LAS float* scr = (LAS float*)(F.lds + RING_OFF + F.wave * 16384);
    constexpr int I_D = (DFF / 64) * (DM / 32);
    for (int r = w; r < I_D; r += nw) { const int kb = r / (DM / 32), nb = r % (DM / 32); tr_item(Wd, DM, 32 * nb, 64 * kb, WB, DFF, 32 * nb, 32, scr, F.lane); }
}
__device__ __forceinline__ void convert_ffn(Frame& F, const float* Wg, const float* Wu, const float* Wd, bf16* WA, bf16* WB) {
    LAS float* scr = (LAS float*)(F.lds + RING_OFF + F.wave * 16384);
    constexpr int NB = DFF / 32, I_G = (DM / 64) * NB, I_D = (DFF / 64) * (DM / 32);
    for (int it = F.gw; it < 2 * I_G + I_D; it += F.NGW) {
        int r = it;
        if (r < 2 * I_G) { const int up = r >= I_G; if (up) r -= I_G; const int kb = r / NB, nb = r % NB, n0 = 32 * nb;
            tr_item(up ? Wu : Wg, DFF, n0, 64 * kb, WA, DM, (n0 >> 7) * 256 + (n0 & 127) + (up ? 128 : 0), 32, scr, F.lane); continue; }
        r -= 2 * I_G; { const int kb = r / (DM / 32), nb = r % (DM / 32); tr_item(Wd, DM, 32 * nb, 64 * kb, WB, DFF, 32 * nb, 32, scr, F.lane); }
    }
}
__device__ __forceinline__ void convert_mix(Frame& F, int w, int nw, const float* Win, const float* Wout, bf16* WA, bf16* WB) {
    LAS float* scr = (LAS float*)(F.lds + RING_OFF + F.wave * 16384);
    constexpr int NB_IN = 177, I_IN = (DM / 64) * NB_IN, I_OUT = (KOUT / 64) * (DM / 32);
    for (int it = w; it < I_IN + I_OUT; it += nw) {
        int r = it;
        if (r < I_IN) { const int kb = r / NB_IN; int nb = r % NB_IN; int src, dst, nv = 32;
            if (nb < 32) { src = 0 + 32 * nb; dst = 3072 + 32 * nb; }
            else if (nb < 80) { nb -= 32; src = 1024 + 32 * nb; dst = 4096 + 32 * nb; }
            else if (nb < 81) { src = 2560; dst = 5632; nv = 16; }
            else if (nb < 113) { nb -= 81; src = 2576 + 32 * nb; dst = 0 + 32 * nb; }
            else if (nb < 145) { nb -= 113; src = 3600 + 32 * nb; dst = 1024 + 32 * nb; }
            else { nb -= 145; src = 4624 + 32 * nb; dst = 2048 + 32 * nb; }
            tr_item(Win, IN_WIDTH, src, 64 * kb, WA, DM, dst, nv, scr, F.lane); continue; }
        r -= I_IN; { const int kb = r / (DM / 32), nb = r % (DM / 32); tr_item(Wout, DM, 32 * nb, 64 * kb, WB, KOUT, 32 * nb, 32, scr, F.lane); }
    }
    { GAS v4u* z = (GAS v4u*)(WA + (size_t)5664 * DM); const int n16 = 224 * DM * 2 / 16;
      for (int i = w * 64 + F.lane; i < n16; i += nw * 64) z[i] = (v4u){0u, 0u, 0u, 0u}; }
}
__device__ __forceinline__ void mod_gemv(Frame& F, const float* c, const float* w_ada, const float* b_ada, float* mod) {
    LAS float* cs = (LAS float*)(F.lds + RING_OFF);
    LAS float* red = cs + 2048;
    __syncthreads();
    for (int i = F.tid; i < 2 * DM; i += NWAVES * 64) cs[i] = silu(c[i]);
    __syncthreads();
    for (int u = blockIdx.x; u < NMOD / 64; u += F.G) {
        const int col = 64 * u + F.lane; float a0 = 0.f, a1 = 0.f;
        const float* wp = w_ada + (size_t)(128 * F.wave) * NMOD + col;
#pragma unroll 16
        for (int k = 0; k < 128; ++k) { const float w = __builtin_nontemporal_load(wp + (size_t)k * NMOD); a0 += cs[128 * F.wave + k] * w; a1 += cs[DM + 128 * F.wave + k] * w; }
        red[(F.wave * 2 + 0) * 64 + F.lane] = a0; red[(F.wave * 2 + 1) * 64 + F.lane] = a1;
        __syncthreads();
        if (F.tid < 128) { const int b = F.tid >> 6, l = F.tid & 63; float s = b_ada[64 * u + l];
#pragma unroll
            for (int w = 0; w < 8; ++w) s += red[(w * 2 + b) * 64 + l];
            mod[b * NMOD + 64 * u + l] = s; }
        __syncthreads();
    }
}

struct Row16 { f32x4 v[4]; };
__device__ __forceinline__ Row16 ld_row(const float* p, int lane) { Row16 r; const GAS f32x4* q = (const GAS f32x4*)p + lane;
#pragma unroll
    for (int j = 0; j < 4; ++j) r.v[j] = q[64 * j];
    return r; }
__device__ __forceinline__ Row16 ld_row_bf(const bf16* p, int lane) { Row16 r; const GAS v2u* q = (const GAS v2u*)p + lane;
#pragma unroll
    for (int j = 0; j < 4; ++j) { const v2u w = q[64 * j]; r.v[j] = (f32x4){bflo(w.x), bfhi(w.x), bflo(w.y), bfhi(w.y)}; }
    return r; }
__device__ __forceinline__ float row_ssq_part(const Row16& r) { float s = 0.f;
#pragma unroll
    for (int j = 0; j < 4; ++j) s += (r.v[j].x * r.v[j].x + r.v[j].y * r.v[j].y) + (r.v[j].z * r.v[j].z + r.v[j].w * r.v[j].w);
    return s; }
__device__ __forceinline__ void st_row_bf(bf16* out, const Row16& h, int lane) { GAS unsigned long long* o8 = (GAS unsigned long long*)out + lane;
#pragma unroll
    for (int j = 0; j < 4; ++j) o8[64 * j] = (unsigned long long)pk2(h.v[j].x, h.v[j].y) | ((unsigned long long)pk2(h.v[j].z, h.v[j].w) << 32); }
constexpr int RW = 4;
__device__ __forceinline__ void rows_first(Frame& F, const float* x, const float* pre_g, const float* mod, int sidx, bf16* H) {
#pragma unroll 1
    for (int b = 0; b < BATCH; ++b) { const float* mb = mod + b * NMOD;
        Row16 A = ld_row(pre_g, F.lane); const Row16 SC = ld_row(mb + (sidx + 1) * DM, F.lane), S = ld_row(mb + sidx * DM, F.lane);
#pragma unroll
        for (int j = 0; j < 4; ++j) A.v[j] = A.v[j] * (SC.v[j] + 1.0f);
#pragma unroll 1
        for (int r = F.gw; r < SEQ; r += RW * F.NGW) { Row16 xr[RW]; size_t m[RW]; bool ok[RW];
#pragma unroll
            for (int q = 0; q < RW; ++q) { ok[q] = r + q * F.NGW < SEQ; m[q] = (size_t)b * SEQ + (ok[q] ? r + q * F.NGW : r); xr[q] = ld_row(x + m[q] * DM, F.lane); }
#pragma unroll
            for (int q = 0; q < RW; ++q) { const float rs = rsqrtf(wave_sum(row_ssq_part(xr[q])) * (1.f / DM) + EPS);
#pragma unroll
                for (int j = 0; j < 4; ++j) xr[q].v[j] = xr[q].v[j] * rs * A.v[j] + S.v[j];
                if (ok[q]) st_row_bf(H + m[q] * DM, xr[q], F.lane); } } }
}
template <bool NEXT, bool XIB, bool XOB> __device__ __forceinline__ void rows_res(Frame& F, const void* xin, const bf16* Dm, const float* post_g, const float* mod, int gidx, float gscale, void* xo,
                                                                                  const float* pre_g, int sidx, bf16* H) {
#pragma unroll 1
    for (int b = 0; b < BATCH; ++b) { const float* mb = mod + b * NMOD;
        Row16 PGT = ld_row(post_g, F.lane); { const Row16 GT = ld_row(mb + gidx * DM, F.lane);
#pragma unroll
            for (int j = 0; j < 4; ++j) PGT.v[j] = PGT.v[j] * GT.v[j] * gscale; }
        Row16 A, S;
        if (NEXT) { A = ld_row(pre_g, F.lane); const Row16 SC = ld_row(mb + (sidx + 1) * DM, F.lane); S = ld_row(mb + sidx * DM, F.lane);
#pragma unroll
            for (int j = 0; j < 4; ++j) A.v[j] = A.v[j] * (SC.v[j] + 1.0f); }
#pragma unroll 1
        for (int r = F.gw; r < SEQ; r += RW * F.NGW) { Row16 xr[RW], dr[RW]; size_t m[RW]; bool ok[RW];
#pragma unroll
            for (int q = 0; q < RW; ++q) { ok[q] = r + q * F.NGW < SEQ; m[q] = (size_t)b * SEQ + (ok[q] ? r + q * F.NGW : r);
                xr[q] = XIB ? ld_row_bf((const bf16*)xin + m[q] * DM, F.lane) : ld_row((const float*)xin + m[q] * DM, F.lane); dr[q] = ld_row_bf(Dm + m[q] * DM, F.lane); }
#pragma unroll
            for (int q = 0; q < RW; ++q) { const float qs = rsqrtf(wave_sum(row_ssq_part(dr[q])) * (1.f / DM) + EPS);
#pragma unroll
                for (int j = 0; j < 4; ++j) xr[q].v[j] = xr[q].v[j] + PGT.v[j] * (dr[q].v[j] * qs);
                if (ok[q]) { if (XOB) st_row_bf((bf16*)xo + m[q] * DM, xr[q], F.lane);
                    else { GAS f32x4* o = (GAS f32x4*)((float*)xo + m[q] * DM) + F.lane;
#pragma unroll
                        for (int j = 0; j < 4; ++j) o[64 * j] = xr[q].v[j]; } }
                if (NEXT) { const float rs = rsqrtf(wave_sum(row_ssq_part(xr[q])) * (1.f / DM) + EPS);
#pragma unroll
                    for (int j = 0; j < 4; ++j) xr[q].v[j] = xr[q].v[j] * rs * A.v[j] + S.v[j];
                    if (ok[q]) st_row_bf(H + m[q] * DM, xr[q], F.lane); } } } }
}
__device__ __forceinline__ float bf_elem(const v4u& w, int e) { const unsigned u = (e >> 1) == 0 ? w.x : (e >> 1) == 1 ? w.y : (e >> 1) == 2 ? w.z : w.w; return (e & 1) ? bfhi(u) : bflo(u); }
__device__ __forceinline__ void conv_item(int lane, int bc, int cg, const bf16* XBC, const float* conv_w, const float* conv_b, bf16* XT, bf16* Bm, bf16* BTm, bf16* Cm) {
    const int o = lane >> 2, q = lane & 3, c = bc % NCHUNK; const size_t t0 = (size_t)bc * 128;
    const int ch0 = cg * 32 + q * 8;
    v4u raw[11];
#pragma unroll
    for (int k = 0; k < 11; ++k) { const int row = 8 * o + k - 3; raw[k] = (v4u){0u, 0u, 0u, 0u};
        if (row >= 0 || c > 0) raw[k] = *(const GAS v4u*)(XBC + (size_t)((long)t0 + row) * 1536 + ch0); }
    float wk[4][8], cb[8];
#pragma unroll
    for (int k = 0; k < 4; ++k) { const f32x4 a = *(const GAS f32x4*)(conv_w + k * 1536 + ch0), b = *(const GAS f32x4*)(conv_w + k * 1536 + ch0 + 4);
#pragma unroll
        for (int e = 0; e < 4; ++e) { wk[k][e] = a[e]; wk[k][4 + e] = b[e]; } }
    { const f32x4 a = *(const GAS f32x4*)(conv_b + ch0), b = *(const GAS f32x4*)(conv_b + ch0 + 4);
#pragma unroll
      for (int e = 0; e < 4; ++e) { cb[e] = a[e]; cb[4 + e] = b[e]; } }
    float outv[8][8];
#pragma unroll
    for (int e = 0; e < 8; ++e) { float x[11];
#pragma unroll
        for (int k = 0; k < 11; ++k) x[k] = bf_elem(raw[k], e);
#pragma unroll
        for (int jj = 0; jj < 8; ++jj) outv[jj][e] = silu(cb[e] + wk[0][e] * x[jj] + wk[1][e] * x[jj + 1] + wk[2][e] * x[jj + 2] + wk[3][e] * x[jj + 3]); }
    if (cg < 40) {
        bf16* dst;
        if (cg < 32) dst = XT + (((size_t)bc * 16 + (cg >> 1)) * 64 + (cg & 1) * 32 + q * 8) * 128 + 8 * o;
        else { const int bb = cg - 32; dst = BTm + (((size_t)bc * 2 + (bb >> 2)) * 128 + (bb & 3) * 32 + q * 8) * 128 + 8 * o; }
#pragma unroll
        for (int e = 0; e < 8; ++e) { v4u w; w.x = pk2(outv[0][e], outv[1][e]); w.y = pk2(outv[2][e], outv[3][e]); w.z = pk2(outv[4][e], outv[5][e]); w.w = pk2(outv[6][e], outv[7][e]);
            *(GAS v4u*)(dst + (size_t)e * 128) = w; }
    }
    if (cg >= 32) {
        const int bb = (cg - 32) & 7; bf16* dst = (cg < 40 ? Bm : Cm) + (((size_t)bc * 2 + ((bb & 7) >> 2)) * 128 + 8 * o) * 128 + (bb & 3) * 32 + q * 8;
#pragma unroll
        for (int jj = 0; jj < 8; ++jj) { v4u w; w.x = pk2(outv[jj][0], outv[jj][1]); w.y = pk2(outv[jj][2], outv[jj][3]); w.z = pk2(outv[jj][4], outv[jj][5]); w.w = pk2(outv[jj][6], outv[jj][7]);
            *(GAS v4u*)(dst + (size_t)jj * 128) = w; }
    }
}
__device__ __forceinline__ void dt_item(int lane, int it, const float* dtraw, const float* dt_bias, const float* a_log, float* DTS, float* AC, float* CDEC) {
    const int bc = it >> 4, h = it & 15; const size_t t0 = (size_t)bc * 128;
    const float bias = dt_bias[h], a = -__expf(a_log[h]);
    const float x0 = dtraw[(t0 + 2 * lane) * 16 + h] + bias, x1 = dtraw[(t0 + 2 * lane + 1) * 16 + h] + bias;
    const float d0 = x0 > 20.f ? x0 : log1pf(__expf(x0)), d1 = x1 > 20.f ? x1 : log1pf(__expf(x1));
    float* dp = DTS + (size_t)it * 128 + 2 * lane; dp[0] = d0; dp[1] = d1;
    const float v0 = d0 * a, v1 = d1 * a, s = v0 + v1; float inc = s;
#pragma unroll
    for (int sh = 1; sh < 64; sh <<= 1) { const float t = __shfl_up(inc, sh); if (lane >= sh) inc += t; }
    const float ex = inc - s; float* acp = AC + (size_t)it * 128 + 2 * lane; acp[0] = ex + v0; acp[1] = ex + v0 + v1;
    if (lane == 63) CDEC[it] = __expf(inc);
}
__device__ __forceinline__ bf16x8 scale8(v4u w, const float* s) {
    v4u o; o.x = pk2(bflo(w.x) * s[0], bfhi(w.x) * s[1]); o.y = pk2(bflo(w.y) * s[2], bfhi(w.y) * s[3]); o.z = pk2(bflo(w.z) * s[4], bfhi(w.z) * s[5]); o.w = pk2(bflo(w.w) * s[6], bfhi(w.w) * s[7]);
    return __builtin_bit_cast(bf16x8, o); }
__device__ __forceinline__ void states_item(Frame& F, int it2, const bf16* XT, const bf16* BTm, const float* DTS, const float* AC, bf16* ST) {
    LAS float* wl = (LAS float*)(F.lds + RING_OFF + F.wave * 1024);
    { const int it = it2 >> 1, nh = it2 & 1, bc = it >> 4, h = it & 15, g = h >> 3;
        int lane_ = F.lane; asm volatile("" : "+v"(lane_));
        const int r32 = lane_ & 31, hi = lane_ >> 5;
        const bf16* xt = XT + (size_t)it * 64 * 128 + (size_t)r32 * 128 + 8 * hi; const bf16* bt = BTm + ((size_t)bc * 2 + g) * 128 * 128 + (size_t)(64 * nh + r32) * 128 + 8 * hi;
        { const float acl = AC[(size_t)it * 128 + 127]; const float2 d2 = *(const float2*)(DTS + (size_t)it * 128 + 2 * lane_), a2 = *(const float2*)(AC + (size_t)it * 128 + 2 * lane_);
          wl[2 * lane_] = d2.x * __expf(acl - a2.x); wl[2 * lane_ + 1] = d2.y * __expf(acl - a2.y); }
        f32x16 acc[2][2];
#pragma unroll
        for (int a = 0; a < 2; ++a) { acc[a][0] = f32x16{}; acc[a][1] = f32x16{}; }
#pragma unroll 1
        for (int kh = 0; kh < 2; ++kh) { v4u xa[4][2], ba[4][2];
#pragma unroll
            for (int ks = 0; ks < 4; ++ks)
#pragma unroll
                for (int b2 = 0; b2 < 2; ++b2) { xa[ks][b2] = *(const GAS v4u*)(xt + (size_t)(32 * b2) * 128 + 16 * (4 * kh + ks)); ba[ks][b2] = *(const GAS v4u*)(bt + (size_t)(32 * b2) * 128 + 16 * (4 * kh + ks)); }
#pragma unroll
            for (int ks = 0; ks < 4; ++ks) { float wv[8];
                { const f32x4 w0 = *(const LAS f32x4*)(wl + 16 * (4 * kh + ks) + 8 * hi), w1 = *(const LAS f32x4*)(wl + 16 * (4 * kh + ks) + 8 * hi + 4);
#pragma unroll
                  for (int e = 0; e < 4; ++e) { wv[e] = w0[e]; wv[4 + e] = w1[e]; } }
                bf16x8 xf[2];
#pragma unroll
                for (int pb = 0; pb < 2; ++pb) xf[pb] = scale8(xa[ks][pb], wv);
#pragma unroll
                for (int nb = 0; nb < 2; ++nb) { const bf16x8 bfv = __builtin_bit_cast(bf16x8, ba[ks][nb]);
#pragma unroll
                    for (int pb = 0; pb < 2; ++pb) acc[nb][pb] = MFMA32(bfv, xf[pb], acc[nb][pb]); } } }
        bf16* st = ST + (size_t)it * 64 * 128 + 64 * nh;
#pragma unroll
        for (int nb = 0; nb < 2; ++nb)
#pragma unroll
            for (int pb = 0; pb < 2; ++pb)
#pragma unroll
                for (int g4 = 0; g4 < 4; ++g4) { v2u w; w.x = pk2(acc[nb][pb][4 * g4], acc[nb][pb][4 * g4 + 1]); w.y = pk2(acc[nb][pb][4 * g4 + 2], acc[nb][pb][4 * g4 + 3]);
                    *(GAS v2u*)(st + (size_t)(32 * pb + r32) * 128 + 32 * nb + 8 * g4 + 4 * hi) = w; }
    }
}
__device__ __forceinline__ void ssd_conv_states(Frame& F, const bf16* XBC, const float* dtraw, const float* conv_w, const float* conv_b, const float* dt_bias, const float* a_log,
                                                bf16* XT, bf16* Bm, bf16* BTm, bf16* Cm, float* DTS, float* AC, float* CDEC, bf16* ST) {
    for (int pr = blockIdx.x; pr < NBC * 2; pr += F.G) { const int bc = pr >> 1, hh = pr & 1;
#pragma unroll 1
        for (int k = F.wave; k < 32; k += NWAVES) {
            if (k < 16) conv_item(F.lane, bc, 16 * hh + k, XBC, conv_w, conv_b, XT, Bm, BTm, Cm);
            else if (k < 20) conv_item(F.lane, bc, 32 + 4 * hh + (k - 16), XBC, conv_w, conv_b, XT, Bm, BTm, Cm);
            else if (k < 24) conv_item(F.lane, bc, 40 + 4 * hh + (k - 20), XBC, conv_w, conv_b, XT, Bm, BTm, Cm);
            else dt_item(F.lane, bc * 16 + 8 * hh + (k - 24), dtraw, dt_bias, a_log, DTS, AC, CDEC); }
        asm volatile("s_waitcnt vmcnt(0)" ::: "memory");
        if (F.tid == 0) { __builtin_amdgcn_fence(__ATOMIC_ACQUIRE, "agent"); asm volatile("s_waitcnt vmcnt(0)" ::: "memory"); }
        __syncthreads();
#pragma unroll 1
        for (int k = F.wave; k < 16; k += NWAVES) states_item(F, ((bc * 16 + 8 * hh + (k >> 1)) << 1) | (k & 1), XT, BTm, DTS, AC, ST);
        __syncthreads();
    }
}
__device__ __forceinline__ void ssd_scan(Frame& F, bf16* ST, const float* CDEC) {
    constexpr int PER_B = 16 * 64 * 128 / 2;
    for (int T = blockIdx.x * (NWAVES * 64) + F.tid; T < BATCH * PER_B; T += F.G * NWAVES * 64) { const int b = T / PER_B, e = T % PER_B, h = e / (64 * 128 / 2);
        GAS unsigned* p = (GAS unsigned*)ST + (size_t)b * NCHUNK * PER_B + e; unsigned v[NCHUNK];
#pragma unroll
        for (int c = 0; c < NCHUNK; ++c) v[c] = p[(size_t)c * PER_B];
        float r0 = 0.f, r1 = 0.f;
#pragma unroll
        for (int c = 0; c < NCHUNK; ++c) { const float dec = CDEC[(b * NCHUNK + c) * 16 + h]; p[(size_t)c * PER_B] = pk2(r0, r1); r0 = r0 * dec + bflo(v[c]); r1 = r1 * dec + bfhi(v[c]); }
    }
}
template <int PM  > __device__ __forceinline__ void ssd_out(Frame& F, const bf16* XT, const bf16* Bm, const bf16* Cm, const bf16* ST, const float* DTS, const float* AC, const bf16* Z,
                                        const float* d_skip, const float* norm_g, bf16* YCAT) {
    constexpr int CP = 136;
    LAS bf16* CmS = (LAS bf16*)(F.lds + RING_OFF);
    LAS bf16* BmS = CmS + 128 * CP;
    LAS float* CBs = (LAS float*)(BmS);
    LAS float* acl = (LAS float*)(F.lds + RING_OFF + 34816 + 67584);
    LAS float* dtl = acl + 8 * 128;
    LAS float* red = dtl + 8 * 128;
    LAS float* rsd = red + 8 * 128;
    for (int it = blockIdx.x; it < NBC * 2; it += F.G) {
        int lane_ = F.lane; asm volatile("" : "+v"(lane_));
        const int r32 = lane_ & 31, hi = lane_ >> 5, w = F.wave;
        const int bc = it >> 1, g = it & 1, h = 8 * g + w; const size_t t0 = (size_t)bc * 128;
        __syncthreads();
        { const GAS v4u* cg_ = (const GAS v4u*)(Cm + (size_t)it * 128 * 128); const GAS v4u* bg_ = (const GAS v4u*)(Bm + (size_t)it * 128 * 128);
#pragma unroll
          for (int q = 0; q < 4; ++q) { const int idx = F.tid + 512 * q, row = idx >> 4, c16 = idx & 15;
              const v4u cv = cg_[idx], bv = bg_[idx];
              *(LAS v4u*)(CmS + row * CP + c16 * 8) = cv; *(LAS v4u*)(BmS + row * CP + c16 * 8) = bv; }
          for (int i = F.tid; i < 1024; i += NWAVES * 64) { acl[i] = AC[((size_t)bc * 16 + 8 * g) * 128 + i] * LOG2E; dtl[i] = DTS[((size_t)bc * 16 + 8 * g) * 128 + i]; } }
        __syncthreads();
        { f32x16 cbt[2];
#pragma unroll
          for (int tt = 0; tt < 2; ++tt) { const int ib = (2 * w + tt) >> 2, jb = (2 * w + tt) & 3; cbt[tt] = f32x16{};
            if (jb <= ib) {
#pragma unroll
                for (int ks = 0; ks < 8; ++ks) { const int n0 = 16 * ks + 8 * hi;
                    const bf16x8 a = *(const LAS bf16x8*)(CmS + (32 * ib + r32) * CP + n0), b = *(const LAS bf16x8*)(BmS + (32 * jb + r32) * CP + n0);
                    cbt[tt] = MFMA32(a, b, cbt[tt]); } } }
          __syncthreads();
#pragma unroll
          for (int tt = 0; tt < 2; ++tt) { const int ib = (2 * w + tt) >> 2, jb = (2 * w + tt) & 3;
            if (jb <= ib) {
#pragma unroll
                for (int r = 0; r < 16; ++r) CBs[(32 * ib + crow(r, hi)) * 132 + 32 * jb + r32] = cbt[tt][r]; } } }
        __syncthreads();
        const LAS float* ach = acl + w * 128; const LAS float* dth = dtl + w * 128;
        const float dsk = d_skip[h];
        if (PM == 1) continue;
        const int prm = (r32 & 3) + 4 * ((r32 >> 3) & 1) + 8 * ((r32 >> 2) & 1) + 16 * (r32 >> 4);
        const bf16* xt = XT + ((size_t)bc * 16 + h) * 64 * 128 + (size_t)prm * 128 + 8 * hi; const bf16* hin = ST + ((size_t)bc * 16 + h) * 64 * 128 + (size_t)prm * 128 + 8 * hi;
        v4u hf[8][2], xf[8][2];
#pragma unroll
        for (int ks = 0; ks < 8; ++ks)
#pragma unroll
            for (int pb = 0; pb < 2; ++pb) { hf[ks][pb] = *(const GAS v4u*)(hin + (size_t)(32 * pb) * 128 + 16 * ks); xf[ks][pb] = *(const GAS v4u*)(xt + (size_t)(32 * pb) * 128 + 16 * ks); }
#pragma unroll 1
        for (int ib = 0; ib < 4; ++ib) { const int i = 32 * ib + r32; const float aci = ach[i];
            int hj = 8 * hi; asm volatile("" : "+v"(hj));
            const bf16* zp = Z + (t0 + i) * 1024 + h * 64 + 8 * hi; v4u zq[2][2];
#pragma unroll
            for (int pb = 0; pb < 2; ++pb)
#pragma unroll
                for (int g2 = 0; g2 < 2; ++g2) zq[pb][g2] = *(const GAS v4u*)(zp + 32 * pb + 16 * g2);
            f32x16 acc0 = f32x16{}, acc1 = f32x16{};
            { const float ei = __builtin_amdgcn_exp2f(aci); float es[8];
#pragma unroll
              for (int e = 0; e < 8; ++e) es[e] = ei;
#pragma unroll
              for (int ks = 0; ks < 8; ++ks) { const bf16x8 bfv = scale8(*(const LAS v4u*)(CmS + i * CP + 16 * ks + hj), es);
                acc0 = MFMA32(__builtin_bit_cast(bf16x8, hf[ks][0]), bfv, acc0); acc1 = MFMA32(__builtin_bit_cast(bf16x8, hf[ks][1]), bfv, acc1); } }
#pragma unroll
            for (int ks = 0; ks < 8; ++ks) if (ks < 2 * ib + 2) { const int j0 = 16 * ks + hj; float m[8];
                { const f32x4 c0 = *(const LAS f32x4*)(CBs + i * 132 + j0), c1 = *(const LAS f32x4*)(CBs + i * 132 + j0 + 4);
                  const f32x4 a0 = *(const LAS f32x4*)(ach + j0), a1 = *(const LAS f32x4*)(ach + j0 + 4), d0 = *(const LAS f32x4*)(dth + j0), d1 = *(const LAS f32x4*)(dth + j0 + 4);
#pragma unroll
                  for (int e = 0; e < 4; ++e) { m[e] = c0[e] * __builtin_amdgcn_exp2f(aci - a0[e]) * d0[e]; m[4 + e] = c1[e] * __builtin_amdgcn_exp2f(aci - a1[e]) * d1[e]; }
                  if (ks >= 2 * ib) {
#pragma unroll
                      for (int e = 0; e < 8; ++e) { m[e] = (j0 + e <= i) ? m[e] : 0.f; if (j0 + e == i) m[e] += dsk; } } }
                v4u pw; pw.x = pk2(m[0], m[1]); pw.y = pk2(m[2], m[3]); pw.z = pk2(m[4], m[5]); pw.w = pk2(m[6], m[7]);
                const bf16x8 mf = __builtin_bit_cast(bf16x8, pw);
                acc0 = MFMA32(__builtin_bit_cast(bf16x8, xf[ks][0]), mf, acc0); acc1 = MFMA32(__builtin_bit_cast(bf16x8, xf[ks][1]), mf, acc1); }
            float ss = 0.f;
#pragma unroll
            for (int pb = 0; pb < 2; ++pb)
#pragma unroll
                for (int g2 = 0; g2 < 2; ++g2) { const v4u z = zq[pb][g2]; const float zv[8] = {bflo(z.x), bfhi(z.x), bflo(z.y), bfhi(z.y), bflo(z.z), bfhi(z.z), bflo(z.w), bfhi(z.w)};
#pragma unroll
                    for (int e = 0; e < 8; ++e) { const float y = (pb ? acc1[8 * g2 + e] : acc0[8 * g2 + e]) * silu(zv[e]); ss += y * y; if (pb) acc1[8 * g2 + e] = y; else acc0[8 * g2 + e] = y; } }
            ss += __shfl_xor(ss, 32);
            if (PM == 2) { asm volatile("" :: "v"(ss)); continue; }
            if (hi == 0) red[w * 32 + r32] = ss;
            __syncthreads();
            if (F.tid < 32) { float s = 0.f;
#pragma unroll
                for (int ww = 0; ww < 8; ++ww) s += red[ww * 32 + F.tid];
                rsd[F.tid] = rsqrtf(s * (1.f / 512.f) + EPS); }
            __syncthreads();
            const float rs = rsd[r32]; const float* gp = norm_g + h * 64 + 8 * hi; bf16* yp = YCAT + (t0 + i) * 2048 + h * 64 + 8 * hi;
#pragma unroll
            for (int pb = 0; pb < 2; ++pb)
#pragma unroll
                for (int g2 = 0; g2 < 2; ++g2) { const f32x4 g0 = *(const GAS f32x4*)(gp + 32 * pb + 16 * g2), g1 = *(const GAS f32x4*)(gp + 32 * pb + 16 * g2 + 4); float y[8];
#pragma unroll
                    for (int e = 0; e < 8; ++e) y[e] = (pb ? acc1[8 * g2 + e] : acc0[8 * g2 + e]) * rs;
                    v4u o; o.x = pk2(y[0] * g0[0], y[1] * g0[1]); o.y = pk2(y[2] * g0[2], y[3] * g0[3]); o.z = pk2(y[4] * g1[0], y[5] * g1[1]); o.w = pk2(y[6] * g1[2], y[7] * g1[3]);
                    *(GAS v4u*)(yp + 32 * pb + 16 * g2) = o; }
        }
    }
}
__device__ __forceinline__ void subln_row(const v4u a, const v4u b, const float* gq, GAS v4u* p) {
    float v[16] = {bflo(a.x), bfhi(a.x), bflo(a.y), bfhi(a.y), bflo(a.z), bfhi(a.z), bflo(a.w), bfhi(a.w), bflo(b.x), bfhi(b.x), bflo(b.y), bfhi(b.y), bflo(b.z), bfhi(b.z), bflo(b.w), bfhi(b.w)};
    float s = 0.f;
#pragma unroll
    for (int e = 0; e < 16; ++e) s += v[e] * v[e];
    s += __shfl_xor(s, 1); s += __shfl_xor(s, 2); s += __shfl_xor(s, 4);
    const float rs = rsqrtf(s * (1.f / 128.f) + EPS);
#pragma unroll
    for (int e = 0; e < 16; ++e) v[e] *= rs * gq[e];
    v4u oa, ob; oa.x = pk2(v[0], v[1]); oa.y = pk2(v[2], v[3]); oa.z = pk2(v[4], v[5]); oa.w = pk2(v[6], v[7]); ob.x = pk2(v[8], v[9]); ob.y = pk2(v[10], v[11]); ob.z = pk2(v[12], v[13]); ob.w = pk2(v[14], v[15]);
    p[0] = oa; p[1] = ob; }
__device__ __forceinline__ void attn_subln(Frame& F, bf16* YCAT, const float* subln_g) {
    const int d0 = (F.lane & 7) * 16; float gq[16];
#pragma unroll
    for (int e = 0; e < 16; ++e) gq[e] = subln_g[d0 + e] * (1.0f - LAM_INIT);
#pragma unroll 1
    for (int m = F.gw; m < M; m += 2 * F.NGW) { const bool two = m + F.NGW < M; const int m1 = two ? m + F.NGW : m;
        GAS v4u* p0 = (GAS v4u*)(YCAT + (size_t)m * 2048 + 1024 + F.lane * 16); GAS v4u* p1 = (GAS v4u*)(YCAT + (size_t)m1 * 2048 + 1024 + F.lane * 16);
        const v4u a0 = p0[0], b0 = p0[1], a1 = p1[0], b1 = p1[1];
        subln_row(a0, b0, gq, p0); if (two) subln_row(a1, b1, gq, p1); }
}
#ifndef MK_PER_PHASE
#define MK_PER_PHASE 0
#endif
#ifndef MK_CG_SYNC
#define MK_CG_SYNC 0
#endif
constexpr int N_PHASES = 17;
#ifndef ATTN_FORM
#define ATTN_FORM 2
#endif
#ifndef PROBE_SSD_MODE
#define PROBE_SSD_MODE 0
#endif
#ifndef PROBE_EXTRA_BARS
#define PROBE_EXTRA_BARS 0
#endif
#ifndef PROBE_DUP
#define PROBE_DUP 0
#endif
struct Args { const float* in[30]; float* out; unsigned char* ws; int ph_lo, ph_hi; };
enum InIdx { I_X = 0, I_C, I_WADA, I_BADA, I_F1PRE, I_F1POST, I_F1WG, I_F1WU, I_F1WD, I_MPRE, I_MPOST, I_WIN, I_CONVW, I_CONVB, I_DTB, I_ALOG, I_DSKIP, I_SSDG,
             I_LQ1, I_LK1, I_LQ2, I_LK2, I_SUBLN, I_WOUT, I_F2PRE, I_F2POST, I_F2WG, I_F2WU, I_F2WD, I_RELB };

__global__ void __launch_bounds__(NWAVES * 64, 2) layer_fwd(Args args) {
    extern __shared__ __attribute__((aligned(16))) unsigned char lds[];
    Frame F;
    F.lds = (LAS unsigned char*)lds;
    F.tid = threadIdx.x; F.lane = F.tid & 63; F.wave = __builtin_amdgcn_readfirstlane(F.tid >> 6);
    F.G = gridDim.x; { const int bx = blockIdx.x; F.vcu = (F.G % 8 == 0) ? (bx % 8) * (F.G / 8) + bx / 8 : bx; }
    F.gw = F.vcu * NWAVES + F.wave; F.NGW = F.G * NWAVES;
    unsigned char* ws = args.ws;
#define MOD ((float*)(ws + WS_MOD))
#define DTRAW ((float*)(ws + WS_DTRAW))
#define DTS ((float*)(ws + WS_DTS))
#define ACm ((float*)(ws + WS_AC))
#define CDEC ((float*)(ws + WS_CDEC))
#define WA ((bf16*)(ws + WS_WA))
#define WB ((bf16*)(ws + WS_WB))
#define H ((bf16*)(ws + WS_H))
#define ACT ((bf16*)(ws + WS_ACT))
#define Dm ((bf16*)(ws + WS_D))
#define Qb ((bf16*)(ws + WS_Q))
#define Kb ((bf16*)(ws + WS_K))
#define Vb ((bf16*)(ws + WS_V))
#define YCAT ((bf16*)(ws + WS_YCAT))
#define Zb ((bf16*)(ws + WS_Z))
#define XBC ((bf16*)(ws + WS_XBC))
#define XT ((bf16*)(ws + WS_XT))
#define Bm ((bf16*)(ws + WS_BM))
#define BTm ((bf16*)(ws + WS_BT))
#define Cm ((bf16*)(ws + WS_CM))
#define ST ((bf16*)(ws + WS_ST))
#define D2 ((bf16*)(ws + WS_D2))
#define WC_IN ((bf16*)((unsigned char*)out + 32 * MiB))
#define WC_OUT ((bf16*)((unsigned char*)out + 32 * MiB) + (size_t)NIN * DM)
#define WC_GU2 (WC_OUT + (size_t)DM * KOUT)
#define WC_D2 (WC_GU2 + (size_t)NGU * DM)
#define X1B ((bf16*)out)
#define X2B ((bf16*)(ws + WS_X2))
    float* out = args.out;
#if MK_CG_SYNC
    cg::grid_group grid = cg::this_grid();
#define GRID_BAR() grid.sync()
#else
    for (int u = F.tid; u < (LDS_BYTES - LDSCTL_OFF) / 4; u += NWAVES * 64) ((LAS unsigned*)(F.lds + LDSCTL_OFF))[u] = 0u;
    __syncthreads();
    XcdBarrier bar = xcd_barrier_post((unsigned*)(ws + WS_CTL) + CW_BAR, (volatile LAS unsigned*)(F.lds + MISC_OFF) + 8);
#define GRID_BAR() xcd_barrier(bar)
#endif
    const int lo = args.ph_lo, hi = args.ph_hi;
#ifndef PH_MASK
#define PH_MASK 0x1FFFF
#endif
#define IN(k) (((PH_MASK >> (k)) & 1) && lo <= (k) && (k) < hi)
#define SEAM(k) do { if (IN(k) && IN((k) + 1)) GRID_BAR(); } while (0)
#define PHASE(k, ...) if (IN(k)) { const bool second_ = false; (void)second_; __VA_ARGS__ } if (((PROBE_DUP >> (k)) & 1) && IN(k)) { const bool second_ = true; (void)second_; GRID_BAR(); __VA_ARGS__ }

    PHASE(0,
        { convert_ffn(F, args.in[I_F1WG], args.in[I_F1WU], args.in[I_F1WD], WA, WB); mod_gemv(F, args.in[I_C], args.in[I_WADA], args.in[I_BADA], MOD); }
    )
    SEAM(0);
    PHASE(1,
        rows_first(F, args.in[I_X], args.in[I_F1PRE], MOD, 0, H);
    )
    SEAM(1);
    PHASE(2,
        { pg8::Gemm g{H, WA, M, NGU, DM}; pg8::StaticOrder S; S.init(M, NGU, F.G, (int)blockIdx.x); pg8::EpiSwiglu E{ACT, DFF};
        pg8::gemm_phase<pg8::EpiSwiglu, pg8::StaticOrder, true, true>(F.lds + RING_OFF, g, S, E);
        }
    )
    SEAM(2);
    PHASE(3,
        { pg8::Gemm g{ACT, WB, M, DM, DFF}; pg8::StaticOrder S; S.init(M, DM, F.G, (int)blockIdx.x); pg8::EpiBf16<0> E{Dm, DM, nullptr, 0, 0, 1.f};
        pg8::gemm_phase<pg8::EpiBf16<0>, pg8::StaticOrder, true, true>(F.lds + RING_OFF, g, S, E); }
    )
    SEAM(3);
    PHASE(4,
        { rows_res<true, false, true>(F, args.in[I_X], Dm, args.in[I_F1POST], MOD, 2, 0.5f, X1B, args.in[I_MPRE], 3, H); convert_mix(F, F.gw, F.NGW, args.in[I_WIN], args.in[I_WOUT], WC_IN, WC_OUT); }
    )
    SEAM(4);
    PHASE(5,
        { pg8::Gemm g{H, WC_IN, M, NQKV, DM}; pg8::StaticOrder S; S.init(M, NQKV, F.G, (int)blockIdx.x);
        pg8::EpiQKV E{Qb, DM, (size_t)(WS_K - WS_Q) / 2, attn_body::C2, (unsigned*)(ws + WS_CTL) + CW_KMAX};
        pg8::gemm_phase<pg8::EpiQKV, pg8::StaticOrder, true, true>(F.lds + RING_OFF, g, S, E); }
    )
    SEAM(5);
    PHASE(6,
        float lam;
        { const float q1 = args.in[I_LQ1][F.lane] * args.in[I_LK1][F.lane], q2 = args.in[I_LQ2][F.lane] * args.in[I_LK2][F.lane];
          lam = __expf(wave_sum(q1)) - __expf(wave_sum(q2)) + LAM_INIT; lam = __builtin_bit_cast(float, __builtin_amdgcn_readfirstlane(__builtin_bit_cast(int, lam))); }
#if ATTN_FORM == 2
        const attn2::Tensors AT{(const attn_body::bf16*)Qb, (const attn_body::bf16*)Kb, (const attn_body::bf16*)Vb, (attn_body::bf16*)YCAT, lam, args.in[I_RELB], args.in[I_SUBLN], (const float*)((const unsigned*)(ws + WS_CTL) + CW_KMAX)};
        attn2::phase<8>((char*)lds + RING_OFF, AT, (int)F.G, (int)blockIdx.x);
#else
        const attn_body::AttnTensors AT{(const attn_body::bf16*)Qb, (const attn_body::bf16*)Kb, (const attn_body::bf16*)Vb, (attn_body::bf16*)YCAT, lam, args.in[I_RELB]};
        const attn_body::StaticOrder S((int)F.G, (int)blockIdx.x);
        attn_body::attn_phase<attn_body::StaticOrder>((char*)lds + RING_OFF, AT, S);
#endif
    )
    SEAM(6);
    PHASE(7,
        { pg8::Gemm g{H, WC_IN + (size_t)NQKV * DM, M, NMIX, DM}; pg8::StaticOrder S; S.init(M, NMIX, F.G, (int)blockIdx.x); pg8::EpiMix E{Zb, XBC, DTRAW};
        pg8::gemm_phase<pg8::EpiMix, pg8::StaticOrder, true, true>(F.lds + RING_OFF, g, S, E);
        if (!second_ && F.G == 256 && blockIdx.x >= 192) convert_gu_half(F, ((int)blockIdx.x - 192) * NWAVES + F.wave, 64 * NWAVES, args.in[I_F2WG], 0, WC_GU2); }
    )
    SEAM(7);
    PHASE(8,
        ssd_conv_states(F, XBC, DTRAW, args.in[I_CONVW], args.in[I_CONVB], args.in[I_DTB], args.in[I_ALOG], XT, Bm, BTm, Cm, DTS, ACm, CDEC, ST);
    )
    SEAM(9);
    PHASE(10,
        ssd_scan(F, ST, CDEC);
    )
    SEAM(10);
    PHASE(11,
        { if (!second_) { ssd_out<0>(F, XT, Bm, Cm, ST, DTS, ACm, Zb, args.in[I_DSKIP], args.in[I_SSDG], YCAT); if (ATTN_FORM != 2) attn_subln(F, YCAT, args.in[I_SUBLN]); }
          else ssd_out<PROBE_SSD_MODE>(F, XT, Bm, Cm, ST, DTS, ACm, Zb, args.in[I_DSKIP], args.in[I_SSDG], YCAT); }
    )
    SEAM(11);
    PHASE(12,
        { pg8::Gemm g{YCAT, WC_OUT, M, DM, KOUT}; pg8::StaticOrder S; S.init(M, DM, F.G, (int)blockIdx.x); pg8::EpiBf16<0> E{D2, DM, nullptr, 0, 0, 1.f};
        pg8::gemm_phase<pg8::EpiBf16<0>, pg8::StaticOrder, true, true>(F.lds + RING_OFF, g, S, E); }
    )
    SEAM(12);
    PHASE(13,
        { rows_res<true, true, true>(F, X1B, D2, args.in[I_MPOST], MOD, 5, 1.0f, X2B, args.in[I_F2PRE], 6, H); convert_gu_half(F, F.gw, F.NGW, args.in[I_F2WU], 1, WC_GU2);
          if (F.G != 256) { convert_gu_half(F, F.gw, F.NGW, args.in[I_F2WG], 0, WC_GU2); convert_down(F, F.gw, F.NGW, args.in[I_F2WD], WC_D2); } }
    )
    SEAM(13);
    PHASE(14,
        { pg8::Gemm g{H, WC_GU2, M, NGU, DM}; pg8::StaticOrder S; S.init(M, NGU, F.G, (int)blockIdx.x); pg8::EpiSwiglu E{ACT, DFF};
        pg8::gemm_phase<pg8::EpiSwiglu, pg8::StaticOrder, true, true>(F.lds + RING_OFF, g, S, E);
        if (!second_ && F.G == 256 && blockIdx.x >= 128) convert_down(F, ((int)blockIdx.x - 128) * NWAVES + F.wave, 128 * NWAVES, args.in[I_F2WD], WC_D2); }
    )
    SEAM(14);
    PHASE(15,
        { pg8::Gemm g{ACT, WC_D2, M, DM, DFF}; pg8::StaticOrder S; S.init(M, DM, F.G, (int)blockIdx.x); pg8::EpiBf16<0> E{Dm, DM, nullptr, 0, 0, 1.f};
        pg8::gemm_phase<pg8::EpiBf16<0>, pg8::StaticOrder, true, true>(F.lds + RING_OFF, g, S, E); }
    )
    SEAM(15);
    PHASE(16,
        rows_res<false, true, false>(F, X2B, Dm, args.in[I_F2POST], MOD, 8, 0.5f, out, nullptr, 0, nullptr);
    )
#if PROBE_EXTRA_BARS
    for (int q_ = 0; q_ < PROBE_EXTRA_BARS; ++q_) GRID_BAR();
#endif
#undef IN
#undef SEAM
}

extern "C" void kernel_launch(void* const* d_in, const int* in_sizes, int n_in, void* d_out, int out_size, void* d_ws, size_t ws_size, hipStream_t stream) {
    static int grid = 0;
    if (grid == 0) {
        if (n_in != 30 || in_sizes[0] != M * DM || out_size != M * DM || ws_size < WS_END) { fprintf(stderr, "kernel_launch: unexpected shapes (n_in %d, in0 %d, out %d, ws %zu); nothing launched\n", n_in, n_in > 0 ? in_sizes[0] : -1, out_size, ws_size); grid = -1; return; }
        int dev = 0, cus = 0, per_cu = 0;
        if (hipGetDevice(&dev) != hipSuccess || hipDeviceGetAttribute(&cus, hipDeviceAttributeMultiprocessorCount, dev) != hipSuccess) { grid = -1; return; }
        if (hipFuncSetAttribute((const void*)layer_fwd, hipFuncAttributeMaxDynamicSharedMemorySize, LDS_BYTES) != hipSuccess) { fprintf(stderr, "kernel_launch: hipFuncSetAttribute failed\n"); grid = -1; return; }
        if (hipOccupancyMaxActiveBlocksPerMultiprocessor(&per_cu, (const void*)layer_fwd, NWAVES * 64, LDS_BYTES) != hipSuccess || per_cu < 1) { fprintf(stderr, "kernel_launch: occupancy query says %d blocks per CU\n", per_cu); per_cu = 1; }
        (void)hipGetLastError();
        grid = cus;
        if (grid % 8 != 0 || grid > 256) fprintf(stderr, "kernel_launch: note: %d CUs\n", grid);
    }
    if (grid < 0) return;
    (void)hipMemsetAsync((char*)d_ws + WS_CTL, 0, CTL_ZERO_BYTES, stream);
    Args a{};
    for (int i = 0; i < 30; ++i) a.in[i] = (const float*)d_in[i];
    a.out = (float*)d_out; a.ws = (unsigned char*)d_ws;
#if MK_PER_PHASE
    for (int p = 0; p < N_PHASES; ++p) { a.ph_lo = p; a.ph_hi = p + 1; void* kargs[] = {&a};
        hipError_t e = hipLaunchCooperativeKernel((const void*)layer_fwd, dim3(grid), dim3(NWAVES * 64), kargs, LDS_BYTES, stream);
        if (e != hipSuccess) { fprintf(stderr, "kernel_launch: phase %d launch failed: %s\n", p, hipGetErrorString(e)); break; } }
#else
    a.ph_lo = 0; a.ph_hi = N_PHASES; void* kargs[] = {&a};
    hipError_t e = hipLaunchCooperativeKernel((const void*)layer_fwd, dim3(grid), dim3(NWAVES * 64), kargs, LDS_BYTES, stream);
    if (e != hipSuccess) fprintf(stderr, "kernel_launch: cooperative launch failed: %s (grid %d)\n", hipGetErrorString(e), grid);
#endif
}
```

```cpp
#include <hip/hip_runtime.h>
#include <hip/hip_cooperative_groups.h>
#include <hip/hip_bf16.h>
#include <cstdio>
#include <cstdint>
#include <cmath>
namespace cg = cooperative_groups;
namespace pg8 {
#define PG8_LAS __attribute__((address_space(3)))
typedef unsigned short bf16_t;
typedef short bf16x8 __attribute__((ext_vector_type(8)));
typedef float f32x4 __attribute__((ext_vector_type(4)));
typedef unsigned u32x4 __attribute__((ext_vector_type(4)));
constexpr int BM = 256, BK = 64, HALF = 128, HTB = HALF * BK * 2  , STAGE_BYTES = 8 * HTB, NXCD = 8, WGM = 8;

__host__ __device__ __forceinline__ int lds_byte(int r, int c) { const int st = (r >> 4) * 2 + (c >> 5), rr = r & 15, cc = c & 31, ob = rr * 64 + cc * 2; return st * 1024 + (ob ^ (((ob >> 9) & 1) << 5)); }
__host__ __device__ __forceinline__ void stage_rc(int b, int& R, int& C) { const int st = b / 1024, sb = b % 1024, swz = sb ^ (((sb >> 9) & 1) << 5); R = (st >> 1) * 16 + swz / 64; C = (st & 1) * 32 + (swz % 64) / 2; }
__host__ __device__ __forceinline__ int perm32(int rho) { const int n = rho >> 4, i = rho & 15; return 8 * (i >> 2) + 4 * n + (i & 3); }

struct Unit { int pm, pn; };
struct Gemm { const bf16_t* A; const bf16_t* Bt; int M, N, K; };

struct StaticOrder {
    int nM, nN, nwg, G, c;
    __host__ __device__ void init(int M, int N, int G_, int c_) { nM = M / BM; nN = N / BM; nwg = nM * nN; G = G_; c = c_; }
    __host__ __device__ bool next(int i, Unit& u) const {
        const long L = (long)i * G + c; if (L >= nwg) return false;
        int wgid = (int)L; { const int q = nwg / NXCD, r = nwg % NXCD, xcd = wgid % NXCD, off = wgid / NXCD; wgid = (xcd < r ? xcd * (q + 1) : r * (q + 1) + (xcd - r) * q) + off; }
        const int nig = WGM * nN, gid = wgid / nig, fm = gid * WGM, gsz = (nM - fm) < WGM ? (nM - fm) : WGM;
        u.pm = fm + ((wgid % nig) % gsz); u.pn = (wgid % nig) / gsz; return true;
    }
    __device__ __forceinline__ void a_ready(const Unit&) const {}
    __device__ __forceinline__ void done(const Unit&) const {}
};

__device__ __forceinline__ unsigned cvt_pk_bf16(float lo, float hi) { unsigned r; asm volatile("v_cvt_pk_bf16_f32 %0, %1, %2" : "=v"(r) : "v"(lo), "v"(hi)); return r; }
__device__ __forceinline__ void st16_wt(void* ptr, u32x4 v) { asm volatile("global_store_dwordx4 %0, %1, off sc1\n\ts_nop 1" :: "v"(ptr), "v"(v) : "memory"); }
typedef float f32x2 __attribute__((ext_vector_type(2)));
__device__ __forceinline__ f32x2 gelu_pk(f32x2 v) {
    const f32x2 av = __builtin_elementwise_abs(v), d = av * 0.2316418882f + 1.0f;
    f32x2 t; t.x = __builtin_amdgcn_rcpf(d.x); t.y = __builtin_amdgcn_rcpf(d.y);
    f32x2 q = t * 0.5307027145f + (-0.7265760135f); q = q * t + 0.7107068705f; q = q * t + (-0.142248368f); q = q * t + 0.127414796f; q = q * t;
    const f32x2 s = (v * v) * (-0.72134752044f);
    f32x2 e; e.x = __builtin_amdgcn_exp2f(s.x); e.y = __builtin_amdgcn_exp2f(s.y);
    const f32x2 m = v * (q * e), r = v - m;
    f32x2 o; o.x = v.x < 0.f ? m.x : r.x; o.y = v.y < 0.f ? m.y : r.y; return o;
}

template <int ACT  > struct EpiBf16 {
    static constexpr bool PERM = true, AFTER_DRAIN = false; static_assert(ACT == 0 || ACT == 1, "EpiBf16: ACT is 0 (none) or 1 (gelu_pk)");
    bf16_t* O; int ldc; const float* bias; int split_cols; size_t split_stride; float scale0;
    __device__ __forceinline__ void operator()(const f32x4 (&acc)[2][2][4][2], const Unit& u, int wr, int wc, int fr, int fq) const {
        const int row0 = u.pm * BM + wr * 64 + fr; int colt = u.pn * BM; bf16_t* base = O;
        float sc = 1.f; if (split_cols) { const int t = colt / split_cols; base += (size_t)t * split_stride; colt -= t * split_cols; if (t == 0) sc = scale0; }
        const int col0 = colt + wc * 32 + 8 * fq, bcol0 = u.pn * BM + wc * 32 + 8 * fq;
        f32x4 bv[2][2];
#pragma unroll
        for (int bj = 0; bj < 2; ++bj)
#pragma unroll
            for (int n = 0; n < 2; ++n) bv[bj][n] = bias ? *(const f32x4*)(bias + bcol0 + bj * HALF + 4 * n) : (f32x4){0.f, 0.f, 0.f, 0.f};
#pragma unroll
        for (int ai = 0; ai < 2; ++ai)
#pragma unroll
            for (int m = 0; m < 4; ++m) { bf16_t* rowp = base + (size_t)(row0 + ai * HALF + m * 16) * ldc + col0;
#pragma unroll
                for (int bj = 0; bj < 2; ++bj) { f32x4 v0 = acc[ai][bj][m][0] + bv[bj][0], v1 = acc[ai][bj][m][1] + bv[bj][1];
                    if (ACT == 1) { f32x2 a = gelu_pk((f32x2){v0[0], v0[1]}), b = gelu_pk((f32x2){v0[2], v0[3]}), c = gelu_pk((f32x2){v1[0], v1[1]}), d = gelu_pk((f32x2){v1[2], v1[3]});
                        v0 = (f32x4){a.x, a.y, b.x, b.y}; v1 = (f32x4){c.x, c.y, d.x, d.y}; }
                    v0 = v0 * sc; v1 = v1 * sc; u32x4 w; w.x = cvt_pk_bf16(v0[0], v0[1]); w.y = cvt_pk_bf16(v0[2], v0[3]); w.z = cvt_pk_bf16(v1[0], v1[1]); w.w = cvt_pk_bf16(v1[2], v1[3]);
                    st16_wt(rowp + bj * HALF, w); } }
    }
};

struct PanelStats {
    unsigned* xbuf;
    unsigned* cnt;
    unsigned* tmo;
    int ntn; float eps;
    unsigned code;
    __device__ __forceinline__ bool run(const f32x4 (&v)[2][2][4][2], const Unit& u, int wr, int wc, int fr, int fq, PG8_LAS unsigned char* lds, int wid, int lane) const {
        typedef float f32x2v __attribute__((ext_vector_type(2)));
        PG8_LAS f32x2v* P = (PG8_LAS f32x2v*)lds;
        PG8_LAS f32x2v* S = (PG8_LAS f32x2v*)(lds + 8192);
        PG8_LAS unsigned* flag = (PG8_LAS unsigned*)(lds + 8192 + 2048);
#pragma unroll
        for (int ai = 0; ai < 2; ++ai)
#pragma unroll
            for (int m = 0; m < 4; ++m) {
                float s = 0.f;
#pragma unroll
                for (int bj = 0; bj < 2; ++bj)
#pragma unroll
                    for (int n = 0; n < 2; ++n) { const f32x4 x = v[ai][bj][m][n]; s += (x[0] + x[1]) + (x[2] + x[3]); }
                s += __shfl_xor(s, 16); s += __shfl_xor(s, 32);
                const float mw = s * (1.0f / 64.0f); float q = 0.f;
#pragma unroll
                for (int bj = 0; bj < 2; ++bj)
#pragma unroll
                    for (int n = 0; n < 2; ++n) { const f32x4 d = v[ai][bj][m][n] - mw; q += (d[0] * d[0] + d[1] * d[1]) + (d[2] * d[2] + d[3] * d[3]); }
                q += __shfl_xor(q, 16); q += __shfl_xor(q, 32);
                if (fq == 0) P[(ai * HALF + wr * 64 + m * 16 + fr) * 4 + wc] = (f32x2v){mw, q};
            }
        asm volatile("s_waitcnt lgkmcnt(0)" ::: "memory"); __builtin_amdgcn_s_barrier(); asm volatile("" ::: "memory");
#if defined(BROKEN_EXCHANGE_NO_WAIT)
#warning BROKEN CONTROL BUILD: the row-statistics exchange does not wait; results are wrong by design
        if (blockIdx.x >= 64) { const long long t0_ = clock64(); while (clock64() - t0_ < 60000) __builtin_amdgcn_s_sleep(8); }
#endif
        const int row = wid * 32 + (lane & 31);
        if (lane < 32) {
            const f32x2v a = P[row * 4 + 0], b = P[row * 4 + 1], c = P[row * 4 + 2], d = P[row * 4 + 3];
            const float mt = (a.x + b.x + c.x + d.x) * 0.25f;
            const float da = a.x - mt, db = b.x - mt, dc = c.x - mt, dd = d.x - mt;
            const float m2 = (a.y + b.y) + (c.y + d.y) + 64.0f * ((da * da + db * db) + (dc * dc + dd * dd));
            unsigned long long* slot = (unsigned long long*)xbuf + ((size_t)(u.pm * BM + row) * 4 + u.pn);
            __hip_atomic_store(slot, ((unsigned long long)__float_as_uint(m2) << 32) | __float_as_uint(mt), __ATOMIC_RELAXED, __HIP_MEMORY_SCOPE_AGENT);
        }
        asm volatile("s_waitcnt vmcnt(0)" ::: "memory");
        if (lane == 0) __hip_atomic_fetch_add(cnt + 64 * u.pm, 1u, __ATOMIC_RELAXED, __HIP_MEMORY_SCOPE_AGENT);
        if (wid == 0) {
            bool dead = false; const unsigned long long t0 = __builtin_amdgcn_s_memrealtime(); const unsigned want = 8u * (unsigned)ntn;
            for (;;) {
#if defined(BROKEN_EXCHANGE_NO_WAIT)
                break;
#endif
                if ((unsigned)__builtin_amdgcn_readfirstlane(__hip_atomic_load(cnt + 64 * u.pm, __ATOMIC_RELAXED, __HIP_MEMORY_SCOPE_AGENT)) >= want) break;
                if (__builtin_amdgcn_s_memrealtime() - t0 > 2000000ull) {
                    if (lane == 0) { unsigned expect = 0u; __hip_atomic_compare_exchange_strong(tmo + 1, &expect, code | (unsigned)(u.pm & 0xff), __ATOMIC_RELAXED, __ATOMIC_RELAXED, __HIP_MEMORY_SCOPE_AGENT);
                                     __hip_atomic_store(tmo, 1u, __ATOMIC_RELAXED, __HIP_MEMORY_SCOPE_AGENT); }
                    dead = true; break; }
                __builtin_amdgcn_s_sleep(2);
            }
            __builtin_amdgcn_fence(__ATOMIC_ACQUIRE, "agent");
            if (lane == 0) flag[0] = dead ? 1u : 0u;
        }
        asm volatile("s_waitcnt vmcnt(0) lgkmcnt(0)" ::: "memory"); __builtin_amdgcn_s_barrier(); asm volatile("" ::: "memory");
        const bool bad = flag[0] != 0u;
        if (lane < 32) {
            const unsigned long long* slot = (const unsigned long long*)xbuf + (size_t)(u.pm * BM + row) * 4; float mt[4], m2[4]; float ms = 0.f;
#pragma unroll
            for (int t = 0; t < 4; ++t) { if (t < ntn) { const unsigned long long w = __hip_atomic_load(slot + t, __ATOMIC_RELAXED, __HIP_MEMORY_SCOPE_AGENT); mt[t] = __uint_as_float((unsigned)w); m2[t] = __uint_as_float((unsigned)(w >> 32)); } else { mt[t] = 0.f; m2[t] = 0.f; } ms += mt[t]; }
            const float mean = ms / (float)ntn; float q = 0.f;
#pragma unroll
            for (int t = 0; t < 4; ++t) if (t < ntn) { const float dm = mt[t] - mean; q += m2[t] + 256.0f * dm * dm; }
            S[row] = (f32x2v){mean, 1.0f / sqrtf(q / (256.0f * (float)ntn) + eps)};
        }
        asm volatile("s_waitcnt lgkmcnt(0)" ::: "memory"); __builtin_amdgcn_s_barrier(); asm volatile("" ::: "memory");
        return bad;
    }
};
struct EpiLnRes {
    static constexpr bool PERM = false, AFTER_DRAIN = true;
    const float* base; float* out; int ldc; const float* bias; PanelStats st; unsigned poison;
    __device__ __forceinline__ void fused(f32x4 (&acc)[2][2][4][2], const Unit& u, int wr, int wc, int fr, int fq, PG8_LAS unsigned char* lds, int wid, int lane) const {
        typedef float f32x2v __attribute__((ext_vector_type(2)));
        const PG8_LAS f32x2v* S = (const PG8_LAS f32x2v*)(lds + 8192);
        const int col0 = u.pn * BM + wc * 32 + 4 * fq;
#pragma unroll
        for (int bj = 0; bj < 2; ++bj)
#pragma unroll
            for (int n = 0; n < 2; ++n) { const f32x4 bv = bias ? *(const f32x4*)(bias + col0 + bj * HALF + n * 16) : (f32x4){0.f, 0.f, 0.f, 0.f};
#pragma unroll
                for (int ai = 0; ai < 2; ++ai)
#pragma unroll
                    for (int m = 0; m < 4; ++m) acc[ai][bj][m][n] += bv; }
        f32x4 pre[4][2][2];
#pragma unroll
        for (int m = 0; m < 4; ++m) { const size_t off = (size_t)(u.pm * BM + wr * 64 + m * 16 + fr) * ldc + col0;
#pragma unroll
            for (int bj = 0; bj < 2; ++bj)
#pragma unroll
                for (int n = 0; n < 2; ++n) pre[m][bj][n] = *(const f32x4*)(base + off + bj * HALF + n * 16); }
        const bool bad = st.run(acc, u, wr, wc, fr, fq, lds, wid, lane) || poison != 0u;
        const float qnan = __builtin_nanf("");
#pragma unroll
        for (int ai = 0; ai < 2; ++ai)
#pragma unroll
            for (int m = 0; m < 4; ++m) { const int r = ai * HALF + wr * 64 + m * 16 + fr; const f32x2v sr = S[r]; const size_t off = (size_t)(u.pm * BM + r) * ldc + col0;
#pragma unroll
                for (int bj = 0; bj < 2; ++bj)
#pragma unroll
                    for (int n = 0; n < 2; ++n) { const f32x4 bs = ai == 0 ? pre[m][bj][n] : *(const f32x4*)(base + off + bj * HALF + n * 16); f32x4 o = bs + (acc[ai][bj][m][n] - sr.x) * sr.y;
                        if (bad) o = (f32x4){qnan, qnan, qnan, qnan}; *(f32x4*)(out + off + bj * HALF + n * 16) = o; }
                if (m & 1) asm volatile("" ::: "memory"); }
    }
};
struct EpiLnResLn {
    static constexpr bool PERM = false, AFTER_DRAIN = true;
    const float* base; float* out; bf16_t* xn; int ldc; const float* bias; PanelStats st1, st2; unsigned poison;
    __device__ __forceinline__ void fused(f32x4 (&acc)[2][2][4][2], const Unit& u, int wr, int wc, int fr, int fq, PG8_LAS unsigned char* lds, int wid, int lane) const {
        typedef float f32x2v __attribute__((ext_vector_type(2))); typedef unsigned u32x2v __attribute__((ext_vector_type(2)));
        const PG8_LAS f32x2v* S = (const PG8_LAS f32x2v*)(lds + 8192);
        const int col0 = u.pn * BM + wc * 32 + 4 * fq;
#pragma unroll
        for (int bj = 0; bj < 2; ++bj)
#pragma unroll
            for (int n = 0; n < 2; ++n) { const f32x4 bv = bias ? *(const f32x4*)(bias + col0 + bj * HALF + n * 16) : (f32x4){0.f, 0.f, 0.f, 0.f};
#pragma unroll
                for (int ai = 0; ai < 2; ++ai)
#pragma unroll
                    for (int m = 0; m < 4; ++m) acc[ai][bj][m][n] += bv; }
        bool bad = st1.run(acc, u, wr, wc, fr, fq, lds, wid, lane) || poison != 0u;
        const float qnan = __builtin_nanf("");
#pragma unroll
        for (int ai = 0; ai < 2; ++ai)
#pragma unroll
            for (int m = 0; m < 4; ++m) { const int r = ai * HALF + wr * 64 + m * 16 + fr; const f32x2v sr = S[r]; const size_t off = (size_t)(u.pm * BM + r) * ldc + col0;
#pragma unroll
                for (int bj = 0; bj < 2; ++bj)
#pragma unroll
                    for (int n = 0; n < 2; ++n) { const f32x4 bs = *(const f32x4*)(base + off + bj * HALF + n * 16); acc[ai][bj][m][n] = bs + (acc[ai][bj][m][n] - sr.x) * sr.y; }
                asm volatile("" : "+v"(acc[ai][0][m][0]), "+v"(acc[ai][0][m][1]), "+v"(acc[ai][1][m][0]), "+v"(acc[ai][1][m][1]));
                if (m & 1) asm volatile("" ::: "memory"); }
        const bool bad1 = bad;
        bad = st2.run(acc, u, wr, wc, fr, fq, lds, wid, lane) || bad;
#pragma unroll
        for (int ai = 0; ai < 2; ++ai)
#pragma unroll
            for (int m = 0; m < 4; ++m) { const int r = ai * HALF + wr * 64 + m * 16 + fr; const f32x2v sr = S[r]; const size_t off = (size_t)(u.pm * BM + r) * ldc + col0;
#pragma unroll
                for (int bj = 0; bj < 2; ++bj)
#pragma unroll
                    for (int n = 0; n < 2; ++n) { const f32x4 x1 = acc[ai][bj][m][n]; *(f32x4*)(out + off + bj * HALF + n * 16) = bad1 ? (f32x4){qnan, qnan, qnan, qnan} : x1;
                        const f32x4 o = (x1 - sr.x) * sr.y; u32x2v w; w.x = cvt_pk_bf16(o[0], o[1]); w.y = cvt_pk_bf16(o[2], o[3]);
                        if (bad) { w.x = 0x7fc07fc0u; w.y = 0x7fc07fc0u; } *(u32x2v*)(xn + off + bj * HALF + n * 16) = w; }
                asm volatile("" ::: "memory"); }
    }
};

template <class Epi, class Sched, bool ALIGN_EPI = false, bool SP2 = false>
__device__ __forceinline__ void gemm_phase(PG8_LAS unsigned char* lds, const Gemm g, const Sched& S, const Epi& E) {
    const int tid = threadIdx.x, wid = __builtin_amdgcn_readfirstlane(tid >> 6), lane = tid & 63, wr = wid >> 2, wc = wid & 3, fr = lane & 15, fq = lane >> 4;
    const int K = g.K, nt = K / BK;
    unsigned voffA[2], voffB[2];
#pragma unroll
    for (int i = 0; i < 2; ++i) { int R, C; stage_rc(tid * 16 + i * 8192, R, C); const int Rb = Epi::PERM ? ((R & ~31) + perm32(R & 31)) : R;
        voffA[i] = (unsigned)(R * K + C) * 2u; voffB[i] = (unsigned)(Rb * K + C) * 2u; }
    const size_t kstep = (size_t)(BK * 2);
    const size_t hstep = (size_t)HALF * K * 2;
    const size_t tstep = 2 * hstep;
    const unsigned ldsw = (unsigned)wid * 1024u;
    const int aoff = lds_byte(wr * 64 + fr, fq * 8), boff = lds_byte(wc * 32 + fr, fq * 8);
#define PG8_SA(b, h) (((b) * 2 + (h)) * HTB)
#define PG8_SB(b, h) ((4 + (b) * 2 + (h)) * HTB)
#define PG8_STAGE(bufoff, gbase, voff) do { _Pragma("unroll") for (int _i = 0; _i < 2; ++_i) \
        __builtin_amdgcn_global_load_lds((const unsigned*)((const char*)(gbase) + (voff)[_i]), (PG8_LAS unsigned*)(lds + (bufoff) + ldsw + _i * 8192), 16, 0, 0); } while (0)
#define PG8_LDA(dst, b, h) do { _Pragma("unroll") for (int m = 0; m < 4; ++m) _Pragma("unroll") for (int k = 0; k < 2; ++k) dst[m][k] = *(const PG8_LAS bf16x8*)(lds + PG8_SA(b, h) + aoff + m * 2048 + k * 1024); } while (0)
#define PG8_LDB(dst, b, h) do { _Pragma("unroll") for (int n = 0; n < 2; ++n) _Pragma("unroll") for (int k = 0; k < 2; ++k) dst[n][k] = *(const PG8_LAS bf16x8*)(lds + PG8_SB(b, h) + boff + n * 2048 + k * 1024); } while (0)
#define PG8_MMA(ai, bj, At, Bt) do { __builtin_amdgcn_s_setprio(1); _Pragma("unroll") for (int m = 0; m < 4; ++m) _Pragma("unroll") for (int n = 0; n < 2; ++n) _Pragma("unroll") for (int k = 0; k < 2; ++k) \
        acc[ai][bj][m][n] = __builtin_amdgcn_mfma_f32_16x16x32_bf16(Bt[n][k], At[m][k], acc[ai][bj][m][n], 0, 0, 0); __builtin_amdgcn_s_setprio(0); } while (0)
#define PG8_WAIT_V(n) asm volatile("s_waitcnt vmcnt(" #n ")" ::: "memory")
#define PG8_WAIT_L(n) asm volatile("s_waitcnt lgkmcnt(" #n ")" ::: "memory")
#define PG8_BAR __builtin_amdgcn_s_barrier()
#define PG8_SCHED __builtin_amdgcn_sched_barrier(0)
    Unit cur, nxt; int ui = 0;
    if (!S.next(0, cur)) return;
    f32x4 acc[2][2][4][2];
#pragma unroll
    for (int a = 0; a < 2; ++a)
#pragma unroll
        for (int b = 0; b < 2; ++b)
#pragma unroll
            for (int m = 0; m < 4; ++m)
#pragma unroll
                for (int n = 0; n < 2; ++n) acc[a][b][m][n] = (f32x4){0.f, 0.f, 0.f, 0.f};
    bf16x8 At[4][2], B0[2][2], B1[2][2];
    const char* cA = (const char*)g.A + (size_t)cur.pm * tstep; const char* cB = (const char*)g.Bt + (size_t)cur.pn * tstep;
    S.a_ready(cur);
    if constexpr (SP2) {
        PG8_STAGE(PG8_SB(0, 0), cB, voffB); PG8_STAGE(PG8_SB(0, 1), cB + hstep, voffB); PG8_STAGE(PG8_SA(0, 0), cA, voffA); PG8_STAGE(PG8_SA(0, 1), cA + hstep, voffA);
        if (wr == 1) PG8_BAR;
        PG8_WAIT_V(2); PG8_BAR;
        PG8_STAGE(PG8_SB(1, 0), cB + kstep, voffB); PG8_STAGE(PG8_SA(1, 0), cA + kstep, voffA); PG8_STAGE(PG8_SB(1, 1), cB + hstep + kstep, voffB);
        PG8_WAIT_V(6); PG8_BAR;
    } else {
        PG8_STAGE(PG8_SB(0, 0), cB, voffB); PG8_STAGE(PG8_SA(0, 0), cA, voffA); PG8_STAGE(PG8_SB(0, 1), cB + hstep, voffB); PG8_STAGE(PG8_SA(0, 1), cA + hstep, voffA);
        if (wr == 1) PG8_BAR;
        PG8_WAIT_V(4); PG8_BAR;
        PG8_STAGE(PG8_SB(1, 0), cB + kstep, voffB); PG8_STAGE(PG8_SA(1, 0), cA + kstep, voffA); PG8_STAGE(PG8_SB(1, 1), cB + hstep + kstep, voffB);
        PG8_WAIT_V(6); PG8_BAR;
    }
    for (;;) {
        const bool has_next = S.next(ui + 1, nxt);
        const char* nA = has_next ? (const char*)g.A + (size_t)nxt.pm * tstep : cA; const char* nB = has_next ? (const char*)g.Bt + (size_t)nxt.pn * tstep : cB;
        for (int t = 0; t < nt; t += 2) {
            const bool last = (t == nt - 2);
            const char* a1 = cA + (size_t)(t + 1) * kstep;
            const char* a2 = last ? nA : cA + (size_t)(t + 2) * kstep; const char* b2 = last ? nB : cB + (size_t)(t + 2) * kstep;
            const char* a3 = a2 + kstep; const char* b3 = b2 + kstep;
            if (last && has_next) S.a_ready(nxt);
            if constexpr (SP2) {
            PG8_LDB(B0, 0, 0); PG8_LDB(B1, 0, 1); PG8_SCHED; PG8_LDA(At, 0, 0); PG8_STAGE(PG8_SA(1, 1), a1 + hstep, voffA);
            PG8_WAIT_V(8); PG8_WAIT_L(0); PG8_BAR; PG8_MMA(0, 0, At, B0); PG8_MMA(0, 1, At, B1); PG8_BAR; PG8_SCHED;
            PG8_LDA(At, 0, 1); PG8_STAGE(PG8_SB(0, 0), b2, voffB); PG8_STAGE(PG8_SB(0, 1), b2 + hstep, voffB); PG8_STAGE(PG8_SA(0, 0), a2, voffA);
            PG8_WAIT_V(8); PG8_WAIT_L(0); PG8_BAR; PG8_MMA(1, 0, At, B0); PG8_MMA(1, 1, At, B1); PG8_BAR; PG8_SCHED;
            PG8_LDB(B0, 1, 0); PG8_LDB(B1, 1, 1); PG8_SCHED; PG8_LDA(At, 1, 0); PG8_STAGE(PG8_SA(0, 1), a2 + hstep, voffA);
            PG8_WAIT_V(8); PG8_WAIT_L(0); PG8_BAR; PG8_MMA(0, 0, At, B0); PG8_MMA(0, 1, At, B1); PG8_BAR; PG8_SCHED;
            PG8_LDA(At, 1, 1); PG8_STAGE(PG8_SB(1, 0), b3, voffB); PG8_STAGE(PG8_SB(1, 1), b3 + hstep, voffB); PG8_STAGE(PG8_SA(1, 0), a3, voffA);
            PG8_WAIT_V(8); PG8_WAIT_L(0); PG8_BAR; PG8_MMA(1, 0, At, B0); PG8_MMA(1, 1, At, B1); PG8_BAR; PG8_SCHED;
            } else {
            PG8_LDB(B0, 0, 0); PG8_SCHED; PG8_LDA(At, 0, 0); PG8_STAGE(PG8_SA(1, 1), a1 + hstep, voffA);
            PG8_WAIT_L(8); PG8_BAR; PG8_WAIT_L(0); PG8_MMA(0, 0, At, B0); PG8_BAR; PG8_SCHED;
            PG8_LDB(B1, 0, 1); PG8_STAGE(PG8_SB(0, 0), b2, voffB);
            PG8_BAR; PG8_WAIT_L(0); PG8_MMA(0, 1, At, B1); PG8_BAR;
            PG8_LDA(At, 0, 1); PG8_STAGE(PG8_SA(0, 0), a2, voffA);
            PG8_BAR; PG8_WAIT_L(0); PG8_MMA(1, 0, At, B0); PG8_BAR; PG8_SCHED;
            PG8_STAGE(PG8_SB(0, 1), b2 + hstep, voffB);
            PG8_WAIT_V(6); PG8_BAR; PG8_MMA(1, 1, At, B1); PG8_BAR;
            PG8_LDB(B0, 1, 0); PG8_SCHED; PG8_LDA(At, 1, 0); PG8_STAGE(PG8_SA(0, 1), a2 + hstep, voffA);
            PG8_WAIT_L(8); PG8_BAR; PG8_WAIT_L(0); PG8_MMA(0, 0, At, B0); PG8_BAR; PG8_SCHED;
            PG8_LDB(B1, 1, 1); PG8_STAGE(PG8_SB(1, 0), b3, voffB);
            PG8_BAR; PG8_WAIT_L(0); PG8_MMA(0, 1, At, B1); PG8_BAR;
            PG8_LDA(At, 1, 1); PG8_STAGE(PG8_SA(1, 0), a3, voffA);
            PG8_BAR; PG8_WAIT_L(0); PG8_MMA(1, 0, At, B0); PG8_BAR; PG8_SCHED;
            PG8_STAGE(PG8_SB(1, 1), b3 + hstep, voffB);
            PG8_WAIT_V(6); PG8_BAR; PG8_MMA(1, 1, At, B1); PG8_BAR;
            }
        }
        if constexpr (ALIGN_EPI) { if (wr == 0) PG8_BAR; }
        if constexpr (!Epi::AFTER_DRAIN) { E(acc, cur, wr, wc, fr, fq); S.done(cur); }
        if (!has_next) break;
#pragma unroll
        for (int a = 0; a < 2; ++a)
#pragma unroll
            for (int b = 0; b < 2; ++b)
#pragma unroll
                for (int m = 0; m < 4; ++m)
#pragma unroll
                    for (int n = 0; n < 2; ++n) acc[a][b][m][n] = (f32x4){0.f, 0.f, 0.f, 0.f};
        cur = nxt; cA = nA; cB = nB; ++ui;
        if constexpr (ALIGN_EPI) { if (wr == 1) PG8_BAR; }
    }
    PG8_WAIT_V(0);
    if constexpr (!ALIGN_EPI) { if (wr == 0) PG8_BAR; }
    PG8_BAR;
    if constexpr (Epi::AFTER_DRAIN) { E.fused(acc, cur, wr, wc, fr, fq, lds, wid, lane); S.done(cur); }
#undef PG8_SA
#undef PG8_SB
#undef PG8_STAGE
#undef PG8_LDA
#undef PG8_LDB
#undef PG8_MMA
#undef PG8_WAIT_V
#undef PG8_WAIT_L
#undef PG8_BAR
#undef PG8_SCHED
}
}
namespace pg8 {
__device__ __forceinline__ float silu_f(float v) { return v * __builtin_amdgcn_rcpf(1.0f + __expf(-v)); }
struct EpiF32 {
    static constexpr bool PERM = false, AFTER_DRAIN = false;
    float* C; int ldc;
    __device__ __forceinline__ void operator()(const f32x4 (&acc)[2][2][4][2], const Unit& u, int wr, int wc, int fr, int fq) const {
        const int row0 = u.pm * BM + wr * 64 + fr, col0 = u.pn * BM + wc * 32 + 4 * fq;
#pragma unroll
        for (int ai = 0; ai < 2; ++ai)
#pragma unroll
            for (int m = 0; m < 4; ++m) { float* rowp = C + (size_t)(row0 + ai * HALF + m * 16) * ldc + col0;
#pragma unroll
                for (int bj = 0; bj < 2; ++bj)
#pragma unroll
                    for (int n = 0; n < 2; ++n) *(f32x4*)(rowp + bj * HALF + n * 16) = acc[ai][bj][m][n]; }
    }
};
struct EpiSwiglu {
    static constexpr bool PERM = true, AFTER_DRAIN = false;
    bf16_t* O; int ldc;
    __device__ __forceinline__ void operator()(const f32x4 (&acc)[2][2][4][2], const Unit& u, int wr, int wc, int fr, int fq) const {
        const int row0 = u.pm * BM + wr * 64 + fr, col0 = u.pn * HALF + wc * 32 + 8 * fq;
#pragma unroll
        for (int ai = 0; ai < 2; ++ai)
#pragma unroll
            for (int m = 0; m < 4; ++m) { bf16_t* rowp = O + (size_t)(row0 + ai * HALF + m * 16) * ldc + col0;
                const f32x4 g0 = acc[ai][0][m][0], g1 = acc[ai][0][m][1], u0 = acc[ai][1][m][0], u1 = acc[ai][1][m][1];
                u32x4 w;
                w.x = cvt_pk_bf16(silu_f(g0[0]) * u0[0], silu_f(g0[1]) * u0[1]); w.y = cvt_pk_bf16(silu_f(g0[2]) * u0[2], silu_f(g0[3]) * u0[3]);
                w.z = cvt_pk_bf16(silu_f(g1[0]) * u1[0], silu_f(g1[1]) * u1[1]); w.w = cvt_pk_bf16(silu_f(g1[2]) * u1[2], silu_f(g1[3]) * u1[3]);
                st16_wt(rowp, w); }
    }
};
struct EpiMix {
    static constexpr bool PERM = true, AFTER_DRAIN = false;
    bf16_t* Z; bf16_t* XBC; float* DT;
    __device__ __forceinline__ void operator()(const f32x4 (&acc)[2][2][4][2], const Unit& u, int wr, int wc, int fr, int fq) const {
        const int row0 = u.pm * BM + wr * 64 + fr;
        if (u.pn < 10) {
            bf16_t* base; int ldc, colt;
            if (u.pn < 4) { base = Z; ldc = 1024; colt = u.pn * BM; } else { base = XBC; ldc = 1536; colt = (u.pn - 4) * BM; }
            const int col0 = colt + wc * 32 + 8 * fq;
#pragma unroll
            for (int ai = 0; ai < 2; ++ai)
#pragma unroll
                for (int m = 0; m < 4; ++m) { bf16_t* rowp = base + (size_t)(row0 + ai * HALF + m * 16) * ldc + col0;
#pragma unroll
                    for (int bj = 0; bj < 2; ++bj) { const f32x4 v0 = acc[ai][bj][m][0], v1 = acc[ai][bj][m][1];
                        u32x4 w; w.x = cvt_pk_bf16(v0[0], v0[1]); w.y = cvt_pk_bf16(v0[2], v0[3]); w.z = cvt_pk_bf16(v1[0], v1[1]); w.w = cvt_pk_bf16(v1[2], v1[3]);
                        st16_wt(rowp + bj * HALF, w); } }
        } else if (wc == 0 && fq < 2) {
#pragma unroll
            for (int ai = 0; ai < 2; ++ai)
#pragma unroll
                for (int m = 0; m < 4; ++m) { float* rowp = DT + (size_t)(row0 + ai * HALF + m * 16) * 16 + 8 * fq;
                    *(f32x4*)rowp = acc[ai][0][m][0]; *(f32x4*)(rowp + 4) = acc[ai][0][m][1]; }
        }
    }
};
struct EpiQKV {
    static constexpr bool PERM = true, AFTER_DRAIN = false;
    bf16_t* O; int ldc; size_t split_stride; float scale0; unsigned* kmax;
    __device__ __forceinline__ void operator()(const f32x4 (&acc)[2][2][4][2], const Unit& u, int wr, int wc, int fr, int fq) const {
        const int row0 = u.pm * BM + wr * 64 + fr; int colt = u.pn * BM; const int t = colt / 1024; bf16_t* base = O + (size_t)t * split_stride; colt -= t * 1024;
        const float sc = (t == 0) ? scale0 : 1.f; const int col0 = colt + wc * 32 + 8 * fq;
        float km[2] = {0.f, 0.f};
#pragma unroll
        for (int ai = 0; ai < 2; ++ai)
#pragma unroll
            for (int m = 0; m < 4; ++m) { bf16_t* rowp = base + (size_t)(row0 + ai * HALF + m * 16) * ldc + col0;
#pragma unroll
                for (int bj = 0; bj < 2; ++bj) { const f32x4 v0 = acc[ai][bj][m][0] * sc, v1 = acc[ai][bj][m][1] * sc;
                    u32x4 w; w.x = cvt_pk_bf16(v0[0], v0[1]); w.y = cvt_pk_bf16(v0[2], v0[3]); w.z = cvt_pk_bf16(v1[0], v1[1]); w.w = cvt_pk_bf16(v1[2], v1[3]);
                    st16_wt(rowp + bj * HALF, w);
                    if (t == 1) { float s = 0.f;
#pragma unroll
                        for (int e = 0; e < 4; ++e) { const float lo = __builtin_bit_cast(float, w[e] << 16), hi = __builtin_bit_cast(float, w[e] & 0xffff0000u); s += lo * lo + hi * hi; }
                        s += __shfl_xor(s, 16); s += __shfl_xor(s, 32); km[bj] = __builtin_fmaxf(km[bj], s); } } }
        if (t == 1) {
#pragma unroll
            for (int bj = 0; bj < 2; ++bj) { float v = km[bj];
                v = __builtin_fmaxf(v, __shfl_xor(v, 1)); v = __builtin_fmaxf(v, __shfl_xor(v, 2)); v = __builtin_fmaxf(v, __shfl_xor(v, 4)); v = __builtin_fmaxf(v, __shfl_xor(v, 8));
                if ((fr | fq) == 0) { const int b = u.pm >> 5, head = (colt >> 7) + bj; atomicMax(kmax + (((b * 8 + head) * 2 + (wc >> 1)) * 2 + (wc & 1)), __builtin_bit_cast(unsigned, v)); } } }
    }
};
}
#include <hip/hip_bf16.h>
#include <cmath>
namespace attn_body {
using bf16=__hip_bfloat16;
using bf16x8=__attribute__((ext_vector_type(8)))short;
using s16x4=__attribute__((ext_vector_type(4)))short;
using f32x16=__attribute__((ext_vector_type(16)))float;
using u32x4=__attribute__((ext_vector_type(4)))unsigned;
constexpr int BATCH=2,NHEAD=16,SEQ=8192,D=64,DM=NHEAD*D;
constexpr int NW=8,QBLK=32,QB=QBLK*NW,KVBLK=64,NQB=SEQ/QB;
constexpr int ATTN_PITCH=DM, ATTN_UNIT_ROWS=QB, OPITCH=2048, OCOL0=1024;
__device__ __forceinline__ int crow(int r,int hi){return (r&3)+8*(r>>2)+4*hi;}
#define SBAR() __builtin_amdgcn_sched_barrier(0)
__device__ __forceinline__ void cmask(f32x16&p0,f32x16&p1,int jb,int qrel,int hi){
  const float NEG=-INFINITY; int kb=64*jb+4*hi;
  #pragma unroll
  for(int r=0;r<16;++r){int kv=kb+(r&3)+8*(r>>2); if(kv>qrel)p0[r]=NEG; if(kv+32>qrel)p1[r]=NEG;}
}

constexpr int BT_N=704;
__device__ __forceinline__ void bmask(f32x16&p0,f32x16&p1,int jb,int qrel,int hi,const float*bt){
  const float NEG=-INFINITY; const int brel=qrel-64*jb-4*hi; const float*bp=bt+(brel+256);
  #pragma unroll
  for(int r=0;r<16;++r){const int c0=(r&3)+8*(r>>2);
    const float b0=bp[-c0], b1=bp[-c0-32];
    p0[r]=(brel<c0)?NEG:p0[r]+b0; p1[r]=(brel<c0+32)?NEG:p1[r]+b1;
    if((r&3)==3)SBAR();}
}
constexpr int NSLOT=3, SLOTB=8192;
constexpr int LDS_K=0, LDS_V=NSLOT*SLOTB, LDS_WS=2*NSLOT*SLOTB, LDS_OST=LDS_WS+NW*64*4, LDS_BYTES=LDS_OST+NW*4096, LDS_OSTA=86016, LDS_BTAB=LDS_OSTA+NW*4096, LDS_TOTAL=LDS_BTAB+704*4;
constexpr float C2=0.125f*1.4426950408889634f;
__device__ __forceinline__ void glds16(const void*gsrc,unsigned lds_dst){unsigned keep;
  asm volatile("s_mov_b32 %0, m0\n\ts_mov_b32 m0, %2\n\ts_nop 0\n\tglobal_load_lds_dwordx4 %1, off\n\ts_mov_b32 m0, %0":"=&s"(keep):"v"(gsrc),"s"(lds_dst):"memory");}
__device__ __forceinline__ float max3f(float a,float b,float c){float r;asm("v_max3_f32 %0, %1, %2, %3":"=v"(r):"v"(a),"v"(b),"v"(c));return r;}
__device__ __forceinline__ float max2f(float a,float b){float r;asm("v_max_f32_e32 %0, %1, %2":"=v"(r):"v"(a),"v"(b));return r;}
__device__ __forceinline__ float fadd_s(float a,float b){float r;asm("v_add_f32_e32 %0, %1, %2":"=v"(r):"v"(a),"v"(b));return r;}
__device__ __forceinline__ float fsub_s(float a,float b){float r;asm("v_sub_f32_e32 %0, %1, %2":"=v"(r):"v"(a),"v"(b));return r;}
typedef float f32x2_t __attribute__((ext_vector_type(2))); typedef __bf16 bf16x2_t __attribute__((ext_vector_type(2)));
__device__ __forceinline__ unsigned cvtpk_s(float lo,float hi){f32x2_t v={lo,hi};bf16x2_t b=__builtin_convertvector(v,bf16x2_t);return __builtin_bit_cast(unsigned,b);}
#define WAIT_BAR(N) asm volatile("s_waitcnt vmcnt(" #N ") lgkmcnt(0)\n\ts_barrier":::"memory")

__device__ __forceinline__ void qkt(f32x16&p0,f32x16&p1,const char*Kslot,const bf16x8*qr,const f32x16&negm,int r32,int hi){
  const char*kb=Kslot+hi*1024+r32*16;
  #pragma unroll
  for(int d0=0;d0<4;++d0){
    const bf16x8 b0=*reinterpret_cast<const bf16x8*>(kb+d0*2048);
    const bf16x8 b1=*reinterpret_cast<const bf16x8*>(kb+d0*2048+512);
    if(d0==0){p0=__builtin_amdgcn_mfma_f32_32x32x16_bf16(b0,qr[0],negm,0,0,0);p1=__builtin_amdgcn_mfma_f32_32x32x16_bf16(b1,qr[0],negm,0,0,0);}
    else{p0=__builtin_amdgcn_mfma_f32_32x32x16_bf16(b0,qr[d0],p0,0,0,0);p1=__builtin_amdgcn_mfma_f32_32x32x16_bf16(b1,qr[d0],p1,0,0,0);}}
}
typedef __attribute__((address_space(3))) const char* lds_cptr;
typedef short v4i16_t __attribute__((ext_vector_type(4)));
__device__ __forceinline__ void kload8(bf16x8*kf,lds_cptr kp){
  kf[0]=*(const __attribute__((address_space(3))) bf16x8*)(kp);      kf[1]=*(const __attribute__((address_space(3))) bf16x8*)(kp+512);
  kf[2]=*(const __attribute__((address_space(3))) bf16x8*)(kp+2048); kf[3]=*(const __attribute__((address_space(3))) bf16x8*)(kp+2560);
  kf[4]=*(const __attribute__((address_space(3))) bf16x8*)(kp+4096); kf[5]=*(const __attribute__((address_space(3))) bf16x8*)(kp+4608);
  kf[6]=*(const __attribute__((address_space(3))) bf16x8*)(kp+6144); kf[7]=*(const __attribute__((address_space(3))) bf16x8*)(kp+6656);
}
__device__ __forceinline__ void kload2(bf16x8*kf,lds_cptr kp,int j){ kf[2*j]=*(const __attribute__((address_space(3))) bf16x8*)(kp+j*2048); kf[2*j+1]=*(const __attribute__((address_space(3))) bf16x8*)(kp+j*2048+512); }
__device__ __forceinline__ s16x4 vtr(lds_cptr p){ return __builtin_bit_cast(s16x4,__builtin_amdgcn_ds_read_tr16_b64_v4i16((__attribute__((address_space(3))) v4i16_t*)p)); }
__device__ __forceinline__ float rowmax(const f32x16&p0,const f32x16&p1){
  float a=max3f(p0[0],p0[1],p1[0]),b=max3f(p0[2],p0[3],p1[1]);a=max3f(a,p1[2],p1[3]);
  #pragma unroll
  for(int r=4;r<16;r+=4){a=max3f(a,p0[r],p0[r+1]);b=max3f(b,p0[r+2],p0[r+3]);a=max3f(a,p1[r],p1[r+1]);b=max3f(b,p1[r+2],p1[r+3]);}
  const float m=max2f(a,b);
  auto rr=__builtin_amdgcn_permlane32_swap(__float_as_uint(m),__float_as_uint(m),false,false);
  return max2f(__uint_as_float(rr[0]),__uint_as_float(rr[1]));
}
__device__ __forceinline__ void pv(f32x16*o,int vb,bf16x8 pa0,bf16x8 pa1,bf16x8 pa2,bf16x8 pa3){
  #pragma unroll
  for(int d0=0;d0<2;++d0){s16x4 lo[4],hi[4];
    #pragma unroll
    for(int ks=0;ks<4;++ks){
      asm volatile("ds_read_b64_tr_b16 %0,%1 offset:%c2":"=&v"(lo[ks]):"v"(vb),"i"(d0*4096+ks*1024):"memory");
      asm volatile("ds_read_b64_tr_b16 %0,%1 offset:%c2":"=&v"(hi[ks]):"v"(vb),"i"(d0*4096+ks*1024+512):"memory");}
    asm volatile("s_waitcnt lgkmcnt(0)":::"memory");SBAR();
    #define PK(k) (bf16x8){lo[k][0],lo[k][1],lo[k][2],lo[k][3],hi[k][0],hi[k][1],hi[k][2],hi[k][3]}
    o[d0]=__builtin_amdgcn_mfma_f32_32x32x16_bf16(pa0,PK(0),o[d0],0,0,0);
    o[d0]=__builtin_amdgcn_mfma_f32_32x32x16_bf16(pa1,PK(1),o[d0],0,0,0);
    o[d0]=__builtin_amdgcn_mfma_f32_32x32x16_bf16(pa2,PK(2),o[d0],0,0,0);
    o[d0]=__builtin_amdgcn_mfma_f32_32x32x16_bf16(pa3,PK(3),o[d0],0,0,0);
    #undef PK
  }
}

#ifndef ATTN_STORE16
#define ATTN_STORE16(p,v) (*(u32x4*)(p)=(v))
#endif
template<int THRL> __device__ __forceinline__ void attn_unit(int b,int hq,int hv,int qb,int pass,float lam,const float*btab,const bf16*Q,const bf16*__restrict__ K,const bf16*__restrict__ V,bf16*O,char*shm){
  const int tid=threadIdx.x,lane=tid&63,r32=lane&31,hi=lane>>5; const int wid=__builtin_amdgcn_readfirstlane(tid>>6);
  const long rowbase=(long)b*SEQ; const int q0=qb*QB;
  const bf16*Qw=Q+(rowbase+q0+wid*QBLK)*DM+hq*D;
  const bf16*Kh=K+rowbase*DM+hq*D,*Vh=V+rowbase*DM+hv*D;
  const unsigned lds0=(unsigned)(uintptr_t)shm;
  float*wsf=(float*)(shm+LDS_WS)+wid*64;
  const bf16*ksrc=Kh+(long)lane*DM+wid*8;
  const bf16*vsrc=Vh+(long)(16*(wid&3)+(lane>>2))*DM+(wid>>2)*32+(lane&3)*8;
  const unsigned kdst=lds0+LDS_K+wid*1024, vdst=lds0+LDS_V+wid*1024;
  #define DMA_K(t,slot) glds16(ksrc+(long)(t)*KVBLK*DM,(unsigned)__builtin_amdgcn_readfirstlane(kdst+(slot)))
  #define DMA_V(t,slot) glds16(vsrc+(long)(t)*KVBLK*DM,(unsigned)__builtin_amdgcn_readfirstlane(vdst+(slot)))
  const int vb0=(int)(lds0+LDS_V)+((lane>>4)&1)*32+(lane&3)*8+(4*hi+((lane&15)>>2))*64;
  const char*Kbase=shm+LDS_K; bf16x8 kf[8];
  const lds_cptr shm3=(lds_cptr)shm; const lds_cptr kp0=shm3+LDS_K+hi*1024+r32*16; const lds_cptr vp0=shm3+LDS_V+((lane>>4)&1)*32+(lane&3)*8+(4*hi+((lane&15)>>2))*64;
  const int NT=(q0+QB)/KVBLK;
  DMA_K(0,0);DMA_V(0,0);DMA_K(1,SLOTB);
  bf16x8 qr[4];
  #pragma unroll
  for(int d0=0;d0<4;++d0)qr[d0]=*reinterpret_cast<const bf16x8*>(&Qw[(long)r32*DM+d0*16+hi*8]);
  float mhat=0.f,l_reg=0.f;f32x16 o[2];o[0]=f32x16{};o[1]=f32x16{};f32x16 negm=f32x16{};asm volatile("":"+v"(negm));
  const int qrel=wid*QBLK+r32;
  #define CMASK(P0,P1,t) do{int jb_=(t)-(NT-4); if(jb_>=-2)bmask(P0,P1,jb_,qrel,hi,btab);}while(0)
  bool resc=false;
  #define START(P0,P1) do{ const float rm=rowmax(P0,P1); resc=false; \
    { const float dl=rm; mhat=fadd_s(mhat,dl); \
      _Pragma("unroll") for(int r=0;r<16;++r){P0[r]=fsub_s(P0[r],dl);P1[r]=fsub_s(P1[r],dl);} \
      _Pragma("unroll") for(int r=0;r<16;++r)negm[r]=-mhat; asm volatile("":"+v"(negm)); } \
    _Pragma("unroll") for(int r=0;r<16;++r)P0[r]=__builtin_amdgcn_exp2f(P0[r]); }while(0)
  #define RESC() do{ if(resc){ asm volatile("s_waitcnt lgkmcnt(0)":::"memory"); \
      _Pragma("unroll") for(int d_=0;d_<2;++d_) _Pragma("unroll") for(int r=0;r<16;++r)o[d_][r]*=wsf[crow(r,hi)]; } }while(0)
  f32x16 pA0,pA1,pB0,pB1;
  int sl_prev=0,sl_cur=0,sl_next=SLOTB;
  #define ROT() do{sl_prev=sl_cur;sl_cur=sl_next;sl_next=(sl_next==(NSLOT-1)*SLOTB)?0:sl_next+SLOTB;}while(0)
  DMA_K(2,2*SLOTB);
  WAIT_BAR(3);
  qkt(pA0,pA1,Kbase,qr,negm,r32,hi);asm volatile("s_nop 15\n\ts_nop 7":"+v"(pA0),"+v"(pA1));CMASK(pA0,pA1,0);
  START(pA0,pA1);
  _Pragma("unroll") for(int r=0;r<16;++r)pA1[r]=__builtin_amdgcn_exp2f(pA1[r]);
  WAIT_BAR(0);
  DMA_K(3,0);DMA_V(1,SLOTB);
  ROT();
  kload8(kf,kp0+sl_cur);
  WAIT_BAR(2);
  s16x4 vlo[8],vhi[8]; u32x4 pw0,pw1,pw2,pw3;
  #define PKW(P,B) cvtpk_s(P[B],P[B+1])
  #define PAF(k) __builtin_bit_cast(bf16x8,pw##k)
  #define VFR(i) (bf16x8){vlo[i][0],vlo[i][1],vlo[i][2],vlo[i][3],vhi[i][0],vhi[i][1],vhi[i][2],vhi[i][3]}
  #define PIN(x) asm volatile("":"+v"(x))
  #define MX3(a,b,c) __builtin_fmaxf(__builtin_fmaxf((a),(b)),(c))
  #define GAPA(MF,A0,A1,A2,A3,W0,W1,PW) do{ MF; sacc+=A0; sacc+=A1; sacc+=A2; sacc+=A3; PIN(sacc); W0; W1; PIN(PW); SBAR(); }while(0)
  #define EX(v) __builtin_amdgcn_exp2f(v)
  #define GAPB(MF,X,B) do{ MF; X[B]=EX(X[B]); X[B+1]=EX(X[B+1]); X[B+2]=EX(X[B+2]); X[B+3]=EX(X[B+3]); PIN(X); SBAR(); }while(0)
  #define VRD(i) do{ vlo[i]=vtr(vp_+(((i)>>2)*4096+((i)&3)*1024)); vhi[i]=vtr(vp_+(((i)>>2)*4096+((i)&3)*1024+512)); }while(0)
  #define KRD(G,j) do{ if(G){ kload2(kf,kp0+sl_next,j); SBAR(); } }while(0)
  #define STEP(C0,C1,P0,P1,t,GK,GV,GL) do{ SBAR(); \
    const lds_cptr vp_=vp0+sl_prev; \
    VRD(0); SBAR(); float sacc=(P0[0]+P0[1]); \
    GAPA(C0=__builtin_amdgcn_mfma_f32_32x32x16_bf16(kf[0],qr[0],negm,0,0,0), P0[2],P0[3],P0[4],P0[5],     pw0[0]=PKW(P0,0), pw0[1]=PKW(P0,2), pw0); \
    VRD(4); SBAR(); GAPA(C1=__builtin_amdgcn_mfma_f32_32x32x16_bf16(kf[1],qr[0],negm,0,0,0), P0[6],P0[7],P0[8],P0[9],     pw0[2]=PKW(P0,4), pw0[3]=PKW(P0,6), pw0); \
    VRD(1); SBAR(); GAPA(C0=__builtin_amdgcn_mfma_f32_32x32x16_bf16(kf[2],qr[1],C0,0,0,0),   P0[10],P0[11],P0[12],P0[13], pw1[0]=PKW(P0,8), pw1[1]=PKW(P0,10), pw1); \
    VRD(5); SBAR(); GAPA(C1=__builtin_amdgcn_mfma_f32_32x32x16_bf16(kf[3],qr[1],C1,0,0,0),   P0[14],P0[15],P1[0],P1[1],   pw1[2]=PKW(P0,12),pw1[3]=PKW(P0,14), pw1); \
    VRD(2); SBAR(); GAPA(C0=__builtin_amdgcn_mfma_f32_32x32x16_bf16(kf[4],qr[2],C0,0,0,0),   P1[2],P1[3],P1[4],P1[5],     pw2[0]=PKW(P1,0), pw2[1]=PKW(P1,2), pw2); \
    VRD(6); SBAR(); GAPA(C1=__builtin_amdgcn_mfma_f32_32x32x16_bf16(kf[5],qr[2],C1,0,0,0),   P1[6],P1[7],P1[8],P1[9],     pw2[2]=PKW(P1,4), pw2[3]=PKW(P1,6), pw2); \
    VRD(3); SBAR(); GAPA(C0=__builtin_amdgcn_mfma_f32_32x32x16_bf16(kf[6],qr[3],C0,0,0,0),   P1[10],P1[11],P1[12],P1[13], pw3[0]=PKW(P1,8), pw3[1]=PKW(P1,10), pw3); \
    VRD(7); SBAR(); GAPA(C1=__builtin_amdgcn_mfma_f32_32x32x16_bf16(kf[7],qr[3],C1,0,0,0),   P1[14],P1[15],0.f,0.f,       pw3[2]=PKW(P1,12),pw3[3]=PKW(P1,14), pw3); \
    l_reg+=sacc; \
    if(GK){DMA_K((t)+3,sl_cur);} if(GV){DMA_V((t)+1,sl_next);} \
    CMASK(C0,C1,t); \
    { float a=MX3(C0[0],C0[1],C1[0]),b=MX3(C0[2],C0[3],C1[1]); a=MX3(a,C1[2],C1[3]); \
      _Pragma("unroll") for(int r=4;r<16;r+=4){a=MX3(a,C0[r],C0[r+1]);b=MX3(b,C0[r+2],C0[r+3]);a=MX3(a,C1[r],C1[r+1]);b=MX3(b,C1[r+2],C1[r+3]);} \
      float rm=__builtin_fmaxf(a,b); { auto rr=__builtin_amdgcn_permlane32_swap(__float_as_uint(rm),__float_as_uint(rm),false,false); rm=__builtin_fmaxf(__uint_as_float(rr[0]),__uint_as_float(rr[1])); } \
      resc=false; \
      if(__builtin_expect(__any(rm>(float)THRL),0)){ const float dl=__builtin_fmaxf(rm,0.f); mhat+=dl; \
        _Pragma("unroll") for(int r=0;r<16;++r){C0[r]-=dl;C1[r]-=dl;} \
        _Pragma("unroll") for(int r=0;r<16;++r)negm[r]=-mhat; asm volatile("":"+v"(negm)); \
        const float f=__builtin_amdgcn_exp2f(-dl); l_reg*=f; if(hi==0)wsf[r32]=f; resc=true; } } \
    SBAR(); \
    GAPB(o[0]=__builtin_amdgcn_mfma_f32_32x32x16_bf16(PAF(0),VFR(0),o[0],0,0,0), C0,0); \
    GAPB(o[1]=__builtin_amdgcn_mfma_f32_32x32x16_bf16(PAF(0),VFR(4),o[1],0,0,0), C0,4); \
    KRD(GL,0); GAPB(o[0]=__builtin_amdgcn_mfma_f32_32x32x16_bf16(PAF(1),VFR(1),o[0],0,0,0), C0,8); \
    KRD(GL,1); GAPB(o[1]=__builtin_amdgcn_mfma_f32_32x32x16_bf16(PAF(1),VFR(5),o[1],0,0,0), C0,12); \
    KRD(GL,2); GAPB(o[0]=__builtin_amdgcn_mfma_f32_32x32x16_bf16(PAF(2),VFR(2),o[0],0,0,0), C1,0); \
    KRD(GL,3); GAPB(o[1]=__builtin_amdgcn_mfma_f32_32x32x16_bf16(PAF(2),VFR(6),o[1],0,0,0), C1,4); \
    GAPB(o[0]=__builtin_amdgcn_mfma_f32_32x32x16_bf16(PAF(3),VFR(3),o[0],0,0,0), C1,8); \
    GAPB(o[1]=__builtin_amdgcn_mfma_f32_32x32x16_bf16(PAF(3),VFR(7),o[1],0,0,0), C1,12); \
    }while(0)
  int t=1;
  #undef CMASK
  #define CMASK(P0,P1,t) do{}while(0)
  for(;t+7<NT;t+=2){
    STEP(pB0,pB1,pA0,pA1,t,true,true,true);     WAIT_BAR(2); RESC(); ROT();
    STEP(pA0,pA1,pB0,pB1,t+1,true,true,true);   WAIT_BAR(2); RESC(); ROT();
  }
  #undef CMASK
  #define CMASK(P0,P1,t) do{int jb_=(t)-(NT-4); if(jb_>=-2)bmask(P0,P1,jb_,qrel,hi,btab);}while(0)
  #define ENDW(tt) do{ if((tt)+3<NT){WAIT_BAR(2);} else if((tt)+2<NT){WAIT_BAR(1);} else {WAIT_BAR(0);} }while(0)
  for(;t+1<NT;t+=2){
    STEP(pB0,pB1,pA0,pA1,t,(t+3<NT),(t+1<NT),(t+1<NT));       ENDW(t);   RESC(); ROT();
    STEP(pA0,pA1,pB0,pB1,t+1,(t+4<NT),(t+2<NT),(t+2<NT));     ENDW(t+1); RESC(); ROT();
  }
  STEP(pB0,pB1,pA0,pA1,NT-1,false,false,false); RESC();
  { float sacc=pB0[0]+pB0[1]; _Pragma("unroll") for(int r=2;r<16;++r)sacc+=pB0[r]; _Pragma("unroll") for(int r=0;r<16;++r)sacc+=pB1[r]; l_reg+=sacc;
    pw0=(u32x4){PKW(pB0,0),PKW(pB0,2),PKW(pB0,4),PKW(pB0,6)};pw1=(u32x4){PKW(pB0,8),PKW(pB0,10),PKW(pB0,12),PKW(pB0,14)};pw2=(u32x4){PKW(pB1,0),PKW(pB1,2),PKW(pB1,4),PKW(pB1,6)};pw3=(u32x4){PKW(pB1,8),PKW(pB1,10),PKW(pB1,12),PKW(pB1,14)};
    SBAR(); pv(o,vb0+sl_cur,PAF(0),PAF(1),PAF(2),PAF(3)); }
  #undef PKW
  #undef PAF
  #undef VFR
  #undef PIN
  #undef MX3
  #undef GAPA
  #undef GAPB
  #undef EX
  #undef VRD
  #undef KRD
  #undef STEP
  #undef ENDW
  {auto rr=__builtin_amdgcn_permlane32_swap(__float_as_uint(l_reg),__float_as_uint(l_reg),false,false);l_reg=__uint_as_float(rr[0])+__uint_as_float(rr[1]);}
  if(hi==0)wsf[32+r32]=l_reg;asm volatile("s_waitcnt lgkmcnt(0)":::"memory");
  float rli[16];
  #pragma unroll
  for(int r=0;r<16;++r)rli[r]=__builtin_amdgcn_rcpf(wsf[32+crow(r,hi)]);
  bf16*Ow=O+(rowbase+q0+wid*QBLK)*OPITCH+OCOL0+hv*D;
  { bf16*stg=(bf16*)(shm+LDS_OST)+wid*2048; bf16*stga=(bf16*)(shm+LDS_OSTA)+wid*2048;
    #pragma unroll
    for(int r=0;r<16;++r){const int orow=crow(r,hi);
      #pragma unroll
      for(int d0=0;d0<2;++d0){const int ix=orow*64+d0*32+r32; const float ov=o[d0][r]*rli[r]; if(pass==0)stga[ix]=__float2bfloat16(ov); else stg[ix]=__float2bfloat16(__bfloat162float(stga[ix])-lam*ov);}}
    asm volatile("s_waitcnt lgkmcnt(0)":::"memory");
    #pragma unroll
    for(int i=0;i<4;++i){const int row=i*8+(lane>>3),ch=lane&7; if(pass!=0){const u32x4 v=*(const u32x4*)(stg+row*64+ch*8); ATTN_STORE16(Ow+(long)row*OPITCH+ch*8,v);}} }
  asm volatile("s_waitcnt lgkmcnt(0)\n\ts_barrier":::"memory");
  #undef DMA_K
  #undef DMA_V
  #undef CMASK
  #undef START
  #undef RESC
  #undef ROT
}
constexpr int ATTN_LDS_BYTES=LDS_BYTES;
struct AttnTensors { const bf16* Q; const bf16* K; const bf16* V; bf16* O; float lam; const float* relb; };
struct AttnUnit { int bh; int qb; };
struct StaticOrder {
  int vcu;
  __device__ __forceinline__ explicit StaticOrder(int grid,int block):vcu((block%8)*(grid/8)+block/8){}
  __device__ __forceinline__ bool next(int i,AttnUnit&u)const{ if(i>=4)return false; const int s=vcu&7; u.bh=vcu>>3; u.qb=(i==0)?s:(i==1)?15-s:(i==2)?16+s:31-s; return true; }
  __device__ __forceinline__ void a_ready(const AttnUnit&)const{}
  __device__ __forceinline__ void done(const AttnUnit&)const{}
};
template<class Sched,int THRL=8> __device__ __forceinline__ void attn_phase(char*lds,const AttnTensors&T,const Sched&S){
  AttnUnit u;
  for(int i=0;S.next(i,u);++i){ S.a_ready(u); const int b_=u.bh/NHEAD,hp_=u.bh%NHEAD; float*bt_=(float*)(lds+LDS_BTAB);
    for(int t_=threadIdx.x;t_<BT_N;t_+=NW*64){ const int rel=t_-256; float v_=0.f;
      if(rel>=0&&rel<113){ int bk=rel; if(rel>=16){ bk=16+(int)(logf((float)rel*(1.0f/16.0f))/logf(8.0f)*16.0f); bk=bk>31?31:bk; } v_=(T.relb[bk*8+(hp_>>1)]-T.relb[31*8+(hp_>>1)])*1.4426950408889634f; }
      bt_[t_]=v_; }
    asm volatile("s_waitcnt lgkmcnt(0)\n\ts_barrier":::"memory");
    for(int pass=0;pass<2;++pass) attn_unit<THRL>(b_,(hp_&~1)+pass,hp_,u.qb,pass,T.lam,bt_,T.Q,T.K,T.V,T.O,lds); S.done(u); }
}
#undef SBAR
#undef WAIT_BAR
}
namespace attn2 {
using attn_body::bf16; using attn_body::bf16x8; using attn_body::s16x4; using attn_body::f32x16; using attn_body::u32x4; using attn_body::lds_cptr;
using attn_body::glds16; using attn_body::vtr; using attn_body::cvtpk_s; using attn_body::crow; using attn_body::BT_N;
constexpr int SEQ=8192,DM=1024,NW=8,QBLK=32,QB=256;
constexpr int KSLOT=8192,VSLOT=8192,NS=4,NSV=5;
constexpr int L_K=0,L_V=NS*KSLOT,L_WS=L_V+NSV*VSLOT,L_OST=0,L_BTAB=L_WS+NW*256,L_TOTAL=L_BTAB+BT_N*4;
static_assert(NW*8192<=L_WS,"O stage inside the ring region");
constexpr int OP=2048,OC0=1024;
#define SBAR() __builtin_amdgcn_sched_barrier(0)
#define WAIT_BAR(N) asm volatile("s_waitcnt vmcnt(" #N ") lgkmcnt(0)\n\ts_barrier":::"memory")
#define A2LAS __attribute__((address_space(3)))
__device__ __forceinline__ void bmask1(f32x16&p,int jb,int qrel,int hi,const float*bt){
  const float NEG=-INFINITY; const int brel=qrel-32*jb-4*hi; const float*bp=bt+(brel+256);
  #pragma unroll
  for(int r=0;r<16;++r){const int c0=(r&3)+8*(r>>2); const float b0=bp[-c0]; p[r]=(brel<c0)?NEG:p[r]+b0; if((r&3)==3)SBAR();}
}
__device__ __forceinline__ float rowmax1(const f32x16&p){
  #define MX3(a,b,c) __builtin_fmaxf(__builtin_fmaxf((a),(b)),(c))
  float a=MX3(p[0],p[1],p[2]),b=MX3(p[3],p[4],p[5]); a=MX3(a,p[6],p[7]); b=MX3(b,p[8],p[9]); a=MX3(a,p[10],p[11]); b=MX3(b,p[12],p[13]); a=MX3(a,p[14],p[15]);
  float m=__builtin_fmaxf(a,b); auto rr=__builtin_amdgcn_permlane32_swap(__float_as_uint(m),__float_as_uint(m),false,false);
  return __builtin_fmaxf(__uint_as_float(rr[0]),__uint_as_float(rr[1]));
  #undef MX3
}
template<int THRL> __device__ __forceinline__ void unit2(int b,int h,int qb,int pass,float lam,float kmax2,float bmax,const float*subg,const float*btab,const bf16*Q,const bf16*__restrict__ K,const bf16*__restrict__ V,bf16*O,char*shm){
  const int tid=threadIdx.x,lane=tid&63,r32=lane&31,hi=lane>>5; const int wid=__builtin_amdgcn_readfirstlane(tid>>6);
  const long rowbase=(long)b*SEQ; const int q0=qb*QB; const int hq=2*h+pass;
  const bf16*Qw=Q+(rowbase+q0+wid*QBLK)*DM+hq*64;
  const bf16*Kh=K+rowbase*DM+hq*64,*Vh=V+rowbase*DM+h*128;
  const unsigned lds0=(unsigned)(uintptr_t)shm;
  float*wsf=(float*)(shm+L_WS)+wid*64;
  const bf16*ksrc=Kh+(long)lane*DM+wid*8;
  const bf16*vsrc=Vh+(long)(16*(wid&1)+(lane>>2))*DM+(wid>>1)*32+(lane&3)*8;
  const unsigned kdst=lds0+L_K+wid*1024, vdst=lds0+L_V+wid*1024;
  #define DMA_K(T,slot) glds16(ksrc+(long)(T)*64*DM,(unsigned)__builtin_amdgcn_readfirstlane(kdst+(slot)))
  #define DMA_V(u,slot) glds16(vsrc+(long)(u)*32*DM,(unsigned)__builtin_amdgcn_readfirstlane(vdst+(slot)))
  const lds_cptr shm3=(lds_cptr)shm; const lds_cptr kp0=shm3+L_K+hi*1024+r32*16;
  const lds_cptr vp0=shm3+L_V+((lane>>4)&1)*32+(lane&3)*8+(4*hi+((lane&15)>>2))*64;
  const int NT2=(q0+QB)/32, NT=NT2/2;
  DMA_K(0,0);DMA_V(0,0);DMA_K(1,KSLOT);
  bf16x8 qr[4];
  #pragma unroll
  for(int d0=0;d0<4;++d0)qr[d0]=*reinterpret_cast<const bf16x8*>(&Qw[(long)r32*DM+d0*16+hi*8]);
  float l_reg=0.f;f32x16 o[4];o[0]=f32x16{};o[1]=f32x16{};o[2]=f32x16{};o[3]=f32x16{};
  f32x16 negm;
  { float q2=0.f;
    #pragma unroll
    for(int d0=0;d0<4;++d0)
      #pragma unroll
      for(int j=0;j<8;++j){ const float qv=__uint_as_float((unsigned)(unsigned short)qr[d0][j]<<16); q2+=qv*qv; }
    auto rr=__builtin_amdgcn_permlane32_swap(__float_as_uint(q2),__float_as_uint(q2),false,false); q2=__uint_as_float(rr[0])+__uint_as_float(rr[1]);
    const float mref=__builtin_sqrtf(q2*kmax2)*1.01f+bmax+0.0078125f;
    #pragma unroll
    for(int r=0;r<16;++r)negm[r]=-mref;
    asm volatile("":"+v"(negm)); }
  const int qrel=wid*QBLK+r32;
  f32x16 pA,pB; bf16x8 kf[4]; s16x4 vlo[8],vhi[8]; u32x4 pw0,pw1;
  int sv_prev=0,sv_cur=VSLOT,sv_n1=2*VSLOT,sv_n2=3*VSLOT,sv_sp=4*VSLOT;
  int sk_cur=0,sk_next=KSLOT,sk_nn=2*KSLOT,sk_sp=3*KSLOT;
  #define ROTV() do{const int t_=sv_prev;sv_prev=sv_cur;sv_cur=sv_n1;sv_n1=sv_n2;sv_n2=sv_sp;sv_sp=t_;}while(0)
  #define ROTK() do{const int t_=sk_cur;sk_cur=sk_next;sk_next=sk_nn;sk_nn=sk_sp;sk_sp=t_;}while(0)
  #define KLD(j,p) kf[j]=*(const A2LAS bf16x8*)((p)+(j)*2048)
  DMA_K(2,2*KSLOT);DMA_V(1,VSLOT);
  WAIT_BAR(4);
  { KLD(0,kp0);KLD(1,kp0);KLD(2,kp0);KLD(3,kp0);
    pA=__builtin_amdgcn_mfma_f32_32x32x16_bf16(kf[0],qr[0],negm,0,0,0); pA=__builtin_amdgcn_mfma_f32_32x32x16_bf16(kf[1],qr[1],pA,0,0,0);
    pA=__builtin_amdgcn_mfma_f32_32x32x16_bf16(kf[2],qr[2],pA,0,0,0); pA=__builtin_amdgcn_mfma_f32_32x32x16_bf16(kf[3],qr[3],pA,0,0,0);
    if(NT2==8)bmask1(pA,0,qrel,hi,btab);
    #pragma unroll
    for(int r=0;r<16;++r)pA[r]=__builtin_amdgcn_exp2f(pA[r]);
    KLD(0,kp0+512);KLD(1,kp0+512);KLD(2,kp0+512);KLD(3,kp0+512); }
  WAIT_BAR(0);
  #define PKW(P,B) cvtpk_s(P[B],P[B+1])
  #define PAF(k) __builtin_bit_cast(bf16x8,pw##k)
  #define VFR(i) (bf16x8){vlo[i][0],vlo[i][1],vlo[i][2],vlo[i][3],vhi[i][0],vhi[i][1],vhi[i][2],vhi[i][3]}
  #define PIN(x) asm volatile("":"+v"(x))
  #define MX3(a,b,c) __builtin_fmaxf(__builtin_fmaxf((a),(b)),(c))
  #define EX(v) __builtin_amdgcn_exp2f(v)
  #define GAPA(MF,A0,A1,A2,A3,W0,W1,PW) do{ MF; sacc+=A0; sacc+=A1; sacc+=A2; sacc+=A3; PIN(sacc); W0; W1; PIN(PW); SBAR(); }while(0)
  #define GAPB(MF,X,B) do{ MF; X[B]=EX(X[B]); X[B+1]=EX(X[B+1]); PIN(X); SBAR(); }while(0)
  #define VRD(i) do{ vlo[i]=vtr(vp_+(((i)>>1)*2048+((i)&1)*1024)); vhi[i]=vtr(vp_+(((i)>>1)*2048+((i)&1)*1024+512)); }while(0)
  #define KRD(G,j) do{ if(G){ KLD(j,kn_); SBAR(); } }while(0)
  #define MF32(a,b,c) __builtin_amdgcn_mfma_f32_32x32x16_bf16(a,b,c,0,0,0)
  #define SUB(C,P,u,ODD,GK,GV,GV2,GL,MASK,MIDW) do{ SBAR(); \
    const lds_cptr vp_=vp0+sv_prev; const lds_cptr kn_=kp0+((ODD)?sk_next:(sk_cur+512)); \
    VRD(0); SBAR(); float sacc=(P[0]+P[1]); \
    GAPA(C=MF32(kf[0],qr[0],negm), P[2],P[3],P[4],P[5],     pw0[0]=PKW(P,0), pw0[1]=PKW(P,2), pw0); \
    VRD(2); SBAR(); GAPA(C=MF32(kf[1],qr[1],C), P[6],P[7],P[8],P[9],     pw0[2]=PKW(P,4), pw0[3]=PKW(P,6), pw0); \
    VRD(1); SBAR(); GAPA(C=MF32(kf[2],qr[2],C), P[10],P[11],P[12],P[13], pw1[0]=PKW(P,8), pw1[1]=PKW(P,10), pw1); \
    VRD(3); SBAR(); GAPA(C=MF32(kf[3],qr[3],C), P[14],P[15],0.f,0.f,     pw1[2]=PKW(P,12),pw1[3]=PKW(P,14), pw1); \
    l_reg+=sacc; \
    if(ODD){ if(GV){DMA_V((u)+1,sv_n1);} if(GV2){DMA_V((u)+2,sv_n2);} if(GK){DMA_K(((u)>>1)+3,sk_sp);} } \
    if(MASK){ const int jb_=(u)-(NT2-8); if(jb_>=-4)bmask1(C,jb_,qrel,hi,btab); } \
    SBAR(); \
    if((MIDW)>=0 && wid>=4){ if((MIDW)==1){WAIT_BAR(1);}else{WAIT_BAR(0);} } \
    SBAR(); \
    VRD(4); SBAR(); GAPB(o[0]=MF32(PAF(0),VFR(0),o[0]), C,0); \
    VRD(6); SBAR(); GAPB(o[1]=MF32(PAF(0),VFR(2),o[1]), C,2); \
    VRD(5); SBAR(); GAPB(o[0]=MF32(PAF(1),VFR(1),o[0]), C,4); \
    VRD(7); SBAR(); GAPB(o[1]=MF32(PAF(1),VFR(3),o[1]), C,6); \
    KRD(GL,0); GAPB(o[2]=MF32(PAF(0),VFR(4),o[2]), C,8); \
    KRD(GL,1); GAPB(o[3]=MF32(PAF(0),VFR(6),o[3]), C,10); \
    KRD(GL,2); GAPB(o[2]=MF32(PAF(1),VFR(5),o[2]), C,12); \
    KRD(GL,3); GAPB(o[3]=MF32(PAF(1),VFR(7),o[3]), C,14); \
    }while(0)
  int u=1;
  for(;u+13<NT2;u+=2){
    SUB(pB,pA,u,true,true,true,true,true,false,-1); ROTV(); ROTK();
    SUB(pA,pB,u+1,false,false,false,false,true,false,1);   if(wid<4){WAIT_BAR(1);} ROTV();
  }
  for(;u+1<NT2;u+=2){
    const bool gk=((u>>1)+3<NT), gv2=(u+2<NT2);
    SUB(pB,pA,u,true,gk,true,gv2,true,true,-1); ROTV(); ROTK();
    { const int mw_=gk?1:0; SUB(pA,pB,u+1,false,false,false,false,gv2,true,mw_); if(wid<4){ if(gk){WAIT_BAR(1);}else{WAIT_BAR(0);} } } ROTV();
  }
  SUB(pB,pA,NT2-1,true,false,false,false,false,true,-1);
  { float sacc=pB[0]+pB[1];
    #pragma unroll
    for(int r=2;r<16;++r)sacc+=pB[r];
    l_reg+=sacc;
    pw0=(u32x4){PKW(pB,0),PKW(pB,2),PKW(pB,4),PKW(pB,6)};pw1=(u32x4){PKW(pB,8),PKW(pB,10),PKW(pB,12),PKW(pB,14)};
    SBAR(); const lds_cptr vp_=vp0+sv_cur;
    #pragma unroll
    for(int db=0;db<4;++db){ VRD(2*db); VRD(2*db+1); o[db]=MF32(PAF(0),VFR(2*db),o[db]); o[db]=MF32(PAF(1),VFR(2*db+1),o[db]); } }
  #undef PKW
  #undef PAF
  #undef VFR
  #undef PIN
  #undef MX3
  #undef EX
  #undef GAPA
  #undef GAPB
  #undef VRD
  #undef KRD
  #undef SUB
  asm volatile("s_waitcnt lgkmcnt(0)\n\ts_barrier":::"memory");
  {auto rr=__builtin_amdgcn_permlane32_swap(__float_as_uint(l_reg),__float_as_uint(l_reg),false,false);l_reg=__uint_as_float(rr[0])+__uint_as_float(rr[1]);}
  if(hi==0)wsf[32+r32]=l_reg;asm volatile("s_waitcnt lgkmcnt(0)":::"memory");
  float rli[16];
  #pragma unroll
  for(int r=0;r<16;++r)rli[r]=__builtin_amdgcn_rcpf(wsf[32+crow(r,hi)]);
  bf16*Ow=O+(rowbase+q0+wid*QBLK)*OP+OC0+h*128;
  { bf16*stg=(bf16*)(shm+L_OST)+wid*4096;
    #pragma unroll
    for(int r=0;r<16;++r){const int orow=crow(r,hi);
      #pragma unroll
      for(int db=0;db<4;++db)stg[orow*128+db*32+r32]=__float2bfloat16(o[db][r]*rli[r]);}
    asm volatile("s_waitcnt lgkmcnt(0)":::"memory");
    float sg[8];
    #pragma unroll
    for(int e=0;e<8;++e)sg[e]=subg[(lane&15)*8+e]*0.8f;
    #pragma unroll
    for(int i=0;i<8;++i){const int row=i*4+(lane>>4),ch=lane&15; u32x4 v=*(const u32x4*)(stg+row*128+ch*8); bf16*gp=Ow+(long)row*OP+ch*8;
      if(pass!=0){ const u32x4 a=*(const u32x4*)gp; u32x4 w; float d[8]; float ss=0.f;
        #pragma unroll
        for(int e=0;e<4;++e){ const float a0=__uint_as_float(a[e]<<16),a1=__uint_as_float(a[e]&0xffff0000u),b0=__uint_as_float(v[e]<<16),b1=__uint_as_float(v[e]&0xffff0000u); d[2*e]=a0-lam*b0; d[2*e+1]=a1-lam*b1; ss+=d[2*e]*d[2*e]+d[2*e+1]*d[2*e+1]; }
        ss+=__shfl_xor(ss,1); ss+=__shfl_xor(ss,2); ss+=__shfl_xor(ss,4); ss+=__shfl_xor(ss,8);
        const float rs=rsqrtf(ss*(1.f/128.f)+1e-6f);
        #pragma unroll
        for(int e=0;e<4;++e) w[e]=cvtpk_s(d[2*e]*rs*sg[2*e],d[2*e+1]*rs*sg[2*e+1]);
        v=w; }
      asm volatile("global_store_dwordx4 %0, %1, off sc1\n\ts_nop 1"::"v"(gp),"v"(v):"memory"); } }
  asm volatile("s_waitcnt lgkmcnt(0)\n\ts_barrier":::"memory");
  #undef DMA_K
  #undef DMA_V
  #undef ROTV
  #undef ROTK
  #undef KLD
  #undef MF32
}
struct Tensors { const bf16* Q; const bf16* K; const bf16* V; bf16* O; float lam; const float* relb; const float* subg; const float* kmax; };
template<int THRL=8> __device__ __forceinline__ void phase(char*lds,const Tensors&T,int grid,int block){
  const int vcu=(block%8)*(grid/8)+block/8;
  for(int i=0;i<2;++i){ const int bh=vcu>>4,s=vcu&15,qb=(i==0)?s:31-s,b_=bh>>3,h_=bh&7; float*bt_=(float*)(lds+L_BTAB);
    for(int t_=threadIdx.x;t_<BT_N;t_+=NW*64){ const int rel=t_-256; float v_=0.f;
      if(rel>=0&&rel<113){ int bk=rel; if(rel>=16){ bk=16+(int)(logf((float)rel*(1.0f/16.0f))/logf(8.0f)*16.0f); bk=bk>31?31:bk; } v_=(T.relb[bk*8+h_]-T.relb[31*8+h_])*1.4426950408889634f; }
      bt_[t_]=v_; }
    asm volatile("s_waitcnt lgkmcnt(0)\n\ts_barrier":::"memory");
    float bmax=0.f;
    for(int bk=0;bk<31;++bk)bmax=__builtin_fmaxf(bmax,(T.relb[bk*8+h_]-T.relb[31*8+h_])*1.4426950408889634f);
    for(int pass=0;pass<2;++pass){ const float*kp_=T.kmax+((bh*2+pass)*2); const float kmax2=__hip_atomic_load(kp_,__ATOMIC_RELAXED,__HIP_MEMORY_SCOPE_AGENT)+__hip_atomic_load(kp_+1,__ATOMIC_RELAXED,__HIP_MEMORY_SCOPE_AGENT);
      unit2<THRL>(b_,h_,qb,pass,T.lam,kmax2,bmax,T.subg,bt_,T.Q,T.K,T.V,T.O,lds); } }
}
#undef SBAR
#undef WAIT_BAR
#undef A2LAS
}
constexpr int NWAVES = 8;
constexpr int BATCH = 2, SEQ = 8192, DM = 1024, M = BATCH * SEQ;
constexpr int DFF = 2816, NGU = 2 * DFF;
constexpr int NQKV = 3072;
constexpr int NMIX = 2816;
constexpr int NIN = NQKV + NMIX;
constexpr int IN_WIDTH = 5648;
constexpr int KOUT = 2048;
constexpr int NMOD = 9 * DM;
constexpr int NCHUNK = SEQ / 128, NBC = BATCH * NCHUNK;
constexpr float EPS = 1e-6f;
constexpr float LAM_INIT = 0.2f;
constexpr float LOG2E = 1.4426950408889634f;

constexpr size_t MiB = 1u << 20;
constexpr size_t WS_CTL = 0, CTL_ZERO_BYTES = 64 * 1024;
constexpr size_t WS_MOD = 1 * MiB;
constexpr size_t WS_DTRAW = 2 * MiB;
constexpr size_t WS_DTS = 3 * MiB;
constexpr size_t WS_AC = 4 * MiB;
constexpr size_t WS_CDEC = 5 * MiB;
constexpr size_t WS_WA = 6 * MiB;
constexpr size_t WS_WB = 18 * MiB;
constexpr size_t WS_H = 24 * MiB;
constexpr size_t WS_U = 56 * MiB;
constexpr size_t WS_ACT = WS_U, WS_D = WS_U + 88 * MiB;
constexpr size_t WS_Q = WS_U, WS_K = WS_U + 32 * MiB, WS_V = WS_U + 64 * MiB;
constexpr size_t WS_YCAT = WS_U + 96 * MiB;
constexpr size_t WS_Z = WS_U, WS_XBC = WS_U + 32 * MiB;
constexpr size_t WS_BT = WS_U + 80 * MiB, WS_CM = WS_U + 88 * MiB;
constexpr size_t WS_XT = WS_U + 160 * MiB, WS_BM = WS_U + 192 * MiB;
constexpr size_t WS_ST = WS_H;
constexpr size_t WS_D2 = WS_U;
constexpr size_t WS_X2 = WS_U + 152 * MiB;
constexpr size_t WS_END = 256 * MiB;
static_assert(WS_BM + 8 * MiB <= WS_END && WS_D + 64 * MiB <= WS_END && WS_YCAT + 64 * MiB <= WS_XT && WS_CM + 8 * MiB <= WS_YCAT && WS_XBC + 48 * MiB <= WS_BT, "d_ws map");

constexpr int RING_OFF = 0, RING_BYTES = 131072;
constexpr int LDSCTL_OFF = RING_BYTES, MISC_OFF = LDSCTL_OFF + 320;
constexpr int LDS_BYTES = 147456;
static_assert(attn_body::LDS_TOTAL <= RING_BYTES && attn2::L_TOTAL <= RING_BYTES, "attention scratch inside the ring region");

#define GAS __attribute__((address_space(1)))
#define LAS __attribute__((address_space(3)))
typedef unsigned short bf16;
typedef unsigned v4u __attribute__((ext_vector_type(4)));
typedef unsigned v2u __attribute__((ext_vector_type(2)));
typedef float f32x4 __attribute__((ext_vector_type(4)));
typedef float f32x16 __attribute__((ext_vector_type(16)));
typedef short bf16x8 __attribute__((ext_vector_type(8)));
typedef GAS unsigned gu32;
#define RLX_AGENT __ATOMIC_RELAXED, __HIP_MEMORY_SCOPE_AGENT
#define LDS_WAIT() asm volatile("s_waitcnt lgkmcnt(0)" ::: "memory")
#define VM_WAIT() asm volatile("s_waitcnt vmcnt(0)" ::: "memory")
__device__ __forceinline__ unsigned f2bf(float f) { unsigned u = __builtin_bit_cast(unsigned, f); return (u + 0x7fffu + ((u >> 16) & 1u)) >> 16; }
typedef float f32x2_p __attribute__((ext_vector_type(2))); typedef __bf16 bf16x2_p __attribute__((ext_vector_type(2)));
__device__ __forceinline__ unsigned pk2(float lo, float hi) { f32x2_p v = {lo, hi}; return __builtin_bit_cast(unsigned, __builtin_convertvector(v, bf16x2_p)); }
__device__ __forceinline__ void st16_wt(void* p, v4u v) { asm volatile("global_store_dwordx4 %0, %1, off sc1\n\ts_nop 1" :: "v"(p), "v"(v) : "memory"); }
__device__ __forceinline__ void st8_wt(void* p, v2u v) { asm volatile("global_store_dwordx2 %0, %1, off sc1\n\ts_nop 1" :: "v"(p), "v"(v) : "memory"); }
__device__ __forceinline__ void st4_wt(void* p, unsigned v) { asm volatile("global_store_dword %0, %1, off sc1\n\ts_nop 1" :: "v"(p), "v"(v) : "memory"); }
__device__ __forceinline__ float bf2f(unsigned short h) { return __builtin_bit_cast(float, (unsigned)h << 16); }
__device__ __forceinline__ float bflo(unsigned w) { return __builtin_bit_cast(float, w << 16); }
__device__ __forceinline__ float bfhi(unsigned w) { return __builtin_bit_cast(float, w & 0xffff0000u); }
__device__ __forceinline__ float silu(float v) { return v * __builtin_amdgcn_rcpf(1.0f + __expf(-v)); }
__device__ __forceinline__ int crow(int r, int hi) { return (r & 3) + 8 * (r >> 2) + 4 * hi; }
#define MFMA32(a, b, c) __builtin_amdgcn_mfma_f32_32x32x16_bf16(a, b, c, 0, 0, 0)

#define XB_TMO      128
#define XB_XCNT(j)  (256  + 64 * (j))
#define XB_XSUB(j)  (1280 + 64 * (j))
#define XB_XGEN(j)  (2304 + 64 * (j))
#define XB_TOP      3328
#define XB_TOPGEN   3392
#define XCD_BAR_WORDS 3456
#define XB_SPIN_CAP (1u << 18)
constexpr int CW_KMAX = 12288;
constexpr int CW_BAR = 4096;
static_assert((CW_BAR + XCD_BAR_WORDS) <= CW_KMAX && (CW_KMAX + 64) * 4 <= (int)CTL_ZERO_BYTES, "control words inside the memset region");
__device__ __forceinline__ unsigned xb_ld(unsigned* p)              { return __hip_atomic_load(p, __ATOMIC_RELAXED, __HIP_MEMORY_SCOPE_AGENT); }
__device__ __forceinline__ unsigned xb_add(unsigned* p, unsigned v) { return __hip_atomic_fetch_add(p, v, __ATOMIC_RELAXED, __HIP_MEMORY_SCOPE_AGENT); }
__device__ __forceinline__ unsigned xb_xcc_id() { return (unsigned)__builtin_amdgcn_s_getreg((3 << 11) | 20) & 0xFu; }
#define XB_SPIN(cond, bar) do { unsigned _sp = 0; while (cond) { __builtin_amdgcn_s_sleep(1); \
    if ((++_sp & 255u) == 0u) { if (xb_ld(&(bar)[XB_TMO])) break; if (_sp > XB_SPIN_CAP) { atomicAdd(&(bar)[XB_TMO], 1u); break; } } } } while (0)
struct XcdBarrier { unsigned* bar; unsigned x; volatile LAS unsigned* st; };
__device__ __forceinline__ XcdBarrier xcd_barrier_post(unsigned* bar, volatile LAS unsigned* st) {
    XcdBarrier b; b.bar = bar; b.x = xb_xcc_id(); b.st = st;
    if (threadIdx.x == 0) (void)xb_add(&bar[XB_XCNT(b.x)], 1u);
    return b;
}
__device__ __forceinline__ void xcd_barrier_complete(unsigned* bar, unsigned x, unsigned& nloc, unsigned& nx) {
    const unsigned G = gridDim.x * gridDim.y * gridDim.z;
    unsigned sum, cnt, mine, sp = 0u;
    for (;;) {
        sum = 0u; cnt = 0u; mine = 0u;
#pragma unroll
        for (unsigned j = 0; j < 16; ++j) { const unsigned c = xb_ld(&bar[XB_XCNT(j)]); sum += c; cnt += (c > 0u) ? 1u : 0u; mine = (j == x) ? c : mine; }
        if (sum == G) break;
        __builtin_amdgcn_s_sleep(1);
        if ((++sp & 255u) == 0u) { if (xb_ld(&bar[XB_TMO])) break; if (sp > XB_SPIN_CAP) { atomicAdd(&bar[XB_TMO], 1u); break; } }
    }
    nloc = mine > 0u ? mine : 1u; nx = cnt > 0u ? cnt : 1u;
}
__device__ __forceinline__ void xcd_barrier(const XcdBarrier& b) {
    asm volatile("s_waitcnt vmcnt(0)" ::: "memory");
    __syncthreads();
    if (threadIdx.x == 0) {
        unsigned* bar = b.bar;
        __builtin_amdgcn_s_waitcnt(0);
        unsigned nloc = b.st[0], nx = b.st[1];
        if (nloc == 0u) { xcd_barrier_complete(bar, b.x, nloc, nx); b.st[0] = nloc; b.st[1] = nx; }
        const unsigned old = xb_add(&bar[XB_XSUB(b.x)], 1u);
        const unsigned gen = old / nloc;
        if (old + 1u == (gen + 1u) * nloc) {
            __builtin_amdgcn_fence(__ATOMIC_RELEASE, "agent");
            asm volatile("s_waitcnt vmcnt(0)" ::: "memory");
            const unsigned og = xb_add(&bar[XB_TOP], 1u);
            const unsigned tg = og / nx;
            if (og + 1u == (tg + 1u) * nx) xb_add(&bar[XB_TOPGEN], 1u);
            else XB_SPIN(xb_ld(&bar[XB_TOPGEN]) == tg, bar);
            __builtin_amdgcn_fence(__ATOMIC_ACQUIRE, "agent");
            xb_add(&bar[XB_XGEN(b.x)], 1u);
            asm volatile("s_waitcnt vmcnt(0)" ::: "memory");
        } else {
            XB_SPIN(xb_ld(&bar[XB_XGEN(b.x)]) == gen, bar);
            __builtin_amdgcn_fence(__ATOMIC_ACQUIRE, "agent");
            asm volatile("s_waitcnt vmcnt(0)" ::: "memory");
        }
    }
    __syncthreads();
}

struct Frame {
    LAS unsigned char* lds;
    int tid, lane, wave;
    int vcu, G;
    int gw, NGW;
};
__device__ __forceinline__ float wave_sum(float v) {
#pragma unroll
    for (int o = 1; o < 64; o <<= 1) v += __shfl_xor(v, o);
    return v;
}
__device__ __forceinline__ void tr_item(const float* W, int N, int n0, int k0, bf16* WT, int K, int drow0, int nvalid, LAS float* scr, int lane) {
#pragma unroll 8
    for (int i = 0; i < 32; ++i) { const int kk = 2 * i + (lane >> 5); scr[kk * 33 + (lane & 31)] = __builtin_nontemporal_load(W + (size_t)(k0 + kk) * N + n0 + (lane & 31)); }
    LDS_WAIT(); asm volatile("" ::: "memory");
    const int c = lane & 7;
#pragma unroll
    for (int j = 0; j < 4; ++j) { const int n = (lane >> 3) + 8 * j; const LAS float* s = scr + (8 * c) * 33 + n;
        v4u o; o.x = pk2(s[0 * 33], s[1 * 33]); o.y = pk2(s[2 * 33], s[3 * 33]); o.z = pk2(s[4 * 33], s[5 * 33]); o.w = pk2(s[6 * 33], s[7 * 33]);
        if (n >= nvalid) o = (v4u){0u, 0u, 0u, 0u};
        st16_wt(WT + (size_t)(drow0 + n) * K + k0 + 8 * c, o); }
    LDS_WAIT(); asm volatile("" ::: "memory");
}
__device__ __forceinline__ void convert_gu_half(Frame& F, int w, int nw, const float* Wx, int up, bf16* WA) {
    LAS float* scr = (LAS float*)(F.lds + RING_OFF + F.wave * 16384);
    constexpr int NB = DFF / 32, I_G = (DM / 64) * NB;
    for (int r = w; r < I_G; r += nw) { const int kb = r / NB, nb = r % NB, n0 = 32 * nb;
        tr_item(Wx, DFF, n0, 64 * kb, WA, DM, (n0 >> 7) * 256 + (n0 & 127) + (up ? 128 : 0), 32, scr, F.lane); }
}
__device__ __forceinline__ void convert_down(Frame& F, int w, int nw, const float* Wd, bf16* WB) {
    LAS float* scr = (LAS float*)(F.lds + RING_OFF + F.wave * 16384);
    constexpr int I_D = (DFF / 64) * (DM / 32);
    for (int r = w; r < I_D; r += nw) { const int kb = r / (DM / 32), nb = r % (DM / 32); tr_item(Wd, DM, 32 * nb, 64 * kb, WB, DFF, 32 * nb, 32, scr, F.lane); }
}
__device__ __forceinline__ void convert_ffn(Frame& F, const float* Wg, const float* Wu, const float* Wd, bf16* WA, bf16* WB) {
    LAS float* scr = (LAS float*)(F.lds + RING_OFF + F.wave * 16384);
    constexpr int NB = DFF / 32, I_G = (DM / 64) * NB, I_D = (DFF / 64) * (DM / 32);
    for (int it = F.gw; it < 2 * I_G + I_D; it += F.NGW) {
        int r = it;
        if (r < 2 * I_G) { const int up = r >= I_G; if (up) r -= I_G; const int kb = r / NB, nb = r % NB, n0 = 32 * nb;
            tr_item(up ? Wu : Wg, DFF, n0, 64 * kb, WA, DM, (n0 >> 7) * 256 + (n0 & 127) + (up ? 128 : 0), 32, scr, F.lane); continue; }
        r -= 2 * I_G; { const int kb = r / (DM / 32), nb = r % (DM / 32); tr_item(Wd, DM, 32 * nb, 64 * kb, WB, DFF, 32 * nb, 32, scr, F.lane); }
    }
}
__device__ __forceinline__ void convert_mix(Frame& F, int w, int nw, const float* Win, const float* Wout, bf16* WA, bf16* WB) {
    LAS float* scr = (LAS float*)(F.lds + RING_OFF + F.wave * 16384);
    constexpr int NB_IN = 177, I_IN = (DM / 64) * NB_IN, I_OUT = (KOUT / 64) * (DM / 32);
    for (int it = w; it < I_IN + I_OUT; it += nw) {
        int r = it;
        if (r < I_IN) { const int kb = r / NB_IN; int nb = r % NB_IN; int src, dst, nv = 32;
            if (nb < 32) { src = 0 + 32 * nb; dst = 3072 + 32 * nb; }
            else if (nb < 80) { nb -= 32; src = 1024 + 32 * nb; dst = 4096 + 32 * nb; }
            else if (nb < 81) { src = 2560; dst = 5632; nv = 16; }
            else if (nb < 113) { nb -= 81; src = 2576 + 32 * nb; dst = 0 + 32 * nb; }
            else if (nb < 145) { nb -= 113; src = 3600 + 32 * nb; dst = 1024 + 32 * nb; }
            else { nb -= 145; src = 4624 + 32 * nb; dst = 2048 + 32 * nb; }
            tr_item(Win, IN_WIDTH, src, 64 * kb, WA, DM, dst, nv, scr, F.lane); continue; }
        r -= I_IN; { const int kb = r / (DM / 32), nb = r % (DM / 32); tr_item(Wout, DM, 32 * nb, 64 * kb, WB, KOUT, 32 * nb, 32, scr, F.lane); }
    }
    { GAS v4u* z = (GAS v4u*)(WA + (size_t)5664 * DM); const int n16 = 224 * DM * 2 / 16;
      for (int i = w * 64 + F.lane; i < n16; i += nw * 64) z[i] = (v4u){0u, 0u, 0u, 0u}; }
}
__device__ __forceinline__ void mod_gemv(Frame& F, const float* c, const float* w_ada, const float* b_ada, float* mod) {
    LAS float* cs = (LAS float*)(F.lds + RING_OFF);
    LAS float* red = cs + 2048;
    __syncthreads();
    for (int i = F.tid; i < 2 * DM; i += NWAVES * 64) cs[i] = silu(c[i]);
    __syncthreads();
    for (int u = blockIdx.x; u < NMOD / 64; u += F.G) {
        const int col = 64 * u + F.lane; float a0 = 0.f, a1 = 0.f;
        const float* wp = w_ada + (size_t)(128 * F.wave) * NMOD + col;
#pragma unroll 16
        for (int k = 0; k < 128; ++k) { const float w = __builtin_nontemporal_load(wp + (size_t)k * NMOD); a0 += cs[128 * F.wave + k] * w; a1 += cs[DM + 128 * F.wave + k] * w; }
        red[(F.wave * 2 + 0) * 64 + F.lane] = a0; red[(F.wave * 2 + 1) * 64 + F.lane] = a1;
        __syncthreads();
        if (F.tid < 128) { const int b = F.tid >> 6, l = F.tid & 63; float s = b_ada[64 * u + l];
#pragma unroll
            for (int w = 0; w < 8; ++w) s += red[(w * 2 + b) * 64 + l];
            mod[b * NMOD + 64 * u + l] = s; }
        __syncthreads();
    }
}

struct Row16 { f32x4 v[4]; };
__device__ __forceinline__ Row16 ld_row(const float* p, int lane) { Row16 r; const GAS f32x4* q = (const GAS f32x4*)p + lane;
#pragma unroll
    for (int j = 0; j < 4; ++j) r.v[j] = q[64 * j];
    return r; }
__device__ __forceinline__ Row16 ld_row_bf(const bf16* p, int lane) { Row16 r; const GAS v2u* q = (const GAS v2u*)p + lane;
#pragma unroll
    for (int j = 0; j < 4; ++j) { const v2u w = q[64 * j]; r.v[j] = (f32x4){bflo(w.x), bfhi(w.x), bflo(w.y), bfhi(w.y)}; }
    return r; }
__device__ __forceinline__ float row_ssq_part(const Row16& r) { float s = 0.f;
#pragma unroll
    for (int j = 0; j < 4; ++j) s += (r.v[j].x * r.v[j].x + r.v[j].y * r.v[j].y) + (r.v[j].z * r.v[j].z + r.v[j].w * r.v[j].w);
    return s; }
__device__ __forceinline__ void st_row_bf(bf16* out, const Row16& h, int lane) { unsigned long long* o8 = (unsigned long long*)out + lane;
#pragma unroll
    for (int j = 0; j < 4; ++j) { v2u w; w.x = pk2(h.v[j].x, h.v[j].y); w.y = pk2(h.v[j].z, h.v[j].w); *(GAS v2u*)(o8 + 64 * j) = w; } }
constexpr int RW = 4;
__device__ __forceinline__ void rows_first(Frame& F, const float* x, const float* pre_g, const float* mod, int sidx, bf16* H) {
#pragma unroll 1
    for (int b = 0; b < BATCH; ++b) { const float* mb = mod + b * NMOD;
        Row16 A = ld_row(pre_g, F.lane); const Row16 SC = ld_row(mb + (sidx + 1) * DM, F.lane), S = ld_row(mb + sidx * DM, F.lane);
#pragma unroll
        for (int j = 0; j < 4; ++j) A.v[j] = A.v[j] * (SC.v[j] + 1.0f);
#pragma unroll 1
        for (int r = F.gw; r < SEQ; r += RW * F.NGW) { Row16 xr[RW]; size_t m[RW]; bool ok[RW];
#pragma unroll
            for (int q = 0; q < RW; ++q) { ok[q] = r + q * F.NGW < SEQ; m[q] = (size_t)b * SEQ + (ok[q] ? r + q * F.NGW : r); xr[q] = ld_row(x + m[q] * DM, F.lane); }
#pragma unroll
            for (int q = 0; q < RW; ++q) { const float rs = rsqrtf(wave_sum(row_ssq_part(xr[q])) * (1.f / DM) + EPS);
#pragma unroll
                for (int j = 0; j < 4; ++j) xr[q].v[j] = xr[q].v[j] * rs * A.v[j] + S.v[j];
                if (ok[q]) st_row_bf(H + m[q] * DM, xr[q], F.lane); } } }
}
template <bool NEXT, bool XIB, bool XOB> __device__ __forceinline__ void rows_res(Frame& F, const void* xin, const bf16* Dm, const float* post_g, const float* mod, int gidx, float gscale, void* xo,
                                                                                  const float* pre_g, int sidx, bf16* H) {
#pragma unroll 1
    for (int b = 0; b < BATCH; ++b) { const float* mb = mod + b * NMOD;
        Row16 PGT = ld_row(post_g, F.lane); { const Row16 GT = ld_row(mb + gidx * DM, F.lane);
#pragma unroll
            for (int j = 0; j < 4; ++j) PGT.v[j] = PGT.v[j] * GT.v[j] * gscale; }
        Row16 A, S;
        if (NEXT) { A = ld_row(pre_g, F.lane); const Row16 SC = ld_row(mb + (sidx + 1) * DM, F.lane); S = ld_row(mb + sidx * DM, F.lane);
#pragma unroll
            for (int j = 0; j < 4; ++j) A.v[j] = A.v[j] * (SC.v[j] + 1.0f); }
#pragma unroll 1
        for (int r = F.gw; r < SEQ; r += RW * F.NGW) { Row16 xr[RW], dr[RW]; size_t m[RW]; bool ok[RW];
#pragma unroll
            for (int q = 0; q < RW; ++q) { ok[q] = r + q * F.NGW < SEQ; m[q] = (size_t)b * SEQ + (ok[q] ? r + q * F.NGW : r);
                xr[q] = XIB ? ld_row_bf((const bf16*)xin + m[q] * DM, F.lane) : ld_row((const float*)xin + m[q] * DM, F.lane); dr[q] = ld_row_bf(Dm + m[q] * DM, F.lane); }
#pragma unroll
            for (int q = 0; q < RW; ++q) { const float qs = rsqrtf(wave_sum(row_ssq_part(dr[q])) * (1.f / DM) + EPS);
#pragma unroll
                for (int j = 0; j < 4; ++j) xr[q].v[j] = xr[q].v[j] + PGT.v[j] * (dr[q].v[j] * qs);
                if (ok[q]) { if (XOB) st_row_bf((bf16*)xo + m[q] * DM, xr[q], F.lane);
                    else { GAS f32x4* o = (GAS f32x4*)((float*)xo + m[q] * DM) + F.lane;
#pragma unroll
                        for (int j = 0; j < 4; ++j) o[64 * j] = xr[q].v[j]; } }
                if (NEXT) { const float rs = rsqrtf(wave_sum(row_ssq_part(xr[q])) * (1.f / DM) + EPS);
#pragma unroll
                    for (int j = 0; j < 4; ++j) xr[q].v[j] = xr[q].v[j] * rs * A.v[j] + S.v[j];
                    if (ok[q]) st_row_bf(H + m[q] * DM, xr[q], F.lane); } } } }
}
__device__ __forceinline__ float bf_elem(const v4u& w, int e) { const unsigned u = (e >> 1) == 0 ? w.x : (e >> 1) == 1 ? w.y : (e >> 1) == 2 ? w.z : w.w; return (e & 1) ? bfhi(u) : bflo(u); }
__device__ __forceinline__ void conv_item(int lane, int bc, int cg, const bf16* XBC, const float* conv_w, const float* conv_b, bf16* XT, bf16* Bm, bf16* BTm, bf16* Cm) {
    const int o = lane >> 2, q = lane & 3, c = bc % NCHUNK; const size_t t0 = (size_t)bc * 128;
    const int ch0 = cg * 32 + q * 8;
    v4u raw[11];
#pragma unroll
    for (int k = 0; k < 11; ++k) { const int row = 8 * o + k - 3; raw[k] = (v4u){0u, 0u, 0u, 0u};
        if (row >= 0 || c > 0) raw[k] = *(const GAS v4u*)(XBC + (size_t)((long)t0 + row) * 1536 + ch0); }
    float wk[4][8], cb[8];
#pragma unroll
    for (int k = 0; k < 4; ++k) { const f32x4 a = *(const GAS f32x4*)(conv_w + k * 1536 + ch0), b = *(const GAS f32x4*)(conv_w + k * 1536 + ch0 + 4);
#pragma unroll
        for (int e = 0; e < 4; ++e) { wk[k][e] = a[e]; wk[k][4 + e] = b[e]; } }
    { const f32x4 a = *(const GAS f32x4*)(conv_b + ch0), b = *(const GAS f32x4*)(conv_b + ch0 + 4);
#pragma unroll
      for (int e = 0; e < 4; ++e) { cb[e] = a[e]; cb[4 + e] = b[e]; } }
    float outv[8][8];
#pragma unroll
    for (int e = 0; e < 8; ++e) { float x[11];
#pragma unroll
        for (int k = 0; k < 11; ++k) x[k] = bf_elem(raw[k], e);
#pragma unroll
        for (int jj = 0; jj < 8; ++jj) outv[jj][e] = silu(cb[e] + wk[0][e] * x[jj] + wk[1][e] * x[jj + 1] + wk[2][e] * x[jj + 2] + wk[3][e] * x[jj + 3]); }
    if (cg < 40) {
        bf16* dst;
        if (cg < 32) dst = XT + (((size_t)bc * 16 + (cg >> 1)) * 64 + (cg & 1) * 32 + q * 8) * 128 + 8 * o;
        else { const int bb = cg - 32; dst = BTm + (((size_t)bc * 2 + (bb >> 2)) * 128 + (bb & 3) * 32 + q * 8) * 128 + 8 * o; }
#pragma unroll
        for (int e = 0; e < 8; ++e) { v4u w; w.x = pk2(outv[0][e], outv[1][e]); w.y = pk2(outv[2][e], outv[3][e]); w.z = pk2(outv[4][e], outv[5][e]); w.w = pk2(outv[6][e], outv[7][e]);
            st16_wt(dst + (size_t)e * 128, w); }
    }
    if (cg >= 32) {
        const int bb = (cg - 32) & 7; bf16* dst = (cg < 40 ? Bm : Cm) + (((size_t)bc * 2 + ((bb & 7) >> 2)) * 128 + 8 * o) * 128 + (bb & 3) * 32 + q * 8;
#pragma unroll
        for (int jj = 0; jj < 8; ++jj) { v4u w; w.x = pk2(outv[jj][0], outv[jj][1]); w.y = pk2(outv[jj][2], outv[jj][3]); w.z = pk2(outv[jj][4], outv[jj][5]); w.w = pk2(outv[jj][6], outv[jj][7]);
            st16_wt(dst + (size_t)jj * 128, w); }
    }
}
__device__ __forceinline__ void dt_item(int lane, int it, const float* dtraw, const float* dt_bias, const float* a_log, float* DTS, float* AC, float* CDEC) {
    const int bc = it >> 4, h = it & 15; const size_t t0 = (size_t)bc * 128;
    const float bias = dt_bias[h], a = -__expf(a_log[h]);
    const float x0 = dtraw[(t0 + 2 * lane) * 16 + h] + bias, x1 = dtraw[(t0 + 2 * lane + 1) * 16 + h] + bias;
    const float d0 = x0 > 20.f ? x0 : log1pf(__expf(x0)), d1 = x1 > 20.f ? x1 : log1pf(__expf(x1));
    float* dp = DTS + (size_t)it * 128 + 2 * lane; dp[0] = d0; dp[1] = d1;
    const float v0 = d0 * a, v1 = d1 * a, s = v0 + v1; float inc = s;
#pragma unroll
    for (int sh = 1; sh < 64; sh <<= 1) { const float t = __shfl_up(inc, sh); if (lane >= sh) inc += t; }
    const float ex = inc - s; float* acp = AC + (size_t)it * 128 + 2 * lane; acp[0] = ex + v0; acp[1] = ex + v0 + v1;
    if (lane == 63) CDEC[it] = __expf(inc);
}
__device__ __forceinline__ bf16x8 scale8(v4u w, const float* s) {
    v4u o; o.x = pk2(bflo(w.x) * s[0], bfhi(w.x) * s[1]); o.y = pk2(bflo(w.y) * s[2], bfhi(w.y) * s[3]); o.z = pk2(bflo(w.z) * s[4], bfhi(w.z) * s[5]); o.w = pk2(bflo(w.w) * s[6], bfhi(w.w) * s[7]);
    return __builtin_bit_cast(bf16x8, o); }
__device__ __forceinline__ void states_item(Frame& F, int it2, const bf16* XT, const bf16* BTm, const float* DTS, const float* AC, bf16* ST) {
    LAS float* wl = (LAS float*)(F.lds + RING_OFF + F.wave * 1024);
    { const int it = it2 >> 1, nh = it2 & 1, bc = it >> 4, h = it & 15, g = h >> 3;
        int lane_ = F.lane; asm volatile("" : "+v"(lane_));
        const int r32 = lane_ & 31, hi = lane_ >> 5;
        const bf16* xt = XT + (size_t)it * 64 * 128 + (size_t)r32 * 128 + 8 * hi; const bf16* bt = BTm + ((size_t)bc * 2 + g) * 128 * 128 + (size_t)(64 * nh + r32) * 128 + 8 * hi;
        { const float acl = AC[(size_t)it * 128 + 127]; const float2 d2 = *(const float2*)(DTS + (size_t)it * 128 + 2 * lane_), a2 = *(const float2*)(AC + (size_t)it * 128 + 2 * lane_);
          wl[2 * lane_] = d2.x * __expf(acl - a2.x); wl[2 * lane_ + 1] = d2.y * __expf(acl - a2.y); }
        f32x16 acc[2][2];
#pragma unroll
        for (int a = 0; a < 2; ++a) { acc[a][0] = f32x16{}; acc[a][1] = f32x16{}; }
#pragma unroll 1
        for (int kh = 0; kh < 2; ++kh) { v4u xa[4][2], ba[4][2];
#pragma unroll
            for (int ks = 0; ks < 4; ++ks)
#pragma unroll
                for (int b2 = 0; b2 < 2; ++b2) { xa[ks][b2] = *(const GAS v4u*)(xt + (size_t)(32 * b2) * 128 + 16 * (4 * kh + ks)); ba[ks][b2] = *(const GAS v4u*)(bt + (size_t)(32 * b2) * 128 + 16 * (4 * kh + ks)); }
#pragma unroll
            for (int ks = 0; ks < 4; ++ks) { float wv[8];
                { const f32x4 w0 = *(const LAS f32x4*)(wl + 16 * (4 * kh + ks) + 8 * hi), w1 = *(const LAS f32x4*)(wl + 16 * (4 * kh + ks) + 8 * hi + 4);
#pragma unroll
                  for (int e = 0; e < 4; ++e) { wv[e] = w0[e]; wv[4 + e] = w1[e]; } }
                bf16x8 xf[2];
#pragma unroll
                for (int pb = 0; pb < 2; ++pb) xf[pb] = scale8(xa[ks][pb], wv);
#pragma unroll
                for (int nb = 0; nb < 2; ++nb) { const bf16x8 bfv = __builtin_bit_cast(bf16x8, ba[ks][nb]);
#pragma unroll
                    for (int pb = 0; pb < 2; ++pb) acc[nb][pb] = MFMA32(bfv, xf[pb], acc[nb][pb]); } } }
        bf16* st = ST + (size_t)it * 64 * 128 + 64 * nh;
#pragma unroll
        for (int nb = 0; nb < 2; ++nb)
#pragma unroll
            for (int pb = 0; pb < 2; ++pb)
#pragma unroll
                for (int g4 = 0; g4 < 4; ++g4) { v2u w; w.x = pk2(acc[nb][pb][4 * g4], acc[nb][pb][4 * g4 + 1]); w.y = pk2(acc[nb][pb][4 * g4 + 2], acc[nb][pb][4 * g4 + 3]);
                    *(GAS v2u*)(st + (size_t)(32 * pb + r32) * 128 + 32 * nb + 8 * g4 + 4 * hi) = w; }
    }
}
__device__ __forceinline__ void ssd_conv_states(Frame& F, const bf16* XBC, const float* dtraw, const float* conv_w, const float* conv_b, const float* dt_bias, const float* a_log,
                                                bf16* XT, bf16* Bm, bf16* BTm, bf16* Cm, float* DTS, float* AC, float* CDEC, bf16* ST) {
    for (int pr = blockIdx.x; pr < NBC * 2; pr += F.G) { const int bc = pr >> 1, hh = pr & 1;
#pragma unroll 1
        for (int k = F.wave; k < 32; k += NWAVES) {
            if (k < 16) conv_item(F.lane, bc, 16 * hh + k, XBC, conv_w, conv_b, XT, Bm, BTm, Cm);
            else if (k < 20) conv_item(F.lane, bc, 32 + 4 * hh + (k - 16), XBC, conv_w, conv_b, XT, Bm, BTm, Cm);
            else if (k < 24) conv_item(F.lane, bc, 40 + 4 * hh + (k - 20), XBC, conv_w, conv_b, XT, Bm, BTm, Cm);
            else dt_item(F.lane, bc * 16 + 8 * hh + (k - 24), dtraw, dt_bias, a_log, DTS, AC, CDEC); }
        asm volatile("s_waitcnt vmcnt(0)" ::: "memory");
        if (F.tid == 0) { __builtin_amdgcn_fence(__ATOMIC_ACQUIRE, "agent"); asm volatile("s_waitcnt vmcnt(0)" ::: "memory"); }
        __syncthreads();
#pragma unroll 1
        for (int k = F.wave; k < 16; k += NWAVES) states_item(F, ((bc * 16 + 8 * hh + (k >> 1)) << 1) | (k & 1), XT, BTm, DTS, AC, ST);
        __syncthreads();
    }
}
__device__ __forceinline__ void ssd_scan(Frame& F, bf16* ST, const float* CDEC) {
    constexpr int PER_B = 16 * 64 * 128 / 2;
    for (int T = blockIdx.x * (NWAVES * 64) + F.tid; T < BATCH * PER_B; T += F.G * NWAVES * 64) { const int b = T / PER_B, e = T % PER_B, h = e / (64 * 128 / 2);
        GAS unsigned* p = (GAS unsigned*)ST + (size_t)b * NCHUNK * PER_B + e; unsigned v[NCHUNK];
#pragma unroll
        for (int c = 0; c < NCHUNK; ++c) v[c] = p[(size_t)c * PER_B];
        float r0 = 0.f, r1 = 0.f;
#pragma unroll
        for (int c = 0; c < NCHUNK; ++c) { const float dec = CDEC[(b * NCHUNK + c) * 16 + h]; p[(size_t)c * PER_B] = pk2(r0, r1); r0 = r0 * dec + bflo(v[c]); r1 = r1 * dec + bfhi(v[c]); }
    }
}
template <int PM  > __device__ __forceinline__ void ssd_out(Frame& F, const bf16* XT, const bf16* Bm, const bf16* Cm, const bf16* ST, const float* DTS, const float* AC, const bf16* Z,
                                        const float* d_skip, const float* norm_g, bf16* YCAT) {
    constexpr int CP = 136;
    LAS bf16* CmS = (LAS bf16*)(F.lds + RING_OFF);
    LAS bf16* BmS = CmS + 128 * CP;
    LAS float* CBs = (LAS float*)(BmS);
    LAS float* acl = (LAS float*)(F.lds + RING_OFF + 34816 + 67584);
    LAS float* dtl = acl + 8 * 128;
    LAS float* red = dtl + 8 * 128;
    LAS float* rsd = red + 8 * 128;
    for (int it = blockIdx.x; it < NBC * 2; it += F.G) {
        int lane_ = F.lane; asm volatile("" : "+v"(lane_));
        const int r32 = lane_ & 31, hi = lane_ >> 5, w = F.wave;
        const int bc = it >> 1, g = it & 1, h = 8 * g + w; const size_t t0 = (size_t)bc * 128;
        __syncthreads();
        { const GAS v4u* cg_ = (const GAS v4u*)(Cm + (size_t)it * 128 * 128); const GAS v4u* bg_ = (const GAS v4u*)(Bm + (size_t)it * 128 * 128);
#pragma unroll
          for (int q = 0; q < 4; ++q) { const int idx = F.tid + 512 * q, row = idx >> 4, c16 = idx & 15;
              const v4u cv = cg_[idx], bv = bg_[idx];
              *(LAS v4u*)(CmS + row * CP + c16 * 8) = cv; *(LAS v4u*)(BmS + row * CP + c16 * 8) = bv; }
          for (int i = F.tid; i < 1024; i += NWAVES * 64) { acl[i] = AC[((size_t)bc * 16 + 8 * g) * 128 + i] * LOG2E; dtl[i] = DTS[((size_t)bc * 16 + 8 * g) * 128 + i]; } }
        __syncthreads();
        { f32x16 cbt[2];
#pragma unroll
          for (int tt = 0; tt < 2; ++tt) { const int ib = (2 * w + tt) >> 2, jb = (2 * w + tt) & 3; cbt[tt] = f32x16{};
            if (jb <= ib) {
#pragma unroll
                for (int ks = 0; ks < 8; ++ks) { const int n0 = 16 * ks + 8 * hi;
                    const bf16x8 a = *(const LAS bf16x8*)(CmS + (32 * ib + r32) * CP + n0), b = *(const LAS bf16x8*)(BmS + (32 * jb + r32) * CP + n0);
                    cbt[tt] = MFMA32(a, b, cbt[tt]); } } }
          __syncthreads();
#pragma unroll
          for (int tt = 0; tt < 2; ++tt) { const int ib = (2 * w + tt) >> 2, jb = (2 * w + tt) & 3;
            if (jb <= ib) {
#pragma unroll
                for (int r = 0; r < 16; ++r) CBs[(32 * ib + crow(r, hi)) * 132 + 32 * jb + r32] = cbt[tt][r]; } } }
        __syncthreads();
        const LAS float* ach = acl + w * 128; const LAS float* dth = dtl + w * 128;
        const float dsk = d_skip[h];
        if (PM == 1) continue;
        const int prm = (r32 & 3) + 4 * ((r32 >> 3) & 1) + 8 * ((r32 >> 2) & 1) + 16 * (r32 >> 4);
        const bf16* xt = XT + ((size_t)bc * 16 + h) * 64 * 128 + (size_t)prm * 128 + 8 * hi; const bf16* hin = ST + ((size_t)bc * 16 + h) * 64 * 128 + (size_t)prm * 128 + 8 * hi;
        v4u hf[8][2], xf[8][2];
#pragma unroll
        for (int ks = 0; ks < 8; ++ks)
#pragma unroll
            for (int pb = 0; pb < 2; ++pb) { hf[ks][pb] = *(const GAS v4u*)(hin + (size_t)(32 * pb) * 128 + 16 * ks); xf[ks][pb] = *(const GAS v4u*)(xt + (size_t)(32 * pb) * 128 + 16 * ks); }
#pragma unroll 1
        for (int ib = 0; ib < 4; ++ib) { const int i = 32 * ib + r32; const float aci = ach[i];
            int hj = 8 * hi; asm volatile("" : "+v"(hj));
            const bf16* zp = Z + (t0 + i) * 1024 + h * 64 + 8 * hi; v4u zq[2][2];
#pragma unroll
            for (int pb = 0; pb < 2; ++pb)
#pragma unroll
                for (int g2 = 0; g2 < 2; ++g2) zq[pb][g2] = *(const GAS v4u*)(zp + 32 * pb + 16 * g2);
            f32x16 acc0 = f32x16{}, acc1 = f32x16{};
            { const float ei = __builtin_amdgcn_exp2f(aci); float es[8];
#pragma unroll
              for (int e = 0; e < 8; ++e) es[e] = ei;
#pragma unroll
              for (int ks = 0; ks < 8; ++ks) { const bf16x8 bfv = scale8(*(const LAS v4u*)(CmS + i * CP + 16 * ks + hj), es);
                acc0 = MFMA32(__builtin_bit_cast(bf16x8, hf[ks][0]), bfv, acc0); acc1 = MFMA32(__builtin_bit_cast(bf16x8, hf[ks][1]), bfv, acc1); } }
#pragma unroll
            for (int ks = 0; ks < 8; ++ks) if (ks < 2 * ib + 2) { const int j0 = 16 * ks + hj; float m[8];
                { const f32x4 c0 = *(const LAS f32x4*)(CBs + i * 132 + j0), c1 = *(const LAS f32x4*)(CBs + i * 132 + j0 + 4);
                  const f32x4 a0 = *(const LAS f32x4*)(ach + j0), a1 = *(const LAS f32x4*)(ach + j0 + 4), d0 = *(const LAS f32x4*)(dth + j0), d1 = *(const LAS f32x4*)(dth + j0 + 4);
#pragma unroll
                  for (int e = 0; e < 4; ++e) { m[e] = c0[e] * __builtin_amdgcn_exp2f(aci - a0[e]) * d0[e]; m[4 + e] = c1[e] * __builtin_amdgcn_exp2f(aci - a1[e]) * d1[e]; }
                  if (ks >= 2 * ib) {
#pragma unroll
                      for (int e = 0; e < 8; ++e) { m[e] = (j0 + e <= i) ? m[e] : 0.f; if (j0 + e == i) m[e] += dsk; } } }
                v4u pw; pw.x = pk2(m[0], m[1]); pw.y = pk2(m[2], m[3]); pw.z = pk2(m[4], m[5]); pw.w = pk2(m[6], m[7]);
                const bf16x8 mf = __builtin_bit_cast(bf16x8, pw);
                acc0 = MFMA32(__builtin_bit_cast(bf16x8, xf[ks][0]), mf, acc0); acc1 = MFMA32(__builtin_bit_cast(bf16x8, xf[ks][1]), mf, acc1); }
            float ss = 0.f;
#pragma unroll
            for (int pb = 0; pb < 2; ++pb)
#pragma unroll
                for (int g2 = 0; g2 < 2; ++g2) { const v4u z = zq[pb][g2]; const float zv[8] = {bflo(z.x), bfhi(z.x), bflo(z.y), bfhi(z.y), bflo(z.z), bfhi(z.z), bflo(z.w), bfhi(z.w)};
#pragma unroll
                    for (int e = 0; e < 8; ++e) { const float y = (pb ? acc1[8 * g2 + e] : acc0[8 * g2 + e]) * silu(zv[e]); ss += y * y; if (pb) acc1[8 * g2 + e] = y; else acc0[8 * g2 + e] = y; } }
            ss += __shfl_xor(ss, 32);
            if (PM == 2) { asm volatile("" :: "v"(ss)); continue; }
            if (hi == 0) red[w * 32 + r32] = ss;
            __syncthreads();
            if (F.tid < 32) { float s = 0.f;
#pragma unroll
                for (int ww = 0; ww < 8; ++ww) s += red[ww * 32 + F.tid];
                rsd[F.tid] = rsqrtf(s * (1.f / 512.f) + EPS); }
            __syncthreads();
            const float rs = rsd[r32]; const float* gp = norm_g + h * 64 + 8 * hi; bf16* yp = YCAT + (t0 + i) * 2048 + h * 64 + 8 * hi;
#pragma unroll
            for (int pb = 0; pb < 2; ++pb)
#pragma unroll
                for (int g2 = 0; g2 < 2; ++g2) { const f32x4 g0 = *(const GAS f32x4*)(gp + 32 * pb + 16 * g2), g1 = *(const GAS f32x4*)(gp + 32 * pb + 16 * g2 + 4); float y[8];
#pragma unroll
                    for (int e = 0; e < 8; ++e) y[e] = (pb ? acc1[8 * g2 + e] : acc0[8 * g2 + e]) * rs;
                    v4u o; o.x = pk2(y[0] * g0[0], y[1] * g0[1]); o.y = pk2(y[2] * g0[2], y[3] * g0[3]); o.z = pk2(y[4] * g1[0], y[5] * g1[1]); o.w = pk2(y[6] * g1[2], y[7] * g1[3]);
                    st16_wt(yp + 32 * pb + 16 * g2, o); }
        }
    }
}
__device__ __forceinline__ void subln_row(const v4u a, const v4u b, const float* gq, GAS v4u* p) {
    float v[16] = {bflo(a.x), bfhi(a.x), bflo(a.y), bfhi(a.y), bflo(a.z), bfhi(a.z), bflo(a.w), bfhi(a.w), bflo(b.x), bfhi(b.x), bflo(b.y), bfhi(b.y), bflo(b.z), bfhi(b.z), bflo(b.w), bfhi(b.w)};
    float s = 0.f;
#pragma unroll
    for (int e = 0; e < 16; ++e) s += v[e] * v[e];
    s += __shfl_xor(s, 1); s += __shfl_xor(s, 2); s += __shfl_xor(s, 4);
    const float rs = rsqrtf(s * (1.f / 128.f) + EPS);
#pragma unroll
    for (int e = 0; e < 16; ++e) v[e] *= rs * gq[e];
    v4u oa, ob; oa.x = pk2(v[0], v[1]); oa.y = pk2(v[2], v[3]); oa.z = pk2(v[4], v[5]); oa.w = pk2(v[6], v[7]); ob.x = pk2(v[8], v[9]); ob.y = pk2(v[10], v[11]); ob.z = pk2(v[12], v[13]); ob.w = pk2(v[14], v[15]);
    p[0] = oa; p[1] = ob; }
__device__ __forceinline__ void attn_subln(Frame& F, bf16* YCAT, const float* subln_g) {
    const int d0 = (F.lane & 7) * 16; float gq[16];
#pragma unroll
    for (int e = 0; e < 16; ++e) gq[e] = subln_g[d0 + e] * (1.0f - LAM_INIT);
#pragma unroll 1
    for (int m = F.gw; m < M; m += 2 * F.NGW) { const bool two = m + F.NGW < M; const int m1 = two ? m + F.NGW : m;
        GAS v4u* p0 = (GAS v4u*)(YCAT + (size_t)m * 2048 + 1024 + F.lane * 16); GAS v4u* p1 = (GAS v4u*)(YCAT + (size_t)m1 * 2048 + 1024 + F.lane * 16);
        const v4u a0 = p0[0], b0 = p0[1], a1 = p1[0], b1 = p1[1];
        subln_row(a0, b0, gq, p0); if (two) subln_row(a1, b1, gq, p1); }
}
#ifndef MK_PER_PHASE
#define MK_PER_PHASE 0
#endif
#ifndef MK_CG_SYNC
#define MK_CG_SYNC 0
#endif
constexpr int N_PHASES = 17;
#ifndef ATTN_FORM
#define ATTN_FORM 2
#endif
#ifndef PROBE_SSD_MODE
#define PROBE_SSD_MODE 0
#endif
#ifndef PROBE_EXTRA_BARS
#define PROBE_EXTRA_BARS 0
#endif
#ifndef PROBE_DUP
#define PROBE_DUP 0
#endif
struct Args { const float* in[30]; float* out; unsigned char* ws; int ph_lo, ph_hi; };
enum InIdx { I_X = 0, I_C, I_WADA, I_BADA, I_F1PRE, I_F1POST, I_F1WG, I_F1WU, I_F1WD, I_MPRE, I_MPOST, I_WIN, I_CONVW, I_CONVB, I_DTB, I_ALOG, I_DSKIP, I_SSDG,
             I_LQ1, I_LK1, I_LQ2, I_LK2, I_SUBLN, I_WOUT, I_F2PRE, I_F2POST, I_F2WG, I_F2WU, I_F2WD, I_RELB };

__global__ void __launch_bounds__(NWAVES * 64, 2) layer_fwd(Args args) {
    extern __shared__ __attribute__((aligned(16))) unsigned char lds[];
    Frame F;
    F.lds = (LAS unsigned char*)lds;
    F.tid = threadIdx.x; F.lane = F.tid & 63; F.wave = __builtin_amdgcn_readfirstlane(F.tid >> 6);
    F.G = gridDim.x; { const int bx = blockIdx.x; F.vcu = (F.G % 8 == 0) ? (bx % 8) * (F.G / 8) + bx / 8 : bx; }
    F.gw = F.vcu * NWAVES + F.wave; F.NGW = F.G * NWAVES;
    unsigned char* ws = args.ws;
#define MOD ((float*)(ws + WS_MOD))
#define DTRAW ((float*)(ws + WS_DTRAW))
#define DTS ((float*)(ws + WS_DTS))
#define ACm ((float*)(ws + WS_AC))
#define CDEC ((float*)(ws + WS_CDEC))
#define WA ((bf16*)(ws + WS_WA))
#define WB ((bf16*)(ws + WS_WB))
#define H ((bf16*)(ws + WS_H))
#define ACT ((bf16*)(ws + WS_ACT))
#define Dm ((bf16*)(ws + WS_D))
#define Qb ((bf16*)(ws + WS_Q))
#define Kb ((bf16*)(ws + WS_K))
#define Vb ((bf16*)(ws + WS_V))
#define YCAT ((bf16*)(ws + WS_YCAT))
#define Zb ((bf16*)(ws + WS_Z))
#define XBC ((bf16*)(ws + WS_XBC))
#define XT ((bf16*)(ws + WS_XT))
#define Bm ((bf16*)(ws + WS_BM))
#define BTm ((bf16*)(ws + WS_BT))
#define Cm ((bf16*)(ws + WS_CM))
#define ST ((bf16*)(ws + WS_ST))
#define D2 ((bf16*)(ws + WS_D2))
#define WC_IN ((bf16*)((unsigned char*)out + 32 * MiB))
#define WC_OUT ((bf16*)((unsigned char*)out + 32 * MiB) + (size_t)NIN * DM)
#define WC_GU2 (WC_OUT + (size_t)DM * KOUT)
#define WC_D2 (WC_GU2 + (size_t)NGU * DM)
#define X1B ((bf16*)out)
#define X2B ((bf16*)(ws + WS_X2))
    float* out = args.out;
#if MK_CG_SYNC
    cg::grid_group grid = cg::this_grid();
#define GRID_BAR() grid.sync()
#else
    for (int u = F.tid; u < (LDS_BYTES - LDSCTL_OFF) / 4; u += NWAVES * 64) ((LAS unsigned*)(F.lds + LDSCTL_OFF))[u] = 0u;
    __syncthreads();
    XcdBarrier bar = xcd_barrier_post((unsigned*)(ws + WS_CTL) + CW_BAR, (volatile LAS unsigned*)(F.lds + MISC_OFF) + 8);
#define GRID_BAR() xcd_barrier(bar)
#endif
    const int lo = args.ph_lo, hi = args.ph_hi;
#ifndef PH_MASK
#define PH_MASK 0x1FFFF
#endif
#define IN(k) (((PH_MASK >> (k)) & 1) && lo <= (k) && (k) < hi)
#define SEAM(k) do { if (IN(k) && IN((k) + 1)) GRID_BAR(); } while (0)
#define PHASE(k, ...) if (IN(k)) { const bool second_ = false; (void)second_; __VA_ARGS__ } if (((PROBE_DUP >> (k)) & 1) && IN(k)) { const bool second_ = true; (void)second_; GRID_BAR(); __VA_ARGS__ }

    PHASE(0,
        { convert_ffn(F, args.in[I_F1WG], args.in[I_F1WU], args.in[I_F1WD], WA, WB); mod_gemv(F, args.in[I_C], args.in[I_WADA], args.in[I_BADA], MOD); }
    )
    SEAM(0);
    PHASE(1,
        rows_first(F, args.in[I_X], args.in[I_F1PRE], MOD, 0, H);
    )
    SEAM(1);
    PHASE(2,
        { pg8::Gemm g{H, WA, M, NGU, DM}; pg8::StaticOrder S; S.init(M, NGU, F.G, (int)blockIdx.x); pg8::EpiSwiglu E{ACT, DFF};
        pg8::gemm_phase<pg8::EpiSwiglu, pg8::StaticOrder, true, true>(F.lds + RING_OFF, g, S, E);
        }
    )
    SEAM(2);
    PHASE(3,
        { pg8::Gemm g{ACT, WB, M, DM, DFF}; pg8::StaticOrder S; S.init(M, DM, F.G, (int)blockIdx.x); pg8::EpiBf16<0> E{Dm, DM, nullptr, 0, 0, 1.f};
        pg8::gemm_phase<pg8::EpiBf16<0>, pg8::StaticOrder, true, true>(F.lds + RING_OFF, g, S, E); }
    )
    SEAM(3);
    PHASE(4,
        { rows_res<true, false, true>(F, args.in[I_X], Dm, args.in[I_F1POST], MOD, 2, 0.5f, X1B, args.in[I_MPRE], 3, H); convert_mix(F, F.gw, F.NGW, args.in[I_WIN], args.in[I_WOUT], WC_IN, WC_OUT); }
    )
    SEAM(4);
    PHASE(5,
        { pg8::Gemm g{H, WC_IN, M, NQKV, DM}; pg8::StaticOrder S; S.init(M, NQKV, F.G, (int)blockIdx.x);
        pg8::EpiQKV E{Qb, DM, (size_t)(WS_K - WS_Q) / 2, attn_body::C2, (unsigned*)(ws + WS_CTL) + CW_KMAX};
        pg8::gemm_phase<pg8::EpiQKV, pg8::StaticOrder, true, true>(F.lds + RING_OFF, g, S, E); }
    )
    SEAM(5);
    PHASE(6,
        float lam;
        { const float q1 = args.in[I_LQ1][F.lane] * args.in[I_LK1][F.lane], q2 = args.in[I_LQ2][F.lane] * args.in[I_LK2][F.lane];
          lam = __expf(wave_sum(q1)) - __expf(wave_sum(q2)) + LAM_INIT; lam = __builtin_bit_cast(float, __builtin_amdgcn_readfirstlane(__builtin_bit_cast(int, lam))); }
#if ATTN_FORM == 2
        const attn2::Tensors AT{(const attn_body::bf16*)Qb, (const attn_body::bf16*)Kb, (const attn_body::bf16*)Vb, (attn_body::bf16*)YCAT, lam, args.in[I_RELB], args.in[I_SUBLN], (const float*)((const unsigned*)(ws + WS_CTL) + CW_KMAX)};
        attn2::phase<8>((char*)lds + RING_OFF, AT, (int)F.G, (int)blockIdx.x);
#else
        const attn_body::AttnTensors AT{(const attn_body::bf16*)Qb, (const attn_body::bf16*)Kb, (const attn_body::bf16*)Vb, (attn_body::bf16*)YCAT, lam, args.in[I_RELB]};
        const attn_body::StaticOrder S((int)F.G, (int)blockIdx.x);
        attn_body::attn_phase<attn_body::StaticOrder>((char*)lds + RING_OFF, AT, S);
#endif
    )
    SEAM(6);
    PHASE(7,
        { pg8::Gemm g{H, WC_IN + (size_t)NQKV * DM, M, NMIX, DM}; pg8::StaticOrder S; S.init(M, NMIX, F.G, (int)blockIdx.x); pg8::EpiMix E{Zb, XBC, DTRAW};
        pg8::gemm_phase<pg8::EpiMix, pg8::StaticOrder, true, true>(F.lds + RING_OFF, g, S, E);
        if (!second_ && F.G == 256 && blockIdx.x >= 192) convert_gu_half(F, ((int)blockIdx.x - 192) * NWAVES + F.wave, 64 * NWAVES, args.in[I_F2WG], 0, WC_GU2); }
    )
    SEAM(7);
    PHASE(8,
        ssd_conv_states(F, XBC, DTRAW, args.in[I_CONVW], args.in[I_CONVB], args.in[I_DTB], args.in[I_ALOG], XT, Bm, BTm, Cm, DTS, ACm, CDEC, ST);
    )
    SEAM(9);
    PHASE(10,
        ssd_scan(F, ST, CDEC);
    )
    SEAM(10);
    PHASE(11,
        { if (!second_) { ssd_out<0>(F, XT, Bm, Cm, ST, DTS, ACm, Zb, args.in[I_DSKIP], args.in[I_SSDG], YCAT); if (ATTN_FORM != 2) attn_subln(F, YCAT, args.in[I_SUBLN]); }
          else ssd_out<PROBE_SSD_MODE>(F, XT, Bm, Cm, ST, DTS, ACm, Zb, args.in[I_DSKIP], args.in[I_SSDG], YCAT); }
    )
    SEAM(11);
    PHASE(12,
        { pg8::Gemm g{YCAT, WC_OUT, M, DM, KOUT}; pg8::StaticOrder S; S.init(M, DM, F.G, (int)blockIdx.x); pg8::EpiBf16<0> E{D2, DM, nullptr, 0, 0, 1.f};
        pg8::gemm_phase<pg8::EpiBf16<0>, pg8::StaticOrder, true, true>(F.lds + RING_OFF, g, S, E); }
    )
    SEAM(12);
    PHASE(13,
        { rows_res<true, true, true>(F, X1B, D2, args.in[I_MPOST], MOD, 5, 1.0f, X2B, args.in[I_F2PRE], 6, H); convert_gu_half(F, F.gw, F.NGW, args.in[I_F2WU], 1, WC_GU2);
          if (F.G != 256) { convert_gu_half(F, F.gw, F.NGW, args.in[I_F2WG], 0, WC_GU2); convert_down(F, F.gw, F.NGW, args.in[I_F2WD], WC_D2); } }
    )
    SEAM(13);
    PHASE(14,
        { pg8::Gemm g{H, WC_GU2, M, NGU, DM}; pg8::StaticOrder S; S.init(M, NGU, F.G, (int)blockIdx.x); pg8::EpiSwiglu E{ACT, DFF};
        pg8::gemm_phase<pg8::EpiSwiglu, pg8::StaticOrder, true, true>(F.lds + RING_OFF, g, S, E);
        if (!second_ && F.G == 256 && blockIdx.x >= 128) convert_down(F, ((int)blockIdx.x - 128) * NWAVES + F.wave, 128 * NWAVES, args.in[I_F2WD], WC_D2); }
    )
    SEAM(14);
    PHASE(15,
        { pg8::Gemm g{ACT, WC_D2, M, DM, DFF}; pg8::StaticOrder S; S.init(M, DM, F.G, (int)blockIdx.x); pg8::EpiBf16<0> E{Dm, DM, nullptr, 0, 0, 1.f};
        pg8::gemm_phase<pg8::EpiBf16<0>, pg8::StaticOrder, true, true>(F.lds + RING_OFF, g, S, E); }
    )
    SEAM(15);
    PHASE(16,
        rows_res<false, true, false>(F, X2B, Dm, args.in[I_F2POST], MOD, 8, 0.5f, out, nullptr, 0, nullptr);
    )
#if PROBE_EXTRA_BARS
    for (int q_ = 0; q_ < PROBE_EXTRA_BARS; ++q_) GRID_BAR();
#endif
#undef IN
#undef SEAM
}

extern "C" void kernel_launch(void* const* d_in, const int* in_sizes, int n_in, void* d_out, int out_size, void* d_ws, size_t ws_size, hipStream_t stream) {
    static int grid = 0;
    if (grid == 0) {
        if (n_in != 30 || in_sizes[0] != M * DM || out_size != M * DM || ws_size < WS_END) { fprintf(stderr, "kernel_launch: unexpected shapes (n_in %d, in0 %d, out %d, ws %zu); nothing launched\n", n_in, n_in > 0 ? in_sizes[0] : -1, out_size, ws_size); grid = -1; return; }
        int dev = 0, cus = 0, per_cu = 0;
        if (hipGetDevice(&dev) != hipSuccess || hipDeviceGetAttribute(&cus, hipDeviceAttributeMultiprocessorCount, dev) != hipSuccess) { grid = -1; return; }
        if (hipFuncSetAttribute((const void*)layer_fwd, hipFuncAttributeMaxDynamicSharedMemorySize, LDS_BYTES) != hipSuccess) { fprintf(stderr, "kernel_launch: hipFuncSetAttribute failed\n"); grid = -1; return; }
        if (hipOccupancyMaxActiveBlocksPerMultiprocessor(&per_cu, (const void*)layer_fwd, NWAVES * 64, LDS_BYTES) != hipSuccess || per_cu < 1) { fprintf(stderr, "kernel_launch: occupancy query says %d blocks per CU\n", per_cu); per_cu = 1; }
        (void)hipGetLastError();
        grid = cus;
        if (grid % 8 != 0 || grid > 256) fprintf(stderr, "kernel_launch: note: %d CUs\n", grid);
    }
    if (grid < 0) return;
    (void)hipMemsetAsync((char*)d_ws + WS_CTL, 0, CTL_ZERO_BYTES, stream);
    Args a{};
    for (int i = 0; i < 30; ++i) a.in[i] = (const float*)d_in[i];
    a.out = (float*)d_out; a.ws = (unsigned char*)d_ws;
#if MK_PER_PHASE
    for (int p = 0; p < N_PHASES; ++p) { a.ph_lo = p; a.ph_hi = p + 1; void* kargs[] = {&a};
        hipError_t e = hipLaunchCooperativeKernel((const void*)layer_fwd, dim3(grid), dim3(NWAVES * 64), kargs, LDS_BYTES, stream);
        if (e != hipSuccess) { fprintf(stderr, "kernel_launch: phase %d launch failed: %s\n", p, hipGetErrorString(e)); break; } }
#else
    a.ph_lo = 0; a.ph_hi = N_PHASES; void* kargs[] = {&a};
    hipError_t e = hipLaunchCooperativeKernel((const void*)layer_fwd, dim3(grid), dim3(NWAVES * 64), kargs, LDS_BYTES, stream);
    if (e != hipSuccess) fprintf(stderr, "kernel_launch: cooperative launch failed: %s (grid %d)\n", hipGetErrorString(e), grid);
#endif
}
```

```cpp
#include <hip/hip_runtime.h>
#include <hip/hip_cooperative_groups.h>
#include <hip/hip_bf16.h>
#include <cstdio>
#include <cstdint>
#include <cmath>
namespace cg = cooperative_groups;
namespace pg8 {
#define PG8_LAS __attribute__((address_space(3)))
typedef unsigned short bf16_t;
typedef short bf16x8 __attribute__((ext_vector_type(8)));
typedef float f32x4 __attribute__((ext_vector_type(4)));
typedef unsigned u32x4 __attribute__((ext_vector_type(4)));
constexpr int BM = 256, BK = 64, HALF = 128, HTB = HALF * BK * 2  , STAGE_BYTES = 8 * HTB, NXCD = 8, WGM = 4;

__host__ __device__ __forceinline__ int lds_byte(int r, int c) { const int st = (r >> 4) * 2 + (c >> 5), rr = r & 15, cc = c & 31, ob = rr * 64 + cc * 2; return st * 1024 + (ob ^ (((ob >> 9) & 1) << 5)); }
__host__ __device__ __forceinline__ void stage_rc(int b, int& R, int& C) { const int st = b / 1024, sb = b % 1024, swz = sb ^ (((sb >> 9) & 1) << 5); R = (st >> 1) * 16 + swz / 64; C = (st & 1) * 32 + (swz % 64) / 2; }
__host__ __device__ __forceinline__ int perm32(int rho) { const int n = rho >> 4, i = rho & 15; return 8 * (i >> 2) + 4 * n + (i & 3); }

struct Unit { int pm, pn; };
struct Gemm { const bf16_t* A; const bf16_t* Bt; int M, N, K; };

struct StaticOrder {
    int nM, nN, nwg, G, c;
    __host__ __device__ void init(int M, int N, int G_, int c_) { nM = M / BM; nN = N / BM; nwg = nM * nN; G = G_; c = c_; }
    __host__ __device__ bool next(int i, Unit& u) const {
        const long L = (long)i * G + c; if (L >= nwg) return false;
        int wgid = (int)L; { const int q = nwg / NXCD, r = nwg % NXCD, xcd = wgid % NXCD, off = wgid / NXCD; wgid = (xcd < r ? xcd * (q + 1) : r * (q + 1) + (xcd - r) * q) + off; }
        const int nig = WGM * nN, gid = wgid / nig, fm = gid * WGM, gsz = (nM - fm) < WGM ? (nM - fm) : WGM;
        u.pm = fm + ((wgid % nig) % gsz); u.pn = (wgid % nig) / gsz; return true;
    }
    __device__ __forceinline__ void a_ready(const Unit&) const {}
    __device__ __forceinline__ void done(const Unit&) const {}
};

__device__ __forceinline__ unsigned cvt_pk_bf16(float lo, float hi) { unsigned r; asm volatile("v_cvt_pk_bf16_f32 %0, %1, %2" : "=v"(r) : "v"(lo), "v"(hi)); return r; }
__device__ __forceinline__ void st16_wt(void* ptr, u32x4 v) { asm volatile("global_store_dwordx4 %0, %1, off sc1\n\ts_nop 1" :: "v"(ptr), "v"(v) : "memory"); }
typedef float f32x2 __attribute__((ext_vector_type(2)));
__device__ __forceinline__ f32x2 gelu_pk(f32x2 v) {
    const f32x2 av = __builtin_elementwise_abs(v), d = av * 0.2316418882f + 1.0f;
    f32x2 t; t.x = __builtin_amdgcn_rcpf(d.x); t.y = __builtin_amdgcn_rcpf(d.y);
    f32x2 q = t * 0.5307027145f + (-0.7265760135f); q = q * t + 0.7107068705f; q = q * t + (-0.142248368f); q = q * t + 0.127414796f; q = q * t;
    const f32x2 s = (v * v) * (-0.72134752044f);
    f32x2 e; e.x = __builtin_amdgcn_exp2f(s.x); e.y = __builtin_amdgcn_exp2f(s.y);
    const f32x2 m = v * (q * e), r = v - m;
    f32x2 o; o.x = v.x < 0.f ? m.x : r.x; o.y = v.y < 0.f ? m.y : r.y; return o;
}

template <int ACT  > struct EpiBf16 {
    static constexpr bool PERM = true, AFTER_DRAIN = false; static_assert(ACT == 0 || ACT == 1, "EpiBf16: ACT is 0 (none) or 1 (gelu_pk)");
    bf16_t* O; int ldc; const float* bias; int split_cols; size_t split_stride; float scale0;
    __device__ __forceinline__ void operator()(const f32x4 (&acc)[2][2][4][2], const Unit& u, int wr, int wc, int fr, int fq) const {
        const int row0 = u.pm * BM + wr * 64 + fr; int colt = u.pn * BM; bf16_t* base = O;
        float sc = 1.f; if (split_cols) { const int t = colt / split_cols; base += (size_t)t * split_stride; colt -= t * split_cols; if (t == 0) sc = scale0; }
        const int col0 = colt + wc * 32 + 8 * fq, bcol0 = u.pn * BM + wc * 32 + 8 * fq;
        f32x4 bv[2][2];
#pragma unroll
        for (int bj = 0; bj < 2; ++bj)
#pragma unroll
            for (int n = 0; n < 2; ++n) bv[bj][n] = bias ? *(const f32x4*)(bias + bcol0 + bj * HALF + 4 * n) : (f32x4){0.f, 0.f, 0.f, 0.f};
#pragma unroll
        for (int ai = 0; ai < 2; ++ai)
#pragma unroll
            for (int m = 0; m < 4; ++m) { bf16_t* rowp = base + (size_t)(row0 + ai * HALF + m * 16) * ldc + col0;
#pragma unroll
                for (int bj = 0; bj < 2; ++bj) { f32x4 v0 = acc[ai][bj][m][0] + bv[bj][0], v1 = acc[ai][bj][m][1] + bv[bj][1];
                    if (ACT == 1) { f32x2 a = gelu_pk((f32x2){v0[0], v0[1]}), b = gelu_pk((f32x2){v0[2], v0[3]}), c = gelu_pk((f32x2){v1[0], v1[1]}), d = gelu_pk((f32x2){v1[2], v1[3]});
                        v0 = (f32x4){a.x, a.y, b.x, b.y}; v1 = (f32x4){c.x, c.y, d.x, d.y}; }
                    v0 = v0 * sc; v1 = v1 * sc; u32x4 w; w.x = cvt_pk_bf16(v0[0], v0[1]); w.y = cvt_pk_bf16(v0[2], v0[3]); w.z = cvt_pk_bf16(v1[0], v1[1]); w.w = cvt_pk_bf16(v1[2], v1[3]);
                    st16_wt(rowp + bj * HALF, w); } }
    }
};

struct PanelStats {
    unsigned* xbuf;
    unsigned* cnt;
    unsigned* tmo;
    int ntn; float eps;
    unsigned code;
    __device__ __forceinline__ bool run(const f32x4 (&v)[2][2][4][2], const Unit& u, int wr, int wc, int fr, int fq, PG8_LAS unsigned char* lds, int wid, int lane) const {
        typedef float f32x2v __attribute__((ext_vector_type(2)));
        PG8_LAS f32x2v* P = (PG8_LAS f32x2v*)lds;
        PG8_LAS f32x2v* S = (PG8_LAS f32x2v*)(lds + 8192);
        PG8_LAS unsigned* flag = (PG8_LAS unsigned*)(lds + 8192 + 2048);
#pragma unroll
        for (int ai = 0; ai < 2; ++ai)
#pragma unroll
            for (int m = 0; m < 4; ++m) {
                float s = 0.f;
#pragma unroll
                for (int bj = 0; bj < 2; ++bj)
#pragma unroll
                    for (int n = 0; n < 2; ++n) { const f32x4 x = v[ai][bj][m][n]; s += (x[0] + x[1]) + (x[2] + x[3]); }
                s += __shfl_xor(s, 16); s += __shfl_xor(s, 32);
                const float mw = s * (1.0f / 64.0f); float q = 0.f;
#pragma unroll
                for (int bj = 0; bj < 2; ++bj)
#pragma unroll
                    for (int n = 0; n < 2; ++n) { const f32x4 d = v[ai][bj][m][n] - mw; q += (d[0] * d[0] + d[1] * d[1]) + (d[2] * d[2] + d[3] * d[3]); }
                q += __shfl_xor(q, 16); q += __shfl_xor(q, 32);
                if (fq == 0) P[(ai * HALF + wr * 64 + m * 16 + fr) * 4 + wc] = (f32x2v){mw, q};
            }
        asm volatile("s_waitcnt lgkmcnt(0)" ::: "memory"); __builtin_amdgcn_s_barrier(); asm volatile("" ::: "memory");
#if defined(BROKEN_EXCHANGE_NO_WAIT)
#warning BROKEN CONTROL BUILD: the row-statistics exchange does not wait; results are wrong by design
        if (blockIdx.x >= 64) { const long long t0_ = clock64(); while (clock64() - t0_ < 60000) __builtin_amdgcn_s_sleep(8); }
#endif
        const int row = wid * 32 + (lane & 31);
        if (lane < 32) {
            const f32x2v a = P[row * 4 + 0], b = P[row * 4 + 1], c = P[row * 4 + 2], d = P[row * 4 + 3];
            const float mt = (a.x + b.x + c.x + d.x) * 0.25f;
            const float da = a.x - mt, db = b.x - mt, dc = c.x - mt, dd = d.x - mt;
            const float m2 = (a.y + b.y) + (c.y + d.y) + 64.0f * ((da * da + db * db) + (dc * dc + dd * dd));
            unsigned long long* slot = (unsigned long long*)xbuf + ((size_t)(u.pm * BM + row) * 4 + u.pn);
            __hip_atomic_store(slot, ((unsigned long long)__float_as_uint(m2) << 32) | __float_as_uint(mt), __ATOMIC_RELAXED, __HIP_MEMORY_SCOPE_AGENT);
        }
        asm volatile("s_waitcnt vmcnt(0)" ::: "memory");
        if (lane == 0) __hip_atomic_fetch_add(cnt + 64 * u.pm, 1u, __ATOMIC_RELAXED, __HIP_MEMORY_SCOPE_AGENT);
        if (wid == 0) {
            bool dead = false; const unsigned long long t0 = __builtin_amdgcn_s_memrealtime(); const unsigned want = 8u * (unsigned)ntn;
            for (;;) {
#if defined(BROKEN_EXCHANGE_NO_WAIT)
                break;
#endif
                if ((unsigned)__builtin_amdgcn_readfirstlane(__hip_atomic_load(cnt + 64 * u.pm, __ATOMIC_RELAXED, __HIP_MEMORY_SCOPE_AGENT)) >= want) break;
                if (__builtin_amdgcn_s_memrealtime() - t0 > 2000000ull) {
                    if (lane == 0) { unsigned expect = 0u; __hip_atomic_compare_exchange_strong(tmo + 1, &expect, code | (unsigned)(u.pm & 0xff), __ATOMIC_RELAXED, __ATOMIC_RELAXED, __HIP_MEMORY_SCOPE_AGENT);
                                     __hip_atomic_store(tmo, 1u, __ATOMIC_RELAXED, __HIP_MEMORY_SCOPE_AGENT); }
                    dead = true; break; }
                __builtin_amdgcn_s_sleep(2);
            }
            __builtin_amdgcn_fence(__ATOMIC_ACQUIRE, "agent");
            if (lane == 0) flag[0] = dead ? 1u : 0u;
        }
        asm volatile("s_waitcnt vmcnt(0) lgkmcnt(0)" ::: "memory"); __builtin_amdgcn_s_barrier(); asm volatile("" ::: "memory");
        const bool bad = flag[0] != 0u;
        if (lane < 32) {
            const unsigned long long* slot = (const unsigned long long*)xbuf + (size_t)(u.pm * BM + row) * 4; float mt[4], m2[4]; float ms = 0.f;
#pragma unroll
            for (int t = 0; t < 4; ++t) { if (t < ntn) { const unsigned long long w = __hip_atomic_load(slot + t, __ATOMIC_RELAXED, __HIP_MEMORY_SCOPE_AGENT); mt[t] = __uint_as_float((unsigned)w); m2[t] = __uint_as_float((unsigned)(w >> 32)); } else { mt[t] = 0.f; m2[t] = 0.f; } ms += mt[t]; }
            const float mean = ms / (float)ntn; float q = 0.f;
#pragma unroll
            for (int t = 0; t < 4; ++t) if (t < ntn) { const float dm = mt[t] - mean; q += m2[t] + 256.0f * dm * dm; }
            S[row] = (f32x2v){mean, 1.0f / sqrtf(q / (256.0f * (float)ntn) + eps)};
        }
        asm volatile("s_waitcnt lgkmcnt(0)" ::: "memory"); __builtin_amdgcn_s_barrier(); asm volatile("" ::: "memory");
        return bad;
    }
};
struct EpiLnRes {
    static constexpr bool PERM = false, AFTER_DRAIN = true;
    const float* base; float* out; int ldc; const float* bias; PanelStats st; unsigned poison;
    __device__ __forceinline__ void fused(f32x4 (&acc)[2][2][4][2], const Unit& u, int wr, int wc, int fr, int fq, PG8_LAS unsigned char* lds, int wid, int lane) const {
        typedef float f32x2v __attribute__((ext_vector_type(2)));
        const PG8_LAS f32x2v* S = (const PG8_LAS f32x2v*)(lds + 8192);
        const int col0 = u.pn * BM + wc * 32 + 4 * fq;
#pragma unroll
        for (int bj = 0; bj < 2; ++bj)
#pragma unroll
            for (int n = 0; n < 2; ++n) { const f32x4 bv = bias ? *(const f32x4*)(bias + col0 + bj * HALF + n * 16) : (f32x4){0.f, 0.f, 0.f, 0.f};
#pragma unroll
                for (int ai = 0; ai < 2; ++ai)
#pragma unroll
                    for (int m = 0; m < 4; ++m) acc[ai][bj][m][n] += bv; }
        f32x4 pre[4][2][2];
#pragma unroll
        for (int m = 0; m < 4; ++m) { const size_t off = (size_t)(u.pm * BM + wr * 64 + m * 16 + fr) * ldc + col0;
#pragma unroll
            for (int bj = 0; bj < 2; ++bj)
#pragma unroll
                for (int n = 0; n < 2; ++n) pre[m][bj][n] = *(const f32x4*)(base + off + bj * HALF + n * 16); }
        const bool bad = st.run(acc, u, wr, wc, fr, fq, lds, wid, lane) || poison != 0u;
        const float qnan = __builtin_nanf("");
#pragma unroll
        for (int ai = 0; ai < 2; ++ai)
#pragma unroll
            for (int m = 0; m < 4; ++m) { const int r = ai * HALF + wr * 64 + m * 16 + fr; const f32x2v sr = S[r]; const size_t off = (size_t)(u.pm * BM + r) * ldc + col0;
#pragma unroll
                for (int bj = 0; bj < 2; ++bj)
#pragma unroll
                    for (int n = 0; n < 2; ++n) { const f32x4 bs = ai == 0 ? pre[m][bj][n] : *(const f32x4*)(base + off + bj * HALF + n * 16); f32x4 o = bs + (acc[ai][bj][m][n] - sr.x) * sr.y;
                        if (bad) o = (f32x4){qnan, qnan, qnan, qnan}; *(f32x4*)(out + off + bj * HALF + n * 16) = o; }
                if (m & 1) asm volatile("" ::: "memory"); }
    }
};
struct EpiLnResLn {
    static constexpr bool PERM = false, AFTER_DRAIN = true;
    const float* base; float* out; bf16_t* xn; int ldc; const float* bias; PanelStats st1, st2; unsigned poison;
    __device__ __forceinline__ void fused(f32x4 (&acc)[2][2][4][2], const Unit& u, int wr, int wc, int fr, int fq, PG8_LAS unsigned char* lds, int wid, int lane) const {
        typedef float f32x2v __attribute__((ext_vector_type(2))); typedef unsigned u32x2v __attribute__((ext_vector_type(2)));
        const PG8_LAS f32x2v* S = (const PG8_LAS f32x2v*)(lds + 8192);
        const int col0 = u.pn * BM + wc * 32 + 4 * fq;
#pragma unroll
        for (int bj = 0; bj < 2; ++bj)
#pragma unroll
            for (int n = 0; n < 2; ++n) { const f32x4 bv = bias ? *(const f32x4*)(bias + col0 + bj * HALF + n * 16) : (f32x4){0.f, 0.f, 0.f, 0.f};
#pragma unroll
                for (int ai = 0; ai < 2; ++ai)
#pragma unroll
                    for (int m = 0; m < 4; ++m) acc[ai][bj][m][n] += bv; }
        bool bad = st1.run(acc, u, wr, wc, fr, fq, lds, wid, lane) || poison != 0u;
        const float qnan = __builtin_nanf("");
#pragma unroll
        for (int ai = 0; ai < 2; ++ai)
#pragma unroll
            for (int m = 0; m < 4; ++m) { const int r = ai * HALF + wr * 64 + m * 16 + fr; const f32x2v sr = S[r]; const size_t off = (size_t)(u.pm * BM + r) * ldc + col0;
#pragma unroll
                for (int bj = 0; bj < 2; ++bj)
#pragma unroll
                    for (int n = 0; n < 2; ++n) { const f32x4 bs = *(const f32x4*)(base + off + bj * HALF + n * 16); acc[ai][bj][m][n] = bs + (acc[ai][bj][m][n] - sr.x) * sr.y; }
                asm volatile("" : "+v"(acc[ai][0][m][0]), "+v"(acc[ai][0][m][1]), "+v"(acc[ai][1][m][0]), "+v"(acc[ai][1][m][1]));
                if (m & 1) asm volatile("" ::: "memory"); }
        const bool bad1 = bad;
        bad = st2.run(acc, u, wr, wc, fr, fq, lds, wid, lane) || bad;
#pragma unroll
        for (int ai = 0; ai < 2; ++ai)
#pragma unroll
            for (int m = 0; m < 4; ++m) { const int r = ai * HALF + wr * 64 + m * 16 + fr; const f32x2v sr = S[r]; const size_t off = (size_t)(u.pm * BM + r) * ldc + col0;
#pragma unroll
                for (int bj = 0; bj < 2; ++bj)
#pragma unroll
                    for (int n = 0; n < 2; ++n) { const f32x4 x1 = acc[ai][bj][m][n]; *(f32x4*)(out + off + bj * HALF + n * 16) = bad1 ? (f32x4){qnan, qnan, qnan, qnan} : x1;
                        const f32x4 o = (x1 - sr.x) * sr.y; u32x2v w; w.x = cvt_pk_bf16(o[0], o[1]); w.y = cvt_pk_bf16(o[2], o[3]);
                        if (bad) { w.x = 0x7fc07fc0u; w.y = 0x7fc07fc0u; } *(u32x2v*)(xn + off + bj * HALF + n * 16) = w; }
                asm volatile("" ::: "memory"); }
    }
};

template <class Epi, class Sched, bool ALIGN_EPI = false, bool SP2 = false>
__device__ __forceinline__ void gemm_phase(PG8_LAS unsigned char* lds, const Gemm g, const Sched& S, const Epi& E) {
    const int tid = threadIdx.x, wid = __builtin_amdgcn_readfirstlane(tid >> 6), lane = tid & 63, wr = wid >> 2, wc = wid & 3, fr = lane & 15, fq = lane >> 4;
    const int K = g.K, nt = K / BK;
    unsigned voffA[2], voffB[2];
#pragma unroll
    for (int i = 0; i < 2; ++i) { int R, C; stage_rc(tid * 16 + i * 8192, R, C); const int Rb = Epi::PERM ? ((R & ~31) + perm32(R & 31)) : R;
        voffA[i] = (unsigned)(R * K + C) * 2u; voffB[i] = (unsigned)(Rb * K + C) * 2u; }
    const size_t kstep = (size_t)(BK * 2);
    const size_t hstep = (size_t)HALF * K * 2;
    const size_t tstep = 2 * hstep;
    const unsigned ldsw = (unsigned)wid * 1024u;
    const int aoff = lds_byte(wr * 64 + fr, fq * 8), boff = lds_byte(wc * 32 + fr, fq * 8);
#define PG8_SA(b, h) (((b) * 2 + (h)) * HTB)
#define PG8_SB(b, h) ((4 + (b) * 2 + (h)) * HTB)
#define PG8_STAGE(bufoff, gbase, voff) do { _Pragma("unroll") for (int _i = 0; _i < 2; ++_i) \
        __builtin_amdgcn_global_load_lds((const unsigned*)((const char*)(gbase) + (voff)[_i]), (PG8_LAS unsigned*)(lds + (bufoff) + ldsw + _i * 8192), 16, 0, 0); } while (0)
#define PG8_LDA(dst, b, h) do { _Pragma("unroll") for (int m = 0; m < 4; ++m) _Pragma("unroll") for (int k = 0; k < 2; ++k) dst[m][k] = *(const PG8_LAS bf16x8*)(lds + PG8_SA(b, h) + aoff + m * 2048 + k * 1024); } while (0)
#define PG8_LDB(dst, b, h) do { _Pragma("unroll") for (int n = 0; n < 2; ++n) _Pragma("unroll") for (int k = 0; k < 2; ++k) dst[n][k] = *(const PG8_LAS bf16x8*)(lds + PG8_SB(b, h) + boff + n * 2048 + k * 1024); } while (0)
#define PG8_MMA(ai, bj, At, Bt) do { __builtin_amdgcn_s_setprio(1); _Pragma("unroll") for (int m = 0; m < 4; ++m) _Pragma("unroll") for (int n = 0; n < 2; ++n) _Pragma("unroll") for (int k = 0; k < 2; ++k) \
        acc[ai][bj][m][n] = __builtin_amdgcn_mfma_f32_16x16x32_bf16(Bt[n][k], At[m][k], acc[ai][bj][m][n], 0, 0, 0); __builtin_amdgcn_s_setprio(0); } while (0)
#define PG8_WAIT_V(n) asm volatile("s_waitcnt vmcnt(" #n ")" ::: "memory")
#define PG8_WAIT_L(n) asm volatile("s_waitcnt lgkmcnt(" #n ")" ::: "memory")
#define PG8_BAR __builtin_amdgcn_s_barrier()
#define PG8_SCHED __builtin_amdgcn_sched_barrier(0)
    Unit cur, nxt; int ui = 0;
    if (!S.next(0, cur)) return;
    f32x4 acc[2][2][4][2];
#pragma unroll
    for (int a = 0; a < 2; ++a)
#pragma unroll
        for (int b = 0; b < 2; ++b)
#pragma unroll
            for (int m = 0; m < 4; ++m)
#pragma unroll
                for (int n = 0; n < 2; ++n) acc[a][b][m][n] = (f32x4){0.f, 0.f, 0.f, 0.f};
    bf16x8 At[4][2], B0[2][2], B1[2][2];
    const char* cA = (const char*)g.A + (size_t)cur.pm * tstep; const char* cB = (const char*)g.Bt + (size_t)cur.pn * tstep;
    S.a_ready(cur);
    if constexpr (SP2) {
        PG8_STAGE(PG8_SB(0, 0), cB, voffB); PG8_STAGE(PG8_SB(0, 1), cB + hstep, voffB); PG8_STAGE(PG8_SA(0, 0), cA, voffA); PG8_STAGE(PG8_SA(0, 1), cA + hstep, voffA);
        if (wr == 1) PG8_BAR;
        PG8_WAIT_V(2); PG8_BAR;
        PG8_STAGE(PG8_SB(1, 0), cB + kstep, voffB); PG8_STAGE(PG8_SA(1, 0), cA + kstep, voffA); PG8_STAGE(PG8_SB(1, 1), cB + hstep + kstep, voffB);
        PG8_WAIT_V(6); PG8_BAR;
    } else {
        PG8_STAGE(PG8_SB(0, 0), cB, voffB); PG8_STAGE(PG8_SA(0, 0), cA, voffA); PG8_STAGE(PG8_SB(0, 1), cB + hstep, voffB); PG8_STAGE(PG8_SA(0, 1), cA + hstep, voffA);
        if (wr == 1) PG8_BAR;
        PG8_WAIT_V(4); PG8_BAR;
        PG8_STAGE(PG8_SB(1, 0), cB + kstep, voffB); PG8_STAGE(PG8_SA(1, 0), cA + kstep, voffA); PG8_STAGE(PG8_SB(1, 1), cB + hstep + kstep, voffB);
        PG8_WAIT_V(6); PG8_BAR;
    }
    for (;;) {
        const bool has_next = S.next(ui + 1, nxt);
        const char* nA = has_next ? (const char*)g.A + (size_t)nxt.pm * tstep : cA; const char* nB = has_next ? (const char*)g.Bt + (size_t)nxt.pn * tstep : cB;
        for (int t = 0; t < nt; t += 2) {
            const bool last = (t == nt - 2);
            const char* a1 = cA + (size_t)(t + 1) * kstep;
            const char* a2 = last ? nA : cA + (size_t)(t + 2) * kstep; const char* b2 = last ? nB : cB + (size_t)(t + 2) * kstep;
            const char* a3 = a2 + kstep; const char* b3 = b2 + kstep;
            if (last && has_next) S.a_ready(nxt);
            if constexpr (SP2) {
            PG8_LDB(B0, 0, 0); PG8_LDB(B1, 0, 1); PG8_SCHED; PG8_LDA(At, 0, 0); PG8_STAGE(PG8_SA(1, 1), a1 + hstep, voffA);
            PG8_WAIT_V(8); PG8_WAIT_L(0); PG8_BAR; PG8_MMA(0, 0, At, B0); PG8_MMA(0, 1, At, B1); PG8_BAR; PG8_SCHED;
            PG8_LDA(At, 0, 1); PG8_STAGE(PG8_SB(0, 0), b2, voffB); PG8_STAGE(PG8_SB(0, 1), b2 + hstep, voffB); PG8_STAGE(PG8_SA(0, 0), a2, voffA);
            PG8_WAIT_V(8); PG8_WAIT_L(0); PG8_BAR; PG8_MMA(1, 0, At, B0); PG8_MMA(1, 1, At, B1); PG8_BAR; PG8_SCHED;
            PG8_LDB(B0, 1, 0); PG8_LDB(B1, 1, 1); PG8_SCHED; PG8_LDA(At, 1, 0); PG8_STAGE(PG8_SA(0, 1), a2 + hstep, voffA);
            PG8_WAIT_V(8); PG8_WAIT_L(0); PG8_BAR; PG8_MMA(0, 0, At, B0); PG8_MMA(0, 1, At, B1); PG8_BAR; PG8_SCHED;
            PG8_LDA(At, 1, 1); PG8_STAGE(PG8_SB(1, 0), b3, voffB); PG8_STAGE(PG8_SB(1, 1), b3 + hstep, voffB); PG8_STAGE(PG8_SA(1, 0), a3, voffA);
            PG8_WAIT_V(8); PG8_WAIT_L(0); PG8_BAR; PG8_MMA(1, 0, At, B0); PG8_MMA(1, 1, At, B1); PG8_BAR; PG8_SCHED;
            } else {
            PG8_LDB(B0, 0, 0); PG8_SCHED; PG8_LDA(At, 0, 0); PG8_STAGE(PG8_SA(1, 1), a1 + hstep, voffA);
            PG8_WAIT_L(8); PG8_BAR; PG8_WAIT_L(0); PG8_MMA(0, 0, At, B0); PG8_BAR; PG8_SCHED;
            PG8_LDB(B1, 0, 1); PG8_STAGE(PG8_SB(0, 0), b2, voffB);
            PG8_BAR; PG8_WAIT_L(0); PG8_MMA(0, 1, At, B1); PG8_BAR;
            PG8_LDA(At, 0, 1); PG8_STAGE(PG8_SA(0, 0), a2, voffA);
            PG8_BAR; PG8_WAIT_L(0); PG8_MMA(1, 0, At, B0); PG8_BAR; PG8_SCHED;
            PG8_STAGE(PG8_SB(0, 1), b2 + hstep, voffB);
            PG8_WAIT_V(6); PG8_BAR; PG8_MMA(1, 1, At, B1); PG8_BAR;
            PG8_LDB(B0, 1, 0); PG8_SCHED; PG8_LDA(At, 1, 0); PG8_STAGE(PG8_SA(0, 1), a2 + hstep, voffA);
            PG8_WAIT_L(8); PG8_BAR; PG8_WAIT_L(0); PG8_MMA(0, 0, At, B0); PG8_BAR; PG8_SCHED;
            PG8_LDB(B1, 1, 1); PG8_STAGE(PG8_SB(1, 0), b3, voffB);
            PG8_BAR; PG8_WAIT_L(0); PG8_MMA(0, 1, At, B1); PG8_BAR;
            PG8_LDA(At, 1, 1); PG8_STAGE(PG8_SA(1, 0), a3, voffA);
            PG8_BAR; PG8_WAIT_L(0); PG8_MMA(1, 0, At, B0); PG8_BAR; PG8_SCHED;
            PG8_STAGE(PG8_SB(1, 1), b3 + hstep, voffB);
            PG8_WAIT_V(6); PG8_BAR; PG8_MMA(1, 1, At, B1); PG8_BAR;
            }
        }
        if constexpr (ALIGN_EPI) { if (wr == 0) PG8_BAR; }
        if constexpr (!Epi::AFTER_DRAIN) { E(acc, cur, wr, wc, fr, fq); S.done(cur); }
        if (!has_next) break;
#pragma unroll
        for (int a = 0; a < 2; ++a)
#pragma unroll
            for (int b = 0; b < 2; ++b)
#pragma unroll
                for (int m = 0; m < 4; ++m)
#pragma unroll
                    for (int n = 0; n < 2; ++n) acc[a][b][m][n] = (f32x4){0.f, 0.f, 0.f, 0.f};
        cur = nxt; cA = nA; cB = nB; ++ui;
        if constexpr (ALIGN_EPI) { if (wr == 1) PG8_BAR; }
    }
    PG8_WAIT_V(0);
    if constexpr (!ALIGN_EPI) { if (wr == 0) PG8_BAR; }
    PG8_BAR;
    if constexpr (Epi::AFTER_DRAIN) { E.fused(acc, cur, wr, wc, fr, fq, lds, wid, lane); S.done(cur); }
#undef PG8_SA
#undef PG8_SB
#undef PG8_STAGE
#undef PG8_LDA
#undef PG8_LDB
#undef PG8_MMA
#undef PG8_WAIT_V
#undef PG8_WAIT_L
#undef PG8_BAR
#undef PG8_SCHED
}
}
namespace pg8 {
__device__ __forceinline__ float silu_f(float v) { return v * __builtin_amdgcn_rcpf(1.0f + __expf(-v)); }
struct EpiF32 {
    static constexpr bool PERM = false, AFTER_DRAIN = false;
    float* C; int ldc;
    __device__ __forceinline__ void operator()(const f32x4 (&acc)[2][2][4][2], const Unit& u, int wr, int wc, int fr, int fq) const {
        const int row0 = u.pm * BM + wr * 64 + fr, col0 = u.pn * BM + wc * 32 + 4 * fq;
#pragma unroll
        for (int ai = 0; ai < 2; ++ai)
#pragma unroll
            for (int m = 0; m < 4; ++m) { float* rowp = C + (size_t)(row0 + ai * HALF + m * 16) * ldc + col0;
#pragma unroll
                for (int bj = 0; bj < 2; ++bj)
#pragma unroll
                    for (int n = 0; n < 2; ++n) *(f32x4*)(rowp + bj * HALF + n * 16) = acc[ai][bj][m][n]; }
    }
};
struct EpiSwiglu {
    static constexpr bool PERM = true, AFTER_DRAIN = false;
    bf16_t* O; int ldc;
    __device__ __forceinline__ void operator()(const f32x4 (&acc)[2][2][4][2], const Unit& u, int wr, int wc, int fr, int fq) const {
        const int row0 = u.pm * BM + wr * 64 + fr, col0 = u.pn * HALF + wc * 32 + 8 * fq;
#pragma unroll
        for (int ai = 0; ai < 2; ++ai)
#pragma unroll
            for (int m = 0; m < 4; ++m) { bf16_t* rowp = O + (size_t)(row0 + ai * HALF + m * 16) * ldc + col0;
                const f32x4 g0 = acc[ai][0][m][0], g1 = acc[ai][0][m][1], u0 = acc[ai][1][m][0], u1 = acc[ai][1][m][1];
                u32x4 w;
                w.x = cvt_pk_bf16(silu_f(g0[0]) * u0[0], silu_f(g0[1]) * u0[1]); w.y = cvt_pk_bf16(silu_f(g0[2]) * u0[2], silu_f(g0[3]) * u0[3]);
                w.z = cvt_pk_bf16(silu_f(g1[0]) * u1[0], silu_f(g1[1]) * u1[1]); w.w = cvt_pk_bf16(silu_f(g1[2]) * u1[2], silu_f(g1[3]) * u1[3]);
                st16_wt(rowp, w); }
    }
};
struct EpiMix {
    static constexpr bool PERM = true, AFTER_DRAIN = false;
    bf16_t* Z; bf16_t* XBC; float* DT;
    __device__ __forceinline__ void operator()(const f32x4 (&acc)[2][2][4][2], const Unit& u, int wr, int wc, int fr, int fq) const {
        const int row0 = u.pm * BM + wr * 64 + fr;
        if (u.pn < 10) {
            bf16_t* base; int ldc, colt;
            if (u.pn < 4) { base = Z; ldc = 1024; colt = u.pn * BM; } else { base = XBC; ldc = 1536; colt = (u.pn - 4) * BM; }
            const int col0 = colt + wc * 32 + 8 * fq;
#pragma unroll
            for (int ai = 0; ai < 2; ++ai)
#pragma unroll
                for (int m = 0; m < 4; ++m) { bf16_t* rowp = base + (size_t)(row0 + ai * HALF + m * 16) * ldc + col0;
#pragma unroll
                    for (int bj = 0; bj < 2; ++bj) { const f32x4 v0 = acc[ai][bj][m][0], v1 = acc[ai][bj][m][1];
                        u32x4 w; w.x = cvt_pk_bf16(v0[0], v0[1]); w.y = cvt_pk_bf16(v0[2], v0[3]); w.z = cvt_pk_bf16(v1[0], v1[1]); w.w = cvt_pk_bf16(v1[2], v1[3]);
                        st16_wt(rowp + bj * HALF, w); } }
        } else if (wc == 0 && fq < 2) {
#pragma unroll
            for (int ai = 0; ai < 2; ++ai)
#pragma unroll
                for (int m = 0; m < 4; ++m) { float* rowp = DT + (size_t)(row0 + ai * HALF + m * 16) * 16 + 8 * fq;
                    *(f32x4*)rowp = acc[ai][0][m][0]; *(f32x4*)(rowp + 4) = acc[ai][0][m][1]; }
        }
    }
};
struct EpiQKV {
    static constexpr bool PERM = true, AFTER_DRAIN = false;
    bf16_t* O; int ldc; size_t split_stride; float scale0; unsigned* kmax;
    __device__ __forceinline__ void operator()(const f32x4 (&acc)[2][2][4][2], const Unit& u, int wr, int wc, int fr, int fq) const {
        const int row0 = u.pm * BM + wr * 64 + fr; int colt = u.pn * BM; const int t = colt / 1024; bf16_t* base = O + (size_t)t * split_stride; colt -= t * 1024;
        const float sc = (t == 0) ? scale0 : 1.f; const int col0 = colt + wc * 32 + 8 * fq;
        float km[2] = {0.f, 0.f};
#pragma unroll
        for (int ai = 0; ai < 2; ++ai)
#pragma unroll
            for (int m = 0; m < 4; ++m) { bf16_t* rowp = base + (size_t)(row0 + ai * HALF + m * 16) * ldc + col0;
#pragma unroll
                for (int bj = 0; bj < 2; ++bj) { const f32x4 v0 = acc[ai][bj][m][0] * sc, v1 = acc[ai][bj][m][1] * sc;
                    u32x4 w; w.x = cvt_pk_bf16(v0[0], v0[1]); w.y = cvt_pk_bf16(v0[2], v0[3]); w.z = cvt_pk_bf16(v1[0], v1[1]); w.w = cvt_pk_bf16(v1[2], v1[3]);
                    st16_wt(rowp + bj * HALF, w);
                    if (t == 1) { float s = 0.f;
#pragma unroll
                        for (int e = 0; e < 4; ++e) { const float lo = __builtin_bit_cast(float, w[e] << 16), hi = __builtin_bit_cast(float, w[e] & 0xffff0000u); s += lo * lo + hi * hi; }
                        s += __shfl_xor(s, 16); s += __shfl_xor(s, 32); km[bj] = __builtin_fmaxf(km[bj], s); } } }
        if (t == 1) {
#pragma unroll
            for (int bj = 0; bj < 2; ++bj) { float v = km[bj];
                v = __builtin_fmaxf(v, __shfl_xor(v, 1)); v = __builtin_fmaxf(v, __shfl_xor(v, 2)); v = __builtin_fmaxf(v, __shfl_xor(v, 4)); v = __builtin_fmaxf(v, __shfl_xor(v, 8));
                if ((fr | fq) == 0) { const int b = u.pm >> 5, head = (colt >> 7) + bj; atomicMax(kmax + (((b * 8 + head) * 2 + (wc >> 1)) * 2 + (wc & 1)), __builtin_bit_cast(unsigned, v)); } } }
    }
};
}
#include <hip/hip_bf16.h>
#include <cmath>
namespace attn_body {
using bf16=__hip_bfloat16;
using bf16x8=__attribute__((ext_vector_type(8)))short;
using s16x4=__attribute__((ext_vector_type(4)))short;
using f32x16=__attribute__((ext_vector_type(16)))float;
using u32x4=__attribute__((ext_vector_type(4)))unsigned;
constexpr int BATCH=2,NHEAD=16,SEQ=8192,D=64,DM=NHEAD*D;
constexpr int NW=8,QBLK=32,QB=QBLK*NW,KVBLK=64,NQB=SEQ/QB;
constexpr int ATTN_PITCH=DM, ATTN_UNIT_ROWS=QB, OPITCH=2048, OCOL0=1024;
__device__ __forceinline__ int crow(int r,int hi){return (r&3)+8*(r>>2)+4*hi;}
#define SBAR() __builtin_amdgcn_sched_barrier(0)
__device__ __forceinline__ void cmask(f32x16&p0,f32x16&p1,int jb,int qrel,int hi){
  const float NEG=-INFINITY; int kb=64*jb+4*hi;
  #pragma unroll
  for(int r=0;r<16;++r){int kv=kb+(r&3)+8*(r>>2); if(kv>qrel)p0[r]=NEG; if(kv+32>qrel)p1[r]=NEG;}
}

constexpr int BT_N=704;
__device__ __forceinline__ void bmask(f32x16&p0,f32x16&p1,int jb,int qrel,int hi,const float*bt){
  const float NEG=-INFINITY; const int brel=qrel-64*jb-4*hi; const float*bp=bt+(brel+256);
  #pragma unroll
  for(int r=0;r<16;++r){const int c0=(r&3)+8*(r>>2);
    const float b0=bp[-c0], b1=bp[-c0-32];
    p0[r]=(brel<c0)?NEG:p0[r]+b0; p1[r]=(brel<c0+32)?NEG:p1[r]+b1;
    if((r&3)==3)SBAR();}
}
constexpr int NSLOT=3, SLOTB=8192;
constexpr int LDS_K=0, LDS_V=NSLOT*SLOTB, LDS_WS=2*NSLOT*SLOTB, LDS_OST=LDS_WS+NW*64*4, LDS_BYTES=LDS_OST+NW*4096, LDS_OSTA=86016, LDS_BTAB=LDS_OSTA+NW*4096, LDS_TOTAL=LDS_BTAB+704*4;
constexpr float C2=0.125f*1.4426950408889634f;
__device__ __forceinline__ void glds16(const void*gsrc,unsigned lds_dst){unsigned keep;
  asm volatile("s_mov_b32 %0, m0\n\ts_mov_b32 m0, %2\n\ts_nop 0\n\tglobal_load_lds_dwordx4 %1, off\n\ts_mov_b32 m0, %0":"=&s"(keep):"v"(gsrc),"s"(lds_dst):"memory");}
__device__ __forceinline__ float max3f(float a,float b,float c){float r;asm("v_max3_f32 %0, %1, %2, %3":"=v"(r):"v"(a),"v"(b),"v"(c));return r;}
__device__ __forceinline__ float max2f(float a,float b){float r;asm("v_max_f32_e32 %0, %1, %2":"=v"(r):"v"(a),"v"(b));return r;}
__device__ __forceinline__ float fadd_s(float a,float b){float r;asm("v_add_f32_e32 %0, %1, %2":"=v"(r):"v"(a),"v"(b));return r;}
__device__ __forceinline__ float fsub_s(float a,float b){float r;asm("v_sub_f32_e32 %0, %1, %2":"=v"(r):"v"(a),"v"(b));return r;}
typedef float f32x2_t __attribute__((ext_vector_type(2))); typedef __bf16 bf16x2_t __attribute__((ext_vector_type(2)));
__device__ __forceinline__ unsigned cvtpk_s(float lo,float hi){f32x2_t v={lo,hi};bf16x2_t b=__builtin_convertvector(v,bf16x2_t);return __builtin_bit_cast(unsigned,b);}
#define WAIT_BAR(N) asm volatile("s_waitcnt vmcnt(" #N ") lgkmcnt(0)\n\ts_barrier":::"memory")

__device__ __forceinline__ void qkt(f32x16&p0,f32x16&p1,const char*Kslot,const bf16x8*qr,const f32x16&negm,int r32,int hi){
  const char*kb=Kslot+hi*1024+r32*16;
  #pragma unroll
  for(int d0=0;d0<4;++d0){
    const bf16x8 b0=*reinterpret_cast<const bf16x8*>(kb+d0*2048);
    const bf16x8 b1=*reinterpret_cast<const bf16x8*>(kb+d0*2048+512);
    if(d0==0){p0=__builtin_amdgcn_mfma_f32_32x32x16_bf16(b0,qr[0],negm,0,0,0);p1=__builtin_amdgcn_mfma_f32_32x32x16_bf16(b1,qr[0],negm,0,0,0);}
    else{p0=__builtin_amdgcn_mfma_f32_32x32x16_bf16(b0,qr[d0],p0,0,0,0);p1=__builtin_amdgcn_mfma_f32_32x32x16_bf16(b1,qr[d0],p1,0,0,0);}}
}
typedef __attribute__((address_space(3))) const char* lds_cptr;
typedef short v4i16_t __attribute__((ext_vector_type(4)));
__device__ __forceinline__ void kload8(bf16x8*kf,lds_cptr kp){
  kf[0]=*(const __attribute__((address_space(3))) bf16x8*)(kp);      kf[1]=*(const __attribute__((address_space(3))) bf16x8*)(kp+512);
  kf[2]=*(const __attribute__((address_space(3))) bf16x8*)(kp+2048); kf[3]=*(const __attribute__((address_space(3))) bf16x8*)(kp+2560);
  kf[4]=*(const __attribute__((address_space(3))) bf16x8*)(kp+4096); kf[5]=*(const __attribute__((address_space(3))) bf16x8*)(kp+4608);
  kf[6]=*(const __attribute__((address_space(3))) bf16x8*)(kp+6144); kf[7]=*(const __attribute__((address_space(3))) bf16x8*)(kp+6656);
}
__device__ __forceinline__ void kload2(bf16x8*kf,lds_cptr kp,int j){ kf[2*j]=*(const __attribute__((address_space(3))) bf16x8*)(kp+j*2048); kf[2*j+1]=*(const __attribute__((address_space(3))) bf16x8*)(kp+j*2048+512); }
__device__ __forceinline__ s16x4 vtr(lds_cptr p){ return __builtin_bit_cast(s16x4,__builtin_amdgcn_ds_read_tr16_b64_v4i16((__attribute__((address_space(3))) v4i16_t*)p)); }
__device__ __forceinline__ float rowmax(const f32x16&p0,const f32x16&p1){
  float a=max3f(p0[0],p0[1],p1[0]),b=max3f(p0[2],p0[3],p1[1]);a=max3f(a,p1[2],p1[3]);
  #pragma unroll
  for(int r=4;r<16;r+=4){a=max3f(a,p0[r],p0[r+1]);b=max3f(b,p0[r+2],p0[r+3]);a=max3f(a,p1[r],p1[r+1]);b=max3f(b,p1[r+2],p1[r+3]);}
  const float m=max2f(a,b);
  auto rr=__builtin_amdgcn_permlane32_swap(__float_as_uint(m),__float_as_uint(m),false,false);
  return max2f(__uint_as_float(rr[0]),__uint_as_float(rr[1]));
}
__device__ __forceinline__ void pv(f32x16*o,int vb,bf16x8 pa0,bf16x8 pa1,bf16x8 pa2,bf16x8 pa3){
  #pragma unroll
  for(int d0=0;d0<2;++d0){s16x4 lo[4],hi[4];
    #pragma unroll
    for(int ks=0;ks<4;++ks){
      asm volatile("ds_read_b64_tr_b16 %0,%1 offset:%c2":"=&v"(lo[ks]):"v"(vb),"i"(d0*4096+ks*1024):"memory");
      asm volatile("ds_read_b64_tr_b16 %0,%1 offset:%c2":"=&v"(hi[ks]):"v"(vb),"i"(d0*4096+ks*1024+512):"memory");}
    asm volatile("s_waitcnt lgkmcnt(0)":::"memory");SBAR();
    #define PK(k) (bf16x8){lo[k][0],lo[k][1],lo[k][2],lo[k][3],hi[k][0],hi[k][1],hi[k][2],hi[k][3]}
    o[d0]=__builtin_amdgcn_mfma_f32_32x32x16_bf16(pa0,PK(0),o[d0],0,0,0);
    o[d0]=__builtin_amdgcn_mfma_f32_32x32x16_bf16(pa1,PK(1),o[d0],0,0,0);
    o[d0]=__builtin_amdgcn_mfma_f32_32x32x16_bf16(pa2,PK(2),o[d0],0,0,0);
    o[d0]=__builtin_amdgcn_mfma_f32_32x32x16_bf16(pa3,PK(3),o[d0],0,0,0);
    #undef PK
  }
}

#ifndef ATTN_STORE16
#define ATTN_STORE16(p,v) (*(u32x4*)(p)=(v))
#endif
template<int THRL> __device__ __forceinline__ void attn_unit(int b,int hq,int hv,int qb,int pass,float lam,const float*btab,const bf16*Q,const bf16*__restrict__ K,const bf16*__restrict__ V,bf16*O,char*shm){
  const int tid=threadIdx.x,lane=tid&63,r32=lane&31,hi=lane>>5; const int wid=__builtin_amdgcn_readfirstlane(tid>>6);
  const long rowbase=(long)b*SEQ; const int q0=qb*QB;
  const bf16*Qw=Q+(rowbase+q0+wid*QBLK)*DM+hq*D;
  const bf16*Kh=K+rowbase*DM+hq*D,*Vh=V+rowbase*DM+hv*D;
  const unsigned lds0=(unsigned)(uintptr_t)shm;
  float*wsf=(float*)(shm+LDS_WS)+wid*64;
  const bf16*ksrc=Kh+(long)lane*DM+wid*8;
  const bf16*vsrc=Vh+(long)(16*(wid&3)+(lane>>2))*DM+(wid>>2)*32+(lane&3)*8;
  const unsigned kdst=lds0+LDS_K+wid*1024, vdst=lds0+LDS_V+wid*1024;
  #define DMA_K(t,slot) glds16(ksrc+(long)(t)*KVBLK*DM,(unsigned)__builtin_amdgcn_readfirstlane(kdst+(slot)))
  #define DMA_V(t,slot) glds16(vsrc+(long)(t)*KVBLK*DM,(unsigned)__builtin_amdgcn_readfirstlane(vdst+(slot)))
  const int vb0=(int)(lds0+LDS_V)+((lane>>4)&1)*32+(lane&3)*8+(4*hi+((lane&15)>>2))*64;
  const char*Kbase=shm+LDS_K; bf16x8 kf[8];
  const lds_cptr shm3=(lds_cptr)shm; const lds_cptr kp0=shm3+LDS_K+hi*1024+r32*16; const lds_cptr vp0=shm3+LDS_V+((lane>>4)&1)*32+(lane&3)*8+(4*hi+((lane&15)>>2))*64;
  const int NT=(q0+QB)/KVBLK;
  DMA_K(0,0);DMA_V(0,0);DMA_K(1,SLOTB);
  bf16x8 qr[4];
  #pragma unroll
  for(int d0=0;d0<4;++d0)qr[d0]=*reinterpret_cast<const bf16x8*>(&Qw[(long)r32*DM+d0*16+hi*8]);
  float mhat=0.f,l_reg=0.f;f32x16 o[2];o[0]=f32x16{};o[1]=f32x16{};f32x16 negm=f32x16{};asm volatile("":"+v"(negm));
  const int qrel=wid*QBLK+r32;
  #define CMASK(P0,P1,t) do{int jb_=(t)-(NT-4); if(jb_>=-2)bmask(P0,P1,jb_,qrel,hi,btab);}while(0)
  bool resc=false;
  #define START(P0,P1) do{ const float rm=rowmax(P0,P1); resc=false; \
    { const float dl=rm; mhat=fadd_s(mhat,dl); \
      _Pragma("unroll") for(int r=0;r<16;++r){P0[r]=fsub_s(P0[r],dl);P1[r]=fsub_s(P1[r],dl);} \
      _Pragma("unroll") for(int r=0;r<16;++r)negm[r]=-mhat; asm volatile("":"+v"(negm)); } \
    _Pragma("unroll") for(int r=0;r<16;++r)P0[r]=__builtin_amdgcn_exp2f(P0[r]); }while(0)
  #define RESC() do{ if(resc){ asm volatile("s_waitcnt lgkmcnt(0)":::"memory"); \
      _Pragma("unroll") for(int d_=0;d_<2;++d_) _Pragma("unroll") for(int r=0;r<16;++r)o[d_][r]*=wsf[crow(r,hi)]; } }while(0)
  f32x16 pA0,pA1,pB0,pB1;
  int sl_prev=0,sl_cur=0,sl_next=SLOTB;
  #define ROT() do{sl_prev=sl_cur;sl_cur=sl_next;sl_next=(sl_next==(NSLOT-1)*SLOTB)?0:sl_next+SLOTB;}while(0)
  DMA_K(2,2*SLOTB);
  WAIT_BAR(3);
  qkt(pA0,pA1,Kbase,qr,negm,r32,hi);asm volatile("s_nop 15\n\ts_nop 7":"+v"(pA0),"+v"(pA1));CMASK(pA0,pA1,0);
  START(pA0,pA1);
  _Pragma("unroll") for(int r=0;r<16;++r)pA1[r]=__builtin_amdgcn_exp2f(pA1[r]);
  WAIT_BAR(0);
  DMA_K(3,0);DMA_V(1,SLOTB);
  ROT();
  kload8(kf,kp0+sl_cur);
  WAIT_BAR(2);
  s16x4 vlo[8],vhi[8]; u32x4 pw0,pw1,pw2,pw3;
  #define PKW(P,B) cvtpk_s(P[B],P[B+1])
  #define PAF(k) __builtin_bit_cast(bf16x8,pw##k)
  #define VFR(i) (bf16x8){vlo[i][0],vlo[i][1],vlo[i][2],vlo[i][3],vhi[i][0],vhi[i][1],vhi[i][2],vhi[i][3]}
  #define PIN(x) asm volatile("":"+v"(x))
  #define MX3(a,b,c) __builtin_fmaxf(__builtin_fmaxf((a),(b)),(c))
  #define GAPA(MF,A0,A1,A2,A3,W0,W1,PW) do{ MF; sacc+=A0; sacc+=A1; sacc+=A2; sacc+=A3; PIN(sacc); W0; W1; PIN(PW); SBAR(); }while(0)
  #define EX(v) __builtin_amdgcn_exp2f(v)
  #define GAPB(MF,X,B) do{ MF; X[B]=EX(X[B]); X[B+1]=EX(X[B+1]); X[B+2]=EX(X[B+2]); X[B+3]=EX(X[B+3]); PIN(X); SBAR(); }while(0)
  #define VRD(i) do{ vlo[i]=vtr(vp_+(((i)>>2)*4096+((i)&3)*1024)); vhi[i]=vtr(vp_+(((i)>>2)*4096+((i)&3)*1024+512)); }while(0)
  #define KRD(G,j) do{ if(G){ kload2(kf,kp0+sl_next,j); SBAR(); } }while(0)
  #define STEP(C0,C1,P0,P1,t,GK,GV,GL) do{ SBAR(); \
    const lds_cptr vp_=vp0+sl_prev; \
    VRD(0); SBAR(); float sacc=(P0[0]+P0[1]); \
    GAPA(C0=__builtin_amdgcn_mfma_f32_32x32x16_bf16(kf[0],qr[0],negm,0,0,0), P0[2],P0[3],P0[4],P0[5],     pw0[0]=PKW(P0,0), pw0[1]=PKW(P0,2), pw0); \
    VRD(4); SBAR(); GAPA(C1=__builtin_amdgcn_mfma_f32_32x32x16_bf16(kf[1],qr[0],negm,0,0,0), P0[6],P0[7],P0[8],P0[9],     pw0[2]=PKW(P0,4), pw0[3]=PKW(P0,6), pw0); \
    VRD(1); SBAR(); GAPA(C0=__builtin_amdgcn_mfma_f32_32x32x16_bf16(kf[2],qr[1],C0,0,0,0),   P0[10],P0[11],P0[12],P0[13], pw1[0]=PKW(P0,8), pw1[1]=PKW(P0,10), pw1); \
    VRD(5); SBAR(); GAPA(C1=__builtin_amdgcn_mfma_f32_32x32x16_bf16(kf[3],qr[1],C1,0,0,0),   P0[14],P0[15],P1[0],P1[1],   pw1[2]=PKW(P0,12),pw1[3]=PKW(P0,14), pw1); \
    VRD(2); SBAR(); GAPA(C0=__builtin_amdgcn_mfma_f32_32x32x16_bf16(kf[4],qr[2],C0,0,0,0),   P1[2],P1[3],P1[4],P1[5],     pw2[0]=PKW(P1,0), pw2[1]=PKW(P1,2), pw2); \
    VRD(6); SBAR(); GAPA(C1=__builtin_amdgcn_mfma_f32_32x32x16_bf16(kf[5],qr[2],C1,0,0,0),   P1[6],P1[7],P1[8],P1[9],     pw2[2]=PKW(P1,4), pw2[3]=PKW(P1,6), pw2); \
    VRD(3); SBAR(); GAPA(C0=__builtin_amdgcn_mfma_f32_32x32x16_bf16(kf[6],qr[3],C0,0,0,0),   P1[10],P1[11],P1[12],P1[13], pw3[0]=PKW(P1,8), pw3[1]=PKW(P1,10), pw3); \
    VRD(7); SBAR(); GAPA(C1=__builtin_amdgcn_mfma_f32_32x32x16_bf16(kf[7],qr[3],C1,0,0,0),   P1[14],P1[15],0.f,0.f,       pw3[2]=PKW(P1,12),pw3[3]=PKW(P1,14), pw3); \
    l_reg+=sacc; \
    if(GK){DMA_K((t)+3,sl_cur);} if(GV){DMA_V((t)+1,sl_next);} \
    CMASK(C0,C1,t); \
    { float a=MX3(C0[0],C0[1],C1[0]),b=MX3(C0[2],C0[3],C1[1]); a=MX3(a,C1[2],C1[3]); \
      _Pragma("unroll") for(int r=4;r<16;r+=4){a=MX3(a,C0[r],C0[r+1]);b=MX3(b,C0[r+2],C0[r+3]);a=MX3(a,C1[r],C1[r+1]);b=MX3(b,C1[r+2],C1[r+3]);} \
      float rm=__builtin_fmaxf(a,b); { auto rr=__builtin_amdgcn_permlane32_swap(__float_as_uint(rm),__float_as_uint(rm),false,false); rm=__builtin_fmaxf(__uint_as_float(rr[0]),__uint_as_float(rr[1])); } \
      resc=false; \
      if(__builtin_expect(__any(rm>(float)THRL),0)){ const float dl=__builtin_fmaxf(rm,0.f); mhat+=dl; \
        _Pragma("unroll") for(int r=0;r<16;++r){C0[r]-=dl;C1[r]-=dl;} \
        _Pragma("unroll") for(int r=0;r<16;++r)negm[r]=-mhat; asm volatile("":"+v"(negm)); \
        const float f=__builtin_amdgcn_exp2f(-dl); l_reg*=f; if(hi==0)wsf[r32]=f; resc=true; } } \
    SBAR(); \
    GAPB(o[0]=__builtin_amdgcn_mfma_f32_32x32x16_bf16(PAF(0),VFR(0),o[0],0,0,0), C0,0); \
    GAPB(o[1]=__builtin_amdgcn_mfma_f32_32x32x16_bf16(PAF(0),VFR(4),o[1],0,0,0), C0,4); \
    KRD(GL,0); GAPB(o[0]=__builtin_amdgcn_mfma_f32_32x32x16_bf16(PAF(1),VFR(1),o[0],0,0,0), C0,8); \
    KRD(GL,1); GAPB(o[1]=__builtin_amdgcn_mfma_f32_32x32x16_bf16(PAF(1),VFR(5),o[1],0,0,0), C0,12); \
    KRD(GL,2); GAPB(o[0]=__builtin_amdgcn_mfma_f32_32x32x16_bf16(PAF(2),VFR(2),o[0],0,0,0), C1,0); \
    KRD(GL,3); GAPB(o[1]=__builtin_amdgcn_mfma_f32_32x32x16_bf16(PAF(2),VFR(6),o[1],0,0,0), C1,4); \
    GAPB(o[0]=__builtin_amdgcn_mfma_f32_32x32x16_bf16(PAF(3),VFR(3),o[0],0,0,0), C1,8); \
    GAPB(o[1]=__builtin_amdgcn_mfma_f32_32x32x16_bf16(PAF(3),VFR(7),o[1],0,0,0), C1,12); \
    }while(0)
  int t=1;
  #undef CMASK
  #define CMASK(P0,P1,t) do{}while(0)
  for(;t+7<NT;t+=2){
    STEP(pB0,pB1,pA0,pA1,t,true,true,true);     WAIT_BAR(2); RESC(); ROT();
    STEP(pA0,pA1,pB0,pB1,t+1,true,true,true);   WAIT_BAR(2); RESC(); ROT();
  }
  #undef CMASK
  #define CMASK(P0,P1,t) do{int jb_=(t)-(NT-4); if(jb_>=-2)bmask(P0,P1,jb_,qrel,hi,btab);}while(0)
  #define ENDW(tt) do{ if((tt)+3<NT){WAIT_BAR(2);} else if((tt)+2<NT){WAIT_BAR(1);} else {WAIT_BAR(0);} }while(0)
  for(;t+1<NT;t+=2){
    STEP(pB0,pB1,pA0,pA1,t,(t+3<NT),(t+1<NT),(t+1<NT));       ENDW(t);   RESC(); ROT();
    STEP(pA0,pA1,pB0,pB1,t+1,(t+4<NT),(t+2<NT),(t+2<NT));     ENDW(t+1); RESC(); ROT();
  }
  STEP(pB0,pB1,pA0,pA1,NT-1,false,false,false); RESC();
  { float sacc=pB0[0]+pB0[1]; _Pragma("unroll") for(int r=2;r<16;++r)sacc+=pB0[r]; _Pragma("unroll") for(int r=0;r<16;++r)sacc+=pB1[r]; l_reg+=sacc;
    pw0=(u32x4){PKW(pB0,0),PKW(pB0,2),PKW(pB0,4),PKW(pB0,6)};pw1=(u32x4){PKW(pB0,8),PKW(pB0,10),PKW(pB0,12),PKW(pB0,14)};pw2=(u32x4){PKW(pB1,0),PKW(pB1,2),PKW(pB1,4),PKW(pB1,6)};pw3=(u32x4){PKW(pB1,8),PKW(pB1,10),PKW(pB1,12),PKW(pB1,14)};
    SBAR(); pv(o,vb0+sl_cur,PAF(0),PAF(1),PAF(2),PAF(3)); }
  #undef PKW
  #undef PAF
  #undef VFR
  #undef PIN
  #undef MX3
  #undef GAPA
  #undef GAPB
  #undef EX
  #undef VRD
  #undef KRD
  #undef STEP
  #undef ENDW
  {auto rr=__builtin_amdgcn_permlane32_swap(__float_as_uint(l_reg),__float_as_uint(l_reg),false,false);l_reg=__uint_as_float(rr[0])+__uint_as_float(rr[1]);}
  if(hi==0)wsf[32+r32]=l_reg;asm volatile("s_waitcnt lgkmcnt(0)":::"memory");
  float rli[16];
  #pragma unroll
  for(int r=0;r<16;++r)rli[r]=__builtin_amdgcn_rcpf(wsf[32+crow(r,hi)]);
  bf16*Ow=O+(rowbase+q0+wid*QBLK)*OPITCH+OCOL0+hv*D;
  { bf16*stg=(bf16*)(shm+LDS_OST)+wid*2048; bf16*stga=(bf16*)(shm+LDS_OSTA)+wid*2048;
    #pragma unroll
    for(int r=0;r<16;++r){const int orow=crow(r,hi);
      #pragma unroll
      for(int d0=0;d0<2;++d0){const int ix=orow*64+d0*32+r32; const float ov=o[d0][r]*rli[r]; if(pass==0)stga[ix]=__float2bfloat16(ov); else stg[ix]=__float2bfloat16(__bfloat162float(stga[ix])-lam*ov);}}
    asm volatile("s_waitcnt lgkmcnt(0)":::"memory");
    #pragma unroll
    for(int i=0;i<4;++i){const int row=i*8+(lane>>3),ch=lane&7; if(pass!=0){const u32x4 v=*(const u32x4*)(stg+row*64+ch*8); ATTN_STORE16(Ow+(long)row*OPITCH+ch*8,v);}} }
  asm volatile("s_waitcnt lgkmcnt(0)\n\ts_barrier":::"memory");
  #undef DMA_K
  #undef DMA_V
  #undef CMASK
  #undef START
  #undef RESC
  #undef ROT
}
constexpr int ATTN_LDS_BYTES=LDS_BYTES;
struct AttnTensors { const bf16* Q; const bf16* K; const bf16* V; bf16* O; float lam; const float* relb; };
struct AttnUnit { int bh; int qb; };
struct StaticOrder {
  int vcu;
  __device__ __forceinline__ explicit StaticOrder(int grid,int block):vcu((block%8)*(grid/8)+block/8){}
  __device__ __forceinline__ bool next(int i,AttnUnit&u)const{ if(i>=4)return false; const int s=vcu&7; u.bh=vcu>>3; u.qb=(i==0)?s:(i==1)?15-s:(i==2)?16+s:31-s; return true; }
  __device__ __forceinline__ void a_ready(const AttnUnit&)const{}
  __device__ __forceinline__ void done(const AttnUnit&)const{}
};
template<class Sched,int THRL=8> __device__ __forceinline__ void attn_phase(char*lds,const AttnTensors&T,const Sched&S){
  AttnUnit u;
  for(int i=0;S.next(i,u);++i){ S.a_ready(u); const int b_=u.bh/NHEAD,hp_=u.bh%NHEAD; float*bt_=(float*)(lds+LDS_BTAB);
    for(int t_=threadIdx.x;t_<BT_N;t_+=NW*64){ const int rel=t_-256; float v_=0.f;
      if(rel>=0&&rel<113){ int bk=rel; if(rel>=16){ bk=16+(int)(logf((float)rel*(1.0f/16.0f))/logf(8.0f)*16.0f); bk=bk>31?31:bk; } v_=(T.relb[bk*8+(hp_>>1)]-T.relb[31*8+(hp_>>1)])*1.4426950408889634f; }
      bt_[t_]=v_; }
    asm volatile("s_waitcnt lgkmcnt(0)\n\ts_barrier":::"memory");
    for(int pass=0;pass<2;++pass) attn_unit<THRL>(b_,(hp_&~1)+pass,hp_,u.qb,pass,T.lam,bt_,T.Q,T.K,T.V,T.O,lds); S.done(u); }
}
#undef SBAR
#undef WAIT_BAR
}
namespace attn2 {
using attn_body::bf16; using attn_body::bf16x8; using attn_body::s16x4; using attn_body::f32x16; using attn_body::u32x4; using attn_body::lds_cptr;
using attn_body::glds16; using attn_body::vtr; using attn_body::cvtpk_s; using attn_body::crow; using attn_body::BT_N;
constexpr int SEQ=8192,DM=1024,NW=8,QBLK=32,QB=256;
constexpr int KSLOT=8192,VSLOT=8192,NS=4,NSV=5;
constexpr int L_K=0,L_V=NS*KSLOT,L_WS=L_V+NSV*VSLOT,L_OST=0,L_BTAB=L_WS+NW*256,L_TOTAL=L_BTAB+BT_N*4;
static_assert(NW*8192<=L_WS,"O stage inside the ring region");
constexpr int OP=2048,OC0=1024;
#define SBAR() __builtin_amdgcn_sched_barrier(0)
#define WAIT_BAR(N) asm volatile("s_waitcnt vmcnt(" #N ") lgkmcnt(0)\n\ts_barrier":::"memory")
#define A2LAS __attribute__((address_space(3)))
__device__ __forceinline__ void bmask1(f32x16&p,int jb,int qrel,int hi,const float*bt){
  const float NEG=-INFINITY; const int brel=qrel-32*jb-4*hi; const float*bp=bt+(brel+256);
  #pragma unroll
  for(int r=0;r<16;++r){const int c0=(r&3)+8*(r>>2); const float b0=bp[-c0]; p[r]=(brel<c0)?NEG:p[r]+b0; if((r&3)==3)SBAR();}
}
__device__ __forceinline__ float rowmax1(const f32x16&p){
  #define MX3(a,b,c) __builtin_fmaxf(__builtin_fmaxf((a),(b)),(c))
  float a=MX3(p[0],p[1],p[2]),b=MX3(p[3],p[4],p[5]); a=MX3(a,p[6],p[7]); b=MX3(b,p[8],p[9]); a=MX3(a,p[10],p[11]); b=MX3(b,p[12],p[13]); a=MX3(a,p[14],p[15]);
  float m=__builtin_fmaxf(a,b); auto rr=__builtin_amdgcn_permlane32_swap(__float_as_uint(m),__float_as_uint(m),false,false);
  return __builtin_fmaxf(__uint_as_float(rr[0]),__uint_as_float(rr[1]));
  #undef MX3
}
template<int THRL> __device__ __forceinline__ void unit2(int b,int h,int qb,int pass,float lam,float kmax2,float bmax,const float*subg,const float*btab,const bf16*Q,const bf16*__restrict__ K,const bf16*__restrict__ V,bf16*O,char*shm){
  const int tid=threadIdx.x,lane=tid&63,r32=lane&31,hi=lane>>5; const int wid=__builtin_amdgcn_readfirstlane(tid>>6);
  const long rowbase=(long)b*SEQ; const int q0=qb*QB; const int hq=2*h+pass;
  const bf16*Qw=Q+(rowbase+q0+wid*QBLK)*DM+hq*64;
  const bf16*Kh=K+rowbase*DM+hq*64,*Vh=V+rowbase*DM+h*128;
  const unsigned lds0=(unsigned)(uintptr_t)shm;
  float*wsf=(float*)(shm+L_WS)+wid*64;
  const bf16*ksrc=Kh+(long)lane*DM+wid*8;
  const bf16*vsrc=Vh+(long)(16*(wid&1)+(lane>>2))*DM+(wid>>1)*32+(lane&3)*8;
  const unsigned kdst=lds0+L_K+wid*1024, vdst=lds0+L_V+wid*1024;
  #define DMA_K(T,slot) glds16(ksrc+(long)(T)*64*DM,(unsigned)__builtin_amdgcn_readfirstlane(kdst+(slot)))
  #define DMA_V(u,slot) glds16(vsrc+(long)(u)*32*DM,(unsigned)__builtin_amdgcn_readfirstlane(vdst+(slot)))
  const lds_cptr shm3=(lds_cptr)shm; const lds_cptr kp0=shm3+L_K+hi*1024+r32*16;
  const lds_cptr vp0=shm3+L_V+((lane>>4)&1)*32+(lane&3)*8+(4*hi+((lane&15)>>2))*64;
  const int NT2=(q0+QB)/32, NT=NT2/2;
  DMA_K(0,0);DMA_V(0,0);DMA_K(1,KSLOT);
  bf16x8 qr[4];
  #pragma unroll
  for(int d0=0;d0<4;++d0)qr[d0]=*reinterpret_cast<const bf16x8*>(&Qw[(long)r32*DM+d0*16+hi*8]);
  float l_reg=0.f;f32x16 o[4];o[0]=f32x16{};o[1]=f32x16{};o[2]=f32x16{};o[3]=f32x16{};
  f32x16 negm;
  { float q2=0.f;
    #pragma unroll
    for(int d0=0;d0<4;++d0)
      #pragma unroll
      for(int j=0;j<8;++j){ const float qv=__uint_as_float((unsigned)(unsigned short)qr[d0][j]<<16); q2+=qv*qv; }
    auto rr=__builtin_amdgcn_permlane32_swap(__float_as_uint(q2),__float_as_uint(q2),false,false); q2=__uint_as_float(rr[0])+__uint_as_float(rr[1]);
    const float mref=__builtin_sqrtf(q2*kmax2)*1.01f+bmax+0.0078125f;
    #pragma unroll
    for(int r=0;r<16;++r)negm[r]=-mref;
    asm volatile("":"+v"(negm)); }
  const int qrel=wid*QBLK+r32;
  f32x16 pA,pB; bf16x8 kf[4]; s16x4 vlo[8],vhi[8]; u32x4 pw0,pw1;
  int sv_prev=0,sv_cur=VSLOT,sv_n1=2*VSLOT,sv_n2=3*VSLOT,sv_sp=4*VSLOT;
  int sk_cur=0,sk_next=KSLOT,sk_nn=2*KSLOT,sk_sp=3*KSLOT;
  #define ROTV() do{const int t_=sv_prev;sv_prev=sv_cur;sv_cur=sv_n1;sv_n1=sv_n2;sv_n2=sv_sp;sv_sp=t_;}while(0)
  #define ROTK() do{const int t_=sk_cur;sk_cur=sk_next;sk_next=sk_nn;sk_nn=sk_sp;sk_sp=t_;}while(0)
  #define KLD(j,p) kf[j]=*(const A2LAS bf16x8*)((p)+(j)*2048)
  DMA_K(2,2*KSLOT);DMA_V(1,VSLOT);
  WAIT_BAR(4);
  { KLD(0,kp0);KLD(1,kp0);KLD(2,kp0);KLD(3,kp0);
    pA=__builtin_amdgcn_mfma_f32_32x32x16_bf16(kf[0],qr[0],negm,0,0,0); pA=__builtin_amdgcn_mfma_f32_32x32x16_bf16(kf[1],qr[1],pA,0,0,0);
    pA=__builtin_amdgcn_mfma_f32_32x32x16_bf16(kf[2],qr[2],pA,0,0,0); pA=__builtin_amdgcn_mfma_f32_32x32x16_bf16(kf[3],qr[3],pA,0,0,0);
    if(NT2==8)bmask1(pA,0,qrel,hi,btab);
    #pragma unroll
    for(int r=0;r<16;++r)pA[r]=__builtin_amdgcn_exp2f(pA[r]);
    KLD(0,kp0+512);KLD(1,kp0+512);KLD(2,kp0+512);KLD(3,kp0+512); }
  WAIT_BAR(0);
  #define PKW(P,B) cvtpk_s(P[B],P[B+1])
  #define PAF(k) __builtin_bit_cast(bf16x8,pw##k)
  #define VFR(i) (bf16x8){vlo[i][0],vlo[i][1],vlo[i][2],vlo[i][3],vhi[i][0],vhi[i][1],vhi[i][2],vhi[i][3]}
  #define PIN(x) asm volatile("":"+v"(x))
  #define MX3(a,b,c) __builtin_fmaxf(__builtin_fmaxf((a),(b)),(c))
  #define EX(v) __builtin_amdgcn_exp2f(v)
  #define GAPA(MF,A0,A1,A2,A3,W0,W1,PW) do{ MF; sacc+=A0; sacc+=A1; sacc+=A2; sacc+=A3; PIN(sacc); W0; W1; PIN(PW); SBAR(); }while(0)
  #define GAPB(MF,X,B) do{ MF; X[B]=EX(X[B]); X[B+1]=EX(X[B+1]); PIN(X); SBAR(); }while(0)
  #define VRD(i) do{ vlo[i]=vtr(vp_+(((i)>>1)*2048+((i)&1)*1024)); vhi[i]=vtr(vp_+(((i)>>1)*2048+((i)&1)*1024+512)); }while(0)
  #define KRD(G,j) do{ if(G){ KLD(j,kn_); SBAR(); } }while(0)
  #define MF32(a,b,c) __builtin_amdgcn_mfma_f32_32x32x16_bf16(a,b,c,0,0,0)
  #define SUB(C,P,u,ODD,GK,GV,GV2,GL,MASK,MIDW) do{ SBAR(); \
    const lds_cptr vp_=vp0+sv_prev; const lds_cptr kn_=kp0+((ODD)?sk_next:(sk_cur+512)); \
    VRD(0); SBAR(); float sacc=(P[0]+P[1]); \
    GAPA(C=MF32(kf[0],qr[0],negm), P[2],P[3],P[4],P[5],     pw0[0]=PKW(P,0), pw0[1]=PKW(P,2), pw0); \
    VRD(2); SBAR(); GAPA(C=MF32(kf[1],qr[1],C), P[6],P[7],P[8],P[9],     pw0[2]=PKW(P,4), pw0[3]=PKW(P,6), pw0); \
    VRD(1); SBAR(); GAPA(C=MF32(kf[2],qr[2],C), P[10],P[11],P[12],P[13], pw1[0]=PKW(P,8), pw1[1]=PKW(P,10), pw1); \
    VRD(3); SBAR(); GAPA(C=MF32(kf[3],qr[3],C), P[14],P[15],0.f,0.f,     pw1[2]=PKW(P,12),pw1[3]=PKW(P,14), pw1); \
    l_reg+=sacc; \
    if(ODD){ if(GV){DMA_V((u)+1,sv_n1);} if(GV2){DMA_V((u)+2,sv_n2);} if(GK){DMA_K(((u)>>1)+3,sk_sp);} } \
    if(MASK){ const int jb_=(u)-(NT2-8); if(jb_>=-4)bmask1(C,jb_,qrel,hi,btab); } \
    SBAR(); \
    if((MIDW)>=0 && wid>=4){ if((MIDW)==1){WAIT_BAR(1);}else{WAIT_BAR(0);} } \
    SBAR(); \
    VRD(4); SBAR(); GAPB(o[0]=MF32(PAF(0),VFR(0),o[0]), C,0); \
    VRD(6); SBAR(); GAPB(o[1]=MF32(PAF(0),VFR(2),o[1]), C,2); \
    VRD(5); SBAR(); GAPB(o[0]=MF32(PAF(1),VFR(1),o[0]), C,4); \
    VRD(7); SBAR(); GAPB(o[1]=MF32(PAF(1),VFR(3),o[1]), C,6); \
    KRD(GL,0); GAPB(o[2]=MF32(PAF(0),VFR(4),o[2]), C,8); \
    KRD(GL,1); GAPB(o[3]=MF32(PAF(0),VFR(6),o[3]), C,10); \
    KRD(GL,2); GAPB(o[2]=MF32(PAF(1),VFR(5),o[2]), C,12); \
    KRD(GL,3); GAPB(o[3]=MF32(PAF(1),VFR(7),o[3]), C,14); \
    }while(0)
  int u=1;
  for(;u+13<NT2;u+=2){
    SUB(pB,pA,u,true,true,true,true,true,false,-1); ROTV(); ROTK();
    SUB(pA,pB,u+1,false,false,false,false,true,false,1);   if(wid<4){WAIT_BAR(1);} ROTV();
  }
  for(;u+1<NT2;u+=2){
    const bool gk=((u>>1)+3<NT), gv2=(u+2<NT2);
    SUB(pB,pA,u,true,gk,true,gv2,true,true,-1); ROTV(); ROTK();
    { const int mw_=gk?1:0; SUB(pA,pB,u+1,false,false,false,false,gv2,true,mw_); if(wid<4){ if(gk){WAIT_BAR(1);}else{WAIT_BAR(0);} } } ROTV();
  }
  SUB(pB,pA,NT2-1,true,false,false,false,false,true,-1);
  { float sacc=pB[0]+pB[1];
    #pragma unroll
    for(int r=2;r<16;++r)sacc+=pB[r];
    l_reg+=sacc;
    pw0=(u32x4){PKW(pB,0),PKW(pB,2),PKW(pB,4),PKW(pB,6)};pw1=(u32x4){PKW(pB,8),PKW(pB,10),PKW(pB,12),PKW(pB,14)};
    SBAR(); const lds_cptr vp_=vp0+sv_cur;
    #pragma unroll
    for(int db=0;db<4;++db){ VRD(2*db); VRD(2*db+1); o[db]=MF32(PAF(0),VFR(2*db),o[db]); o[db]=MF32(PAF(1),VFR(2*db+1),o[db]); } }
  #undef PKW
  #undef PAF
  #undef VFR
  #undef PIN
  #undef MX3
  #undef EX
  #undef GAPA
  #undef GAPB
  #undef VRD
  #undef KRD
  #undef SUB
  asm volatile("s_waitcnt lgkmcnt(0)\n\ts_barrier":::"memory");
  {auto rr=__builtin_amdgcn_permlane32_swap(__float_as_uint(l_reg),__float_as_uint(l_reg),false,false);l_reg=__uint_as_float(rr[0])+__uint_as_float(rr[1]);}
  if(hi==0)wsf[32+r32]=l_reg;asm volatile("s_waitcnt lgkmcnt(0)":::"memory");
  float rli[16];
  #pragma unroll
  for(int r=0;r<16;++r)rli[r]=__builtin_amdgcn_rcpf(wsf[32+crow(r,hi)]);
  bf16*Ow=O+(rowbase+q0+wid*QBLK)*OP+OC0+h*128;
  { bf16*stg=(bf16*)(shm+L_OST)+wid*4096;
    #pragma unroll
    for(int r=0;r<16;++r){const int orow=crow(r,hi);
      #pragma unroll
      for(int db=0;db<4;++db)stg[orow*128+db*32+r32]=__float2bfloat16(o[db][r]*rli[r]);}
    asm volatile("s_waitcnt lgkmcnt(0)":::"memory");
    float sg[8];
    #pragma unroll
    for(int e=0;e<8;++e)sg[e]=subg[(lane&15)*8+e]*0.8f;
    #pragma unroll
    for(int i=0;i<8;++i){const int row=i*4+(lane>>4),ch=lane&15; u32x4 v=*(const u32x4*)(stg+row*128+ch*8); bf16*gp=Ow+(long)row*OP+ch*8;
      if(pass!=0){ const u32x4 a=*(const u32x4*)gp; u32x4 w; float d[8]; float ss=0.f;
        #pragma unroll
        for(int e=0;e<4;++e){ const float a0=__uint_as_float(a[e]<<16),a1=__uint_as_float(a[e]&0xffff0000u),b0=__uint_as_float(v[e]<<16),b1=__uint_as_float(v[e]&0xffff0000u); d[2*e]=a0-lam*b0; d[2*e+1]=a1-lam*b1; ss+=d[2*e]*d[2*e]+d[2*e+1]*d[2*e+1]; }
        ss+=__shfl_xor(ss,1); ss+=__shfl_xor(ss,2); ss+=__shfl_xor(ss,4); ss+=__shfl_xor(ss,8);
        const float rs=rsqrtf(ss*(1.f/128.f)+1e-6f);
        #pragma unroll
        for(int e=0;e<4;++e) w[e]=cvtpk_s(d[2*e]*rs*sg[2*e],d[2*e+1]*rs*sg[2*e+1]);
        v=w; }
      asm volatile("global_store_dwordx4 %0, %1, off sc1\n\ts_nop 1"::"v"(gp),"v"(v):"memory"); } }
  asm volatile("s_waitcnt lgkmcnt(0)\n\ts_barrier":::"memory");
  #undef DMA_K
  #undef DMA_V
  #undef ROTV
  #undef ROTK
  #undef KLD
  #undef MF32
}
struct Tensors { const bf16* Q; const bf16* K; const bf16* V; bf16* O; float lam; const float* relb; const float* subg; const float* kmax; };
template<int THRL=8> __device__ __forceinline__ void phase(char*lds,const Tensors&T,int grid,int block){
  const int vcu=(block%8)*(grid/8)+block/8;
  for(int i=0;i<2;++i){ const int bh=vcu>>4,s=vcu&15,qb=(i==0)?s:31-s,b_=bh>>3,h_=bh&7; float*bt_=(float*)(lds+L_BTAB);
    for(int t_=threadIdx.x;t_<BT_N;t_+=NW*64){ const int rel=t_-256; float v_=0.f;
      if(rel>=0&&rel<113){ int bk=rel; if(rel>=16){ bk=16+(int)(logf((float)rel*(1.0f/16.0f))/logf(8.0f)*16.0f); bk=bk>31?31:bk; } v_=(T.relb[bk*8+h_]-T.relb[31*8+h_])*1.4426950408889634f; }
      bt_[t_]=v_; }
    asm volatile("s_waitcnt lgkmcnt(0)\n\ts_barrier":::"memory");
    float bmax=0.f;
    for(int bk=0;bk<31;++bk)bmax=__builtin_fmaxf(bmax,(T.relb[bk*8+h_]-T.relb[31*8+h_])*1.4426950408889634f);
    for(int pass=0;pass<2;++pass){ const float*kp_=T.kmax+((bh*2+pass)*2); const float kmax2=__hip_atomic_load(kp_,__ATOMIC_RELAXED,__HIP_MEMORY_SCOPE_AGENT)+__hip_atomic_load(kp_+1,__ATOMIC_RELAXED,__HIP_MEMORY_SCOPE_AGENT);
      unit2<THRL>(b_,h_,qb,pass,T.lam,kmax2,bmax,T.subg,bt_,T.Q,T.K,T.V,T.O,lds); } }
}
#undef SBAR
#undef WAIT_BAR
#undef A2LAS
}
constexpr int NWAVES = 8;
constexpr int BATCH = 2, SEQ = 8192, DM = 1024, M = BATCH * SEQ;
constexpr int DFF = 2816, NGU = 2 * DFF;
constexpr int NQKV = 3072;
constexpr int NMIX = 2816;
constexpr int NIN = NQKV + NMIX;
constexpr int IN_WIDTH = 5648;
constexpr int KOUT = 2048;
constexpr int NMOD = 9 * DM;
constexpr int NCHUNK = SEQ / 128, NBC = BATCH * NCHUNK;
constexpr float EPS = 1e-6f;
constexpr float LAM_INIT = 0.2f;
constexpr float LOG2E = 1.4426950408889634f;

constexpr size_t MiB = 1u << 20;
constexpr size_t WS_CTL = 0, CTL_ZERO_BYTES = 64 * 1024;
constexpr size_t WS_MOD = 1 * MiB;
constexpr size_t WS_DTRAW = 2 * MiB;
constexpr size_t WS_DTS = 3 * MiB;
constexpr size_t WS_AC = 4 * MiB;
constexpr size_t WS_CDEC = 5 * MiB;
constexpr size_t WS_WA = 6 * MiB;
constexpr size_t WS_WB = 18 * MiB;
constexpr size_t WS_H = 24 * MiB;
constexpr size_t WS_U = 56 * MiB;
constexpr size_t WS_ACT = WS_U, WS_D = WS_U + 88 * MiB;
constexpr size_t WS_Q = WS_U, WS_K = WS_U + 32 * MiB, WS_V = WS_U + 64 * MiB;
constexpr size_t WS_YCAT = WS_U + 96 * MiB;
constexpr size_t WS_Z = WS_U, WS_XBC = WS_U + 32 * MiB;
constexpr size_t WS_BT = WS_U + 80 * MiB, WS_CM = WS_U + 88 * MiB;
constexpr size_t WS_XT = WS_U + 160 * MiB, WS_BM = WS_U + 192 * MiB;
constexpr size_t WS_ST = WS_H;
constexpr size_t WS_D2 = WS_U;
constexpr size_t WS_X2 = WS_U + 152 * MiB;
constexpr size_t WS_END = 256 * MiB;
static_assert(WS_BM + 8 * MiB <= WS_END && WS_D + 64 * MiB <= WS_END && WS_YCAT + 64 * MiB <= WS_XT && WS_CM + 8 * MiB <= WS_YCAT && WS_XBC + 48 * MiB <= WS_BT, "d_ws map");

constexpr int RING_OFF = 0, RING_BYTES = 131072;
constexpr int LDSCTL_OFF = RING_BYTES, MISC_OFF = LDSCTL_OFF + 320;
constexpr int LDS_BYTES = 147456;
static_assert(attn_body::LDS_TOTAL <= RING_BYTES && attn2::L_TOTAL <= RING_BYTES, "attention scratch inside the ring region");

#define GAS __attribute__((address_space(1)))
#define LAS __attribute__((address_space(3)))
typedef unsigned short bf16;
typedef unsigned v4u __attribute__((ext_vector_type(4)));
typedef unsigned v2u __attribute__((ext_vector_type(2)));
typedef float f32x4 __attribute__((ext_vector_type(4)));
typedef float f32x16 __attribute__((ext_vector_type(16)));
typedef short bf16x8 __attribute__((ext_vector_type(8)));
typedef GAS unsigned gu32;
#define RLX_AGENT __ATOMIC_RELAXED, __HIP_MEMORY_SCOPE_AGENT
#define LDS_WAIT() asm volatile("s_waitcnt lgkmcnt(0)" ::: "memory")
#define VM_WAIT() asm volatile("s_waitcnt vmcnt(0)" ::: "memory")
__device__ __forceinline__ unsigned f2bf(float f) { unsigned u = __builtin_bit_cast(unsigned, f); return (u + 0x7fffu + ((u >> 16) & 1u)) >> 16; }
typedef float f32x2_p __attribute__((ext_vector_type(2))); typedef __bf16 bf16x2_p __attribute__((ext_vector_type(2)));
__device__ __forceinline__ unsigned pk2(float lo, float hi) { f32x2_p v = {lo, hi}; return __builtin_bit_cast(unsigned, __builtin_convertvector(v, bf16x2_p)); }
__device__ __forceinline__ void st16_wt(void* p, v4u v) { asm volatile("global_store_dwordx4 %0, %1, off sc1\n\ts_nop 1" :: "v"(p), "v"(v) : "memory"); }
__device__ __forceinline__ void st8_wt(void* p, v2u v) { asm volatile("global_store_dwordx2 %0, %1, off sc1\n\ts_nop 1" :: "v"(p), "v"(v) : "memory"); }
__device__ __forceinline__ void st4_wt(void* p, unsigned v) { asm volatile("global_store_dword %0, %1, off sc1\n\ts_nop 1" :: "v"(p), "v"(v) : "memory"); }
__device__ __forceinline__ float bf2f(unsigned short h) { return __builtin_bit_cast(float, (unsigned)h << 16); }
__device__ __forceinline__ float bflo(unsigned w) { return __builtin_bit_cast(float, w << 16); }
__device__ __forceinline__ float bfhi(unsigned w) { return __builtin_bit_cast(float, w & 0xffff0000u); }
__device__ __forceinline__ float silu(float v) { return v * __builtin_amdgcn_rcpf(1.0f + __expf(-v)); }
__device__ __forceinline__ int crow(int r, int hi) { return (r & 3) + 8 * (r >> 2) + 4 * hi; }
#define MFMA32(a, b, c) __builtin_amdgcn_mfma_f32_32x32x16_bf16(a, b, c, 0, 0, 0)

#define XB_TMO      128
#define XB_XCNT(j)  (256  + 64 * (j))
#define XB_XSUB(j)  (1280 + 64 * (j))
#define XB_XGEN(j)  (2304 + 64 * (j))
#define XB_TOP      3328
#define XB_TOPGEN   3392
#define XCD_BAR_WORDS 3456
#define XB_SPIN_CAP (1u << 18)
constexpr int CW_KMAX = 12288;
constexpr int CW_BAR = 4096;
static_assert((CW_BAR + XCD_BAR_WORDS) <= CW_KMAX && (CW_KMAX + 64) * 4 <= (int)CTL_ZERO_BYTES, "control words inside the memset region");
__device__ __forceinline__ unsigned xb_ld(unsigned* p)              { return __hip_atomic_load(p, __ATOMIC_RELAXED, __HIP_MEMORY_SCOPE_AGENT); }
__device__ __forceinline__ unsigned xb_add(unsigned* p, unsigned v) { return __hip_atomic_fetch_add(p, v, __ATOMIC_RELAXED, __HIP_MEMORY_SCOPE_AGENT); }
__device__ __forceinline__ unsigned xb_xcc_id() { return (unsigned)__builtin_amdgcn_s_getreg((3 << 11) | 20) & 0xFu; }
#define XB_SPIN(cond, bar) do { unsigned _sp = 0; while (cond) { __builtin_amdgcn_s_sleep(1); \
    if ((++_sp & 255u) == 0u) { if (xb_ld(&(bar)[XB_TMO])) break; if (_sp > XB_SPIN_CAP) { atomicAdd(&(bar)[XB_TMO], 1u); break; } } } } while (0)
struct XcdBarrier { unsigned* bar; unsigned x; volatile LAS unsigned* st; };
__device__ __forceinline__ XcdBarrier xcd_barrier_post(unsigned* bar, volatile LAS unsigned* st) {
    XcdBarrier b; b.bar = bar; b.x = xb_xcc_id(); b.st = st;
    if (threadIdx.x == 0) (void)xb_add(&bar[XB_XCNT(b.x)], 1u);
    return b;
}
__device__ __forceinline__ void xcd_barrier_complete(unsigned* bar, unsigned x, unsigned& nloc, unsigned& nx) {
    const unsigned G = gridDim.x * gridDim.y * gridDim.z;
    unsigned sum, cnt, mine, sp = 0u;
    for (;;) {
        sum = 0u; cnt = 0u; mine = 0u;
#pragma unroll
        for (unsigned j = 0; j < 16; ++j) { const unsigned c = xb_ld(&bar[XB_XCNT(j)]); sum += c; cnt += (c > 0u) ? 1u : 0u; mine = (j == x) ? c : mine; }
        if (sum == G) break;
        __builtin_amdgcn_s_sleep(1);
        if ((++sp & 255u) == 0u) { if (xb_ld(&bar[XB_TMO])) break; if (sp > XB_SPIN_CAP) { atomicAdd(&bar[XB_TMO], 1u); break; } }
    }
    nloc = mine > 0u ? mine : 1u; nx = cnt > 0u ? cnt : 1u;
}
__device__ __forceinline__ void xcd_barrier(const XcdBarrier& b) {
    asm volatile("s_waitcnt vmcnt(0)" ::: "memory");
    __syncthreads();
    if (threadIdx.x == 0) {
        unsigned* bar = b.bar;
        __builtin_amdgcn_s_waitcnt(0);
        unsigned nloc = b.st[0], nx = b.st[1];
        if (nloc == 0u) { xcd_barrier_complete(bar, b.x, nloc, nx); b.st[0] = nloc; b.st[1] = nx; }
        const unsigned old = xb_add(&bar[XB_XSUB(b.x)], 1u);
        const unsigned gen = old / nloc;
        if (old + 1u == (gen + 1u) * nloc) {
            __builtin_amdgcn_fence(__ATOMIC_RELEASE, "agent");
            asm volatile("s_waitcnt vmcnt(0)" ::: "memory");
            const unsigned og = xb_add(&bar[XB_TOP], 1u);
            const unsigned tg = og / nx;
            if (og + 1u == (tg + 1u) * nx) xb_add(&bar[XB_TOPGEN], 1u);
            else XB_SPIN(xb_ld(&bar[XB_TOPGEN]) == tg, bar);
            __builtin_amdgcn_fence(__ATOMIC_ACQUIRE, "agent");
            xb_add(&bar[XB_XGEN(b.x)], 1u);
            asm volatile("s_waitcnt vmcnt(0)" ::: "memory");
        } else {
            XB_SPIN(xb_ld(&bar[XB_XGEN(b.x)]) == gen, bar);
            __builtin_amdgcn_fence(__ATOMIC_ACQUIRE, "agent");
            asm volatile("s_waitcnt vmcnt(0)" ::: "memory");
        }
    }
    __syncthreads();
}

struct Frame {
    LAS unsigned char* lds;
    int tid, lane, wave;
    int vcu, G;
    int gw, NGW;
};
__device__ __forceinline__ float wave_sum(float v) {
#pragma unroll
    for (int o = 1; o < 64; o <<= 1) v += __shfl_xor(v, o);
    return v;
}
__device__ __forceinline__ void tr_item(const float* W, int N, int n0, int k0, bf16* WT, int K, int drow0, int nvalid, LAS float* scr, int lane) {
#pragma unroll 8
    for (int i = 0; i < 32; ++i) { const int kk = 2 * i + (lane >> 5); scr[kk * 33 + (lane & 31)] = __builtin_nontemporal_load(W + (size_t)(k0 + kk) * N + n0 + (lane & 31)); }
    LDS_WAIT(); asm volatile("" ::: "memory");
    const int c = lane & 7;
#pragma unroll
    for (int j = 0; j < 4; ++j) { const int n = (lane >> 3) + 8 * j; const LAS float* s = scr + (8 * c) * 33 + n;
        v4u o; o.x = pk2(s[0 * 33], s[1 * 33]); o.y = pk2(s[2 * 33], s[3 * 33]); o.z = pk2(s[4 * 33], s[5 * 33]); o.w = pk2(s[6 * 33], s[7 * 33]);
        if (n >= nvalid) o = (v4u){0u, 0u, 0u, 0u};
        st16_wt(WT + (size_t)(drow0 + n) * K + k0 + 8 * c, o); }
    LDS_WAIT(); asm volatile("" ::: "memory");
}
__device__ __forceinline__ void convert_gu_half(Frame& F, int w, int nw, const float* Wx, int up, bf16* WA) {
    LAS float* scr = (LAS float*)(F.lds + RING_OFF + F.wave * 16384);
    constexpr int NB = DFF / 32, I_G = (DM / 64) * NB;
    for (int r = w; r < I_G; r += nw) { const int kb = r / NB, nb = r % NB, n0 = 32 * nb;
        tr_item(Wx, DFF, n0, 64 * kb, WA, DM, (n0 >> 7) * 256 + (n0 & 127) + (up ? 128 : 0), 32, scr, F.lane); }
}
__device__ __forceinline__ void convert_down(Frame& F, int w, int nw, const float* Wd, bf16* WB) {
    LAS float* scr = (LAS float*)(F.lds + RING_OFF + F.wave * 16384);
    constexpr int I_D = (DFF / 64) * (DM / 32);
    for (int r = w; r < I_D; r += nw) { const int kb = r / (DM / 32), nb = r % (DM / 32); tr_item(Wd, DM, 32 * nb, 64 * kb, WB, DFF, 32 * nb, 32, scr, F.lane); }
}
__device__ __forceinline__ void convert_ffn(Frame& F, const float* Wg, const float* Wu, const float* Wd, bf16* WA, bf16* WB) {
    LAS float* scr = (LAS float*)(F.lds + RING_OFF + F.wave * 16384);
    constexpr int NB = DFF / 32, I_G = (DM / 64) * NB, I_D = (DFF / 64) * (DM / 32);
    for (int it = F.gw; it < 2 * I_G + I_D; it += F.NGW) {
        int r = it;
        if (r < 2 * I_G) { const int up = r >= I_G; if (up) r -= I_G; const int kb = r / NB, nb = r % NB, n0 = 32 * nb;
            tr_item(up ? Wu : Wg, DFF, n0, 64 * kb, WA, DM, (n0 >> 7) * 256 + (n0 & 127) + (up ? 128 : 0), 32, scr, F.lane); continue; }
        r -= 2 * I_G; { const int kb = r / (DM / 32), nb = r % (DM / 32); tr_item(Wd, DM, 32 * nb, 64 * kb, WB, DFF, 32 * nb, 32, scr, F.lane); }
    }
}
__device__ __forceinline__ void convert_mix(Frame& F, int w, int nw, const float* Win, const float* Wout, bf16* WA, bf16* WB) {
    LAS float* scr = (LAS float*)(F.lds + RING_OFF + F.wave * 16384);
    constexpr int NB_IN = 177, I_IN = (DM / 64) * NB_IN, I_OUT = (KOUT / 64) * (DM / 32);
    for (int it = w; it < I_IN + I_OUT; it += nw) {
        int r = it;
        if (r < I_IN) { const int kb = r / NB_IN; int nb = r % NB_IN; int src, dst, nv = 32;
            if (nb < 32) { src = 0 + 32 * nb; dst = 3072 + 32 * nb; }
            else if (nb < 80) { nb -= 32; src = 1024 + 32 * nb; dst = 4096 + 32 * nb; }
            else if (nb < 81) { src = 2560; dst = 5632; nv = 16; }
            else if (nb < 113) { nb -= 81; src = 2576 + 32 * nb; dst = 0 + 32 * nb; }
            else if (nb < 145) { nb -= 113; src = 3600 + 32 * nb; dst = 1024 + 32 * nb; }
            else { nb -= 145; src = 4624 + 32 * nb; dst = 2048 + 32 * nb; }
            tr_item(Win, IN_WIDTH, src, 64 * kb, WA, DM, dst, nv, scr, F.lane); continue; }
        r -= I_IN; { const int kb = r / (DM / 32), nb = r % (DM / 32); tr_item(Wout, DM, 32 * nb, 64 * kb, WB, KOUT, 32 * nb, 32, scr, F.lane); }
    }
    { GAS v4u* z = (GAS v4u*)(WA + (size_t)5664 * DM); const int n16 = 224 * DM * 2 / 16;
      for (int i = w * 64 + F.lane; i < n16; i += nw * 64) z[i] = (v4u){0u, 0u, 0u, 0u}; }
}
__device__ __forceinline__ void mod_gemv(Frame& F, const float* c, const float* w_ada, const float* b_ada, float* mod) {
    LAS float* cs = (LAS float*)(F.lds + RING_OFF);
    LAS float* red = cs + 2048;
    __syncthreads();
    for (int i = F.tid; i < 2 * DM; i += NWAVES * 64) cs[i] = silu(c[i]);
    __syncthreads();
    for (int u = blockIdx.x; u < NMOD / 64; u += F.G) {
        const int col = 64 * u + F.lane; float a0 = 0.f, a1 = 0.f;
        const float* wp = w_ada + (size_t)(128 * F.wave) * NMOD + col;
#pragma unroll 16
        for (int k = 0; k < 128; ++k) { const float w = __builtin_nontemporal_load(wp + (size_t)k * NMOD); a0 += cs[128 * F.wave + k] * w; a1 += cs[DM + 128 * F.wave + k] * w; }
        red[(F.wave * 2 + 0) * 64 + F.lane] = a0; red[(F.wave * 2 + 1) * 64 + F.lane] = a1;
        __syncthreads();
        if (F.tid < 128) { const int b = F.tid >> 6, l = F.tid & 63; float s = b_ada[64 * u + l];
#pragma unroll
            for (int w = 0; w < 8; ++w) s += red[(w * 2 + b) * 64 + l];
            mod[b * NMOD + 64 * u + l] = s; }
        __syncthreads();
    }
}

struct Row16 { f32x4 v[4]; };
__device__ __forceinline__ Row16 ld_row(const float* p, int lane) { Row16 r; const GAS f32x4* q = (const GAS f32x4*)p + lane;
#pragma unroll
    for (int j = 0; j < 4; ++j) r.v[j] = q[64 * j];
    return r; }
__device__ __forceinline__ Row16 ld_row_bf(const bf16* p, int lane) { Row16 r; const GAS v2u* q = (const GAS v2u*)p + lane;
#pragma unroll
    for (int j = 0; j < 4; ++j) { const v2u w = q[64 * j]; r.v[j] = (f32x4){bflo(w.x), bfhi(w.x), bflo(w.y), bfhi(w.y)}; }
    return r; }
__device__ __forceinline__ float row_ssq_part(const Row16& r) { float s = 0.f;
#pragma unroll
    for (int j = 0; j < 4; ++j) s += (r.v[j].x * r.v[j].x + r.v[j].y * r.v[j].y) + (r.v[j].z * r.v[j].z + r.v[j].w * r.v[j].w);
    return s; }
__device__ __forceinline__ void st_row_bf(bf16* out, const Row16& h, int lane) { unsigned long long* o8 = (unsigned long long*)out + lane;
#pragma unroll
    for (int j = 0; j < 4; ++j) { v2u w; w.x = pk2(h.v[j].x, h.v[j].y); w.y = pk2(h.v[j].z, h.v[j].w); *(GAS v2u*)(o8 + 64 * j) = w; } }
constexpr int RW = 4;
__device__ __forceinline__ void rows_first(Frame& F, const float* x, const float* pre_g, const float* mod, int sidx, bf16* H) {
#pragma unroll 1
    for (int b = 0; b < BATCH; ++b) { const float* mb = mod + b * NMOD;
        Row16 A = ld_row(pre_g, F.lane); const Row16 SC = ld_row(mb + (sidx + 1) * DM, F.lane), S = ld_row(mb + sidx * DM, F.lane);
#pragma unroll
        for (int j = 0; j < 4; ++j) A.v[j] = A.v[j] * (SC.v[j] + 1.0f);
#pragma unroll 1
        for (int r = F.gw; r < SEQ; r += RW * F.NGW) { Row16 xr[RW]; size_t m[RW]; bool ok[RW];
#pragma unroll
            for (int q = 0; q < RW; ++q) { ok[q] = r + q * F.NGW < SEQ; m[q] = (size_t)b * SEQ + (ok[q] ? r + q * F.NGW : r); xr[q] = ld_row(x + m[q] * DM, F.lane); }
#pragma unroll
            for (int q = 0; q < RW; ++q) { const float rs = rsqrtf(wave_sum(row_ssq_part(xr[q])) * (1.f / DM) + EPS);
#pragma unroll
                for (int j = 0; j < 4; ++j) xr[q].v[j] = xr[q].v[j] * rs * A.v[j] + S.v[j];
                if (ok[q]) st_row_bf(H + m[q] * DM, xr[q], F.lane); } } }
}
template <bool NEXT, bool XIB, bool XOB> __device__ __forceinline__ void rows_res(Frame& F, const void* xin, const bf16* Dm, const float* post_g, const float* mod, int gidx, float gscale, void* xo,
                                                                                  const float* pre_g, int sidx, bf16* H) {
#pragma unroll 1
    for (int b = 0; b < BATCH; ++b) { const float* mb = mod + b * NMOD;
        Row16 PGT = ld_row(post_g, F.lane); { const Row16 GT = ld_row(mb + gidx * DM, F.lane);
#pragma unroll
            for (int j = 0; j < 4; ++j) PGT.v[j] = PGT.v[j] * GT.v[j] * gscale; }
        Row16 A, S;
        if (NEXT) { A = ld_row(pre_g, F.lane); const Row16 SC = ld_row(mb + (sidx + 1) * DM, F.lane); S = ld_row(mb + sidx * DM, F.lane);
#pragma unroll
            for (int j = 0; j < 4; ++j) A.v[j] = A.v[j] * (SC.v[j] + 1.0f); }
#pragma unroll 1
        for (int r = F.gw; r < SEQ; r += RW * F.NGW) { Row16 xr[RW], dr[RW]; size_t m[RW]; bool ok[RW];
#pragma unroll
            for (int q = 0; q < RW; ++q) { ok[q] = r + q * F.NGW < SEQ; m[q] = (size_t)b * SEQ + (ok[q] ? r + q * F.NGW : r);
                xr[q] = XIB ? ld_row_bf((const bf16*)xin + m[q] * DM, F.lane) : ld_row((const float*)xin + m[q] * DM, F.lane); dr[q] = ld_row_bf(Dm + m[q] * DM, F.lane); }
#pragma unroll
            for (int q = 0; q < RW; ++q) { const float qs = rsqrtf(wave_sum(row_ssq_part(dr[q])) * (1.f / DM) + EPS);
#pragma unroll
                for (int j = 0; j < 4; ++j) xr[q].v[j] = xr[q].v[j] + PGT.v[j] * (dr[q].v[j] * qs);
                if (ok[q]) { if (XOB) st_row_bf((bf16*)xo + m[q] * DM, xr[q], F.lane);
                    else { GAS f32x4* o = (GAS f32x4*)((float*)xo + m[q] * DM) + F.lane;
#pragma unroll
                        for (int j = 0; j < 4; ++j) o[64 * j] = xr[q].v[j]; } }
                if (NEXT) { const float rs = rsqrtf(wave_sum(row_ssq_part(xr[q])) * (1.f / DM) + EPS);
#pragma unroll
                    for (int j = 0; j < 4; ++j) xr[q].v[j] = xr[q].v[j] * rs * A.v[j] + S.v[j];
                    if (ok[q]) st_row_bf(H + m[q] * DM, xr[q], F.lane); } } } }
}
__device__ __forceinline__ float bf_elem(const v4u& w, int e) { const unsigned u = (e >> 1) == 0 ? w.x : (e >> 1) == 1 ? w.y : (e >> 1) == 2 ? w.z : w.w; return (e & 1) ? bfhi(u) : bflo(u); }
__device__ __forceinline__ void conv_item(int lane, int bc, int cg, const bf16* XBC, const float* conv_w, const float* conv_b, bf16* XT, bf16* Bm, bf16* BTm, bf16* Cm) {
    const int o = lane >> 2, q = lane & 3, c = bc % NCHUNK; const size_t t0 = (size_t)bc * 128;
    const int ch0 = cg * 32 + q * 8;
    v4u raw[11];
#pragma unroll
    for (int k = 0; k < 11; ++k) { const int row = 8 * o + k - 3; raw[k] = (v4u){0u, 0u, 0u, 0u};
        if (row >= 0 || c > 0) raw[k] = *(const GAS v4u*)(XBC + (size_t)((long)t0 + row) * 1536 + ch0); }
    float wk[4][8], cb[8];
#pragma unroll
    for (int k = 0; k < 4; ++k) { const f32x4 a = *(const GAS f32x4*)(conv_w + k * 1536 + ch0), b = *(const GAS f32x4*)(conv_w + k * 1536 + ch0 + 4);
#pragma unroll
        for (int e = 0; e < 4; ++e) { wk[k][e] = a[e]; wk[k][4 + e] = b[e]; } }
    { const f32x4 a = *(const GAS f32x4*)(conv_b + ch0), b = *(const GAS f32x4*)(conv_b + ch0 + 4);
#pragma unroll
      for (int e = 0; e < 4; ++e) { cb[e] = a[e]; cb[4 + e] = b[e]; } }
    float outv[8][8];
#pragma unroll
    for (int e = 0; e < 8; ++e) { float x[11];
#pragma unroll
        for (int k = 0; k < 11; ++k) x[k] = bf_elem(raw[k], e);
#pragma unroll
        for (int jj = 0; jj < 8; ++jj) outv[jj][e] = silu(cb[e] + wk[0][e] * x[jj] + wk[1][e] * x[jj + 1] + wk[2][e] * x[jj + 2] + wk[3][e] * x[jj + 3]); }
    if (cg < 40) {
        bf16* dst;
        if (cg < 32) dst = XT + (((size_t)bc * 16 + (cg >> 1)) * 64 + (cg & 1) * 32 + q * 8) * 128 + 8 * o;
        else { const int bb = cg - 32; dst = BTm + (((size_t)bc * 2 + (bb >> 2)) * 128 + (bb & 3) * 32 + q * 8) * 128 + 8 * o; }
#pragma unroll
        for (int e = 0; e < 8; ++e) { v4u w; w.x = pk2(outv[0][e], outv[1][e]); w.y = pk2(outv[2][e], outv[3][e]); w.z = pk2(outv[4][e], outv[5][e]); w.w = pk2(outv[6][e], outv[7][e]);
            st16_wt(dst + (size_t)e * 128, w); }
    }
    if (cg >= 32) {
        const int bb = (cg - 32) & 7; bf16* dst = (cg < 40 ? Bm : Cm) + (((size_t)bc * 2 + ((bb & 7) >> 2)) * 128 + 8 * o) * 128 + (bb & 3) * 32 + q * 8;
#pragma unroll
        for (int jj = 0; jj < 8; ++jj) { v4u w; w.x = pk2(outv[jj][0], outv[jj][1]); w.y = pk2(outv[jj][2], outv[jj][3]); w.z = pk2(outv[jj][4], outv[jj][5]); w.w = pk2(outv[jj][6], outv[jj][7]);
            st16_wt(dst + (size_t)jj * 128, w); }
    }
}
__device__ __forceinline__ void dt_item(int lane, int it, const float* dtraw, const float* dt_bias, const float* a_log, float* DTS, float* AC, float* CDEC) {
    const int bc = it >> 4, h = it & 15; const size_t t0 = (size_t)bc * 128;
    const float bias = dt_bias[h], a = -__expf(a_log[h]);
    const float x0 = dtraw[(t0 + 2 * lane) * 16 + h] + bias, x1 = dtraw[(t0 + 2 * lane + 1) * 16 + h] + bias;
    const float d0 = x0 > 20.f ? x0 : log1pf(__expf(x0)), d1 = x1 > 20.f ? x1 : log1pf(__expf(x1));
    float* dp = DTS + (size_t)it * 128 + 2 * lane; dp[0] = d0; dp[1] = d1;
    const float v0 = d0 * a, v1 = d1 * a, s = v0 + v1; float inc = s;
#pragma unroll
    for (int sh = 1; sh < 64; sh <<= 1) { const float t = __shfl_up(inc, sh); if (lane >= sh) inc += t; }
    const float ex = inc - s; float* acp = AC + (size_t)it * 128 + 2 * lane; acp[0] = ex + v0; acp[1] = ex + v0 + v1;
    if (lane == 63) CDEC[it] = __expf(inc);
}
__device__ __forceinline__ bf16x8 scale8(v4u w, const float* s) {
    v4u o; o.x = pk2(bflo(w.x) * s[0], bfhi(w.x) * s[1]); o.y = pk2(bflo(w.y) * s[2], bfhi(w.y) * s[3]); o.z = pk2(bflo(w.z) * s[4], bfhi(w.z) * s[5]); o.w = pk2(bflo(w.w) * s[6], bfhi(w.w) * s[7]);
    return __builtin_bit_cast(bf16x8, o); }
__device__ __forceinline__ void states_item(Frame& F, int it2, const bf16* XT, const bf16* BTm, const float* DTS, const float* AC, bf16* ST) {
    LAS float* wl = (LAS float*)(F.lds + RING_OFF + F.wave * 1024);
    { const int it = it2 >> 1, nh = it2 & 1, bc = it >> 4, h = it & 15, g = h >> 3;
        int lane_ = F.lane; asm volatile("" : "+v"(lane_));
        const int r32 = lane_ & 31, hi = lane_ >> 5;
        const bf16* xt = XT + (size_t)it * 64 * 128 + (size_t)r32 * 128 + 8 * hi; const bf16* bt = BTm + ((size_t)bc * 2 + g) * 128 * 128 + (size_t)(64 * nh + r32) * 128 + 8 * hi;
        { const float acl = AC[(size_t)it * 128 + 127]; const float2 d2 = *(const float2*)(DTS + (size_t)it * 128 + 2 * lane_), a2 = *(const float2*)(AC + (size_t)it * 128 + 2 * lane_);
          wl[2 * lane_] = d2.x * __expf(acl - a2.x); wl[2 * lane_ + 1] = d2.y * __expf(acl - a2.y); }
        f32x16 acc[2][2];
#pragma unroll
        for (int a = 0; a < 2; ++a) { acc[a][0] = f32x16{}; acc[a][1] = f32x16{}; }
#pragma unroll 1
        for (int kh = 0; kh < 2; ++kh) { v4u xa[4][2], ba[4][2];
#pragma unroll
            for (int ks = 0; ks < 4; ++ks)
#pragma unroll
                for (int b2 = 0; b2 < 2; ++b2) { xa[ks][b2] = *(const GAS v4u*)(xt + (size_t)(32 * b2) * 128 + 16 * (4 * kh + ks)); ba[ks][b2] = *(const GAS v4u*)(bt + (size_t)(32 * b2) * 128 + 16 * (4 * kh + ks)); }
#pragma unroll
            for (int ks = 0; ks < 4; ++ks) { float wv[8];
                { const f32x4 w0 = *(const LAS f32x4*)(wl + 16 * (4 * kh + ks) + 8 * hi), w1 = *(const LAS f32x4*)(wl + 16 * (4 * kh + ks) + 8 * hi + 4);
#pragma unroll
                  for (int e = 0; e < 4; ++e) { wv[e] = w0[e]; wv[4 + e] = w1[e]; } }
                bf16x8 xf[2];
#pragma unroll
                for (int pb = 0; pb < 2; ++pb) xf[pb] = scale8(xa[ks][pb], wv);
#pragma unroll
                for (int nb = 0; nb < 2; ++nb) { const bf16x8 bfv = __builtin_bit_cast(bf16x8, ba[ks][nb]);
#pragma unroll
                    for (int pb = 0; pb < 2; ++pb) acc[nb][pb] = MFMA32(bfv, xf[pb], acc[nb][pb]); } } }
        bf16* st = ST + (size_t)it * 64 * 128 + 64 * nh;
#pragma unroll
        for (int nb = 0; nb < 2; ++nb)
#pragma unroll
            for (int pb = 0; pb < 2; ++pb)
#pragma unroll
                for (int g4 = 0; g4 < 4; ++g4) { v2u w; w.x = pk2(acc[nb][pb][4 * g4], acc[nb][pb][4 * g4 + 1]); w.y = pk2(acc[nb][pb][4 * g4 + 2], acc[nb][pb][4 * g4 + 3]);
                    *(GAS v2u*)(st + (size_t)(32 * pb + r32) * 128 + 32 * nb + 8 * g4 + 4 * hi) = w; }
    }
}
__device__ __forceinline__ void ssd_conv_states(Frame& F, const bf16* XBC, const float* dtraw, const float* conv_w, const float* conv_b, const float* dt_bias, const float* a_log,
                                                bf16* XT, bf16* Bm, bf16* BTm, bf16* Cm, float* DTS, float* AC, float* CDEC, bf16* ST) {
    for (int pr = blockIdx.x; pr < NBC * 2; pr += F.G) { const int bc = pr >> 1, hh = pr & 1;
#pragma unroll 1
        for (int k = F.wave; k < 32; k += NWAVES) {
            if (k < 16) conv_item(F.lane, bc, 16 * hh + k, XBC, conv_w, conv_b, XT, Bm, BTm, Cm);
            else if (k < 20) conv_item(F.lane, bc, 32 + 4 * hh + (k - 16), XBC, conv_w, conv_b, XT, Bm, BTm, Cm);
            else if (k < 24) conv_item(F.lane, bc, 40 + 4 * hh + (k - 20), XBC, conv_w, conv_b, XT, Bm, BTm, Cm);
            else dt_item(F.lane, bc * 16 + 8 * hh + (k - 24), dtraw, dt_bias, a_log, DTS, AC, CDEC); }
        asm volatile("s_waitcnt vmcnt(0)" ::: "memory");
        if (F.tid == 0) { __builtin_amdgcn_fence(__ATOMIC_ACQUIRE, "agent"); asm volatile("s_waitcnt vmcnt(0)" ::: "memory"); }
        __syncthreads();
#pragma unroll 1
        for (int k = F.wave; k < 16; k += NWAVES) states_item(F, ((bc * 16 + 8 * hh + (k >> 1)) << 1) | (k & 1), XT, BTm, DTS, AC, ST);
        __syncthreads();
    }
}
__device__ __forceinline__ void ssd_scan(Frame& F, bf16* ST, const float* CDEC) {
    constexpr int PER_B = 16 * 64 * 128 / 2;
    for (int T = blockIdx.x * (NWAVES * 64) + F.tid; T < BATCH * PER_B; T += F.G * NWAVES * 64) { const int b = T / PER_B, e = T % PER_B, h = e / (64 * 128 / 2);
        GAS unsigned* p = (GAS unsigned*)ST + (size_t)b * NCHUNK * PER_B + e; unsigned v[NCHUNK];
#pragma unroll
        for (int c = 0; c < NCHUNK; ++c) v[c] = p[(size_t)c * PER_B];
        float r0 = 0.f, r1 = 0.f;
#pragma unroll
        for (int c = 0; c < NCHUNK; ++c) { const float dec = CDEC[(b * NCHUNK + c) * 16 + h]; p[(size_t)c * PER_B] = pk2(r0, r1); r0 = r0 * dec + bflo(v[c]); r1 = r1 * dec + bfhi(v[c]); }
    }
}
template <int PM  > __device__ __forceinline__ void ssd_out(Frame& F, const bf16* XT, const bf16* Bm, const bf16* Cm, const bf16* ST, const float* DTS, const float* AC, const bf16* Z,
                                        const float* d_skip, const float* norm_g, bf16* YCAT) {
    constexpr int CP = 136;
    LAS bf16* CmS = (LAS bf16*)(F.lds + RING_OFF);
    LAS bf16* BmS = CmS + 128 * CP;
    LAS float* CBs = (LAS float*)(BmS);
    LAS float* acl = (LAS float*)(F.lds + RING_OFF + 34816 + 67584);
    LAS float* dtl = acl + 8 * 128;
    LAS float* red = dtl + 8 * 128;
    LAS float* rsd = red + 8 * 128;
    for (int it = blockIdx.x; it < NBC * 2; it += F.G) {
        int lane_ = F.lane; asm volatile("" : "+v"(lane_));
        const int r32 = lane_ & 31, hi = lane_ >> 5, w = F.wave;
        const int bc = it >> 1, g = it & 1, h = 8 * g + w; const size_t t0 = (size_t)bc * 128;
        __syncthreads();
        { const GAS v4u* cg_ = (const GAS v4u*)(Cm + (size_t)it * 128 * 128); const GAS v4u* bg_ = (const GAS v4u*)(Bm + (size_t)it * 128 * 128);
#pragma unroll
          for (int q = 0; q < 4; ++q) { const int idx = F.tid + 512 * q, row = idx >> 4, c16 = idx & 15;
              const v4u cv = cg_[idx], bv = bg_[idx];
              *(LAS v4u*)(CmS + row * CP + c16 * 8) = cv; *(LAS v4u*)(BmS + row * CP + c16 * 8) = bv; }
          for (int i = F.tid; i < 1024; i += NWAVES * 64) { acl[i] = AC[((size_t)bc * 16 + 8 * g) * 128 + i] * LOG2E; dtl[i] = DTS[((size_t)bc * 16 + 8 * g) * 128 + i]; } }
        __syncthreads();
        { f32x16 cbt[2];
#pragma unroll
          for (int tt = 0; tt < 2; ++tt) { const int ib = (2 * w + tt) >> 2, jb = (2 * w + tt) & 3; cbt[tt] = f32x16{};
            if (jb <= ib) {
#pragma unroll
                for (int ks = 0; ks < 8; ++ks) { const int n0 = 16 * ks + 8 * hi;
                    const bf16x8 a = *(const LAS bf16x8*)(CmS + (32 * ib + r32) * CP + n0), b = *(const LAS bf16x8*)(BmS + (32 * jb + r32) * CP + n0);
                    cbt[tt] = MFMA32(a, b, cbt[tt]); } } }
          __syncthreads();
#pragma unroll
          for (int tt = 0; tt < 2; ++tt) { const int ib = (2 * w + tt) >> 2, jb = (2 * w + tt) & 3;
            if (jb <= ib) {
#pragma unroll
                for (int r = 0; r < 16; ++r) CBs[(32 * ib + crow(r, hi)) * 132 + 32 * jb + r32] = cbt[tt][r]; } } }
        __syncthreads();
        const LAS float* ach = acl + w * 128; const LAS float* dth = dtl + w * 128;
        const float dsk = d_skip[h];
        if (PM == 1) continue;
        const int prm = (r32 & 3) + 4 * ((r32 >> 3) & 1) + 8 * ((r32 >> 2) & 1) + 16 * (r32 >> 4);
        const bf16* xt = XT + ((size_t)bc * 16 + h) * 64 * 128 + (size_t)prm * 128 + 8 * hi; const bf16* hin = ST + ((size_t)bc * 16 + h) * 64 * 128 + (size_t)prm * 128 + 8 * hi;
        v4u hf[8][2], xf[8][2];
#pragma unroll
        for (int ks = 0; ks < 8; ++ks)
#pragma unroll
            for (int pb = 0; pb < 2; ++pb) { hf[ks][pb] = *(const GAS v4u*)(hin + (size_t)(32 * pb) * 128 + 16 * ks); xf[ks][pb] = *(const GAS v4u*)(xt + (size_t)(32 * pb) * 128 + 16 * ks); }
#pragma unroll 1
        for (int ib = 0; ib < 4; ++ib) { const int i = 32 * ib + r32; const float aci = ach[i];
            int hj = 8 * hi; asm volatile("" : "+v"(hj));
            const bf16* zp = Z + (t0 + i) * 1024 + h * 64 + 8 * hi; v4u zq[2][2];
#pragma unroll
            for (int pb = 0; pb < 2; ++pb)
#pragma unroll
                for (int g2 = 0; g2 < 2; ++g2) zq[pb][g2] = *(const GAS v4u*)(zp + 32 * pb + 16 * g2);
            f32x16 acc0 = f32x16{}, acc1 = f32x16{};
            { const float ei = __builtin_amdgcn_exp2f(aci); float es[8];
#pragma unroll
              for (int e = 0; e < 8; ++e) es[e] = ei;
#pragma unroll
              for (int ks = 0; ks < 8; ++ks) { const bf16x8 bfv = scale8(*(const LAS v4u*)(CmS + i * CP + 16 * ks + hj), es);
                acc0 = MFMA32(__builtin_bit_cast(bf16x8, hf[ks][0]), bfv, acc0); acc1 = MFMA32(__builtin_bit_cast(bf16x8, hf[ks][1]), bfv, acc1); } }
#pragma unroll
            for (int ks = 0; ks < 8; ++ks) if (ks < 2 * ib + 2) { const int j0 = 16 * ks + hj; float m[8];
                { const f32x4 c0 = *(const LAS f32x4*)(CBs + i * 132 + j0), c1 = *(const LAS f32x4*)(CBs + i * 132 + j0 + 4);
                  const f32x4 a0 = *(const LAS f32x4*)(ach + j0), a1 = *(const LAS f32x4*)(ach + j0 + 4), d0 = *(const LAS f32x4*)(dth + j0), d1 = *(const LAS f32x4*)(dth + j0 + 4);
#pragma unroll
                  for (int e = 0; e < 4; ++e) { m[e] = c0[e] * __builtin_amdgcn_exp2f(aci - a0[e]) * d0[e]; m[4 + e] = c1[e] * __builtin_amdgcn_exp2f(aci - a1[e]) * d1[e]; }
                  if (ks >= 2 * ib) {
#pragma unroll
                      for (int e = 0; e < 8; ++e) { m[e] = (j0 + e <= i) ? m[e] : 0.f; if (j0 + e == i) m[e] += dsk; } } }
                v4u pw; pw.x = pk2(m[0], m[1]); pw.y = pk2(m[2], m[3]); pw.z = pk2(m[4], m[5]); pw.w = pk2(m[6], m[7]);
                const bf16x8 mf = __builtin_bit_cast(bf16x8, pw);
                acc0 = MFMA32(__builtin_bit_cast(bf16x8, xf[ks][0]), mf, acc0); acc1 = MFMA32(__builtin_bit_cast(bf16x8, xf[ks][1]), mf, acc1); }
            float ss = 0.f;
#pragma unroll
            for (int pb = 0; pb < 2; ++pb)
#pragma unroll
                for (int g2 = 0; g2 < 2; ++g2) { const v4u z = zq[pb][g2]; const float zv[8] = {bflo(z.x), bfhi(z.x), bflo(z.y), bfhi(z.y), bflo(z.z), bfhi(z.z), bflo(z.w), bfhi(z.w)};
#pragma unroll
                    for (int e = 0; e < 8; ++e) { const float y = (pb ? acc1[8 * g2 + e] : acc0[8 * g2 + e]) * silu(zv[e]); ss += y * y; if (pb) acc1[8 * g2 + e] = y; else acc0[8 * g2 + e] = y; } }
            ss += __shfl_xor(ss, 32);
            if (PM == 2) { asm volatile("" :: "v"(ss)); continue; }
            if (hi == 0) red[w * 32 + r32] = ss;
            __syncthreads();
            if (F.tid < 32) { float s = 0.f;
#pragma unroll
                for (int ww = 0; ww < 8; ++ww) s += red[ww * 32 + F.tid];
                rsd[F.tid] = rsqrtf(s * (1.f / 512.f) + EPS); }
            __syncthreads();
            const float rs = rsd[r32]; const float* gp = norm_g + h * 64 + 8 * hi; bf16* yp = YCAT + (t0 + i) * 2048 + h * 64 + 8 * hi;
#pragma unroll
            for (int pb = 0; pb < 2; ++pb)
#pragma unroll
                for (int g2 = 0; g2 < 2; ++g2) { const f32x4 g0 = *(const GAS f32x4*)(gp + 32 * pb + 16 * g2), g1 = *(const GAS f32x4*)(gp + 32 * pb + 16 * g2 + 4); float y[8];
#pragma unroll
                    for (int e = 0; e < 8; ++e) y[e] = (pb ? acc1[8 * g2 + e] : acc0[8 * g2 + e]) * rs;
                    v4u o; o.x = pk2(y[0] * g0[0], y[1] * g0[1]); o.y = pk2(y[2] * g0[2], y[3] * g0[3]); o.z = pk2(y[4] * g1[0], y[5] * g1[1]); o.w = pk2(y[6] * g1[2], y[7] * g1[3]);
                    st16_wt(yp + 32 * pb + 16 * g2, o); }
        }
    }
}
__device__ __forceinline__ void subln_row(const v4u a, const v4u b, const float* gq, GAS v4u* p) {
    float v[16] = {bflo(a.x), bfhi(a.x), bflo(a.y), bfhi(a.y), bflo(a.z), bfhi(a.z), bflo(a.w), bfhi(a.w), bflo(b.x), bfhi(b.x), bflo(b.y), bfhi(b.y), bflo(b.z), bfhi(b.z), bflo(b.w), bfhi(b.w)};
    float s = 0.f;
#pragma unroll
    for (int e = 0; e < 16; ++e) s += v[e] * v[e];
    s += __shfl_xor(s, 1); s += __shfl_xor(s, 2); s += __shfl_xor(s, 4);
    const float rs = rsqrtf(s * (1.f / 128.f) + EPS);
#pragma unroll
    for (int e = 0; e < 16; ++e) v[e] *= rs * gq[e];
    v4u oa, ob; oa.x = pk2(v[0], v[1]); oa.y = pk2(v[2], v[3]); oa.z = pk2(v[4], v[5]); oa.w = pk2(v[6], v[7]); ob.x = pk2(v[8], v[9]); ob.y = pk2(v[10], v[11]); ob.z = pk2(v[12], v[13]); ob.w = pk2(v[14], v[15]);
    p[0] = oa; p[1] = ob; }
__device__ __forceinline__ void attn_subln(Frame& F, bf16* YCAT, const float* subln_g) {
    const int d0 = (F.lane & 7) * 16; float gq[16];
#pragma unroll
    for (int e = 0; e < 16; ++e) gq[e] = subln_g[d0 + e] * (1.0f - LAM_INIT);
#pragma unroll 1
    for (int m = F.gw; m < M; m += 2 * F.NGW) { const bool two = m + F.NGW < M; const int m1 = two ? m + F.NGW : m;
        GAS v4u* p0 = (GAS v4u*)(YCAT + (size_t)m * 2048 + 1024 + F.lane * 16); GAS v4u* p1 = (GAS v4u*)(YCAT + (size_t)m1 * 2048 + 1024 + F.lane * 16);
        const v4u a0 = p0[0], b0 = p0[1], a1 = p1[0], b1 = p1[1];
        subln_row(a0, b0, gq, p0); if (two) subln_row(a1, b1, gq, p1); }
}
#ifndef MK_PER_PHASE
#define MK_PER_PHASE 0
#endif
#ifndef MK_CG_SYNC
#define MK_CG_SYNC 0
#endif
constexpr int N_PHASES = 17;
#ifndef ATTN_FORM
#define ATTN_FORM 2
#endif
#ifndef PROBE_SSD_MODE
#define PROBE_SSD_MODE 0
#endif
#ifndef PROBE_EXTRA_BARS
#define PROBE_EXTRA_BARS 0
#endif
#ifndef PROBE_DUP
#define PROBE_DUP 0
#endif
struct Args { const float* in[30]; float* out; unsigned char* ws; int ph_lo, ph_hi; };
enum InIdx { I_X = 0, I_C, I_WADA, I_BADA, I_F1PRE, I_F1POST, I_F1WG, I_F1WU, I_F1WD, I_MPRE, I_MPOST, I_WIN, I_CONVW, I_CONVB, I_DTB, I_ALOG, I_DSKIP, I_SSDG,
             I_LQ1, I_LK1, I_LQ2, I_LK2, I_SUBLN, I_WOUT, I_F2PRE, I_F2POST, I_F2WG, I_F2WU, I_F2WD, I_RELB };

__global__ void __launch_bounds__(NWAVES * 64, 2) layer_fwd(Args args) {
    extern __shared__ __attribute__((aligned(16))) unsigned char lds[];
    Frame F;
    F.lds = (LAS unsigned char*)lds;
    F.tid = threadIdx.x; F.lane = F.tid & 63; F.wave = __builtin_amdgcn_readfirstlane(F.tid >> 6);
    F.G = gridDim.x; { const int bx = blockIdx.x; F.vcu = (F.G % 8 == 0) ? (bx % 8) * (F.G / 8) + bx / 8 : bx; }
    F.gw = F.vcu * NWAVES + F.wave; F.NGW = F.G * NWAVES;
    unsigned char* ws = args.ws;
#define MOD ((float*)(ws + WS_MOD))
#define DTRAW ((float*)(ws + WS_DTRAW))
#define DTS ((float*)(ws + WS_DTS))
#define ACm ((float*)(ws + WS_AC))
#define CDEC ((float*)(ws + WS_CDEC))
#define WA ((bf16*)(ws + WS_WA))
#define WB ((bf16*)(ws + WS_WB))
#define H ((bf16*)(ws + WS_H))
#define ACT ((bf16*)(ws + WS_ACT))
#define Dm ((bf16*)(ws + WS_D))
#define Qb ((bf16*)(ws + WS_Q))
#define Kb ((bf16*)(ws + WS_K))
#define Vb ((bf16*)(ws + WS_V))
#define YCAT ((bf16*)(ws + WS_YCAT))
#define Zb ((bf16*)(ws + WS_Z))
#define XBC ((bf16*)(ws + WS_XBC))
#define XT ((bf16*)(ws + WS_XT))
#define Bm ((bf16*)(ws + WS_BM))
#define BTm ((bf16*)(ws + WS_BT))
#define Cm ((bf16*)(ws + WS_CM))
#define ST ((bf16*)(ws + WS_ST))
#define D2 ((bf16*)(ws + WS_D2))
#define WC_IN ((bf16*)((unsigned char*)out + 32 * MiB))
#define WC_OUT ((bf16*)((unsigned char*)out + 32 * MiB) + (size_t)NIN * DM)
#define WC_GU2 (WC_OUT + (size_t)DM * KOUT)
#define WC_D2 (WC_GU2 + (size_t)NGU * DM)
#define X1B ((bf16*)out)
#define X2B ((bf16*)(ws + WS_X2))
    float* out = args.out;
#if MK_CG_SYNC
    cg::grid_group grid = cg::this_grid();
#define GRID_BAR() grid.sync()
#else
    for (int u = F.tid; u < (LDS_BYTES - LDSCTL_OFF) / 4; u += NWAVES * 64) ((LAS unsigned*)(F.lds + LDSCTL_OFF))[u] = 0u;
    __syncthreads();
    XcdBarrier bar = xcd_barrier_post((unsigned*)(ws + WS_CTL) + CW_BAR, (volatile LAS unsigned*)(F.lds + MISC_OFF) + 8);
#define GRID_BAR() xcd_barrier(bar)
#endif
    const int lo = args.ph_lo, hi = args.ph_hi;
#ifndef PH_MASK
#define PH_MASK 0x1FFFF
#endif
#define IN(k) (((PH_MASK >> (k)) & 1) && lo <= (k) && (k) < hi)
#define SEAM(k) do { if (IN(k) && IN((k) + 1)) GRID_BAR(); } while (0)
#define PHASE(k, ...) if (IN(k)) { const bool second_ = false; (void)second_; __VA_ARGS__ } if (((PROBE_DUP >> (k)) & 1) && IN(k)) { const bool second_ = true; (void)second_; GRID_BAR(); __VA_ARGS__ }

    PHASE(0,
        { convert_ffn(F, args.in[I_F1WG], args.in[I_F1WU], args.in[I_F1WD], WA, WB); mod_gemv(F, args.in[I_C], args.in[I_WADA], args.in[I_BADA], MOD); }
    )
    SEAM(0);
    PHASE(1,
        rows_first(F, args.in[I_X], args.in[I_F1PRE], MOD, 0, H);
    )
    SEAM(1);
    PHASE(2,
        { pg8::Gemm g{H, WA, M, NGU, DM}; pg8::StaticOrder S; S.init(M, NGU, F.G, (int)blockIdx.x); pg8::EpiSwiglu E{ACT, DFF};
        pg8::gemm_phase<pg8::EpiSwiglu, pg8::StaticOrder, true, true>(F.lds + RING_OFF, g, S, E);
        }
    )
    SEAM(2);
    PHASE(3,
        { pg8::Gemm g{ACT, WB, M, DM, DFF}; pg8::StaticOrder S; S.init(M, DM, F.G, (int)blockIdx.x); pg8::EpiBf16<0> E{Dm, DM, nullptr, 0, 0, 1.f};
        pg8::gemm_phase<pg8::EpiBf16<0>, pg8::StaticOrder, true, true>(F.lds + RING_OFF, g, S, E); }
    )
    SEAM(3);
    PHASE(4,
        { rows_res<true, false, true>(F, args.in[I_X], Dm, args.in[I_F1POST], MOD, 2, 0.5f, X1B, args.in[I_MPRE], 3, H); convert_mix(F, F.gw, F.NGW, args.in[I_WIN], args.in[I_WOUT], WC_IN, WC_OUT); }
    )
    SEAM(4);
    PHASE(5,
        { pg8::Gemm g{H, WC_IN, M, NQKV, DM}; pg8::StaticOrder S; S.init(M, NQKV, F.G, (int)blockIdx.x);
        pg8::EpiQKV E{Qb, DM, (size_t)(WS_K - WS_Q) / 2, attn_body::C2, (unsigned*)(ws + WS_CTL) + CW_KMAX};
        pg8::gemm_phase<pg8::EpiQKV, pg8::StaticOrder, true, true>(F.lds + RING_OFF, g, S, E); }
    )
    SEAM(5);
    PHASE(6,
        float lam;
        { const float q1 = args.in[I_LQ1][F.lane] * args.in[I_LK1][F.lane], q2 = args.in[I_LQ2][F.lane] * args.in[I_LK2][F.lane];
          lam = __expf(wave_sum(q1)) - __expf(wave_sum(q2)) + LAM_INIT; lam = __builtin_bit_cast(float, __builtin_amdgcn_readfirstlane(__builtin_bit_cast(int, lam))); }
#if ATTN_FORM == 2
        const attn2::Tensors AT{(const attn_body::bf16*)Qb, (const attn_body::bf16*)Kb, (const attn_body::bf16*)Vb, (attn_body::bf16*)YCAT, lam, args.in[I_RELB], args.in[I_SUBLN], (const float*)((const unsigned*)(ws + WS_CTL) + CW_KMAX)};
        attn2::phase<8>((char*)lds + RING_OFF, AT, (int)F.G, (int)blockIdx.x);
#else
        const attn_body::AttnTensors AT{(const attn_body::bf16*)Qb, (const attn_body::bf16*)Kb, (const attn_body::bf16*)Vb, (attn_body::bf16*)YCAT, lam, args.in[I_RELB]};
        const attn_body::StaticOrder S((int)F.G, (int)blockIdx.x);
        attn_body::attn_phase<attn_body::StaticOrder>((char*)lds + RING_OFF, AT, S);
#endif
    )
    SEAM(6);
    PHASE(7,
        { pg8::Gemm g{H, WC_IN + (size_t)NQKV * DM, M, NMIX, DM}; pg8::StaticOrder S; S.init(M, NMIX, F.G, (int)blockIdx.x); pg8::EpiMix E{Zb, XBC, DTRAW};
        pg8::gemm_phase<pg8::EpiMix, pg8::StaticOrder, true, true>(F.lds + RING_OFF, g, S, E);
        if (!second_ && F.G == 256 && blockIdx.x >= 192) convert_gu_half(F, ((int)blockIdx.x - 192) * NWAVES + F.wave, 64 * NWAVES, args.in[I_F2WG], 0, WC_GU2); }
    )
    SEAM(7);
    PHASE(8,
        ssd_conv_states(F, XBC, DTRAW, args.in[I_CONVW], args.in[I_CONVB], args.in[I_DTB], args.in[I_ALOG], XT, Bm, BTm, Cm, DTS, ACm, CDEC, ST);
    )
    SEAM(9);
    PHASE(10,
        ssd_scan(F, ST, CDEC);
    )
    SEAM(10);
    PHASE(11,
        { if (!second_) { ssd_out<0>(F, XT, Bm, Cm, ST, DTS, ACm, Zb, args.in[I_DSKIP], args.in[I_SSDG], YCAT); if (ATTN_FORM != 2) attn_subln(F, YCAT, args.in[I_SUBLN]); }
          else ssd_out<PROBE_SSD_MODE>(F, XT, Bm, Cm, ST, DTS, ACm, Zb, args.in[I_DSKIP], args.in[I_SSDG], YCAT); }
    )
    SEAM(11);
    PHASE(12,
        { pg8::Gemm g{YCAT, WC_OUT, M, DM, KOUT}; pg8::StaticOrder S; S.init(M, DM, F.G, (int)blockIdx.x); pg8::EpiBf16<0> E{D2, DM, nullptr, 0, 0, 1.f};
        pg8::gemm_phase<pg8::EpiBf16<0>, pg8::StaticOrder, true, true>(F.lds + RING_OFF, g, S, E); }
    )
    SEAM(12);
    PHASE(13,
        { rows_res<true, true, true>(F, X1B, D2, args.in[I_MPOST], MOD, 5, 1.0f, X2B, args.in[I_F2PRE], 6, H); convert_gu_half(F, F.gw, F.NGW, args.in[I_F2WU], 1, WC_GU2);
          if (F.G != 256) { convert_gu_half(F, F.gw, F.NGW, args.in[I_F2WG], 0, WC_GU2); convert_down(F, F.gw, F.NGW, args.in[I_F2WD], WC_D2); } }
    )
    SEAM(13);
    PHASE(14,
        { pg8::Gemm g{H, WC_GU2, M, NGU, DM}; pg8::StaticOrder S; S.init(M, NGU, F.G, (int)blockIdx.x); pg8::EpiSwiglu E{ACT, DFF};
        pg8::gemm_phase<pg8::EpiSwiglu, pg8::StaticOrder, true, true>(F.lds + RING_OFF, g, S, E);
        if (!second_ && F.G == 256 && blockIdx.x >= 128) convert_down(F, ((int)blockIdx.x - 128) * NWAVES + F.wave, 128 * NWAVES, args.in[I_F2WD], WC_D2); }
    )
    SEAM(14);
    PHASE(15,
        { pg8::Gemm g{ACT, WC_D2, M, DM, DFF}; pg8::StaticOrder S; S.init(M, DM, F.G, (int)blockIdx.x); pg8::EpiBf16<0> E{Dm, DM, nullptr, 0, 0, 1.f};
        pg8::gemm_phase<pg8::EpiBf16<0>, pg8::StaticOrder, true, true>(F.lds + RING_OFF, g, S, E); }
    )
    SEAM(15);
    PHASE(16,
        rows_res<false, true, false>(F, X2B, Dm, args.in[I_F2POST], MOD, 8, 0.5f, out, nullptr, 0, nullptr);
    )
#if PROBE_EXTRA_BARS
    for (int q_ = 0; q_ < PROBE_EXTRA_BARS; ++q_) GRID_BAR();
#endif
#undef IN
#undef SEAM
}

extern "C" void kernel_launch(void* const* d_in, const int* in_sizes, int n_in, void* d_out, int out_size, void* d_ws, size_t ws_size, hipStream_t stream) {
    static int grid = 0;
    if (grid == 0) {
        if (n_in != 30 || in_sizes[0] != M * DM || out_size != M * DM || ws_size < WS_END) { fprintf(stderr, "kernel_launch: unexpected shapes (n_in %d, in0 %d, out %d, ws %zu); nothing launched\n", n_in, n_in > 0 ? in_sizes[0] : -1, out_size, ws_size); grid = -1; return; }
        int dev = 0, cus = 0, per_cu = 0;
        if (hipGetDevice(&dev) != hipSuccess || hipDeviceGetAttribute(&cus, hipDeviceAttributeMultiprocessorCount, dev) != hipSuccess) { grid = -1; return; }
        if (hipFuncSetAttribute((const void*)layer_fwd, hipFuncAttributeMaxDynamicSharedMemorySize, LDS_BYTES) != hipSuccess) { fprintf(stderr, "kernel_launch: hipFuncSetAttribute failed\n"); grid = -1; return; }
        if (hipOccupancyMaxActiveBlocksPerMultiprocessor(&per_cu, (const void*)layer_fwd, NWAVES * 64, LDS_BYTES) != hipSuccess || per_cu < 1) { fprintf(stderr, "kernel_launch: occupancy query says %d blocks per CU\n", per_cu); per_cu = 1; }
        (void)hipGetLastError();
        grid = cus;
        if (grid % 8 != 0 || grid > 256) fprintf(stderr, "kernel_launch: note: %d CUs\n", grid);
    }
    if (grid < 0) return;
    (void)hipMemsetAsync((char*)d_ws + WS_CTL, 0, CTL_ZERO_BYTES, stream);
    Args a{};
    for (int i = 0; i < 30; ++i) a.in[i] = (const float*)d_in[i];
    a.out = (float*)d_out; a.ws = (unsigned char*)d_ws;
#if MK_PER_PHASE
    for (int p = 0; p < N_PHASES; ++p) { a.ph_lo = p; a.ph_hi = p + 1; void* kargs[] = {&a};
        hipError_t e = hipLaunchCooperativeKernel((const void*)layer_fwd, dim3(grid), dim3(NWAVES * 64), kargs, LDS_BYTES, stream);
        if (e != hipSuccess) { fprintf(stderr, "kernel_launch: phase %d launch failed: %s\n", p, hipGetErrorString(e)); break; } }
#else
    a.ph_lo = 0; a.ph_hi = N_PHASES; void* kargs[] = {&a};
    hipError_t e = hipLaunchCooperativeKernel((const void*)layer_fwd, dim3(grid), dim3(NWAVES * 64), kargs, LDS_BYTES, stream);
    if (e != hipSuccess) fprintf(stderr, "kernel_launch: cooperative launch failed: %s (grid %d)\n", hipGetErrorString(e), grid);
#endif
}
```
